# Optimizing an MI355X kernel written in HIP

```python
import math
import jax, jax.numpy as jnp
from jax import lax
import numpy as np

D_MODEL = 1024
BATCH = 8
SEQ = 4096
DEPTH = 4

N_MIXERS = 3
REL_BUCKETS = 32
REL_EXACT = REL_BUCKETS // 2
REL_MAX_DIST = 128
ATTN_HEADS = 16
HEAD_DIM = D_MODEL // ATTN_HEADS
NSA_KV_HEADS = 4
NSA_QPG = ATTN_HEADS // NSA_KV_HEADS
CMP_STRIDE = 16
CMP_LEN = 2 * CMP_STRIDE
CMP_HIDDEN = 2 * HEAD_DIM
SEL_BLOCK = 64
SEL_COUNT = 16
NSA_WINDOW = 512
NSA_QBLOCK = 64
NSA_IN = ATTN_HEADS * HEAD_DIM + 6 * NSA_KV_HEADS * HEAD_DIM + 3 * ATTN_HEADS
HGRN_HEADS = 8
HGRN_KDIM = D_MODEL // HGRN_HEADS
HGRN_VDIM = D_MODEL // HGRN_HEADS
HGRN_CHUNK = 64
SWA_KV_HEADS = 2
SWA_QPG = ATTN_HEADS // SWA_KV_HEADS
SWA_WINDOW = 128
SWA_BLOCK = SWA_WINDOW
SWA_IN = ATTN_HEADS * HEAD_DIM + 2 * SWA_KV_HEADS * HEAD_DIM
D_FF = 2816
LN_EPS = 1e-5
RMS_EPS = 1e-6
NEG_INF = -1e30
N_NSA = len(range(0, DEPTH, N_MIXERS))
N_HGRN = len(range(1, DEPTH, N_MIXERS))
N_SWA = len(range(2, DEPTH, N_MIXERS))

kernel_name = 'hybrid_nsa_hgrn2_swa_macaron_deepnorm'

F32 = jnp.float32


def _layer_norm(x, g, b):
    xf = x.astype(F32)
    mu = jnp.mean(xf, axis=-1, keepdims=True)
    xc = xf - mu
    var = jnp.mean(xc * xc, axis=-1, keepdims=True)
    return (xc * lax.rsqrt(var + LN_EPS) * g.astype(F32) + b.astype(F32)).astype(x.dtype)


def _swiglu(x, w_gate, w_up, w_down):
    return (jax.nn.silu(x @ w_gate) * (x @ w_up)) @ w_down


def _t5_bucket(dist):
    n = jnp.maximum(dist, 0)
    nf = jnp.maximum(n, 1).astype(F32)
    large = REL_EXACT + (jnp.log(nf / REL_EXACT) / math.log(REL_MAX_DIST / REL_EXACT)
                         * (REL_BUCKETS - REL_EXACT)).astype(jnp.int32)
    return jnp.where(n < REL_EXACT, n, jnp.minimum(large, REL_BUCKETS - 1))


def _rel_bias(table, dist):
    return jnp.moveaxis(table[_t5_bucket(dist)], -1, 0).astype(F32)


def _masked_softmax(logits, valid):
    p = jax.nn.softmax(jnp.where(valid, logits.astype(F32), NEG_INF), axis=-1)
    return jnp.where(valid, p, 0.0)


def _lower_bounds(lb_param):
    sm = jax.nn.softmax(lb_param.astype(F32), axis=0)
    return jnp.cumsum(sm, axis=0) - sm[0]


def _nsa(x, w_in, w_out, cmp_pos, cmp_w1, cmp_w2, rel_bias):
    B, T, _ = x.shape
    dt = x.dtype
    G, Q, Dh = NSA_KV_HEADS, NSA_QPG, HEAD_DIM
    n_cmp = T // CMP_STRIDE - 1
    n_blk = T // SEL_BLOCK
    n_sel = min(SEL_COUNT, n_blk)
    n_qb = T // NSA_QBLOCK
    scale = Dh ** -0.5
    kvw = G * Dh
    h = x @ w_in
    sizes = [ATTN_HEADS * Dh] + [kvw] * 6
    q, k_c, v_c, k_s, v_s, k_w, v_w, gate = jnp.split(h, np.cumsum(sizes).tolist(), axis=-1)

    def heads(z):
        return z.reshape(B, T, G, Dh)

    def compress(z, pos, w1, w2):
        ch = heads(z).reshape(B, T // CMP_STRIDE, CMP_STRIDE, G, Dh)
        blk = jnp.concatenate([ch[:, :-1], ch[:, 1:]], axis=2) + pos[:, None, :]
        hid = jax.nn.gelu(jnp.einsum('bnlgd,lde->bnge', blk, w1))
        return jnp.einsum('bnge,ed->bgnd', hid, w2)

    kc = compress(k_c, cmp_pos[0], cmp_w1[0], cmp_w2[0])
    vc = compress(v_c, cmp_pos[1], cmp_w1[1], cmp_w2[1])
    cmp_end = CMP_STRIDE * jnp.arange(n_cmp, dtype=jnp.int32) + CMP_LEN - 1
    ci = np.arange(n_cmp)[:, None]
    bj = np.arange(n_blk)[None, :]
    overlap = jnp.asarray(((CMP_STRIDE * ci < SEL_BLOCK * (bj + 1)) &
                           (CMP_STRIDE * ci + CMP_LEN > SEL_BLOCK * bj)).astype(np.float32))

    def sel_blocks(z):
        return heads(z).reshape(B, n_blk, SEL_BLOCK, G, Dh).transpose(0, 3, 1, 2, 4)

    ks, vs = sel_blocks(k_s), sel_blocks(v_s)

    def win_keys(z):
        return jnp.pad(heads(z).transpose(0, 2, 1, 3), ((0, 0), (0, 0), (NSA_WINDOW, 0), (0, 0)))

    kw, vw = win_keys(k_w), win_keys(v_w)
    q_blocks = q.reshape(B, n_qb, NSA_QBLOCK, G, Q, Dh).transpose(1, 0, 3, 4, 2, 5)
    g_blocks = jax.nn.sigmoid(gate.astype(F32)).reshape(B, n_qb, NSA_QBLOCK, G, Q, 3).transpose(1, 0, 3, 4, 2, 5)
    bi = jnp.arange(B)[:, None, None, None]
    gi = jnp.arange(G)[None, :, None, None]
    tab_g = rel_bias.reshape(REL_BUCKETS, G, Q).transpose(1, 0, 2)
    blk_ids = jnp.arange(n_blk, dtype=jnp.int32)
    tok_in_blk = jnp.arange(SEL_BLOCK, dtype=jnp.int32)
    win_off = jnp.arange(NSA_WINDOW + NSA_QBLOCK, dtype=jnp.int32)

    def block(args):
        qb, gb, qi = args
        t = qi * NSA_QBLOCK + jnp.arange(NSA_QBLOCK, dtype=jnp.int32)
        d_c = t[:, None] - cmp_end[None, :]
        l_c = (jnp.einsum('bgqtd,bgnd->bgqtn', qb, kc).astype(F32) * scale
               + _rel_bias(rel_bias, d_c).reshape(G, Q, NSA_QBLOCK, n_cmp))
        p_c = _masked_softmax(l_c, d_c >= 0)
        o_c = jnp.einsum('bgqtn,bgnd->bgqtd', p_c.astype(dt), vc)
        imp = jnp.einsum('bgqtn,nj->bgtj', p_c, overlap)
        cur = (t // SEL_BLOCK)[:, None]
        forced = (blk_ids == 0) | (blk_ids == cur) | (blk_ids == cur - 1)
        imp = jnp.where(blk_ids > cur, -1e9, jnp.where(forced, 1e9, imp))
        _, idx = lax.top_k(imp, n_sel)
        k_g = ks[bi, gi, idx].reshape(B, G, NSA_QBLOCK, n_sel * SEL_BLOCK, Dh)
        v_g = vs[bi, gi, idx].reshape(B, G, NSA_QBLOCK, n_sel * SEL_BLOCK, Dh)
        pos = (idx[..., None] * SEL_BLOCK + tok_in_blk).reshape(B, G, NSA_QBLOCK, n_sel * SEL_BLOCK)
        d_s = t[:, None] - pos
        b_s = tab_g[gi, _t5_bucket(d_s)].transpose(0, 1, 4, 2, 3).astype(F32)
        l_s = jnp.einsum('bgqtd,bgtsd->bgqts', qb, k_g).astype(F32) * scale + b_s
        p_s = _masked_softmax(l_s, (d_s >= 0)[:, :, None])
        o_s = jnp.einsum('bgqts,bgtsd->bgqtd', p_s.astype(dt), v_g)
        start = qi * NSA_QBLOCK
        k_wb = lax.dynamic_slice_in_dim(kw, start, NSA_WINDOW + NSA_QBLOCK, axis=2)
        v_wb = lax.dynamic_slice_in_dim(vw, start, NSA_WINDOW + NSA_QBLOCK, axis=2)
        s_abs = start - NSA_WINDOW + win_off
        d_w = t[:, None] - s_abs[None, :]
        valid_w = (d_w >= 0) & (d_w < NSA_WINDOW) & (s_abs >= 0)[None, :]
        l_w = (jnp.einsum('bgqtd,bgsd->bgqts', qb, k_wb).astype(F32) * scale
               + _rel_bias(rel_bias, d_w).reshape(G, Q, NSA_QBLOCK, NSA_WINDOW + NSA_QBLOCK))
        p_w = _masked_softmax(l_w, valid_w)
        o_w = jnp.einsum('bgqts,bgsd->bgqtd', p_w.astype(dt), v_wb)
        return (gb[..., 0:1] * o_c + gb[..., 1:2] * o_s + gb[..., 2:3] * o_w).astype(dt)

    o = lax.map(block, (q_blocks, g_blocks, jnp.arange(n_qb, dtype=jnp.int32)))
    o = o.transpose(1, 0, 4, 2, 3, 5).reshape(B, T, D_MODEL)
    return o @ w_out


def _hgrn2(x, w_in, w_out, norm_gain, lb):
    B, T, _ = x.shape
    H, K, V, C = HGRN_HEADS, HGRN_KDIM, HGRN_VDIM, HGRN_CHUNK
    n_ch = T // C
    h = (x @ w_in).astype(F32)
    zq, zf, zi, zg = jnp.split(h, 4, axis=-1)
    lbf = lb.astype(F32)
    q = jax.nn.silu(zq)
    log_f = jnp.logaddexp(jnp.log(lbf), jnp.log1p(-lbf) + jax.nn.log_sigmoid(zf))
    k = (1.0 - lbf) * jax.nn.sigmoid(-zf)

    def chunks(z, d):
        return z.reshape(B, n_ch, C, H, d).transpose(1, 0, 3, 2, 4)

    causal = jnp.tril(jnp.ones((C, C), dtype=bool))[None, None, :, :, None]

    def step(S, inp):
        qc, kc, vc, gc = inp
        bcum = jnp.cumsum(gc, axis=2)
        o_inter = jnp.einsum('bhck,bhkv->bhcv', qc * jnp.exp(bcum), S)
        diff = jnp.where(causal, bcum[:, :, :, None, :] - bcum[:, :, None, :, :], -jnp.inf)
        a = jnp.einsum('bhtk,bhsk,bhtsk->bhts', qc, kc, jnp.exp(diff))
        o_intra = jnp.einsum('bhts,bhsv->bhtv', a, vc)
        b_last = bcum[:, :, -1]
        S_new = (jnp.exp(b_last)[..., None] * S
                 + jnp.einsum('bhsk,bhsv->bhkv', kc * jnp.exp(b_last[:, :, None] - bcum), vc))
        return S_new, o_inter + o_intra

    S0 = jnp.zeros((B, H, K, V), F32)
    _, o = lax.scan(step, S0, (chunks(q, K), chunks(k, K), chunks(zi, V), chunks(log_f, K)))
    o = o.transpose(1, 0, 3, 2, 4).reshape(B, T, H, V)
    o = o * lax.rsqrt(jnp.mean(o * o, axis=-1, keepdims=True) + RMS_EPS) * norm_gain.astype(F32)
    o = o * jax.nn.silu(zg.reshape(B, T, H, V))
    return o.reshape(B, T, D_MODEL).astype(x.dtype) @ w_out


def _swa(x, w_in, w_out, sinks, rel_bias):
    B, T, _ = x.shape
    nb = T // SWA_BLOCK
    Kv, Q, Dh, L = SWA_KV_HEADS, SWA_QPG, HEAD_DIM, SWA_BLOCK
    scale = Dh ** -0.5
    h = x @ w_in
    q, k, v = jnp.split(h, [ATTN_HEADS * Dh, ATTN_HEADS * Dh + Kv * Dh], axis=-1)
    q = q.reshape(B, nb, L, Kv, Q, Dh)

    def band(z):
        z = jnp.pad(z.reshape(B, T, Kv, Dh), ((0, 0), (L, 0), (0, 0), (0, 0))).reshape(B, nb + 1, L, Kv, Dh)
        return jnp.concatenate([z[:, :-1], z[:, 1:]], axis=2)

    kb, vb = band(k), band(v)
    tl = jnp.arange(L, dtype=jnp.int32)
    sl = jnp.arange(2 * L, dtype=jnp.int32)
    dist = tl[:, None] + L - sl[None, :]
    bias = _rel_bias(rel_bias, dist).reshape(Kv, Q, L, 2 * L)
    abs_s = jnp.arange(nb, dtype=jnp.int32)[:, None] * L - L + sl[None, :]
    valid = ((dist >= 0) & (dist < SWA_WINDOW))[None] & (abs_s >= 0)[:, None, :]
    logits = jnp.einsum('bntgqd,bnsgd->bngqts', q, kb).astype(F32) * scale + bias
    logits = jnp.where(valid[None, :, None, None], logits, NEG_INF)
    sink = sinks.astype(F32).reshape(Kv, Q)[None, None, :, :, None, None]
    m = jnp.maximum(jnp.max(logits, axis=-1, keepdims=True), sink)
    e = jnp.exp(logits - m)
    p = e / (jnp.sum(e, axis=-1, keepdims=True) + jnp.exp(sink - m))
    o = jnp.einsum('bngqts,bnsgd->bntgqd', p.astype(x.dtype), vb).reshape(B, T, D_MODEL)
    return o @ w_out


def setup_inputs(seed: int = 0) -> dict:
    key = jax.random.key(seed)
    ks = jax.random.split(key, 22)
    beta = (8.0 * DEPTH) ** -0.25
    D = D_MODEL

    def nrm(k, shape, scale):
        return jax.random.normal(k, shape, F32) * scale

    return {
        'x': nrm(ks[0], (BATCH, SEQ, D), 1.0),
        'rel_bias': nrm(ks[1], (REL_BUCKETS, ATTN_HEADS), 0.5),
        'ln_gain': 1.0 + nrm(ks[2], (DEPTH, 3, D), 0.02),
        'ln_bias': nrm(ks[3], (DEPTH, 3, D), 0.02),
        'ffn1_w_gate': nrm(ks[4], (DEPTH, D, D_FF), D ** -0.5),
        'ffn1_w_up': nrm(ks[5], (DEPTH, D, D_FF), D ** -0.5),
        'ffn1_w_down': nrm(ks[6], (DEPTH, D_FF, D), beta * D_FF ** -0.5),
        'ffn2_w_gate': nrm(ks[7], (DEPTH, D, D_FF), D ** -0.5),
        'ffn2_w_up': nrm(ks[8], (DEPTH, D, D_FF), D ** -0.5),
        'ffn2_w_down': nrm(ks[9], (DEPTH, D_FF, D), beta * D_FF ** -0.5),
        'nsa_w_in': nrm(ks[10], (N_NSA, D, NSA_IN), D ** -0.5),
        'nsa_w_out': nrm(ks[11], (N_NSA, D, D), beta * D ** -0.5),
        'nsa_cmp_pos': nrm(ks[12], (N_NSA, 2, CMP_LEN, HEAD_DIM), 0.1),
        'nsa_cmp_w1': nrm(ks[13], (N_NSA, 2, CMP_LEN, HEAD_DIM, CMP_HIDDEN), (CMP_LEN * HEAD_DIM) ** -0.5),
        'nsa_cmp_w2': nrm(ks[14], (N_NSA, 2, CMP_HIDDEN, HEAD_DIM), CMP_HIDDEN ** -0.5),
        'hgrn_w_in': nrm(ks[15], (N_HGRN, D, 4 * D), D ** -0.5),
        'hgrn_w_out': nrm(ks[16], (N_HGRN, D, D), beta * D ** -0.5),
        'hgrn_norm_gain': 1.0 + nrm(ks[17], (N_HGRN, HGRN_VDIM), 0.02),
        'hgrn_lb': nrm(ks[18], (DEPTH, D), 1.0),
        'swa_w_in': nrm(ks[19], (N_SWA, D, SWA_IN), D ** -0.5),
        'swa_w_out': nrm(ks[20], (N_SWA, D, D), beta * D ** -0.5),
        'swa_sinks': nrm(ks[21], (N_SWA, ATTN_HEADS), 0.5),
    }


def reference(x, rel_bias, ln_gain, ln_bias, ffn1_w_gate, ffn1_w_up, ffn1_w_down,
              ffn2_w_gate, ffn2_w_up, ffn2_w_down, nsa_w_in, nsa_w_out, nsa_cmp_pos,
              nsa_cmp_w1, nsa_cmp_w2, hgrn_w_in, hgrn_w_out, hgrn_norm_gain, hgrn_lb,
              swa_w_in, swa_w_out, swa_sinks):
    alpha = (2.0 * DEPTH) ** 0.25
    lbs = _lower_bounds(hgrn_lb)
    for i in range(DEPTH):
        x = _layer_norm(alpha * x + 0.5 * _swiglu(x, ffn1_w_gate[i], ffn1_w_up[i], ffn1_w_down[i]),
                        ln_gain[i, 0], ln_bias[i, 0])
        kind, slot = i % N_MIXERS, i // N_MIXERS
        if kind == 0:
            y = _nsa(x, nsa_w_in[slot], nsa_w_out[slot], nsa_cmp_pos[slot], nsa_cmp_w1[slot],
                     nsa_cmp_w2[slot], rel_bias)
        elif kind == 1:
            y = _hgrn2(x, hgrn_w_in[slot], hgrn_w_out[slot], hgrn_norm_gain[slot], lbs[i])
        else:
            y = _swa(x, swa_w_in[slot], swa_w_out[slot], swa_sinks[slot], rel_bias)
        x = _layer_norm(alpha * x + y, ln_gain[i, 1], ln_bias[i, 1])
        x = _layer_norm(alpha * x + 0.5 * _swiglu(x, ffn2_w_gate[i], ffn2_w_up[i], ffn2_w_down[i]),
                        ln_gain[i, 2], ln_bias[i, 2])
    return x
```

```cpp
#include <hip/hip_runtime.h>
#include <hip/hip_cooperative_groups.h>
#include <cstdio>
namespace cg = cooperative_groups;

typedef unsigned short bf16_t;
typedef short bf16x8 __attribute__((ext_vector_type(8)));
typedef short s16x4 __attribute__((ext_vector_type(4)));
typedef float f32x4 __attribute__((ext_vector_type(4)));
typedef float f32x16 __attribute__((ext_vector_type(16)));
typedef unsigned u32x2 __attribute__((ext_vector_type(2)));
typedef unsigned u32x4 __attribute__((ext_vector_type(4)));
#define LAS __attribute__((address_space(3)))
#define DI __device__ __forceinline__

constexpr int MTOK = 32768, DM = 1024, DFF = 2816, SEQ = 4096, NB = 8;
constexpr float ALPHA = 1.681792830507429f;
constexpr size_t MiB = 1ull << 20;
constexpr size_t W_GU1 = 0, W_D1 = 11534336, W_GU2 = 17301504, W_D2 = 28835840, W_IN = 34603008, W_OUT = 42991616,
                 W_W1T = 45088768, W_W2T = 46137344, W_C = 46170112;
constexpr size_t C_GU1 = W_C, C_GU2 = C_GU1 + 2 * 5632 * 4, C_IN = C_GU2 + 2 * 5632 * 4, C_POSB = C_IN + 2 * 4096 * 4,
                 C_LBV = C_POSB + 2 * 256 * 4, C_BTAB = C_LBV + 1024 * 4, C_END = C_BTAB + 16 * 132 * 4;
constexpr size_t WS_TB = 48 * MiB, WS_BIG = 112 * MiB, WS_O = 432 * MiB, WS_MISC = 496 * MiB;
constexpr size_t WS_STATS = WS_MISC, WS_SUMSQ = WS_STATS + 3 * MiB, WS_KC = WS_SUMSQ + 1 * MiB, WS_VC = WS_KC + 1 * MiB, WS_END = WS_VC + 1 * MiB;
static_assert(C_END <= 48 * MiB, "weights region");
constexpr int LDS_BYTES = 144 * 1024;

struct P {
  const float *x, *rel_bias, *ln_gain, *ln_bias, *f1g, *f1u, *f1d, *f2g, *f2u, *f2d, *nsa_win, *nsa_wout, *nsa_pos, *nsa_w1, *nsa_w2,
      *hg_win, *hg_wout, *hg_gain, *hg_lb, *swa_win, *swa_wout, *swa_sinks;
  float* out; unsigned char* ws;
};

DI unsigned pk2(float a, float b) { typedef __bf16 bf2 __attribute__((ext_vector_type(2))); bf2 v; v[0] = (__bf16)a; v[1] = (__bf16)b; return __builtin_bit_cast(unsigned, v); }
DI bf16_t f2bf(float a) { return __builtin_bit_cast(unsigned short, (__bf16)a); }
DI float bf2f(bf16_t v) { return __uint_as_float(((unsigned)v) << 16); }
DI float sigmoidf_(float v) { return 1.0f / (1.0f + __expf(-v)); }

namespace pg8 {
constexpr int BM = 256, BK = 64, HALF = 128, HTB = HALF * BK * 2, STAGE_BYTES = 8 * HTB, NXCD = 8, WGM = 8;
DI int lds_byte(int r, int c) { const int st = (r >> 4) * 2 + (c >> 5), rr = r & 15, cc = c & 31, ob = rr * 64 + cc * 2; return st * 1024 + (ob ^ (((ob >> 9) & 1) << 5)); }
DI void stage_rc(int b, int& R, int& C) { const int st = b / 1024, sb = b % 1024, swz = sb ^ (((sb >> 9) & 1) << 5); R = (st >> 1) * 16 + swz / 64; C = (st & 1) * 32 + (swz % 64) / 2; }
struct Unit { int pm, pn; };
struct Gemm { const bf16_t* A; const bf16_t* Bt; int M, N, K; };
struct StaticOrder {
  int nM, nN, nwg, G, c;
  DI void init(int M, int N, int G_, int c_) { nM = M / BM; nN = N / BM; nwg = nM * nN; G = G_; c = c_; }
  DI bool next(int i, Unit& u) const {
    const long L = (long)i * G + c; if (L >= nwg) return false;
    int wgid = (int)L; { const int q = nwg / NXCD, r = nwg % NXCD, xcd = wgid % NXCD, off = wgid / NXCD; wgid = (xcd < r ? xcd * (q + 1) : r * (q + 1) + (xcd - r) * q) + off; }
    const int nig = WGM * nN, gid = wgid / nig, fm = gid * WGM, gsz = (nM - fm) < WGM ? (nM - fm) : WGM;
    u.pm = fm + ((wgid % nig) % gsz); u.pn = (wgid % nig) / gsz; return true;
  }
};
template <class Epi>
DI void gemm_phase(LAS unsigned char* lds, const Gemm g, const StaticOrder& S, const Epi& E) {
  int tid_ = threadIdx.x; asm volatile("" : "+v"(tid_)); const int tid = tid_, wid = __builtin_amdgcn_readfirstlane(tid >> 6), lane = tid & 63, wr = wid >> 2, wc = wid & 3, fr = lane & 15, fq = lane >> 4;
  const int K = g.K, nt = K / BK;
  unsigned voffA[2];
#pragma unroll
  for (int i = 0; i < 2; ++i) { int R, C; stage_rc(tid * 16 + i * 8192, R, C); voffA[i] = (unsigned)(R * K + C) * 2u; }
  const size_t kstep = (size_t)(BK * 2), hstep = (size_t)HALF * K * 2, tstep = 2 * hstep;
  const unsigned ldsw = (unsigned)wid * 1024u;
  const int aoff = lds_byte(wr * 64 + fr, fq * 8), boff = lds_byte(wc * 32 + fr, fq * 8);
#define PG8_SA(b, h) (((b) * 2 + (h)) * HTB)
#define PG8_SB(b, h) ((4 + (b) * 2 + (h)) * HTB)
#define PG8_STAGE(bufoff, gbase, voff) do { _Pragma("unroll") for (int _i = 0; _i < 2; ++_i) \
    __builtin_amdgcn_global_load_lds((const unsigned*)((const char*)(gbase) + (voff)[_i]), (LAS unsigned*)(lds + (bufoff) + ldsw + _i * 8192), 16, 0, 0); } while (0)
#define PG8_LDA(dst, b, h) do { _Pragma("unroll") for (int m = 0; m < 4; ++m) _Pragma("unroll") for (int k = 0; k < 2; ++k) dst[m][k] = *(const LAS bf16x8*)(lds + PG8_SA(b, h) + aoff + m * 2048 + k * 1024); } while (0)
#define PG8_LDB(dst, b, h) do { _Pragma("unroll") for (int n = 0; n < 2; ++n) _Pragma("unroll") for (int k = 0; k < 2; ++k) dst[n][k] = *(const LAS bf16x8*)(lds + PG8_SB(b, h) + boff + n * 2048 + k * 1024); } while (0)
#define PG8_MMA(ai, bj, At, Bt) do { __builtin_amdgcn_s_setprio(1); _Pragma("unroll") for (int m = 0; m < 4; ++m) _Pragma("unroll") for (int n = 0; n < 2; ++n) _Pragma("unroll") for (int k = 0; k < 2; ++k) \
    acc[ai][bj][m][n] = __builtin_amdgcn_mfma_f32_16x16x32_bf16(Bt[n][k], At[m][k], acc[ai][bj][m][n], 0, 0, 0); __builtin_amdgcn_s_setprio(0); } while (0)
#define PG8_WAIT_V(n) asm volatile("s_waitcnt vmcnt(" #n ")" ::: "memory")
#define PG8_WAIT_L(n) asm volatile("s_waitcnt lgkmcnt(" #n ")" ::: "memory")
#define PG8_BAR __builtin_amdgcn_s_barrier()
#define PG8_SCHED __builtin_amdgcn_sched_barrier(0)
  Unit cur, nxt; int ui = 0;
  if (!S.next(0, cur)) return;
  f32x4 acc[2][2][4][2];
#pragma unroll
  for (int a = 0; a < 2; ++a)
#pragma unroll
    for (int b = 0; b < 2; ++b)
#pragma unroll
      for (int m = 0; m < 4; ++m)
#pragma unroll
        for (int n = 0; n < 2; ++n) acc[a][b][m][n] = (f32x4){0.f, 0.f, 0.f, 0.f};
  bf16x8 At[4][2], B0[2][2], B1[2][2];
  const char* cA = (const char*)g.A + (size_t)cur.pm * tstep; const char* cB = (const char*)g.Bt + (size_t)cur.pn * tstep;
  PG8_STAGE(PG8_SB(0, 0), cB, voffA); PG8_STAGE(PG8_SA(0, 0), cA, voffA); PG8_STAGE(PG8_SB(0, 1), cB + hstep, voffA); PG8_STAGE(PG8_SA(0, 1), cA + hstep, voffA);
  if (wr == 1) PG8_BAR;
  PG8_WAIT_V(4); PG8_BAR;
  PG8_STAGE(PG8_SB(1, 0), cB + kstep, voffA); PG8_STAGE(PG8_SA(1, 0), cA + kstep, voffA); PG8_STAGE(PG8_SB(1, 1), cB + hstep + kstep, voffA);
  PG8_WAIT_V(6); PG8_BAR;
  for (;;) {
    const bool has_next = S.next(ui + 1, nxt);
    const char* nA = has_next ? (const char*)g.A + (size_t)nxt.pm * tstep : cA; const char* nB = has_next ? (const char*)g.Bt + (size_t)nxt.pn * tstep : cB;
    for (int t = 0; t < nt; t += 2) {
      const bool last = (t == nt - 2);
      const char* a1 = cA + (size_t)(t + 1) * kstep;
      const char* a2 = last ? nA : cA + (size_t)(t + 2) * kstep; const char* b2 = last ? nB : cB + (size_t)(t + 2) * kstep;
      const char* a3 = a2 + kstep; const char* b3 = b2 + kstep;
      PG8_LDB(B0, 0, 0); PG8_SCHED; PG8_LDA(At, 0, 0); PG8_STAGE(PG8_SA(1, 1), a1 + hstep, voffA);
      PG8_WAIT_L(8); PG8_BAR; PG8_WAIT_L(0); PG8_MMA(0, 0, At, B0); PG8_BAR; PG8_SCHED;
      PG8_LDB(B1, 0, 1); PG8_STAGE(PG8_SB(0, 0), b2, voffA);
      PG8_BAR; PG8_WAIT_L(0); PG8_MMA(0, 1, At, B1); PG8_BAR;
      PG8_LDA(At, 0, 1); PG8_STAGE(PG8_SA(0, 0), a2, voffA);
      PG8_BAR; PG8_WAIT_L(0); PG8_MMA(1, 0, At, B0); PG8_BAR; PG8_SCHED;
      PG8_STAGE(PG8_SB(0, 1), b2 + hstep, voffA);
      PG8_WAIT_V(6); PG8_BAR; PG8_MMA(1, 1, At, B1); PG8_BAR;
      PG8_LDB(B0, 1, 0); PG8_SCHED; PG8_LDA(At, 1, 0); PG8_STAGE(PG8_SA(0, 1), a2 + hstep, voffA);
      PG8_WAIT_L(8); PG8_BAR; PG8_WAIT_L(0); PG8_MMA(0, 0, At, B0); PG8_BAR; PG8_SCHED;
      PG8_LDB(B1, 1, 1); PG8_STAGE(PG8_SB(1, 0), b3, voffA);
      PG8_BAR; PG8_WAIT_L(0); PG8_MMA(0, 1, At, B1); PG8_BAR;
      PG8_LDA(At, 1, 1); PG8_STAGE(PG8_SA(1, 0), a3, voffA);
      PG8_BAR; PG8_WAIT_L(0); PG8_MMA(1, 0, At, B0); PG8_BAR; PG8_SCHED;
      PG8_STAGE(PG8_SB(1, 1), b3 + hstep, voffA);
      PG8_WAIT_V(6); PG8_BAR; PG8_MMA(1, 1, At, B1); PG8_BAR;
    }
    E(acc, cur, wr, wc, fr, fq);
    if (!has_next) break;
#pragma unroll
    for (int a = 0; a < 2; ++a)
#pragma unroll
      for (int b = 0; b < 2; ++b)
#pragma unroll
        for (int m = 0; m < 4; ++m)
#pragma unroll
          for (int n = 0; n < 2; ++n) acc[a][b][m][n] = (f32x4){0.f, 0.f, 0.f, 0.f};
    cur = nxt; cA = nA; cB = nB; ++ui;
  }
  PG8_WAIT_V(0);
  if (wr == 0) PG8_BAR;
  PG8_BAR;
}
}
DI void row_affine(const float* stats, int row, float& a, float& bb, float& mu, float& rstd) {
  if (stats) { const float s = stats[2 * row], ss = stats[2 * row + 1]; mu = s * (1.0f / 1024.0f); const float var = fmaxf(ss * (1.0f / 1024.0f) - mu * mu, 0.f); rstd = rsqrtf(var + 1e-5f); a = rstd; bb = -rstd * mu; }
  else { a = 1.f; bb = 0.f; mu = 0.f; rstd = 1.f; }
}
struct EpiUp {
  bf16_t* H; const float* stats; const float* c1; const float* c2;
  DI void operator()(const f32x4 (&acc)[2][2][4][2], const pg8::Unit& u, int wr, int wc, int fr, int fq) const {
    const int colg = u.pn * 256 + wc * 32 + 4 * fq, hcol = u.pn * 128 + wc * 32 + 4 * fq;
    f32x4 c1g[2], c2g[2], c1u[2], c2u[2];
#pragma unroll
    for (int n = 0; n < 2; ++n) { c1g[n] = *(const f32x4*)(c1 + colg + 16 * n); c2g[n] = *(const f32x4*)(c2 + colg + 16 * n); c1u[n] = *(const f32x4*)(c1 + colg + 128 + 16 * n); c2u[n] = *(const f32x4*)(c2 + colg + 128 + 16 * n); }
#pragma unroll
    for (int ai = 0; ai < 2; ++ai)
#pragma unroll
      for (int m = 0; m < 4; ++m) {
        const int row = u.pm * 256 + ai * 128 + wr * 64 + m * 16 + fr; float a, bb, mu, rstd; row_affine(stats, row, a, bb, mu, rstd);
#pragma unroll
        for (int n = 0; n < 2; ++n) {
          const f32x4 gv = acc[ai][0][m][n] * a + c1g[n] * bb + c2g[n], uv = acc[ai][1][m][n] * a + c1u[n] * bb + c2u[n];
          float h[4];
#pragma unroll
          for (int j = 0; j < 4; ++j) h[j] = gv[j] * sigmoidf_(gv[j]) * uv[j];
          u32x2 w; w.x = pk2(h[0], h[1]); w.y = pk2(h[2], h[3]);
          *(u32x2*)(H + (size_t)row * DFF + hcol + 16 * n) = w;
        }
        asm volatile("" ::: "memory");
      }
  }
};
struct EpiRes {
  float* T; const float* Tin; const float* stats_prev; const float* g; const float* b; float* stats_new; bf16_t* tb; float scale;
  DI void operator()(const f32x4 (&acc)[2][2][4][2], const pg8::Unit& u, int wr, int wc, int fr, int fq) const {
    const int col0 = u.pn * 256 + wc * 32 + 4 * fq;
    f32x4 gv[2][2], bv[2][2];
#pragma unroll
    for (int bj = 0; bj < 2; ++bj)
#pragma unroll
      for (int n = 0; n < 2; ++n) { gv[bj][n] = *(const f32x4*)(g + col0 + bj * 128 + 16 * n); bv[bj][n] = *(const f32x4*)(b + col0 + bj * 128 + 16 * n); }
#pragma unroll
    for (int ai = 0; ai < 2; ++ai)
#pragma unroll
      for (int m = 0; m < 4; ++m) {
        const int row = u.pm * 256 + ai * 128 + wr * 64 + m * 16 + fr; float a, bb, mu, rstd; row_affine(stats_prev, row, a, bb, mu, rstd);
        float rs = 0.f, rq = 0.f;
#pragma unroll
        for (int bj = 0; bj < 2; ++bj)
#pragma unroll
          for (int n = 0; n < 2; ++n) {
            const size_t off = (size_t)row * DM + col0 + bj * 128 + 16 * n;
            f32x4 tp = *(const f32x4*)(Tin + off);
            if (stats_prev) tp = (tp - mu) * rstd * gv[bj][n] + bv[bj][n];
            const f32x4 tn = tp * ALPHA + acc[ai][bj][m][n] * scale;
            *(f32x4*)(T + off) = tn;
            u32x2 w; w.x = pk2(tn[0], tn[1]); w.y = pk2(tn[2], tn[3]); *(u32x2*)(tb + off) = w;
            rs += tn[0] + tn[1] + tn[2] + tn[3]; rq += tn[0] * tn[0] + tn[1] * tn[1] + tn[2] * tn[2] + tn[3] * tn[3];
          }
        rs += __shfl_xor(rs, 16); rs += __shfl_xor(rs, 32); rq += __shfl_xor(rq, 16); rq += __shfl_xor(rq, 32);
        if (fq == 0) { atomicAdd(stats_new + 2 * row, rs); atomicAdd(stats_new + 2 * row + 1, rq); }
        asm volatile("" ::: "memory");
      }
  }
};
struct EpiIn {
  int mode; bf16_t* h; int ld; const float* stats; const float* c1; const float* c2; const float* lbv;
  bf16_t *hq, *hk, *hv, *hg; _Float16* hlf;
  template <int SECT>
  DI void body(const f32x4 (&acc)[2][2][4][2], const pg8::Unit& u, int wr, int wc, int fr, int fq) const {
    const int col0 = u.pn * 256 + wc * 32 + 4 * fq;
#pragma unroll
    for (int ai = 0; ai < 2; ++ai)
#pragma unroll
      for (int m = 0; m < 4; ++m) {
        const int row = u.pm * 256 + ai * 128 + wr * 64 + m * 16 + fr; float a, bb, mu, rstd; row_affine(stats, row, a, bb, mu, rstd);
#pragma unroll
        for (int bj = 0; bj < 2; ++bj)
#pragma unroll
          for (int n = 0; n < 2; ++n) {
            const int col = col0 + bj * 128 + 16 * n;
            const f32x4 v = acc[ai][bj][m][n] * a + (*(const f32x4*)(c1 + col)) * bb + *(const f32x4*)(c2 + col);
            if (SECT < 0) { u32x2 w; w.x = pk2(v[0], v[1]); w.y = pk2(v[2], v[3]); *(u32x2*)(h + (size_t)row * ld + col) = w; }
            else {
              const int cc = col & 1023; const size_t off = (size_t)row * 1024 + cc;
              if (SECT == 0 || SECT == 3) { u32x2 w; w.x = pk2(v[0] * sigmoidf_(v[0]), v[1] * sigmoidf_(v[1])); w.y = pk2(v[2] * sigmoidf_(v[2]), v[3] * sigmoidf_(v[3])); *(u32x2*)((SECT == 0 ? hq : hg) + off) = w; }
              else if (SECT == 1) {
                const f32x4 lb = *(const f32x4*)(lbv + cc); float kk[4]; typedef _Float16 h4 __attribute__((ext_vector_type(4))); h4 lf;
#pragma unroll
                for (int j = 0; j < 4; ++j) { kk[j] = (1.0f - lb[j]) / (1.0f + __expf(v[j])); lf[j] = (_Float16)__logf(1.0f - kk[j]); }
                u32x2 w; w.x = pk2(kk[0], kk[1]); w.y = pk2(kk[2], kk[3]); *(u32x2*)(hk + off) = w; *(h4*)(hlf + off) = lf;
              }
              else { u32x2 w; w.x = pk2(v[0], v[1]); w.y = pk2(v[2], v[3]); *(u32x2*)(hv + off) = w; }
            }
          }
        asm volatile("" ::: "memory");
      }
  }
  DI void operator()(const f32x4 (&acc)[2][2][4][2], const pg8::Unit& u, int wr, int wc, int fr, int fq) const {
    if (mode == 0) body<-1>(acc, u, wr, wc, fr, fq);
    else { const int sect = u.pn >> 2;
      if (sect == 0) body<0>(acc, u, wr, wc, fr, fq); else if (sect == 1) body<1>(acc, u, wr, wc, fr, fq); else if (sect == 2) body<2>(acc, u, wr, wc, fr, fq); else body<3>(acc, u, wr, wc, fr, fq); }
  }
};

DI void conv_strip(unsigned char* lds, const float* src, int ldn, int K, int n0, int nvalid, bf16_t* dst, int dstrow0, const float* g, const float* b, float* c1, float* c2) {
  bf16_t* tile = (bf16_t*)lds;
  float* red = (float*)(lds + 64 * 72 * 2);
  int tid_ = threadIdx.x; asm volatile("" : "+v"(tid_)); const int tid = tid_, kr = tid >> 4, nc = (tid & 15) * 4;
  const bool colok = (n0 + nc) < nvalid;
  float s1[4] = {0.f, 0.f, 0.f, 0.f}, s2[4] = {0.f, 0.f, 0.f, 0.f};
  for (int k0 = 0; k0 < K; k0 += 64) {
    f32x4 w[2];
#pragma unroll
    for (int rr = 0; rr < 2; ++rr) { const int k = k0 + kr + rr * 32; w[rr] = colok ? *(const f32x4*)(src + (size_t)k * ldn + n0 + nc) : (f32x4){0.f, 0.f, 0.f, 0.f}; }
    __syncthreads();
#pragma unroll
    for (int rr = 0; rr < 2; ++rr) { const int k = k0 + kr + rr * 32; const float gk = g ? g[k] : 1.0f, bk = b ? b[k] : 0.0f;
#pragma unroll
      for (int j = 0; j < 4; ++j) { const bf16_t v = f2bf(w[rr][j] * gk); tile[(nc + j) * 72 + kr + rr * 32] = v; s1[j] += bf2f(v); s2[j] += bk * w[rr][j]; } }
    __syncthreads();
    { const int n = tid >> 3, kc = (tid & 7) * 8; *(u32x4*)(dst + (size_t)(dstrow0 + n) * K + k0 + kc) = *(const u32x4*)(tile + n * 72 + kc); }
  }
  if (c1) {
    __syncthreads();
#pragma unroll
    for (int j = 0; j < 4; ++j) { red[kr * 64 + nc + j] = s1[j]; red[2048 + kr * 64 + nc + j] = s2[j]; }
    __syncthreads();
    if (tid < 128) { const int n = tid & 63, which = tid >> 6; float s = 0.f; for (int i = 0; i < 32; ++i) s += red[which * 2048 + i * 64 + n]; (which ? c2 : c1)[dstrow0 + n] = s; }
  }
  __syncthreads();
}

DI void convert_phase(const P& p, int L, unsigned char* lds) {
  const int kind = L % 3, slot = L / 3;
  const int nin = kind == 0 ? 44 : (kind == 1 ? 64 : 20);
  const int njobs = 208 + nin + 16 + (kind == 0 ? 6 : 0);
  unsigned char* ws = p.ws;
  for (int j = blockIdx.x; j < njobs; j += gridDim.x) {
    if (j < 208) {
      const int f = j / 104, jj = j % 104;
      const float* lg = p.ln_gain + (size_t)(L * 3 + (f == 0 ? -1 : 1)) * DM; const float* lbias = p.ln_bias + (size_t)(L * 3 + (f == 0 ? -1 : 1)) * DM;
      const bool fold = !(L == 0 && f == 0);
      float* cbase = (float*)(ws + (f == 0 ? C_GU1 : C_GU2));
      if (jj < 88) {
        const int up = jj / 44, s = jj % 44, n0 = s * 64;
        const float* src = (f == 0 ? (up ? p.f1u : p.f1g) : (up ? p.f2u : p.f2g)) + (size_t)L * DM * DFF;
        conv_strip(lds, src, DFF, DM, n0, DFF, (bf16_t*)(ws + (f == 0 ? W_GU1 : W_GU2)), (n0 >> 7) * 256 + (n0 & 127) + up * 128, fold ? lg : nullptr, fold ? lbias : nullptr, cbase, cbase + 5632);
      } else {
        const int s = jj - 88;
        const float* src = (f == 0 ? p.f1d : p.f2d) + (size_t)L * DFF * DM;
        conv_strip(lds, src, DM, DFF, s * 64, DM, (bf16_t*)(ws + (f == 0 ? W_D1 : W_D2)), s * 64, nullptr, nullptr, nullptr, nullptr);
      }
    } else if (j < 208 + nin) {
      const int s = j - 208; const float* lg = p.ln_gain + (size_t)(L * 3) * DM; const float* lbias = p.ln_bias + (size_t)(L * 3) * DM;
      const float* src = kind == 0 ? p.nsa_win + (size_t)slot * DM * 2608 : (kind == 1 ? p.hg_win + (size_t)slot * DM * 4096 : p.swa_win + (size_t)slot * DM * 1280);
      const int ldn = kind == 0 ? 2608 : (kind == 1 ? 4096 : 1280);
      float* cbase = (float*)(ws + C_IN);
      conv_strip(lds, src, ldn, DM, s * 64, ldn, (bf16_t*)(ws + W_IN), s * 64, lg, lbias, cbase, cbase + 4096);
    } else if (j < 208 + nin + 16) {
      const int s = j - 208 - nin;
      const float* src = kind == 0 ? p.nsa_wout + (size_t)slot * DM * DM : (kind == 1 ? p.hg_wout + (size_t)slot * DM * DM : p.swa_wout + (size_t)slot * DM * DM);
      conv_strip(lds, src, DM, DM, s * 64, DM, (bf16_t*)(ws + W_OUT), s * 64, nullptr, nullptr, nullptr, nullptr);
    } else {
      const int s = j - 208 - nin - 16;
      if (s < 4) { const int kv = s >> 1, st = s & 1; float* pb = (float*)(ws + C_POSB) + kv * 256;
        conv_strip(lds, p.nsa_w1 + ((size_t)slot * 2 + kv) * 2048 * 128, 128, 2048, st * 64, 128, (bf16_t*)(ws + W_W1T) + (size_t)kv * 128 * 2048, st * 64, nullptr, p.nsa_pos + ((size_t)slot * 2 + kv) * 2048, pb + 128, pb); }
      else { const int kv = s - 4; conv_strip(lds, p.nsa_w2 + ((size_t)slot * 2 + kv) * 128 * 64, 64, 128, 0, 64, (bf16_t*)(ws + W_W2T) + (size_t)kv * 64 * 128, 0, nullptr, nullptr, nullptr, nullptr); }
    }
  }
}

DI void init_phase(const P& p) {
  int tid_ = threadIdx.x; asm volatile("" : "+v"(tid_)); const size_t gtid = (size_t)blockIdx.x * 512 + tid_, gsz = (size_t)gridDim.x * 512;
  for (size_t i = gtid; i < (4 * MiB) / 16; i += gsz) ((f32x4*)(p.ws + WS_STATS))[i] = (f32x4){0.f, 0.f, 0.f, 0.f};
  for (size_t i = gtid; i < (size_t)MTOK * DM / 4; i += gsz) { const f32x4 v = ((const f32x4*)p.x)[i]; u32x2 w; w.x = pk2(v[0], v[1]); w.y = pk2(v[2], v[3]); ((u32x2*)(p.ws + WS_TB))[i] = w; }
  if (gtid < 16 * 132) { const int hd = (int)gtid / 132, d = (int)gtid % 132; int bk;
    if (d < 16) bk = d; else { const float v = logf((float)d / 16.0f) / 2.0794415416798357f * 16.0f; bk = 16 + (int)v; if (bk > 31 || d >= 128) bk = 31; }
    ((float*)(p.ws + C_BTAB))[gtid] = p.rel_bias[bk * 16 + hd]; }
  if (gtid < 1024) { const float a0 = p.hg_lb[gtid], a1 = p.hg_lb[1024 + gtid], a2 = p.hg_lb[2048 + gtid], a3 = p.hg_lb[3072 + gtid];
    const float mx = fmaxf(fmaxf(a0, a1), fmaxf(a2, a3)); const float e0 = expf(a0 - mx), e1 = expf(a1 - mx), e2 = expf(a2 - mx), e3 = expf(a3 - mx);
    ((float*)(p.ws + C_LBV))[gtid] = e1 / (e0 + e1 + e2 + e3); }
}

DI void final_ln(const P& p, const float* stats, const float* g, const float* b) {
  int tid_ = threadIdx.x; asm volatile("" : "+v"(tid_)); const size_t gtid = (size_t)blockIdx.x * 512 + tid_, gsz = (size_t)gridDim.x * 512;
  for (size_t i = gtid; i < (size_t)MTOK * DM / 4; i += gsz) {
    const int row = (int)(i >> 8), c = (int)(i & 255) * 4; float a, bb, mu, rstd; row_affine(stats, row, a, bb, mu, rstd);
    const f32x4 v = ((const f32x4*)p.out)[i]; ((f32x4*)p.out)[i] = (v - mu) * rstd * (*(const f32x4*)(g + c)) + *(const f32x4*)(b + c);
  }
}
#define MFMA32(a, b, c) __builtin_amdgcn_mfma_f32_32x32x16_bf16((a), (b), (c), 0, 0, 0)
#define MFMA16(a, b, c) __builtin_amdgcn_mfma_f32_16x16x32_bf16((a), (b), (c), 0, 0, 0)
DI int crow(int reg, int h) { return (reg & 3) + 8 * (reg >> 2) + 4 * h; }
constexpr int KS_STRIDE = 72;

DI void stage_kv(LAS bf16_t* Ks, LAS bf16_t* Vt, int vstride, int vcol0, const bf16_t* kg, const bf16_t* vg, size_t ldg) {
  int tid_ = threadIdx.x; asm volatile("" : "+v"(tid_)); const int tid = tid_, key = tid >> 3, d8 = (tid & 7) * 8;
  const u32x4 kv = *(const u32x4*)(kg + (size_t)key * ldg + d8);
  const bf16x8 vv = *(const bf16x8*)(vg + (size_t)key * ldg + d8);
  *(LAS u32x4*)(Ks + key * KS_STRIDE + d8) = kv;
#pragma unroll
  for (int i = 0; i < 8; ++i) Vt[(d8 + i) * vstride + vcol0 + key] = (bf16_t)vv[i];
}
DI void attn_scores(const LAS bf16_t* Ks, const bf16x8 (&qf)[4], int r, int h, f32x16 (&s)[2]) {
#pragma unroll
  for (int sub = 0; sub < 2; ++sub) {
    f32x16 a;
#pragma unroll
    for (int i = 0; i < 16; ++i) a[i] = 0.f;
#pragma unroll
    for (int ks = 0; ks < 4; ++ks) { const bf16x8 kf = *(const LAS bf16x8*)(Ks + (sub * 32 + r) * KS_STRIDE + ks * 16 + 8 * h); a = MFMA32(kf, qf[ks], a); }
    s[sub] = a;
  }
}
DI void attn_logits(f32x16 (&s)[2], int t, int tmin_wave, int h, int base, int stride, int dmax, bool ok, const LAS float* btl) {
  const bool far = (tmin_wave - (base + 63 * stride)) >= 128;
  const float bfar = btl[128];
#pragma unroll
  for (int sub = 0; sub < 2; ++sub)
#pragma unroll
    for (int reg = 0; reg < 16; ++reg) {
      const int kk = sub * 32 + crow(reg, h); const int d = t - (base + kk * stride);
      const bool valid = (d >= 0) && (d < dmax) && ok;
      float bias; if (far) bias = bfar; else { const int di = d < 0 ? 0 : (d > 128 ? 128 : d); bias = btl[di]; }
      s[sub][reg] = valid ? s[sub][reg] * 0.125f + bias : -1e30f;
    }
}
DI void attn_pv(const LAS bf16_t* Vt, int vstride, const f32x16 (&p)[2], f32x16 (&O)[2], int r, int h) {
#pragma unroll
  for (int sub = 0; sub < 2; ++sub)
#pragma unroll
    for (int s2 = 0; s2 < 2; ++s2) {
      u32x4 pp;
#pragma unroll
      for (int j = 0; j < 4; ++j) pp[j] = pk2(p[sub][8 * s2 + 2 * j], p[sub][8 * s2 + 2 * j + 1]);
      const bf16x8 pf = __builtin_bit_cast(bf16x8, pp);
#pragma unroll
      for (int dt = 0; dt < 2; ++dt) {
        const LAS bf16_t* vp = Vt + (dt * 32 + r) * vstride + sub * 32 + 16 * s2 + 4 * h;
        const s16x4 lo = *(const LAS s16x4*)vp, hi = *(const LAS s16x4*)(vp + 8);
        const bf16x8 vf = __builtin_shufflevector(lo, hi, 0, 1, 2, 3, 4, 5, 6, 7);
        O[dt] = MFMA32(vf, pf, O[dt]);
      }
    }
}
template <bool WITH_O>
DI void attn_online(f32x16 (&s)[2], float& m, float& l, f32x16 (&O)[2]) {
  float mx = -1e30f;
#pragma unroll
  for (int sub = 0; sub < 2; ++sub)
#pragma unroll
    for (int reg = 0; reg < 16; ++reg) mx = fmaxf(mx, s[sub][reg]);
  mx = fmaxf(mx, __shfl_xor(mx, 32));
  const float mn = fmaxf(m, mx), al = __expf(m - mn); m = mn;
  float ls = 0.f;
#pragma unroll
  for (int sub = 0; sub < 2; ++sub)
#pragma unroll
    for (int reg = 0; reg < 16; ++reg) { const float v = s[sub][reg]; const float e = v > -1e29f ? __expf(v - mn) : 0.f; s[sub][reg] = e; ls += e; }
  l = l * al + ls;
  if (WITH_O) {
#pragma unroll
    for (int dt = 0; dt < 2; ++dt)
#pragma unroll
      for (int reg = 0; reg < 16; ++reg) O[dt][reg] *= al;
  }
}
DI void attn_tile(const LAS bf16_t* Ks, const LAS bf16_t* Vt, int vstride, const bf16x8 (&qf)[4], f32x16 (&O)[2], float& m, float& l,
                  int t, int tmin_wave, int r, int h, int base, int stride, int dmax, bool ok, const LAS float* btl) {
  f32x16 s[2];
  attn_scores(Ks, qf, r, h, s);
  attn_logits(s, t, tmin_wave, h, base, stride, dmax, ok, btl);
  attn_online<true>(s, m, l, O);
  attn_pv(Vt, vstride, s, O, r, h);
}
DI void zero_o(f32x16 (&O)[2]) {
#pragma unroll
  for (int dt = 0; dt < 2; ++dt)
#pragma unroll
    for (int reg = 0; reg < 16; ++reg) O[dt][reg] = 0.f;
}

DI void nsa_compress_phase(const P& p, LAS unsigned char* lds) {
  const bf16_t* hb = (const bf16_t*)(p.ws + WS_BIG); const int ld = 2816;
  int tid_ = threadIdx.x; asm volatile("" : "+v"(tid_)); const int tid = tid_, wid = tid >> 6, lane = tid & 63, fr = lane & 15, fq = lane >> 4;
  LAS bf16_t* hid = (LAS bf16_t*)lds + wid * 16 * 136;
  for (int base = blockIdx.x * 8; base < 1024; base += gridDim.x * 8) {
    const int task = base + wid;
    const int kv = task >> 9, b = (task >> 6) & 7, g = (task >> 4) & 3, n0 = (task & 15) * 16;
    const bf16_t* w1t = (const bf16_t*)(p.ws + W_W1T) + (size_t)kv * 128 * 2048; const bf16_t* w2t = (const bf16_t*)(p.ws + W_W2T) + (size_t)kv * 64 * 128;
    const float* posb = (const float*)(p.ws + C_POSB) + kv * 256;
    const int colb = 1024 + kv * 256 + g * 64;
    int n = n0 + fr; if (n > 254) n = 254;
    f32x4 acc[8];
#pragma unroll
    for (int i = 0; i < 8; ++i) acc[i] = (f32x4){0.f, 0.f, 0.f, 0.f};
    for (int l = 0; l < 32; ++l) {
#pragma unroll
      for (int dk = 0; dk < 2; ++dk) {
        const bf16x8 af = *(const bf16x8*)(hb + (size_t)(b * SEQ + 16 * n + l) * ld + colb + dk * 32 + fq * 8);
#pragma unroll
        for (int nt = 0; nt < 8; ++nt) { const bf16x8 bfr = *(const bf16x8*)(w1t + (size_t)(nt * 16 + fr) * 2048 + l * 64 + dk * 32 + fq * 8); acc[nt] = MFMA16(af, bfr, acc[nt]); }
      }
    }
#pragma unroll
    for (int nt = 0; nt < 8; ++nt) { const float pbv = posb[nt * 16 + fr];
#pragma unroll
      for (int j = 0; j < 4; ++j) { const float v = acc[nt][j] + pbv; const float u = 0.7978845608028654f * (v + 0.044715f * v * v * v); const float th = 1.0f - 2.0f / (1.0f + __expf(2.0f * u));
        hid[(4 * fq + j) * 136 + nt * 16 + fr] = f2bf(0.5f * v * (1.0f + th)); } }
    __syncthreads();
    f32x4 o[4];
#pragma unroll
    for (int i = 0; i < 4; ++i) o[i] = (f32x4){0.f, 0.f, 0.f, 0.f};
#pragma unroll
    for (int ks = 0; ks < 4; ++ks) { const bf16x8 af = *(const LAS bf16x8*)(hid + fr * 136 + ks * 32 + fq * 8);
#pragma unroll
      for (int nt = 0; nt < 4; ++nt) { const bf16x8 bfr = *(const bf16x8*)(w2t + (size_t)(nt * 16 + fr) * 128 + ks * 32 + fq * 8); o[nt] = MFMA16(af, bfr, o[nt]); } }
    bf16_t* dst = (bf16_t*)(p.ws + (kv ? WS_VC : WS_KC)) + (size_t)((b * 4 + g) * 256) * 64;
#pragma unroll
    for (int nt = 0; nt < 4; ++nt)
#pragma unroll
      for (int j = 0; j < 4; ++j) { const int nn = n0 + 4 * fq + j; dst[(size_t)nn * 64 + nt * 16 + fr] = nn > 254 ? (bf16_t)0 : f2bf(o[nt][j]); }
    __syncthreads();
  }
}

DI void nsa_attn_phase(const P& p, LAS unsigned char* lds) {
  const bf16_t* hb = (const bf16_t*)(p.ws + WS_BIG); const int ld = 2816;
  bf16_t* ob = (bf16_t*)(p.ws + WS_O);
  LAS bf16_t* Ks = (LAS bf16_t*)lds; LAS bf16_t* Vt = (LAS bf16_t*)(lds + 9216); LAS bf16_t* KC = (LAS bf16_t*)(lds + 17920); LAS bf16_t* VCT = (LAS bf16_t*)(lds + 54784);
  LAS float* G4s = (LAS float*)(lds + 88064); LAS float* Lsm = (LAS float*)(lds + 104448); LAS float* BT = (LAS float*)(lds + 120832);
  LAS float* OUTL = (LAS float*)(lds + 17920);
  LAS unsigned* SELM = (LAS unsigned*)(lds + 122944); LAS unsigned* UNI = (LAS unsigned*)(lds + 123456);
  int tid_ = threadIdx.x; asm volatile("" : "+v"(tid_)); const int tid = tid_, wid = tid >> 6, lane = tid & 63, r = lane & 31, h = lane >> 5, tl = r >> 2, hd = r & 3;
  for (int it = blockIdx.x; it < 2048; it += gridDim.x) {
    const int c = it & 255, ii = it >> 8, bg = c >> 3, b = bg >> 2, g = bg & 3, j8 = c & 7;
    const int qi = (ii & 1) ? (16 * (ii >> 1) + 15 - j8) : (16 * (ii >> 1) + j8);
    const int t0 = 64 * qi, tw = t0 + 8 * wid, t = tw + tl, head = g * 4 + hd;
    const int nct = (4 * qi + 2) / 64 + 1;
    __syncthreads();
    for (int tile = 0; tile < nct; ++tile) { const size_t go = (size_t)((b * 4 + g) * 256 + tile * 64) * 64;
      stage_kv(KC + tile * 64 * KS_STRIDE, VCT, 260, tile * 64, (const bf16_t*)(p.ws + WS_KC) + go, (const bf16_t*)(p.ws + WS_VC) + go, 64); }
    for (int i = tid; i < 4 * 132; i += 512) BT[i] = ((const float*)(p.ws + C_BTAB))[g * 4 * 132 + i];
    if (tid < 128) SELM[tid] = 0u; if (tid < 2) UNI[tid] = 0u;
    const size_t rowoff = (size_t)(b * SEQ + t) * ld;
    bf16x8 qf[4];
#pragma unroll
    for (int ks = 0; ks < 4; ++ks) qf[ks] = *(const bf16x8*)(hb + rowoff + head * 64 + ks * 16 + 8 * h);
    const float gc = sigmoidf_(bf2f(hb[rowoff + 2560 + head * 3 + 0])), gs = sigmoidf_(bf2f(hb[rowoff + 2560 + head * 3 + 1])), gw = sigmoidf_(bf2f(hb[rowoff + 2560 + head * 3 + 2]));
    const LAS float* btl = BT + hd * 132;
    __syncthreads();
    f32x16 O[2];
    float m = -1e30f, l = 0.f;
#pragma unroll 1
    for (int tile = 0; tile < nct; ++tile) { f32x16 s[2]; attn_scores(KC + tile * 64 * KS_STRIDE, qf, r, h, s); attn_logits(s, t, tw, h, 16 * (tile * 64) + 31, 16, 0x7fffffff, true, btl); attn_online<false>(s, m, l, O); }
    { const float lt = l + __shfl_xor(l, 32); const float inv = lt > 0.f ? 1.0f / lt : 0.f;
      zero_o(O);
#pragma unroll 1
      for (int tile = 0; tile < nct; ++tile) {
        f32x16 s[2]; attn_scores(KC + tile * 64 * KS_STRIDE, qf, r, h, s); attn_logits(s, t, tw, h, 16 * (tile * 64) + 31, 16, 0x7fffffff, true, btl);
#pragma unroll
        for (int sub = 0; sub < 2; ++sub) {
#pragma unroll
          for (int reg = 0; reg < 16; ++reg) { const float v = s[sub][reg]; s[sub][reg] = v > -1e29f ? __expf(v - m) * inv : 0.f; }
#pragma unroll
          for (int lg = 0; lg < 4; ++lg) { float G = s[sub][4 * lg] + s[sub][4 * lg + 1] + s[sub][4 * lg + 2] + s[sub][4 * lg + 3], Lv = s[sub][4 * lg + 3];
            G += __shfl_xor(G, 1); G += __shfl_xor(G, 2); Lv += __shfl_xor(Lv, 1); Lv += __shfl_xor(Lv, 2);
            if (hd == 0) { const int gk = 16 * tile + 8 * sub + 2 * lg + h; G4s[(8 * wid + tl) * 64 + gk] = G; Lsm[(8 * wid + tl) * 64 + gk] = Lv; } }
        }
        attn_pv(VCT + tile * 64, 260, s, O, r, h);
      }
    }
    __syncthreads();
#pragma unroll
    for (int dt = 0; dt < 2; ++dt)
#pragma unroll
      for (int reg = 0; reg < 16; ++reg) OUTL[(dt * 16 + reg) * 512 + tid] = gc * O[dt][reg];
    if (qi < 16) { const unsigned long long full = (qi == 63) ? ~0ull : ((1ull << (qi + 1)) - 1ull);
      if (tid < 64) { SELM[2 * tid] = (unsigned)full; SELM[2 * tid + 1] = (unsigned)(full >> 32); } if (tid == 0) { UNI[0] = (unsigned)full; UNI[1] = (unsigned)(full >> 32); } }
    else {
      int tsel = tid; asm volatile("" : "+v"(tsel));
      const int tok = tsel >> 3, jj = tsel & 7, hiJ = qi - 2;
#pragma unroll
      for (int e = 0; e < 8; ++e) { const int j = jj * 8 + e; if (j >= 1 && j <= hiJ) G4s[tok * 64 + j] += Lsm[tok * 64 + j - 1]; }
      __syncthreads();
      float mine[8]; int cnt[8];
#pragma unroll
      for (int e = 0; e < 8; ++e) { const int j = jj * 8 + e; mine[e] = (j >= 1 && j <= hiJ) ? G4s[tok * 64 + j] : 0.f; cnt[e] = 0; }
      for (int j2 = 1; j2 <= hiJ; ++j2) { const float v = G4s[tok * 64 + j2];
#pragma unroll
        for (int e = 0; e < 8; ++e) { const int j = jj * 8 + e; cnt[e] += (v > mine[e] || (v == mine[e] && j2 < j)) ? 1 : 0; } }
      unsigned long long bits = 0ull;
#pragma unroll
      for (int e = 0; e < 8; ++e) { const int j = jj * 8 + e; if (j >= 1 && j <= hiJ && cnt[e] < 13) bits |= 1ull << j; }
      if (jj == 0) bits |= 1ull | (1ull << qi) | (1ull << (qi - 1));
      const unsigned blo = (unsigned)bits, bhi = (unsigned)(bits >> 32);
      if (blo) { atomicOr((unsigned*)&SELM[2 * tok], blo); atomicOr((unsigned*)&UNI[0], blo); }
      if (bhi) { atomicOr((unsigned*)&SELM[2 * tok + 1], bhi); atomicOr((unsigned*)&UNI[1], bhi); }
    }
    __syncthreads();
    { const unsigned long long selm = (unsigned long long)SELM[2 * (8 * wid + tl)] | ((unsigned long long)SELM[2 * (8 * wid + tl) + 1] << 32);
      const unsigned long long uni = (unsigned long long)UNI[0] | ((unsigned long long)UNI[1] << 32);
      m = -1e30f; l = 0.f; zero_o(O);
#pragma unroll 1
      for (int j = 0; j <= qi; ++j) {
        if (!((uni >> j) & 1ull)) continue;
        __syncthreads();
        const size_t go = (size_t)(b * SEQ + j * 64) * ld + g * 64;
        stage_kv(Ks, Vt, 68, 0, hb + go + 1536, hb + go + 1792, ld);
        __syncthreads();
        attn_tile(Ks, Vt, 68, qf, O, m, l, t, tw, r, h, j * 64, 1, 0x7fffffff, ((selm >> j) & 1ull) != 0ull, btl);
      }
      const float lt = l + __shfl_xor(l, 32); const float sc = lt > 0.f ? gs / lt : 0.f;
#pragma unroll
      for (int dt = 0; dt < 2; ++dt)
#pragma unroll
        for (int reg = 0; reg < 16; ++reg) OUTL[(dt * 16 + reg) * 512 + tid] += sc * O[dt][reg];
    }
    { m = -1e30f; l = 0.f; zero_o(O);
#pragma unroll 1
      for (int j = (qi > 8 ? qi - 8 : 0); j <= qi; ++j) {
        __syncthreads();
        const size_t go = (size_t)(b * SEQ + j * 64) * ld + g * 64;
        stage_kv(Ks, Vt, 68, 0, hb + go + 2048, hb + go + 2304, ld);
        __syncthreads();
        attn_tile(Ks, Vt, 68, qf, O, m, l, t, tw, r, h, j * 64, 1, 512, true, btl);
      }
      const float lt = l + __shfl_xor(l, 32); const float sc = lt > 0.f ? gw / lt : 0.f;
#pragma unroll
      for (int dt = 0; dt < 2; ++dt)
#pragma unroll
        for (int reg = 0; reg < 16; ++reg) O[dt][reg] = OUTL[(dt * 16 + reg) * 512 + tid] + sc * O[dt][reg];
    }
    bf16_t* op = ob + (size_t)(b * SEQ + t) * DM + head * 64;
#pragma unroll
    for (int dt = 0; dt < 2; ++dt)
#pragma unroll
      for (int i4 = 0; i4 < 4; ++i4) { u32x2 w; w.x = pk2(O[dt][4 * i4], O[dt][4 * i4 + 1]); w.y = pk2(O[dt][4 * i4 + 2], O[dt][4 * i4 + 3]); *(u32x2*)(op + dt * 32 + 8 * i4 + 4 * h) = w; }
  }
}

DI void swa_attn_phase(const P& p, int slot, LAS unsigned char* lds) {
  const bf16_t* hb = (const bf16_t*)(p.ws + WS_BIG); const int ld = 1280;
  bf16_t* ob = (bf16_t*)(p.ws + WS_O);
  LAS bf16_t* Ks = (LAS bf16_t*)lds; LAS bf16_t* Vt = (LAS bf16_t*)(lds + 9216); LAS float* BT = (LAS float*)(lds + 17920);
  int tid_ = threadIdx.x; asm volatile("" : "+v"(tid_)); const int tid = tid_, wid = tid >> 6, lane = tid & 63, r = lane & 31, h = lane >> 5, tl = r >> 3, hd = r & 7;
  for (int it = blockIdx.x; it < 2048; it += gridDim.x) {
    const int b = it >> 8, kv = (it >> 7) & 1, t0 = (it & 127) * 32;
    const int tw = t0 + 4 * wid, t = tw + tl, head = kv * 8 + hd;
    __syncthreads();
    for (int i = tid; i < 8 * 132; i += 512) BT[i] = ((const float*)(p.ws + C_BTAB))[kv * 8 * 132 + i];
    const size_t rowoff = (size_t)(b * SEQ + t) * ld;
    bf16x8 qf[4];
#pragma unroll
    for (int ks = 0; ks < 4; ++ks) qf[ks] = *(const bf16x8*)(hb + rowoff + head * 64 + ks * 16 + 8 * h);
    const LAS float* btl = BT + hd * 132;
    float m = p.swa_sinks[slot * 16 + head], l = (h == 0) ? 1.0f : 0.0f;
    f32x16 O[2]; zero_o(O);
    const int lo = t0 - 127, first = lo <= 0 ? 0 : (lo >> 6), last = (t0 + 31) >> 6;
#pragma unroll 1
    for (int j = first; j <= last; ++j) {
      __syncthreads();
      const size_t go = (size_t)(b * SEQ + j * 64) * ld + kv * 64;
      stage_kv(Ks, Vt, 68, 0, hb + go + 1024, hb + go + 1152, ld);
      __syncthreads();
      attn_tile(Ks, Vt, 68, qf, O, m, l, t, tw, r, h, j * 64, 1, 128, true, btl);
    }
    const float lt = l + __shfl_xor(l, 32); const float sc = 1.0f / lt;
    bf16_t* op = ob + (size_t)(b * SEQ + t) * DM + head * 64;
#pragma unroll
    for (int dt = 0; dt < 2; ++dt)
#pragma unroll
      for (int i4 = 0; i4 < 4; ++i4) { u32x2 w; w.x = pk2(sc * O[dt][4 * i4], sc * O[dt][4 * i4 + 1]); w.y = pk2(sc * O[dt][4 * i4 + 2], sc * O[dt][4 * i4 + 3]); *(u32x2*)(op + dt * 32 + 8 * i4 + 4 * h) = w; }
  }
}
constexpr size_t HG_Q = WS_BIG, HG_K = WS_BIG + 64 * MiB, HG_V = WS_BIG + 128 * MiB, HG_G = WS_BIG + 192 * MiB, HG_LF = WS_BIG + 256 * MiB;
DI void hgrn_scan_phase(const P& p, LAS unsigned char* lds) {
  const bf16_t* hq = (const bf16_t*)(p.ws + HG_Q); const bf16_t* hk = (const bf16_t*)(p.ws + HG_K); const bf16_t* hv = (const bf16_t*)(p.ws + HG_V);
  const _Float16* hlf = (const _Float16*)(p.ws + HG_LF);
  bf16_t* oraw = (bf16_t*)(p.ws + WS_TB); float* sumsq = (float*)(p.ws + WS_SUMSQ);
  LAS bf16_t* Q = (LAS bf16_t*)lds; LAS bf16_t* Kr = (LAS bf16_t*)(lds + 17408); LAS float* BC = (LAS float*)(lds + 34816); LAS bf16_t* KDT = (LAS bf16_t*)(lds + 68608);
  LAS bf16_t* VT = (LAS bf16_t*)(lds + 87040); LAS bf16_t* ST = (LAS bf16_t*)(lds + 91648); LAS bf16_t* AB = (LAS bf16_t*)(lds + 100352);
  LAS float* SEG = (LAS float*)(lds + 109568); LAS float* DEC = (LAS float*)(lds + 111616); LAS _Float16* LF = (LAS _Float16*)(lds + 112128);
  int tid_ = threadIdx.x; asm volatile("" : "+v"(tid_)); const int tid = tid_, wid = tid >> 6, lane = tid & 63, fr = lane & 15, fq = lane >> 4;
  for (int it = blockIdx.x; it < 256; it += gridDim.x) {
    const int b = it >> 5, hh = (it >> 2) & 7, vq = it & 3;
    __syncthreads();
    for (int i = tid; i < 32 * 136 / 2; i += 512) ((LAS unsigned*)ST)[i] = 0u;
    f32x4 sreg[2]; sreg[0] = (f32x4){0.f, 0.f, 0.f, 0.f}; sreg[1] = sreg[0];
    u32x4 pq[2], pkk[2], plf[2], pv;
    const size_t gb = (size_t)(b * SEQ) * 1024 + hh * 128;
    auto prefetch = [&](int c) {
#pragma unroll
      for (int i = 0; i < 2; ++i) { const int idx = tid + 512 * i, row = idx >> 4, c8 = (idx & 15) * 8; const size_t off = gb + (size_t)(c * 64 + row) * 1024 + c8;
        pq[i] = *(const u32x4*)(hq + off); pkk[i] = *(const u32x4*)(hk + off); plf[i] = *(const u32x4*)(hlf + off); }
      if (tid < 256) { const int row = tid >> 2, c8 = (tid & 3) * 8; pv = *(const u32x4*)(hv + gb + (size_t)(c * 64 + row) * 1024 + vq * 32 + c8); }
    };
    prefetch(0);
    for (int c = 0; c < 64; ++c) {
      __syncthreads();
#pragma unroll
      for (int i = 0; i < 2; ++i) { const int idx = tid + 512 * i, row = idx >> 4, c8 = (idx & 15) * 8;
        *(LAS u32x4*)(Q + row * 136 + c8) = pq[i]; *(LAS u32x4*)(Kr + row * 136 + c8) = pkk[i]; *(LAS u32x4*)(LF + row * 128 + c8) = plf[i]; }
      if (tid < 256) { const int row = tid >> 2, c8 = (tid & 3) * 8; const bf16x8 vv = __builtin_bit_cast(bf16x8, pv);
#pragma unroll
        for (int i = 0; i < 8; ++i) VT[(c8 + i) * 72 + row] = (bf16_t)vv[i]; }
      if (c + 1 < 64) prefetch(c + 1);
      __syncthreads();
      const int kx = tid & 127, seg = tid >> 7;
      float bl[16];
      { float run = 0.f;
#pragma unroll
        for (int i = 0; i < 16; ++i) { run += (float)LF[(16 * seg + i) * 128 + kx]; bl[i] = run; }
        SEG[seg * 128 + kx] = run; }
      __syncthreads();
      { float pre = 0.f, blast = 0.f;
#pragma unroll
        for (int s2 = 0; s2 < 4; ++s2) { const float v = SEG[s2 * 128 + kx]; blast += v; if (s2 < seg) pre += v; }
        u32x4 w0, w1; float kd[16];
#pragma unroll
        for (int i = 0; i < 16; ++i) { const float bc = pre + bl[i]; BC[(16 * seg + i) * 132 + kx] = bc; kd[i] = bf2f(Kr[(16 * seg + i) * 136 + kx]) * __expf(blast - bc); }
#pragma unroll
        for (int j = 0; j < 4; ++j) { w0[j] = pk2(kd[2 * j], kd[2 * j + 1]); w1[j] = pk2(kd[8 + 2 * j], kd[8 + 2 * j + 1]); }
        *(LAS u32x4*)(KDT + kx * 72 + 16 * seg) = w0; *(LAS u32x4*)(KDT + kx * 72 + 16 * seg + 8) = w1;
        if (seg == 0) DEC[kx] = __expf(blast); }
      __syncthreads();
      const int mt = wid >> 1, vt = wid & 1;
      f32x4 oacc = (f32x4){0.f, 0.f, 0.f, 0.f}, a0 = oacc, a1 = oacc;
      const int J0 = 2 * vt;
#pragma unroll
      for (int ks = 0; ks < 4; ++ks) {
        const int kb = 32 * ks + 8 * fq, trow = 16 * mt + fr;
        const bf16x8 qv = *(const LAS bf16x8*)(Q + trow * 136 + kb);
        const f32x4 bc0 = *(const LAS f32x4*)(BC + trow * 132 + kb), bc1 = *(const LAS f32x4*)(BC + trow * 132 + kb + 4);
        const f32x4 r0 = *(const LAS f32x4*)(BC + (16 * mt) * 132 + kb), r1 = *(const LAS f32x4*)(BC + (16 * mt) * 132 + kb + 4);
        u32x4 ai, aq;
#pragma unroll
        for (int j = 0; j < 4; ++j) {
          const float q0 = bf2f((bf16_t)qv[2 * j]), q1 = bf2f((bf16_t)qv[2 * j + 1]);
          const float b0 = j < 2 ? bc0[2 * j] : bc1[2 * j - 4], b1 = j < 2 ? bc0[2 * j + 1] : bc1[2 * j - 3];
          const float rr0 = j < 2 ? r0[2 * j] : r1[2 * j - 4], rr1 = j < 2 ? r0[2 * j + 1] : r1[2 * j - 3];
          ai[j] = pk2(q0 * __expf(b0), q1 * __expf(b1)); aq[j] = pk2(q0 * __expf(b0 - rr0), q1 * __expf(b1 - rr1));
        }
        const bf16x8 sb = *(const LAS bf16x8*)(ST + (16 * vt + fr) * 136 + kb);
        oacc = MFMA16(__builtin_bit_cast(bf16x8, ai), sb, oacc);
#pragma unroll
        for (int jj = 0; jj < 2; ++jj) {
          const int J = J0 + jj; if (J > mt) continue;
          const int srow = 16 * J + fr;
          const bf16x8 kv = *(const LAS bf16x8*)(Kr + srow * 136 + kb);
          const f32x4 c0 = *(const LAS f32x4*)(BC + srow * 132 + kb), c1 = *(const LAS f32x4*)(BC + srow * 132 + kb + 4);
          u32x4 bk;
#pragma unroll
          for (int j = 0; j < 4; ++j) {
            const float k0 = bf2f((bf16_t)kv[2 * j]), k1 = bf2f((bf16_t)kv[2 * j + 1]);
            const float b0 = j < 2 ? c0[2 * j] : c1[2 * j - 4], b1 = j < 2 ? c0[2 * j + 1] : c1[2 * j - 3];
            const float rr0 = j < 2 ? r0[2 * j] : r1[2 * j - 4], rr1 = j < 2 ? r0[2 * j + 1] : r1[2 * j - 3];
            bk[j] = pk2(k0 * __expf(fminf(rr0 - b0, 80.f)), k1 * __expf(fminf(rr1 - b1, 80.f)));
          }
          if (jj == 0) a0 = MFMA16(__builtin_bit_cast(bf16x8, aq), __builtin_bit_cast(bf16x8, bk), a0);
          else a1 = MFMA16(__builtin_bit_cast(bf16x8, aq), __builtin_bit_cast(bf16x8, bk), a1);
        }
      }
#pragma unroll
      for (int jj = 0; jj < 2; ++jj) { const int J = J0 + jj;
#pragma unroll
        for (int reg = 0; reg < 4; ++reg) { const int tt = 16 * mt + 4 * fq + reg, ss = 16 * J + fr; const float v = jj == 0 ? a0[reg] : a1[reg];
          AB[tt * 72 + ss] = (J <= mt && ss <= tt) ? f2bf(v) : (bf16_t)0; } }
      __syncthreads();
#pragma unroll
      for (int k2 = 0; k2 < 2; ++k2) {
        const bf16x8 af = *(const LAS bf16x8*)(AB + (16 * mt + fr) * 72 + 32 * k2 + 8 * fq);
        const bf16x8 vb = *(const LAS bf16x8*)(VT + (16 * vt + fr) * 72 + 32 * k2 + 8 * fq);
        oacc = MFMA16(af, vb, oacc);
      }
#pragma unroll
      for (int reg = 0; reg < 4; ++reg) {
        const int tok = b * SEQ + c * 64 + 16 * mt + 4 * fq + reg; const float v = oacc[reg];
        oraw[(size_t)tok * 1024 + hh * 128 + vq * 32 + 16 * vt + fr] = f2bf(v);
        float sq = v * v; sq += __shfl_xor(sq, 1); sq += __shfl_xor(sq, 2); sq += __shfl_xor(sq, 4); sq += __shfl_xor(sq, 8);
        if (fr == 0) atomicAdd(sumsq + (size_t)tok * 8 + hh, sq);
      }
      { const f32x4 dc = *(const LAS f32x4*)(DEC + 16 * wid + 4 * fq);
        sreg[0] *= dc; sreg[1] *= dc;
#pragma unroll
        for (int k2 = 0; k2 < 2; ++k2) {
          const bf16x8 af = *(const LAS bf16x8*)(KDT + (16 * wid + fr) * 72 + 32 * k2 + 8 * fq);
#pragma unroll
          for (int v2 = 0; v2 < 2; ++v2) { const bf16x8 vb = *(const LAS bf16x8*)(VT + (16 * v2 + fr) * 72 + 32 * k2 + 8 * fq); sreg[v2] = MFMA16(af, vb, sreg[v2]); }
        }
#pragma unroll
        for (int v2 = 0; v2 < 2; ++v2) { u32x2 w; w.x = pk2(sreg[v2][0], sreg[v2][1]); w.y = pk2(sreg[v2][2], sreg[v2][3]); *(LAS u32x2*)(ST + (16 * v2 + fr) * 136 + 16 * wid + 4 * fq) = w; }
      }
    }
  }
}
DI void hgrn_norm_phase(const P& p, int slot) {
  const bf16_t* oraw = (const bf16_t*)(p.ws + WS_TB); const bf16_t* hg = (const bf16_t*)(p.ws + HG_G); const float* sumsq = (const float*)(p.ws + WS_SUMSQ);
  bf16_t* ob = (bf16_t*)(p.ws + WS_O); const float* gain = p.hg_gain + slot * 128;
  int tid_ = threadIdx.x; asm volatile("" : "+v"(tid_)); const size_t gtid = (size_t)blockIdx.x * 512 + tid_, gsz = (size_t)gridDim.x * 512;
  for (size_t i = gtid; i < (size_t)MTOK * 1024 / 8; i += gsz) {
    const size_t e = i * 8; const int row = (int)(e >> 10), col = (int)(e & 1023), hh = col >> 7, vv = col & 127;
    const float rs = rsqrtf(sumsq[(size_t)row * 8 + hh] * (1.0f / 128.0f) + 1e-6f);
    const bf16x8 o8 = *(const bf16x8*)(oraw + e), g8 = *(const bf16x8*)(hg + e);
    u32x4 w;
#pragma unroll
    for (int j = 0; j < 4; ++j) w[j] = pk2(bf2f((bf16_t)o8[2 * j]) * rs * gain[vv + 2 * j] * bf2f((bf16_t)g8[2 * j]), bf2f((bf16_t)o8[2 * j + 1]) * rs * gain[vv + 2 * j + 1] * bf2f((bf16_t)g8[2 * j + 1]));
    *(u32x4*)(ob + e) = w;
  }
}
#ifndef SKIP_MIXERS
#define SKIP_MIXERS 0
#endif
__global__ void __launch_bounds__(512, 2) mega_fwd(P p) {
  extern __shared__ __attribute__((aligned(16))) unsigned char lds_raw[];
  LAS unsigned char* lds = (LAS unsigned char*)lds_raw;
  cg::grid_group grid = cg::this_grid();
  unsigned char* ws = p.ws;
  float* stats = (float*)(ws + WS_STATS);
  bf16_t* tb = (bf16_t*)(ws + WS_TB); bf16_t* Hb = (bf16_t*)(ws + WS_BIG); bf16_t* ob = (bf16_t*)(ws + WS_O);
  init_phase(p);
  for (int L = 0; L < 4; ++L) {
    convert_phase(p, L, lds_raw);
    grid.sync();
    const int kind = L % 3, slot = L / 3;
    for (int s = 0; s < 3; ++s) {
      const int lnp = L * 3 + s - 1;
      const float* stp = lnp >= 0 ? stats + (size_t)lnp * MTOK * 2 : nullptr;
      pg8::Gemm gr; float scale;
      if (s != 1) {
        pg8::Gemm g; g.A = tb; g.Bt = (const bf16_t*)(ws + (s == 0 ? W_GU1 : W_GU2)); g.M = MTOK; g.N = 5632; g.K = DM;
        pg8::StaticOrder S; S.init(g.M, g.N, gridDim.x, blockIdx.x);
        EpiUp E; E.H = Hb; E.stats = stp; E.c1 = (const float*)(ws + (s == 0 ? C_GU1 : C_GU2)); E.c2 = E.c1 + 5632;
        pg8::gemm_phase(lds, g, S, E);
        grid.sync();
        gr.A = Hb; gr.Bt = (const bf16_t*)(ws + (s == 0 ? W_D1 : W_D2)); gr.M = MTOK; gr.N = DM; gr.K = DFF; scale = 0.5f;
      } else {
        pg8::Gemm g; g.A = tb; g.Bt = (const bf16_t*)(ws + W_IN); g.M = MTOK; g.N = kind == 0 ? 2816 : (kind == 1 ? 4096 : 1280); g.K = DM;
        pg8::StaticOrder S; S.init(g.M, g.N, gridDim.x, blockIdx.x);
        EpiIn E; E.mode = kind == 1 ? 1 : 0; E.h = Hb; E.ld = g.N; E.stats = stp; E.c1 = (const float*)(ws + C_IN); E.c2 = E.c1 + 4096; E.lbv = (const float*)(ws + C_LBV);
        E.hq = (bf16_t*)(ws + HG_Q); E.hk = (bf16_t*)(ws + HG_K); E.hv = (bf16_t*)(ws + HG_V); E.hg = (bf16_t*)(ws + HG_G); E.hlf = (_Float16*)(ws + HG_LF);
        pg8::gemm_phase(lds, g, S, E);
        grid.sync();
#if !SKIP_MIXERS
        if (kind == 0) {
#ifndef NO_CMP
          nsa_compress_phase(p, lds);
#endif
          grid.sync();
#ifndef NO_NSA
          nsa_attn_phase(p, lds);
#endif
        }
        else if (kind == 1) {
#ifndef NO_HGRN
          hgrn_scan_phase(p, lds);
#endif
          grid.sync(); hgrn_norm_phase(p, slot); }
        else {
#ifndef NO_SWA
          swa_attn_phase(p, slot, lds);
#endif
        }
#endif
        grid.sync();
        gr.A = ob; gr.Bt = (const bf16_t*)(ws + W_OUT); gr.M = MTOK; gr.N = DM; gr.K = DM; scale = 1.0f;
      }
      pg8::StaticOrder S2; S2.init(gr.M, gr.N, gridDim.x, blockIdx.x);
      EpiRes R; R.T = p.out; R.Tin = lnp >= 0 ? p.out : p.x; R.stats_prev = stp; R.g = p.ln_gain + (size_t)(lnp >= 0 ? lnp : 0) * DM; R.b = p.ln_bias + (size_t)(lnp >= 0 ? lnp : 0) * DM;
      R.stats_new = stats + (size_t)(lnp + 1) * MTOK * 2; R.tb = tb; R.scale = scale;
      pg8::gemm_phase(lds, gr, S2, R);
      grid.sync();
    }
  }
  final_ln(p, stats + (size_t)11 * MTOK * 2, p.ln_gain + 11 * DM, p.ln_bias + 11 * DM);
}

extern "C" void kernel_launch(void* const* d_in, const int* in_sizes, int n_in, void* d_out, int out_size, void* d_ws, size_t ws_size, hipStream_t stream) {
  static int grid = 0;
  if (grid == 0) {
    if (n_in != 22 || ws_size < WS_END) { fprintf(stderr, "kernel_launch: unexpected n_in %d / ws_size %zu (need %zu)\n", n_in, ws_size, (size_t)WS_END); grid = -1; return; }
    int dev = 0, cus = 0, per_cu = 0;
    hipGetDevice(&dev); hipDeviceGetAttribute(&cus, hipDeviceAttributeMultiprocessorCount, dev);
    if (hipFuncSetAttribute((const void*)mega_fwd, hipFuncAttributeMaxDynamicSharedMemorySize, LDS_BYTES) != hipSuccess) { fprintf(stderr, "hipFuncSetAttribute failed\n"); grid = -1; return; }
    hipOccupancyMaxActiveBlocksPerMultiprocessor(&per_cu, (const void*)mega_fwd, 512, LDS_BYTES);
    if (per_cu < 1) { fprintf(stderr, "occupancy query says %d blocks/CU\n", per_cu); per_cu = 1; }
    (void)hipGetLastError();
    grid = cus * 1;
  }
  if (grid < 0) return;
  P p{};
  const float** pp = (const float**)&p;
  for (int i = 0; i < 22; ++i) pp[i] = (const float*)d_in[i];
  p.out = (float*)d_out; p.ws = (unsigned char*)d_ws;
  void* args[] = {&p};
  hipError_t e = hipLaunchCooperativeKernel((const void*)mega_fwd, dim3(grid), dim3(512), args, LDS_BYTES, stream);
  if (e != hipSuccess) fprintf(stderr, "cooperative launch failed: %s (grid %d)\n", hipGetErrorString(e), grid);
}
```

```cpp
#include <hip/hip_runtime.h>
#include <hip/hip_cooperative_groups.h>
#include <cstdio>
namespace cg = cooperative_groups;

typedef unsigned short bf16_t;
typedef short bf16x8 __attribute__((ext_vector_type(8)));
typedef short s16x4 __attribute__((ext_vector_type(4)));
typedef float f32x4 __attribute__((ext_vector_type(4)));
typedef float f32x16 __attribute__((ext_vector_type(16)));
typedef unsigned u32x2 __attribute__((ext_vector_type(2)));
typedef unsigned u32x4 __attribute__((ext_vector_type(4)));
#define LAS __attribute__((address_space(3)))
#define DI __device__ __forceinline__

constexpr int MTOK = 32768, DM = 1024, DFF = 2816, SEQ = 4096, NB = 8;
constexpr float ALPHA = 1.681792830507429f;
constexpr size_t MiB = 1ull << 20;
constexpr size_t W_GU1 = 0, W_D1 = 11534336, W_GU2 = 17301504, W_D2 = 28835840, W_IN = 34603008, W_OUT = 42991616,
                 W_W1T = 45088768, W_W2T = 46137344, W_C = 46170112;
constexpr size_t C_GU1 = W_C, C_GU2 = C_GU1 + 2 * 5632 * 4, C_IN = C_GU2 + 2 * 5632 * 4, C_POSB = C_IN + 2 * 4096 * 4,
                 C_LBV = C_POSB + 2 * 256 * 4, C_BTAB = C_LBV + 1024 * 4, C_END = C_BTAB + 16 * 132 * 4;
constexpr size_t WS_TB = 48 * MiB, WS_BIG = 112 * MiB, WS_O = 432 * MiB, WS_MISC = 496 * MiB;
constexpr size_t WS_STATS = WS_MISC, WS_SUMSQ = WS_STATS + 3 * MiB, WS_KC = WS_SUMSQ + 1 * MiB, WS_VC = WS_KC + 1 * MiB, WS_BAR = WS_VC + 1 * MiB, WS_END = WS_BAR + 16384;
static_assert(C_END <= 48 * MiB, "weights region");
constexpr int LDS_BYTES = 144 * 1024;

struct P {
  const float *x, *rel_bias, *ln_gain, *ln_bias, *f1g, *f1u, *f1d, *f2g, *f2u, *f2d, *nsa_win, *nsa_wout, *nsa_pos, *nsa_w1, *nsa_w2,
      *hg_win, *hg_wout, *hg_gain, *hg_lb, *swa_win, *swa_wout, *swa_sinks;
  float* out; unsigned char* ws;
};

DI unsigned pk2(float a, float b) { typedef __bf16 bf2 __attribute__((ext_vector_type(2))); bf2 v; v[0] = (__bf16)a; v[1] = (__bf16)b; return __builtin_bit_cast(unsigned, v); }
DI bf16_t f2bf(float a) { return __builtin_bit_cast(unsigned short, (__bf16)a); }
DI float bf2f(bf16_t v) { return __uint_as_float(((unsigned)v) << 16); }
DI int lane_id_() { int l; asm volatile("v_mbcnt_lo_u32_b32 %0, -1, 0\n\tv_mbcnt_hi_u32_b32 %0, -1, %0" : "=v"(l)); return l; }
DI float sigmoidf_(float v) { return 1.0f / (1.0f + __expf(-v)); }


#define XB_TMO      128
#define XB_XCNT(j)  (256  + 64 * (j))
#define XB_XSUB(j)  (1280 + 64 * (j))
#define XB_XGEN(j)  (2304 + 64 * (j))
#define XB_TOP      3328
#define XB_TOPGEN   3392
#define XCD_BAR_WORDS 3456
#define XB_SPIN_CAP (1u << 20)
DI unsigned xb_ld(unsigned* p)              { return __hip_atomic_load(p, __ATOMIC_RELAXED, __HIP_MEMORY_SCOPE_AGENT); }
DI unsigned xb_add(unsigned* p, unsigned v) { return __hip_atomic_fetch_add(p, v, __ATOMIC_RELAXED, __HIP_MEMORY_SCOPE_AGENT); }
DI unsigned xb_xcc_id() { return (unsigned)__builtin_amdgcn_s_getreg((3 << 11) | 20) & 0xFu; }
#define XB_SPIN(cond, bar) do { unsigned _sp = 0; while (cond) { __builtin_amdgcn_s_sleep(1); \
    if ((++_sp & 255u) == 0u) { if (xb_ld(&(bar)[XB_TMO])) break; if (_sp > XB_SPIN_CAP) { atomicAdd(&(bar)[XB_TMO], 1u); break; } } } } while (0)
struct XcdBarrier { unsigned* bar; unsigned x; volatile LAS unsigned* st; };
DI XcdBarrier xcd_barrier_post(int wv, unsigned* bar, volatile LAS unsigned* st) {
  XcdBarrier b; b.bar = bar; b.x = xb_xcc_id(); b.st = st;
  if (wv == 0 && lane_id_() == 0) (void)xb_add(&bar[XB_XCNT(b.x)], 1u);
  return b;
}
DI void xcd_barrier_complete(unsigned* bar, unsigned x, unsigned& nloc, unsigned& nx) {
  const unsigned G = gridDim.x * gridDim.y * gridDim.z;
  unsigned sum, cnt, mine, sp = 0u;
  for (;;) {
    sum = 0u; cnt = 0u; mine = 0u;
#pragma unroll 1
    for (unsigned j = 0; j < 16; ++j) { const unsigned c = xb_ld(&bar[XB_XCNT(j)]); sum += c; cnt += (c > 0u) ? 1u : 0u; mine = (j == x) ? c : mine; }
    if (sum == G) break;
    __builtin_amdgcn_s_sleep(1);
    if ((++sp & 255u) == 0u) { if (xb_ld(&bar[XB_TMO])) break; if (sp > XB_SPIN_CAP) { atomicAdd(&bar[XB_TMO], 1u); break; } }
  }
  nloc = mine > 0u ? mine : 1u; nx = cnt > 0u ? cnt : 1u;
}
DI void xcd_barrier(int wv, const XcdBarrier& b) {
  asm volatile("s_waitcnt vmcnt(0)" ::: "memory");
  __syncthreads();
  if (wv == 0 && lane_id_() == 0) {
    unsigned* bar = b.bar;
    __builtin_amdgcn_s_waitcnt(0);
    unsigned nloc = b.st[0], nx = b.st[1];
    if (nloc == 0u) { xcd_barrier_complete(bar, b.x, nloc, nx); b.st[0] = nloc; b.st[1] = nx; }
    const unsigned old = xb_add(&bar[XB_XSUB(b.x)], 1u);
    const unsigned gen = old / nloc;
    if (old + 1u == (gen + 1u) * nloc) {
      __builtin_amdgcn_fence(__ATOMIC_RELEASE, "agent");
      asm volatile("s_waitcnt vmcnt(0)" ::: "memory");
      const unsigned og = xb_add(&bar[XB_TOP], 1u);
      const unsigned tg = og / nx;
      if (og + 1u == (tg + 1u) * nx) xb_add(&bar[XB_TOPGEN], 1u);
      else XB_SPIN(xb_ld(&bar[XB_TOPGEN]) == tg, bar);
      __builtin_amdgcn_fence(__ATOMIC_ACQUIRE, "agent");
      xb_add(&bar[XB_XGEN(b.x)], 1u);
      asm volatile("s_waitcnt vmcnt(0)" ::: "memory");
    } else {
      XB_SPIN(xb_ld(&bar[XB_XGEN(b.x)]) == gen, bar);
      __builtin_amdgcn_fence(__ATOMIC_ACQUIRE, "agent");
      asm volatile("s_waitcnt vmcnt(0)" ::: "memory");
    }
  }
  __syncthreads();
}

namespace pg8 {
constexpr int BM = 256, BK = 64, HALF = 128, HTB = HALF * BK * 2, STAGE_BYTES = 8 * HTB, NXCD = 8, WGM = 8;
DI int lds_byte(int r, int c) { const int st = (r >> 4) * 2 + (c >> 5), rr = r & 15, cc = c & 31, ob = rr * 64 + cc * 2; return st * 1024 + (ob ^ (((ob >> 9) & 1) << 5)); }
DI void stage_rc(int b, int& R, int& C) { const int st = b / 1024, sb = b % 1024, swz = sb ^ (((sb >> 9) & 1) << 5); R = (st >> 1) * 16 + swz / 64; C = (st & 1) * 32 + (swz % 64) / 2; }
struct Unit { int pm, pn; };
struct Gemm { const bf16_t* A; const bf16_t* Bt; int M, N, K; };
struct StaticOrder {
  int nM, nN, nwg, G, c;
  DI void init(int M, int N, int G_, int c_) { nM = M / BM; nN = N / BM; nwg = nM * nN; G = G_; c = c_; }
  DI bool next(int i, Unit& u) const {
    const long L = (long)i * G + c; if (L >= nwg) return false;
    int wgid = (int)L; { const int q = nwg / NXCD, r = nwg % NXCD, xcd = wgid % NXCD, off = wgid / NXCD; wgid = (xcd < r ? xcd * (q + 1) : r * (q + 1) + (xcd - r) * q) + off; }
    const int nig = WGM * nN, gid = wgid / nig, fm = gid * WGM, gsz = (nM - fm) < WGM ? (nM - fm) : WGM;
    u.pm = fm + ((wgid % nig) % gsz); u.pn = (wgid % nig) / gsz; return true;
  }
};
template <class Epi>
DI void gemm_phase(int wv, LAS unsigned char* lds, const Gemm g, const StaticOrder& S, const Epi& E) {
  int tid_ = wv * 64 + lane_id_(); asm volatile("" : "+v"(tid_)); const int tid = tid_, wid = __builtin_amdgcn_readfirstlane(tid >> 6), lane = tid & 63, wr = wid >> 2, wc = wid & 3, fr = lane & 15, fq = lane >> 4;
  const int K = g.K, nt = K / BK;
  unsigned voffA[2];
#pragma unroll
  for (int i = 0; i < 2; ++i) { int R, C; stage_rc(tid * 16 + i * 8192, R, C); voffA[i] = (unsigned)(R * K + C) * 2u; }
  const size_t kstep = (size_t)(BK * 2), hstep = (size_t)HALF * K * 2, tstep = 2 * hstep;
  const unsigned ldsw = (unsigned)wid * 1024u;
  const int aoff = lds_byte(wr * 64 + fr, fq * 8), boff = lds_byte(wc * 32 + fr, fq * 8);
#define PG8_SA(b, h) (((b) * 2 + (h)) * HTB)
#define PG8_SB(b, h) ((4 + (b) * 2 + (h)) * HTB)
#define PG8_STAGE(bufoff, gbase, voff) do { _Pragma("unroll") for (int _i = 0; _i < 2; ++_i) \
    __builtin_amdgcn_global_load_lds((const unsigned*)((const char*)(gbase) + (voff)[_i]), (LAS unsigned*)(lds + (bufoff) + ldsw + _i * 8192), 16, 0, 0); } while (0)
#define PG8_LDA(dst, b, h) do { _Pragma("unroll") for (int m = 0; m < 4; ++m) _Pragma("unroll") for (int k = 0; k < 2; ++k) dst[m][k] = *(const LAS bf16x8*)(lds + PG8_SA(b, h) + aoff + m * 2048 + k * 1024); } while (0)
#define PG8_LDB(dst, b, h) do { _Pragma("unroll") for (int n = 0; n < 2; ++n) _Pragma("unroll") for (int k = 0; k < 2; ++k) dst[n][k] = *(const LAS bf16x8*)(lds + PG8_SB(b, h) + boff + n * 2048 + k * 1024); } while (0)
#define PG8_MMA(ai, bj, At, Bt) do { __builtin_amdgcn_s_setprio(1); _Pragma("unroll") for (int m = 0; m < 4; ++m) _Pragma("unroll") for (int n = 0; n < 2; ++n) _Pragma("unroll") for (int k = 0; k < 2; ++k) \
    acc[ai][bj][m][n] = __builtin_amdgcn_mfma_f32_16x16x32_bf16(Bt[n][k], At[m][k], acc[ai][bj][m][n], 0, 0, 0); __builtin_amdgcn_s_setprio(0); } while (0)
#define PG8_WAIT_V(n) asm volatile("s_waitcnt vmcnt(" #n ")" ::: "memory")
#define PG8_WAIT_L(n) asm volatile("s_waitcnt lgkmcnt(" #n ")" ::: "memory")
#define PG8_BAR __builtin_amdgcn_s_barrier()
#define PG8_SCHED __builtin_amdgcn_sched_barrier(0)
  Unit cur, nxt; int ui = 0;
  if (!S.next(0, cur)) return;
  f32x4 acc[2][2][4][2];
#pragma unroll
  for (int a = 0; a < 2; ++a)
#pragma unroll
    for (int b = 0; b < 2; ++b)
#pragma unroll
      for (int m = 0; m < 4; ++m)
#pragma unroll
        for (int n = 0; n < 2; ++n) acc[a][b][m][n] = (f32x4){0.f, 0.f, 0.f, 0.f};
  bf16x8 At[4][2], B0[2][2], B1[2][2];
  const char* cA = (const char*)g.A + (size_t)cur.pm * tstep; const char* cB = (const char*)g.Bt + (size_t)cur.pn * tstep;
  PG8_STAGE(PG8_SB(0, 0), cB, voffA); PG8_STAGE(PG8_SA(0, 0), cA, voffA); PG8_STAGE(PG8_SB(0, 1), cB + hstep, voffA); PG8_STAGE(PG8_SA(0, 1), cA + hstep, voffA);
  if (wr == 1) PG8_BAR;
  PG8_WAIT_V(4); PG8_BAR;
  PG8_STAGE(PG8_SB(1, 0), cB + kstep, voffA); PG8_STAGE(PG8_SA(1, 0), cA + kstep, voffA); PG8_STAGE(PG8_SB(1, 1), cB + hstep + kstep, voffA);
  PG8_WAIT_V(6); PG8_BAR;
  for (;;) {
    const bool has_next = S.next(ui + 1, nxt);
    const char* nA = has_next ? (const char*)g.A + (size_t)nxt.pm * tstep : cA; const char* nB = has_next ? (const char*)g.Bt + (size_t)nxt.pn * tstep : cB;
    for (int t = 0; t < nt; t += 2) {
      const bool last = (t == nt - 2);
      const char* a1 = cA + (size_t)(t + 1) * kstep;
      const char* a2 = last ? nA : cA + (size_t)(t + 2) * kstep; const char* b2 = last ? nB : cB + (size_t)(t + 2) * kstep;
      const char* a3 = a2 + kstep; const char* b3 = b2 + kstep;
      PG8_LDB(B0, 0, 0); PG8_SCHED; PG8_LDA(At, 0, 0); PG8_STAGE(PG8_SA(1, 1), a1 + hstep, voffA);
      PG8_WAIT_L(8); PG8_BAR; PG8_WAIT_L(0); PG8_MMA(0, 0, At, B0); PG8_BAR; PG8_SCHED;
      PG8_LDB(B1, 0, 1); PG8_STAGE(PG8_SB(0, 0), b2, voffA);
      PG8_BAR; PG8_WAIT_L(0); PG8_MMA(0, 1, At, B1); PG8_BAR;
      PG8_LDA(At, 0, 1); PG8_STAGE(PG8_SA(0, 0), a2, voffA);
      PG8_BAR; PG8_WAIT_L(0); PG8_MMA(1, 0, At, B0); PG8_BAR; PG8_SCHED;
      PG8_STAGE(PG8_SB(0, 1), b2 + hstep, voffA);
      PG8_WAIT_V(6); PG8_BAR; PG8_MMA(1, 1, At, B1); PG8_BAR;
      PG8_LDB(B0, 1, 0); PG8_SCHED; PG8_LDA(At, 1, 0); PG8_STAGE(PG8_SA(0, 1), a2 + hstep, voffA);
      PG8_WAIT_L(8); PG8_BAR; PG8_WAIT_L(0); PG8_MMA(0, 0, At, B0); PG8_BAR; PG8_SCHED;
      PG8_LDB(B1, 1, 1); PG8_STAGE(PG8_SB(1, 0), b3, voffA);
      PG8_BAR; PG8_WAIT_L(0); PG8_MMA(0, 1, At, B1); PG8_BAR;
      PG8_LDA(At, 1, 1); PG8_STAGE(PG8_SA(1, 0), a3, voffA);
      PG8_BAR; PG8_WAIT_L(0); PG8_MMA(1, 0, At, B0); PG8_BAR; PG8_SCHED;
      PG8_STAGE(PG8_SB(1, 1), b3 + hstep, voffA);
      PG8_WAIT_V(6); PG8_BAR; PG8_MMA(1, 1, At, B1); PG8_BAR;
    }
    E(acc, cur, wr, wc, fr, fq);
    if (!has_next) break;
#pragma unroll
    for (int a = 0; a < 2; ++a)
#pragma unroll
      for (int b = 0; b < 2; ++b)
#pragma unroll
        for (int m = 0; m < 4; ++m)
#pragma unroll
          for (int n = 0; n < 2; ++n) acc[a][b][m][n] = (f32x4){0.f, 0.f, 0.f, 0.f};
    cur = nxt; cA = nA; cB = nB; ++ui;
  }
  PG8_WAIT_V(0);
  if (wr == 0) PG8_BAR;
  PG8_BAR;
}
}
DI void row_affine(const float* stats, int row, float& a, float& bb, float& mu, float& rstd) {
  if (stats) { const float s = stats[2 * row], ss = stats[2 * row + 1]; mu = s * (1.0f / 1024.0f); const float var = fmaxf(ss * (1.0f / 1024.0f) - mu * mu, 0.f); rstd = rsqrtf(var + 1e-5f); a = rstd; bb = -rstd * mu; }
  else { a = 1.f; bb = 0.f; mu = 0.f; rstd = 1.f; }
}
struct EpiUp {
  bf16_t* H; const float* stats; const float* c1; const float* c2;
  DI void operator()(const f32x4 (&acc)[2][2][4][2], const pg8::Unit& u, int wr, int wc, int fr, int fq) const {
    const int colg = u.pn * 256 + wc * 32 + 4 * fq, hcol = u.pn * 128 + wc * 32 + 4 * fq;
    f32x4 c1g[2], c2g[2], c1u[2], c2u[2];
#pragma unroll
    for (int n = 0; n < 2; ++n) { c1g[n] = *(const f32x4*)(c1 + colg + 16 * n); c2g[n] = *(const f32x4*)(c2 + colg + 16 * n); c1u[n] = *(const f32x4*)(c1 + colg + 128 + 16 * n); c2u[n] = *(const f32x4*)(c2 + colg + 128 + 16 * n); }
#pragma unroll
    for (int ai = 0; ai < 2; ++ai)
#pragma unroll
      for (int m = 0; m < 4; ++m) {
        const int row = u.pm * 256 + ai * 128 + wr * 64 + m * 16 + fr; float a, bb, mu, rstd; row_affine(stats, row, a, bb, mu, rstd);
#pragma unroll
        for (int n = 0; n < 2; ++n) {
          const f32x4 gv = acc[ai][0][m][n] * a + c1g[n] * bb + c2g[n], uv = acc[ai][1][m][n] * a + c1u[n] * bb + c2u[n];
          float h[4];
#pragma unroll
          for (int j = 0; j < 4; ++j) h[j] = gv[j] * sigmoidf_(gv[j]) * uv[j];
          u32x2 w; w.x = pk2(h[0], h[1]); w.y = pk2(h[2], h[3]);
          *(u32x2*)(H + (size_t)row * DFF + hcol + 16 * n) = w;
        }
        asm volatile("" ::: "memory");
      }
  }
};
struct EpiRes {
  float* T; const float* Tin; const float* stats_prev; const float* g; const float* b; float* stats_new; bf16_t* tb; float scale;
  DI void operator()(const f32x4 (&acc)[2][2][4][2], const pg8::Unit& u, int wr, int wc, int fr, int fq) const {
    const int col0 = u.pn * 256 + wc * 32 + 4 * fq;
    f32x4 gv[2][2], bv[2][2];
#pragma unroll
    for (int bj = 0; bj < 2; ++bj)
#pragma unroll
      for (int n = 0; n < 2; ++n) { gv[bj][n] = *(const f32x4*)(g + col0 + bj * 128 + 16 * n); bv[bj][n] = *(const f32x4*)(b + col0 + bj * 128 + 16 * n); }
#pragma unroll
    for (int ai = 0; ai < 2; ++ai)
#pragma unroll
      for (int m = 0; m < 4; ++m) {
        const int row = u.pm * 256 + ai * 128 + wr * 64 + m * 16 + fr; float a, bb, mu, rstd; row_affine(stats_prev, row, a, bb, mu, rstd);
        float rs = 0.f, rq = 0.f;
#pragma unroll
        for (int bj = 0; bj < 2; ++bj)
#pragma unroll
          for (int n = 0; n < 2; ++n) {
            const size_t off = (size_t)row * DM + col0 + bj * 128 + 16 * n;
            f32x4 tp = *(const f32x4*)(Tin + off);
            if (stats_prev) tp = (tp - mu) * rstd * gv[bj][n] + bv[bj][n];
            const f32x4 tn = tp * ALPHA + acc[ai][bj][m][n] * scale;
            *(f32x4*)(T + off) = tn;
            u32x2 w; w.x = pk2(tn[0], tn[1]); w.y = pk2(tn[2], tn[3]); *(u32x2*)(tb + off) = w;
            rs += tn[0] + tn[1] + tn[2] + tn[3]; rq += tn[0] * tn[0] + tn[1] * tn[1] + tn[2] * tn[2] + tn[3] * tn[3];
          }
        rs += __shfl_xor(rs, 16); rs += __shfl_xor(rs, 32); rq += __shfl_xor(rq, 16); rq += __shfl_xor(rq, 32);
        if (fq == 0) { atomicAdd(stats_new + 2 * row, rs); atomicAdd(stats_new + 2 * row + 1, rq); }
        asm volatile("" ::: "memory");
      }
  }
};
struct EpiIn {
  int mode; bf16_t* h; int ld; const float* stats; const float* c1; const float* c2; const float* lbv;
  bf16_t *hq, *hk, *hv, *hg; _Float16* hlf;
  template <int SECT>
  DI void body(const f32x4 (&acc)[2][2][4][2], const pg8::Unit& u, int wr, int wc, int fr, int fq) const {
    const int col0 = u.pn * 256 + wc * 32 + 4 * fq;
#pragma unroll
    for (int ai = 0; ai < 2; ++ai)
#pragma unroll
      for (int m = 0; m < 4; ++m) {
        const int row = u.pm * 256 + ai * 128 + wr * 64 + m * 16 + fr; float a, bb, mu, rstd; row_affine(stats, row, a, bb, mu, rstd);
#pragma unroll
        for (int bj = 0; bj < 2; ++bj)
#pragma unroll
          for (int n = 0; n < 2; ++n) {
            const int col = col0 + bj * 128 + 16 * n;
            const f32x4 v = acc[ai][bj][m][n] * a + (*(const f32x4*)(c1 + col)) * bb + *(const f32x4*)(c2 + col);
            if (SECT < 0) { u32x2 w; w.x = pk2(v[0], v[1]); w.y = pk2(v[2], v[3]); *(u32x2*)(h + (size_t)row * ld + col) = w; }
            else {
              const int cc = col & 1023; const size_t off = (size_t)row * 1024 + cc;
              if (SECT == 0 || SECT == 3) { u32x2 w; w.x = pk2(v[0] * sigmoidf_(v[0]), v[1] * sigmoidf_(v[1])); w.y = pk2(v[2] * sigmoidf_(v[2]), v[3] * sigmoidf_(v[3])); *(u32x2*)((SECT == 0 ? hq : hg) + off) = w; }
              else if (SECT == 1) {
                const f32x4 lb = *(const f32x4*)(lbv + cc); float kk[4]; typedef _Float16 h4 __attribute__((ext_vector_type(4))); h4 lf;
#pragma unroll
                for (int j = 0; j < 4; ++j) { kk[j] = (1.0f - lb[j]) / (1.0f + __expf(v[j])); lf[j] = (_Float16)__logf(1.0f - kk[j]); }
                u32x2 w; w.x = pk2(kk[0], kk[1]); w.y = pk2(kk[2], kk[3]); *(u32x2*)(hk + off) = w; *(h4*)(hlf + off) = lf;
              }
              else { u32x2 w; w.x = pk2(v[0], v[1]); w.y = pk2(v[2], v[3]); *(u32x2*)(hv + off) = w; }
            }
          }
        asm volatile("" ::: "memory");
      }
  }
  DI void operator()(const f32x4 (&acc)[2][2][4][2], const pg8::Unit& u, int wr, int wc, int fr, int fq) const {
    if (mode == 0) body<-1>(acc, u, wr, wc, fr, fq);
    else { const int sect = u.pn >> 2;
      if (sect == 0) body<0>(acc, u, wr, wc, fr, fq); else if (sect == 1) body<1>(acc, u, wr, wc, fr, fq); else if (sect == 2) body<2>(acc, u, wr, wc, fr, fq); else body<3>(acc, u, wr, wc, fr, fq); }
  }
};

DI void conv_strip(int wv, LAS unsigned char* lds, const float* src, int ldn, int K, int n0, int nvalid, bf16_t* dst, int dstrow0, const float* g, const float* b, float* c1, float* c2) {
  LAS bf16_t* tile = (LAS bf16_t*)lds;
  LAS float* red = (LAS float*)(lds + 64 * 72 * 2);
  int tid_ = wv * 64 + lane_id_(); asm volatile("" : "+v"(tid_)); const int tid = tid_, kr = tid >> 4, nc = (tid & 15) * 4;
  const bool colok = (n0 + nc) < nvalid;
  float s1[4] = {0.f, 0.f, 0.f, 0.f}, s2[4] = {0.f, 0.f, 0.f, 0.f};
  for (int k0 = 0; k0 < K; k0 += 64) {
    f32x4 w[2];
#pragma unroll
    for (int rr = 0; rr < 2; ++rr) { const int k = k0 + kr + rr * 32; w[rr] = colok ? *(const f32x4*)(src + (size_t)k * ldn + n0 + nc) : (f32x4){0.f, 0.f, 0.f, 0.f}; }
    __syncthreads();
#pragma unroll
    for (int rr = 0; rr < 2; ++rr) { const int k = k0 + kr + rr * 32; const float gk = g ? g[k] : 1.0f, bk = b ? b[k] : 0.0f;
#pragma unroll
      for (int j = 0; j < 4; ++j) { const bf16_t v = f2bf(w[rr][j] * gk); tile[(nc + j) * 72 + kr + rr * 32] = v; s1[j] += bf2f(v); s2[j] += bk * w[rr][j]; } }
    __syncthreads();
    { const int n = tid >> 3, kc = (tid & 7) * 8; *(u32x4*)(dst + (size_t)(dstrow0 + n) * K + k0 + kc) = *(const LAS u32x4*)(tile + n * 72 + kc); }
  }
  if (c1) {
    __syncthreads();
#pragma unroll
    for (int j = 0; j < 4; ++j) { red[kr * 64 + nc + j] = s1[j]; red[2048 + kr * 64 + nc + j] = s2[j]; }
    __syncthreads();
    if (tid < 128) { const int n = tid & 63, which = tid >> 6; float s = 0.f; for (int i = 0; i < 32; ++i) s += red[which * 2048 + i * 64 + n]; (which ? c2 : c1)[dstrow0 + n] = s; }
  }
  __syncthreads();
}

DI void convert_phase(int wv, const P& p, int L, LAS unsigned char* lds) {
  const int kind = L % 3, slot = L / 3;
  const int nin = kind == 0 ? 44 : (kind == 1 ? 64 : 20);
  const int njobs = 208 + nin + 16 + (kind == 0 ? 6 : 0);
  unsigned char* ws = p.ws;
  for (int j = blockIdx.x; j < njobs; j += gridDim.x) {
    if (j < 208) {
      const int f = j / 104, jj = j % 104;
      const float* lg = p.ln_gain + (size_t)(L * 3 + (f == 0 ? -1 : 1)) * DM; const float* lbias = p.ln_bias + (size_t)(L * 3 + (f == 0 ? -1 : 1)) * DM;
      const bool fold = !(L == 0 && f == 0);
      float* cbase = (float*)(ws + (f == 0 ? C_GU1 : C_GU2));
      if (jj < 88) {
        const int up = jj / 44, s = jj % 44, n0 = s * 64;
        const float* src = (f == 0 ? (up ? p.f1u : p.f1g) : (up ? p.f2u : p.f2g)) + (size_t)L * DM * DFF;
        conv_strip(wv, lds, src, DFF, DM, n0, DFF, (bf16_t*)(ws + (f == 0 ? W_GU1 : W_GU2)), (n0 >> 7) * 256 + (n0 & 127) + up * 128, fold ? lg : nullptr, fold ? lbias : nullptr, cbase, cbase + 5632);
      } else {
        const int s = jj - 88;
        const float* src = (f == 0 ? p.f1d : p.f2d) + (size_t)L * DFF * DM;
        conv_strip(wv, lds, src, DM, DFF, s * 64, DM, (bf16_t*)(ws + (f == 0 ? W_D1 : W_D2)), s * 64, nullptr, nullptr, nullptr, nullptr);
      }
    } else if (j < 208 + nin) {
      const int s = j - 208; const float* lg = p.ln_gain + (size_t)(L * 3) * DM; const float* lbias = p.ln_bias + (size_t)(L * 3) * DM;
      const float* src = kind == 0 ? p.nsa_win + (size_t)slot * DM * 2608 : (kind == 1 ? p.hg_win + (size_t)slot * DM * 4096 : p.swa_win + (size_t)slot * DM * 1280);
      const int ldn = kind == 0 ? 2608 : (kind == 1 ? 4096 : 1280);
      float* cbase = (float*)(ws + C_IN);
      conv_strip(wv, lds, src, ldn, DM, s * 64, ldn, (bf16_t*)(ws + W_IN), s * 64, lg, lbias, cbase, cbase + 4096);
    } else if (j < 208 + nin + 16) {
      const int s = j - 208 - nin;
      const float* src = kind == 0 ? p.nsa_wout + (size_t)slot * DM * DM : (kind == 1 ? p.hg_wout + (size_t)slot * DM * DM : p.swa_wout + (size_t)slot * DM * DM);
      conv_strip(wv, lds, src, DM, DM, s * 64, DM, (bf16_t*)(ws + W_OUT), s * 64, nullptr, nullptr, nullptr, nullptr);
    } else {
      const int s = j - 208 - nin - 16;
      if (s < 4) { const int kv = s >> 1, st = s & 1; float* pb = (float*)(ws + C_POSB) + kv * 256;
        conv_strip(wv, lds, p.nsa_w1 + ((size_t)slot * 2 + kv) * 2048 * 128, 128, 2048, st * 64, 128, (bf16_t*)(ws + W_W1T) + (size_t)kv * 128 * 2048, st * 64, nullptr, p.nsa_pos + ((size_t)slot * 2 + kv) * 2048, pb + 128, pb); }
      else { const int kv = s - 4; conv_strip(wv, lds, p.nsa_w2 + ((size_t)slot * 2 + kv) * 128 * 64, 64, 128, 0, 64, (bf16_t*)(ws + W_W2T) + (size_t)kv * 64 * 128, 0, nullptr, nullptr, nullptr, nullptr); }
    }
  }
}

DI void init_phase(int wv, const P& p) {
  int tid_ = wv * 64 + lane_id_(); asm volatile("" : "+v"(tid_)); const size_t gtid = (size_t)blockIdx.x * 512 + tid_, gsz = (size_t)gridDim.x * 512;
  for (size_t i = gtid; i < (4 * MiB) / 16; i += gsz) ((f32x4*)(p.ws + WS_STATS))[i] = (f32x4){0.f, 0.f, 0.f, 0.f};
  for (size_t i = gtid; i < (size_t)MTOK * DM / 4; i += gsz) { const f32x4 v = ((const f32x4*)p.x)[i]; u32x2 w; w.x = pk2(v[0], v[1]); w.y = pk2(v[2], v[3]); ((u32x2*)(p.ws + WS_TB))[i] = w; }
  if (gtid < 16 * 132) { const int hd = (int)gtid / 132, d = (int)gtid % 132; int bk;
    if (d < 16) bk = d; else { const float v = logf((float)d / 16.0f) / 2.0794415416798357f * 16.0f; bk = 16 + (int)v; if (bk > 31 || d >= 128) bk = 31; }
    ((float*)(p.ws + C_BTAB))[gtid] = p.rel_bias[bk * 16 + hd]; }
  if (gtid < 1024) { const float a0 = p.hg_lb[gtid], a1 = p.hg_lb[1024 + gtid], a2 = p.hg_lb[2048 + gtid], a3 = p.hg_lb[3072 + gtid];
    const float mx = fmaxf(fmaxf(a0, a1), fmaxf(a2, a3)); const float e0 = expf(a0 - mx), e1 = expf(a1 - mx), e2 = expf(a2 - mx), e3 = expf(a3 - mx);
    ((float*)(p.ws + C_LBV))[gtid] = e1 / (e0 + e1 + e2 + e3); }
}

DI void final_ln(int wv, const P& p, const float* stats, const float* g, const float* b) {
  int tid_ = wv * 64 + lane_id_(); asm volatile("" : "+v"(tid_)); const size_t gtid = (size_t)blockIdx.x * 512 + tid_, gsz = (size_t)gridDim.x * 512;
  for (size_t i = gtid; i < (size_t)MTOK * DM / 4; i += gsz) {
    const int row = (int)(i >> 8), c = (int)(i & 255) * 4; float a, bb, mu, rstd; row_affine(stats, row, a, bb, mu, rstd);
    const f32x4 v = ((const f32x4*)p.out)[i]; ((f32x4*)p.out)[i] = (v - mu) * rstd * (*(const f32x4*)(g + c)) + *(const f32x4*)(b + c);
  }
}
#define MFMA32(a, b, c) __builtin_amdgcn_mfma_f32_32x32x16_bf16((a), (b), (c), 0, 0, 0)
#define MFMA16(a, b, c) __builtin_amdgcn_mfma_f32_16x16x32_bf16((a), (b), (c), 0, 0, 0)
DI int crow(int reg, int h) { return (reg & 3) + 8 * (reg >> 2) + 4 * h; }
constexpr int KS_STRIDE = 72;

struct KVRegs { u32x4 k; bf16x8 v; };
DI void kv_load(KVRegs& r, const bf16_t* kg, const bf16_t* vg, size_t ldg, int tid) {
  asm volatile("" : "+v"(tid));
  const int key = tid >> 3, d8 = (tid & 7) * 8;
  r.k = *(const u32x4*)(kg + (size_t)key * ldg + d8); r.v = *(const bf16x8*)(vg + (size_t)key * ldg + d8);
}
DI void kv_store(const KVRegs& r, LAS bf16_t* Ks, LAS bf16_t* Vt, int vstride, int vcol0, int tid) {
  asm volatile("" : "+v"(tid));
  const int key = tid >> 3, d8 = (tid & 7) * 8;
  *(LAS u32x4*)(Ks + key * KS_STRIDE + d8) = r.k;
#pragma unroll
  for (int i = 0; i < 8; ++i) Vt[(d8 + i) * vstride + vcol0 + key] = (bf16_t)r.v[i];
}
DI void attn_scores(const LAS bf16_t* Ks, const bf16x8 (&qf)[4], int r, int h, f32x16 (&s)[2]) {
#pragma unroll
  for (int sub = 0; sub < 2; ++sub) {
    f32x16 a;
#pragma unroll
    for (int i = 0; i < 16; ++i) a[i] = 0.f;
#pragma unroll
    for (int ks = 0; ks < 4; ++ks) { const bf16x8 kf = *(const LAS bf16x8*)(Ks + (sub * 32 + r) * KS_STRIDE + ks * 16 + 8 * h); a = MFMA32(kf, qf[ks], a); }
    s[sub] = a;
  }
}
constexpr float QK_SCALE2 = 0.125f * 1.4426950408889634f;
DI void attn_logits(f32x16 (&s)[2], int t, int tw, int nt, int h, int base, int stride, int dmax, bool ok, const LAS float* btl) {
  const int dmin = tw - (base + 63 * stride), dmaxw = tw + nt - 1 - base;
  const bool far = dmin >= 128, interior = dmin >= 0 && dmaxw < dmax;
  const float bfar = btl[128];
  if (far && interior) {
#pragma unroll
    for (int sub = 0; sub < 2; ++sub)
#pragma unroll
      for (int reg = 0; reg < 16; ++reg) s[sub][reg] = ok ? s[sub][reg] * QK_SCALE2 + bfar : -1e30f;
  } else {
#pragma unroll
    for (int sub = 0; sub < 2; ++sub)
#pragma unroll
      for (int reg = 0; reg < 16; ++reg) {
        const int kk = sub * 32 + crow(reg, h); const int d = t - (base + kk * stride);
        const bool valid = (d >= 0) && (d < dmax) && ok;
        float bias; if (far) bias = bfar; else { const int di = d < 0 ? 0 : (d > 128 ? 128 : d); bias = btl[di]; }
        s[sub][reg] = valid ? s[sub][reg] * QK_SCALE2 + bias : -1e30f;
      }
  }
}
DI void attn_pv(const LAS bf16_t* Vt, int vstride, const f32x16 (&p)[2], f32x16 (&O)[2], int r, int h) {
#pragma unroll
  for (int sub = 0; sub < 2; ++sub)
#pragma unroll
    for (int s2 = 0; s2 < 2; ++s2) {
      u32x4 pp;
#pragma unroll
      for (int j = 0; j < 4; ++j) pp[j] = pk2(p[sub][8 * s2 + 2 * j], p[sub][8 * s2 + 2 * j + 1]);
      const bf16x8 pf = __builtin_bit_cast(bf16x8, pp);
#pragma unroll
      for (int dt = 0; dt < 2; ++dt) {
        const LAS bf16_t* vp = Vt + (dt * 32 + r) * vstride + sub * 32 + 16 * s2 + 4 * h;
        const s16x4 lo = *(const LAS s16x4*)vp, hi = *(const LAS s16x4*)(vp + 8);
        const bf16x8 vf = __builtin_shufflevector(lo, hi, 0, 1, 2, 3, 4, 5, 6, 7);
        O[dt] = MFMA32(vf, pf, O[dt]);
      }
    }
}
template <bool WITH_O>
DI void attn_online(f32x16 (&s)[2], float& m, float& l, f32x16 (&O)[2]) {
  float mx = -1e30f;
#pragma unroll
  for (int sub = 0; sub < 2; ++sub)
#pragma unroll
    for (int reg = 0; reg < 16; ++reg) mx = fmaxf(mx, s[sub][reg]);
  mx = fmaxf(mx, __shfl_xor(mx, 32));
  const float mn = fmaxf(m, mx);
  const bool grow = mn > m;
  float ls = 0.f;
#pragma unroll
  for (int sub = 0; sub < 2; ++sub)
#pragma unroll
    for (int reg = 0; reg < 16; ++reg) { const float e = __builtin_amdgcn_exp2f(s[sub][reg] - mn); s[sub][reg] = e; ls += e; }
  if (__any(grow)) {
    const float al = __builtin_amdgcn_exp2f(m - mn); m = mn;
    l = l * al + ls;
    if (WITH_O) {
#pragma unroll
      for (int dt = 0; dt < 2; ++dt)
#pragma unroll
        for (int reg = 0; reg < 16; ++reg) O[dt][reg] *= al;
    }
  } else l += ls;
}
DI void attn_tile(const LAS bf16_t* Ks, const LAS bf16_t* Vt, int vstride, const bf16x8 (&qf)[4], f32x16 (&O)[2], float& m, float& l,
                  int t, int tw, int nt, int r, int h, int base, int stride, int dmax, bool ok, const LAS float* btl) {
  f32x16 s[2];
  attn_scores(Ks, qf, r, h, s);
  attn_logits(s, t, tw, nt, h, base, stride, dmax, ok, btl);
  attn_online<true>(s, m, l, O);
  attn_pv(Vt, vstride, s, O, r, h);
}
DI void zero_o(f32x16 (&O)[2]) {
#pragma unroll
  for (int dt = 0; dt < 2; ++dt)
#pragma unroll
    for (int reg = 0; reg < 16; ++reg) O[dt][reg] = 0.f;
}

DI void nsa_compress_phase(int wv, const P& p, LAS unsigned char* lds) {
  const bf16_t* hb = (const bf16_t*)(p.ws + WS_BIG); const int ld = 2816;
  int tid_ = wv * 64 + lane_id_(); asm volatile("" : "+v"(tid_)); const int tid = tid_, wid = tid >> 6, lane = tid & 63, fr = lane & 15, fq = lane >> 4;
  LAS bf16_t* hid = (LAS bf16_t*)lds + wid * 16 * 136;
  for (int base = blockIdx.x * 8; base < 1024; base += gridDim.x * 8) {
    const int task = base + wid;
    const int kv = task >> 9, b = (task >> 6) & 7, g = (task >> 4) & 3, n0 = (task & 15) * 16;
    const bf16_t* w1t = (const bf16_t*)(p.ws + W_W1T) + (size_t)kv * 128 * 2048; const bf16_t* w2t = (const bf16_t*)(p.ws + W_W2T) + (size_t)kv * 64 * 128;
    const float* posb = (const float*)(p.ws + C_POSB) + kv * 256;
    const int colb = 1024 + kv * 256 + g * 64;
    int n = n0 + fr; if (n > 254) n = 254;
    f32x4 acc[8];
#pragma unroll
    for (int i = 0; i < 8; ++i) acc[i] = (f32x4){0.f, 0.f, 0.f, 0.f};
    for (int l = 0; l < 32; ++l) {
#pragma unroll
      for (int dk = 0; dk < 2; ++dk) {
        const bf16x8 af = *(const bf16x8*)(hb + (size_t)(b * SEQ + 16 * n + l) * ld + colb + dk * 32 + fq * 8);
#pragma unroll
        for (int nt = 0; nt < 8; ++nt) { const bf16x8 bfr = *(const bf16x8*)(w1t + (size_t)(nt * 16 + fr) * 2048 + l * 64 + dk * 32 + fq * 8); acc[nt] = MFMA16(af, bfr, acc[nt]); }
      }
    }
#pragma unroll
    for (int nt = 0; nt < 8; ++nt) { const float pbv = posb[nt * 16 + fr];
#pragma unroll
      for (int j = 0; j < 4; ++j) { const float v = acc[nt][j] + pbv; const float u = 0.7978845608028654f * (v + 0.044715f * v * v * v); const float th = 1.0f - 2.0f / (1.0f + __expf(2.0f * u));
        hid[(4 * fq + j) * 136 + nt * 16 + fr] = f2bf(0.5f * v * (1.0f + th)); } }
    __syncthreads();
    f32x4 o[4];
#pragma unroll
    for (int i = 0; i < 4; ++i) o[i] = (f32x4){0.f, 0.f, 0.f, 0.f};
#pragma unroll
    for (int ks = 0; ks < 4; ++ks) { const bf16x8 af = *(const LAS bf16x8*)(hid + fr * 136 + ks * 32 + fq * 8);
#pragma unroll
      for (int nt = 0; nt < 4; ++nt) { const bf16x8 bfr = *(const bf16x8*)(w2t + (size_t)(nt * 16 + fr) * 128 + ks * 32 + fq * 8); o[nt] = MFMA16(af, bfr, o[nt]); } }
    bf16_t* dst = (bf16_t*)(p.ws + (kv ? WS_VC : WS_KC)) + (size_t)((b * 4 + g) * 256) * 64;
#pragma unroll
    for (int nt = 0; nt < 4; ++nt)
#pragma unroll
      for (int j = 0; j < 4; ++j) { const int nn = n0 + 4 * fq + j; dst[(size_t)nn * 64 + nt * 16 + fr] = nn > 254 ? (bf16_t)0 : f2bf(o[nt][j]); }
    __syncthreads();
  }
}

DI void nsa_attn_phase(int wv, const P& p, LAS unsigned char* lds) {
  const bf16_t* hb = (const bf16_t*)(p.ws + WS_BIG); const int ld = 2816;
  bf16_t* ob = (bf16_t*)(p.ws + WS_O);
  LAS bf16_t* KsB[2] = {(LAS bf16_t*)lds, (LAS bf16_t*)(lds + 17920)}; LAS bf16_t* VtB[2] = {(LAS bf16_t*)(lds + 9216), (LAS bf16_t*)(lds + 17920 + 9216)};
  LAS bf16_t* KC = (LAS bf16_t*)(lds + 35840); LAS bf16_t* VCT = (LAS bf16_t*)(lds + 72704);
  LAS float* OUTL = (LAS float*)(lds + 35840);
  LAS float* G4s = (LAS float*)(lds + 105984); LAS float* Lsm = (LAS float*)(lds + 122368); LAS float* BT = (LAS float*)(lds + 138752);
  LAS unsigned* SELM = (LAS unsigned*)(lds + 140864); LAS unsigned* UNI = (LAS unsigned*)(lds + 141376);
  for (int it = blockIdx.x; it < 2048; it += gridDim.x) {
    int tid_ = wv * 64 + lane_id_(); asm volatile("" : "+v"(tid_)); const int tid = tid_, wid = wv, lane = tid & 63, r = lane & 31, h = lane >> 5, tl = r >> 2, hd = r & 3;
    const int c = it & 255, ii = it >> 8, bg = c >> 3, b = bg >> 2, g = bg & 3, j8 = c & 7;
    const int qi = (ii & 1) ? (16 * (ii >> 1) + 15 - j8) : (16 * (ii >> 1) + j8);
    const int t0 = 64 * qi, tw = t0 + 8 * wid, t = tw + tl, head = g * 4 + hd;
    const int nct = (4 * qi + 2) / 64 + 1;
    __syncthreads();
    { KVRegs ka, kb; const bf16_t* kcg = (const bf16_t*)(p.ws + WS_KC) + (size_t)((b * 4 + g) * 256) * 64; const bf16_t* vcg = (const bf16_t*)(p.ws + WS_VC) + (size_t)((b * 4 + g) * 256) * 64;
      kv_load(ka, kcg, vcg, 64, tid); if (nct > 1) kv_load(kb, kcg + 64 * 64, vcg + 64 * 64, 64, tid);
      kv_store(ka, KC, VCT, 260, 0, tid); if (nct > 1) kv_store(kb, KC + 64 * KS_STRIDE, VCT, 260, 64, tid);
      if (nct > 2) { kv_load(ka, kcg + 128 * 64, vcg + 128 * 64, 64, tid); if (nct > 3) kv_load(kb, kcg + 192 * 64, vcg + 192 * 64, 64, tid);
        kv_store(ka, KC + 128 * KS_STRIDE, VCT, 260, 128, tid); if (nct > 3) kv_store(kb, KC + 192 * KS_STRIDE, VCT, 260, 192, tid); } }
    for (int i = tid; i < 4 * 132; i += 512) BT[i] = ((const float*)(p.ws + C_BTAB))[g * 4 * 132 + i] * 1.4426950408889634f;
    if (tid < 128) SELM[tid] = 0u; if (tid < 2) UNI[tid] = 0u;
    bf16x8 qf[4];
#pragma unroll
    for (int ks = 0; ks < 4; ++ks) qf[ks] = *(const bf16x8*)(hb + (size_t)(b * SEQ + t) * ld + head * 64 + ks * 16 + 8 * h);
    const size_t rowoff = (size_t)(b * SEQ + t) * ld;
    const float gc = sigmoidf_(bf2f(hb[rowoff + 2560 + head * 3 + 0])), gs = sigmoidf_(bf2f(hb[rowoff + 2560 + head * 3 + 1])), gw = sigmoidf_(bf2f(hb[rowoff + 2560 + head * 3 + 2]));
    const LAS float* btl = BT + hd * 132;
    KVRegs kvr; { const size_t go = (size_t)(b * SEQ) * ld + g * 64; kv_load(kvr, hb + go + 1536, hb + go + 1792, ld, tid); }
    __syncthreads();
    f32x16 O[2];
    float m = -1e30f, l = 0.f;
#pragma unroll 1
    for (int tile = 0; tile < nct; ++tile) { f32x16 s[2]; attn_scores(KC + tile * 64 * KS_STRIDE, qf, r, h, s); attn_logits(s, t, tw, 8, h, 16 * (tile * 64) + 31, 16, 0x7fffffff, true, btl); attn_online<false>(s, m, l, O); }
    { const float lt = l + __shfl_xor(l, 32); const float inv = (m > -1e29f && lt > 0.f) ? 1.0f / lt : 0.f;
      zero_o(O);
#pragma unroll 1
      for (int tile = 0; tile < nct; ++tile) {
        f32x16 s[2]; attn_scores(KC + tile * 64 * KS_STRIDE, qf, r, h, s); attn_logits(s, t, tw, 8, h, 16 * (tile * 64) + 31, 16, 0x7fffffff, true, btl);
        LAS float* gp = G4s + (8 * wid + tl) * 64 + 16 * tile + h; asm volatile("" : "+v"(gp));
#pragma unroll
        for (int sub = 0; sub < 2; ++sub) {
#pragma unroll
          for (int reg = 0; reg < 16; ++reg) { const float v = s[sub][reg]; s[sub][reg] = v > -1e29f ? __builtin_amdgcn_exp2f(v - m) * inv : 0.f; }
#pragma unroll
          for (int lg = 0; lg < 4; ++lg) { float G = s[sub][4 * lg] + s[sub][4 * lg + 1] + s[sub][4 * lg + 2] + s[sub][4 * lg + 3], Lv = s[sub][4 * lg + 3];
            G += __shfl_xor(G, 1); G += __shfl_xor(G, 2); Lv += __shfl_xor(Lv, 1); Lv += __shfl_xor(Lv, 2);
            if (hd == 0) { gp[8 * sub + 2 * lg] = G; gp[4096 + 8 * sub + 2 * lg] = Lv; } }
        }
        attn_pv(VCT + tile * 64, 260, s, O, r, h);
      }
    }
    __syncthreads();
#pragma unroll
    for (int dt = 0; dt < 2; ++dt)
#pragma unroll
      for (int reg = 0; reg < 16; ++reg) OUTL[(dt * 16 + reg) * 512 + tid] = gc * O[dt][reg];
    if (qi < 16) { const unsigned long long full = (qi == 63) ? ~0ull : ((1ull << (qi + 1)) - 1ull);
      int tsel = tid; asm volatile("" : "+v"(tsel));
      if (tsel < 64) { SELM[2 * tsel] = (unsigned)full; SELM[2 * tsel + 1] = (unsigned)(full >> 32); } if (tsel == 0) { UNI[0] = (unsigned)full; UNI[1] = (unsigned)(full >> 32); } }
    else {
      int tsel = tid; asm volatile("" : "+v"(tsel));
      const int tok = tsel >> 3, jj = tsel & 7, hiJ = qi - 2;
#pragma unroll
      for (int e = 0; e < 8; ++e) { const int j = jj * 8 + e; if (j >= 1 && j <= hiJ) G4s[tok * 64 + j] += Lsm[tok * 64 + j - 1]; }
      __syncthreads();
      float mine[8]; int cnt[8];
#pragma unroll
      for (int e = 0; e < 8; ++e) { const int j = jj * 8 + e; mine[e] = (j >= 1 && j <= hiJ) ? G4s[tok * 64 + j] : 0.f; cnt[e] = 0; }
      for (int j2 = 1; j2 <= hiJ; ++j2) { const float v = G4s[tok * 64 + j2];
#pragma unroll
        for (int e = 0; e < 8; ++e) { const int j = jj * 8 + e; cnt[e] += (v > mine[e] || (v == mine[e] && j2 < j)) ? 1 : 0; } }
      unsigned long long bits = 0ull;
#pragma unroll
      for (int e = 0; e < 8; ++e) { const int j = jj * 8 + e; if (j >= 1 && j <= hiJ && cnt[e] < 13) bits |= 1ull << j; }
      if (jj == 0) bits |= 1ull | (1ull << qi) | (1ull << (qi - 1));
      const unsigned blo = (unsigned)bits, bhi = (unsigned)(bits >> 32);
      if (blo) { atomicOr((unsigned*)&SELM[2 * tok], blo); atomicOr((unsigned*)&UNI[0], blo); }
      if (bhi) { atomicOr((unsigned*)&SELM[2 * tok + 1], bhi); atomicOr((unsigned*)&UNI[1], bhi); }
    }
    __syncthreads();
    int buf = 0;
    { const unsigned long long selm = (unsigned long long)SELM[2 * (8 * wid + tl)] | ((unsigned long long)SELM[2 * (8 * wid + tl) + 1] << 32);
      unsigned long long rem = (unsigned long long)UNI[0] | ((unsigned long long)UNI[1] << 32);
      m = -1e30f; l = 0.f; zero_o(O);
      const int jw0 = qi > 8 ? qi - 8 : 0;
#pragma unroll 1
      while (rem) {
        const int j = __builtin_ctzll(rem); rem &= rem - 1ull;
        kv_store(kvr, KsB[buf], VtB[buf], 68, 0, tid);
        __syncthreads();
        { const bool more = rem != 0ull; const int jn = more ? __builtin_ctzll(rem) : jw0;
          const size_t go = (size_t)(b * SEQ + jn * 64) * ld + g * 64; kv_load(kvr, hb + go + (more ? 1536 : 2048), hb + go + (more ? 1792 : 2304), ld, tid); }
        attn_tile(KsB[buf], VtB[buf], 68, qf, O, m, l, t, tw, 8, r, h, j * 64, 1, 0x7fffffff, ((selm >> j) & 1ull) != 0ull, btl);
        buf ^= 1;
      }
      const float lt = l + __shfl_xor(l, 32); const float sc = lt > 0.f ? gs / lt : 0.f;
#pragma unroll
      for (int dt = 0; dt < 2; ++dt)
#pragma unroll
        for (int reg = 0; reg < 16; ++reg) OUTL[(dt * 16 + reg) * 512 + tid] += sc * O[dt][reg];
    }
    { m = -1e30f; l = 0.f; zero_o(O);
#pragma unroll 1
      for (int j = (qi > 8 ? qi - 8 : 0); j <= qi; ++j) {
        kv_store(kvr, KsB[buf], VtB[buf], 68, 0, tid);
        __syncthreads();
        if (j < qi) { const size_t go = (size_t)(b * SEQ + (j + 1) * 64) * ld + g * 64; kv_load(kvr, hb + go + 2048, hb + go + 2304, ld, tid); }
        attn_tile(KsB[buf], VtB[buf], 68, qf, O, m, l, t, tw, 8, r, h, j * 64, 1, 512, true, btl);
        buf ^= 1;
      }
      const float lt = l + __shfl_xor(l, 32); const float sc = lt > 0.f ? gw / lt : 0.f;
#pragma unroll
      for (int dt = 0; dt < 2; ++dt)
#pragma unroll
        for (int reg = 0; reg < 16; ++reg) O[dt][reg] = OUTL[(dt * 16 + reg) * 512 + tid] + sc * O[dt][reg];
    }
    bf16_t* op = ob + (size_t)(b * SEQ + t) * DM + head * 64;
#pragma unroll
    for (int dt = 0; dt < 2; ++dt)
#pragma unroll
      for (int i4 = 0; i4 < 4; ++i4) { u32x2 w; w.x = pk2(O[dt][4 * i4], O[dt][4 * i4 + 1]); w.y = pk2(O[dt][4 * i4 + 2], O[dt][4 * i4 + 3]); *(u32x2*)(op + dt * 32 + 8 * i4 + 4 * h) = w; }
  }
}

DI void swa_attn_phase(int wv, const P& p, int slot, LAS unsigned char* lds) {
  const bf16_t* hb = (const bf16_t*)(p.ws + WS_BIG); const int ld = 1280;
  bf16_t* ob = (bf16_t*)(p.ws + WS_O);
  LAS bf16_t* KsB[2] = {(LAS bf16_t*)lds, (LAS bf16_t*)(lds + 17920)}; LAS bf16_t* VtB[2] = {(LAS bf16_t*)(lds + 9216), (LAS bf16_t*)(lds + 17920 + 9216)};
  LAS float* BT = (LAS float*)(lds + 35840);
  int tid_ = wv * 64 + lane_id_(); asm volatile("" : "+v"(tid_)); const int tid = tid_, wid = tid >> 6, lane = tid & 63, r = lane & 31, h = lane >> 5, tl = r >> 3, hd = r & 7;
  int buf = 0;
  for (int it = blockIdx.x; it < 2048; it += gridDim.x) {
    const int b = it >> 8, kv = (it >> 7) & 1, t0 = (it & 127) * 32;
    const int tw = t0 + 4 * wid, t = tw + tl, head = kv * 8 + hd;
    const int lo = t0 - 127, first = lo <= 0 ? 0 : (lo >> 6), last = (t0 + 31) >> 6;
    KVRegs kvr; { const size_t go = (size_t)(b * SEQ + first * 64) * ld + kv * 64; kv_load(kvr, hb + go + 1024, hb + go + 1152, ld, tid); }
    __syncthreads();
    for (int i = tid; i < 8 * 132; i += 512) BT[i] = ((const float*)(p.ws + C_BTAB))[kv * 8 * 132 + i] * 1.4426950408889634f;
    const size_t rowoff = (size_t)(b * SEQ + t) * ld;
    bf16x8 qf[4];
#pragma unroll
    for (int ks = 0; ks < 4; ++ks) qf[ks] = *(const bf16x8*)(hb + rowoff + head * 64 + ks * 16 + 8 * h);
    const LAS float* btl = BT + hd * 132;
    float m = p.swa_sinks[slot * 16 + head] * 1.4426950408889634f, l = (h == 0) ? 1.0f : 0.0f;
    f32x16 O[2]; zero_o(O);
#pragma unroll 1
    for (int j = first; j <= last; ++j) {
      kv_store(kvr, KsB[buf], VtB[buf], 68, 0, tid);
      __syncthreads();
      if (j < last) { const size_t go = (size_t)(b * SEQ + (j + 1) * 64) * ld + kv * 64; kv_load(kvr, hb + go + 1024, hb + go + 1152, ld, tid); }
      attn_tile(KsB[buf], VtB[buf], 68, qf, O, m, l, t, tw, 4, r, h, j * 64, 1, 128, true, btl);
      buf ^= 1;
    }
    const float lt = l + __shfl_xor(l, 32); const float sc = 1.0f / lt;
    bf16_t* op = ob + (size_t)(b * SEQ + t) * DM + head * 64;
#pragma unroll
    for (int dt = 0; dt < 2; ++dt)
#pragma unroll
      for (int i4 = 0; i4 < 4; ++i4) { u32x2 w; w.x = pk2(sc * O[dt][4 * i4], sc * O[dt][4 * i4 + 1]); w.y = pk2(sc * O[dt][4 * i4 + 2], sc * O[dt][4 * i4 + 3]); *(u32x2*)(op + dt * 32 + 8 * i4 + 4 * h) = w; }
  }
}
constexpr size_t HG_Q = WS_BIG, HG_K = WS_BIG + 64 * MiB, HG_V = WS_BIG + 128 * MiB, HG_G = WS_BIG + 192 * MiB, HG_LF = WS_BIG + 256 * MiB;
DI void hgrn_scan_phase(int wv, const P& p, LAS unsigned char* lds) {
  const bf16_t* hq = (const bf16_t*)(p.ws + HG_Q); const bf16_t* hk = (const bf16_t*)(p.ws + HG_K); const bf16_t* hv = (const bf16_t*)(p.ws + HG_V);
  const _Float16* hlf = (const _Float16*)(p.ws + HG_LF);
  bf16_t* oraw = (bf16_t*)(p.ws + WS_TB); float* sumsq = (float*)(p.ws + WS_SUMSQ);
  LAS bf16_t* Q = (LAS bf16_t*)lds; LAS bf16_t* Kr = (LAS bf16_t*)(lds + 17408); LAS float* BC = (LAS float*)(lds + 34816); LAS bf16_t* KDT = (LAS bf16_t*)(lds + 68608);
  LAS bf16_t* VT = (LAS bf16_t*)(lds + 87040); LAS bf16_t* ST = (LAS bf16_t*)(lds + 91648); LAS bf16_t* AB = (LAS bf16_t*)(lds + 100352);
  LAS float* SEG = (LAS float*)(lds + 109568); LAS float* DEC = (LAS float*)(lds + 111616); LAS _Float16* LF = (LAS _Float16*)(lds + 112128);
  int tid_ = wv * 64 + lane_id_(); asm volatile("" : "+v"(tid_)); const int tid = tid_, wid = tid >> 6, lane = tid & 63, fr = lane & 15, fq = lane >> 4;
  for (int it = blockIdx.x; it < 256; it += gridDim.x) {
    const int b = it >> 5, hh = (it >> 2) & 7, vq = it & 3;
    __syncthreads();
    for (int i = tid; i < 32 * 136 / 2; i += 512) ((LAS unsigned*)ST)[i] = 0u;
    f32x4 sreg[2]; sreg[0] = (f32x4){0.f, 0.f, 0.f, 0.f}; sreg[1] = sreg[0];
    u32x4 pq[2], pkk[2], plf[2], pv;
    const size_t gb = (size_t)(b * SEQ) * 1024 + hh * 128;
    auto prefetch = [&](int c) {
#pragma unroll
      for (int i = 0; i < 2; ++i) { const int idx = tid + 512 * i, row = idx >> 4, c8 = (idx & 15) * 8; const size_t off = gb + (size_t)(c * 64 + row) * 1024 + c8;
        pq[i] = *(const u32x4*)(hq + off); pkk[i] = *(const u32x4*)(hk + off); plf[i] = *(const u32x4*)(hlf + off); }
      if (tid < 256) { const int row = tid >> 2, c8 = (tid & 3) * 8; pv = *(const u32x4*)(hv + gb + (size_t)(c * 64 + row) * 1024 + vq * 32 + c8); }
    };
    prefetch(0);
    for (int c = 0; c < 64; ++c) {
      __syncthreads();
#pragma unroll
      for (int i = 0; i < 2; ++i) { const int idx = tid + 512 * i, row = idx >> 4, c8 = (idx & 15) * 8;
        *(LAS u32x4*)(Q + row * 136 + c8) = pq[i]; *(LAS u32x4*)(Kr + row * 136 + c8) = pkk[i]; *(LAS u32x4*)(LF + row * 128 + c8) = plf[i]; }
      if (tid < 256) { const int row = tid >> 2, c8 = (tid & 3) * 8; const bf16x8 vv = __builtin_bit_cast(bf16x8, pv);
#pragma unroll
        for (int i = 0; i < 8; ++i) VT[(c8 + i) * 72 + row] = (bf16_t)vv[i]; }
      if (c + 1 < 64) prefetch(c + 1);
      __syncthreads();
      const int kx = tid & 127, seg = tid >> 7;
      float bl[16];
      { float run = 0.f;
#pragma unroll
        for (int i = 0; i < 16; ++i) { run += (float)LF[(16 * seg + i) * 128 + kx]; bl[i] = run; }
        SEG[seg * 128 + kx] = run; }
      __syncthreads();
      { float pre = 0.f, blast = 0.f;
#pragma unroll
        for (int s2 = 0; s2 < 4; ++s2) { const float v = SEG[s2 * 128 + kx]; blast += v; if (s2 < seg) pre += v; }
        u32x4 w0, w1; float kd[16];
#pragma unroll
        for (int i = 0; i < 16; ++i) { const float bc = pre + bl[i]; BC[(16 * seg + i) * 132 + kx] = bc; kd[i] = bf2f(Kr[(16 * seg + i) * 136 + kx]) * __expf(blast - bc); }
#pragma unroll
        for (int j = 0; j < 4; ++j) { w0[j] = pk2(kd[2 * j], kd[2 * j + 1]); w1[j] = pk2(kd[8 + 2 * j], kd[8 + 2 * j + 1]); }
        *(LAS u32x4*)(KDT + kx * 72 + 16 * seg) = w0; *(LAS u32x4*)(KDT + kx * 72 + 16 * seg + 8) = w1;
        if (seg == 0) DEC[kx] = __expf(blast); }
      __syncthreads();
      const int mt = wid >> 1, vt = wid & 1;
      f32x4 oacc = (f32x4){0.f, 0.f, 0.f, 0.f}, a0 = oacc, a1 = oacc;
      const int J0 = 2 * vt;
#pragma unroll
      for (int ks = 0; ks < 4; ++ks) {
        const int kb = 32 * ks + 8 * fq, trow = 16 * mt + fr;
        const bf16x8 qv = *(const LAS bf16x8*)(Q + trow * 136 + kb);
        const f32x4 bc0 = *(const LAS f32x4*)(BC + trow * 132 + kb), bc1 = *(const LAS f32x4*)(BC + trow * 132 + kb + 4);
        const f32x4 r0 = *(const LAS f32x4*)(BC + (16 * mt) * 132 + kb), r1 = *(const LAS f32x4*)(BC + (16 * mt) * 132 + kb + 4);
        u32x4 ai, aq;
#pragma unroll
        for (int j = 0; j < 4; ++j) {
          const float q0 = bf2f((bf16_t)qv[2 * j]), q1 = bf2f((bf16_t)qv[2 * j + 1]);
          const float b0 = j < 2 ? bc0[2 * j] : bc1[2 * j - 4], b1 = j < 2 ? bc0[2 * j + 1] : bc1[2 * j - 3];
          const float rr0 = j < 2 ? r0[2 * j] : r1[2 * j - 4], rr1 = j < 2 ? r0[2 * j + 1] : r1[2 * j - 3];
          ai[j] = pk2(q0 * __expf(b0), q1 * __expf(b1)); aq[j] = pk2(q0 * __expf(b0 - rr0), q1 * __expf(b1 - rr1));
        }
        const bf16x8 sb = *(const LAS bf16x8*)(ST + (16 * vt + fr) * 136 + kb);
        oacc = MFMA16(__builtin_bit_cast(bf16x8, ai), sb, oacc);
#pragma unroll
        for (int jj = 0; jj < 2; ++jj) {
          const int J = J0 + jj; if (J > mt) continue;
          const int srow = 16 * J + fr;
          const bf16x8 kv = *(const LAS bf16x8*)(Kr + srow * 136 + kb);
          const f32x4 c0 = *(const LAS f32x4*)(BC + srow * 132 + kb), c1 = *(const LAS f32x4*)(BC + srow * 132 + kb + 4);
          u32x4 bk;
#pragma unroll
          for (int j = 0; j < 4; ++j) {
            const float k0 = bf2f((bf16_t)kv[2 * j]), k1 = bf2f((bf16_t)kv[2 * j + 1]);
            const float b0 = j < 2 ? c0[2 * j] : c1[2 * j - 4], b1 = j < 2 ? c0[2 * j + 1] : c1[2 * j - 3];
            const float rr0 = j < 2 ? r0[2 * j] : r1[2 * j - 4], rr1 = j < 2 ? r0[2 * j + 1] : r1[2 * j - 3];
            bk[j] = pk2(k0 * __expf(fminf(rr0 - b0, 80.f)), k1 * __expf(fminf(rr1 - b1, 80.f)));
          }
          if (jj == 0) a0 = MFMA16(__builtin_bit_cast(bf16x8, aq), __builtin_bit_cast(bf16x8, bk), a0);
          else a1 = MFMA16(__builtin_bit_cast(bf16x8, aq), __builtin_bit_cast(bf16x8, bk), a1);
        }
      }
#pragma unroll
      for (int jj = 0; jj < 2; ++jj) { const int J = J0 + jj;
#pragma unroll
        for (int reg = 0; reg < 4; ++reg) { const int tt = 16 * mt + 4 * fq + reg, ss = 16 * J + fr; const float v = jj == 0 ? a0[reg] : a1[reg];
          AB[tt * 72 + ss] = (J <= mt && ss <= tt) ? f2bf(v) : (bf16_t)0; } }
      __syncthreads();
#pragma unroll
      for (int k2 = 0; k2 < 2; ++k2) {
        const bf16x8 af = *(const LAS bf16x8*)(AB + (16 * mt + fr) * 72 + 32 * k2 + 8 * fq);
        const bf16x8 vb = *(const LAS bf16x8*)(VT + (16 * vt + fr) * 72 + 32 * k2 + 8 * fq);
        oacc = MFMA16(af, vb, oacc);
      }
#pragma unroll
      for (int reg = 0; reg < 4; ++reg) {
        const int tok = b * SEQ + c * 64 + 16 * mt + 4 * fq + reg; const float v = oacc[reg];
        oraw[(size_t)tok * 1024 + hh * 128 + vq * 32 + 16 * vt + fr] = f2bf(v);
        float sq = v * v; sq += __shfl_xor(sq, 1); sq += __shfl_xor(sq, 2); sq += __shfl_xor(sq, 4); sq += __shfl_xor(sq, 8);
        if (fr == 0) atomicAdd(sumsq + (size_t)tok * 8 + hh, sq);
      }
      { const f32x4 dc = *(const LAS f32x4*)(DEC + 16 * wid + 4 * fq);
        sreg[0] *= dc; sreg[1] *= dc;
#pragma unroll
        for (int k2 = 0; k2 < 2; ++k2) {
          const bf16x8 af = *(const LAS bf16x8*)(KDT + (16 * wid + fr) * 72 + 32 * k2 + 8 * fq);
#pragma unroll
          for (int v2 = 0; v2 < 2; ++v2) { const bf16x8 vb = *(const LAS bf16x8*)(VT + (16 * v2 + fr) * 72 + 32 * k2 + 8 * fq); sreg[v2] = MFMA16(af, vb, sreg[v2]); }
        }
#pragma unroll
        for (int v2 = 0; v2 < 2; ++v2) { u32x2 w; w.x = pk2(sreg[v2][0], sreg[v2][1]); w.y = pk2(sreg[v2][2], sreg[v2][3]); *(LAS u32x2*)(ST + (16 * v2 + fr) * 136 + 16 * wid + 4 * fq) = w; }
      }
    }
  }
}
DI void hgrn_norm_phase(int wv, const P& p, int slot) {
  const bf16_t* oraw = (const bf16_t*)(p.ws + WS_TB); const bf16_t* hg = (const bf16_t*)(p.ws + HG_G); const float* sumsq = (const float*)(p.ws + WS_SUMSQ);
  bf16_t* ob = (bf16_t*)(p.ws + WS_O); const float* gain = p.hg_gain + slot * 128;
  int tid_ = wv * 64 + lane_id_(); asm volatile("" : "+v"(tid_)); const size_t gtid = (size_t)blockIdx.x * 512 + tid_, gsz = (size_t)gridDim.x * 512;
  for (size_t i = gtid; i < (size_t)MTOK * 1024 / 8; i += gsz) {
    const size_t e = i * 8; const int row = (int)(e >> 10), col = (int)(e & 1023), hh = col >> 7, vv = col & 127;
    const float rs = rsqrtf(sumsq[(size_t)row * 8 + hh] * (1.0f / 128.0f) + 1e-6f);
    const bf16x8 o8 = *(const bf16x8*)(oraw + e), g8 = *(const bf16x8*)(hg + e);
    u32x4 w;
#pragma unroll
    for (int j = 0; j < 4; ++j) w[j] = pk2(bf2f((bf16_t)o8[2 * j]) * rs * gain[vv + 2 * j] * bf2f((bf16_t)g8[2 * j]), bf2f((bf16_t)o8[2 * j + 1]) * rs * gain[vv + 2 * j + 1] * bf2f((bf16_t)g8[2 * j + 1]));
    *(u32x4*)(ob + e) = w;
  }
}
#ifndef SKIP_MIXERS
#define SKIP_MIXERS 0
#endif
__global__ void __launch_bounds__(512, 2) mega_fwd(P p) {
  extern __shared__ __attribute__((aligned(16))) unsigned char lds_raw[];
  LAS unsigned char* lds = (LAS unsigned char*)lds_raw;
  cg::grid_group grid = cg::this_grid();
  const int wv = __builtin_amdgcn_readfirstlane((int)(threadIdx.x >> 6));
  volatile LAS unsigned* xst = (volatile LAS unsigned*)(lds + LDS_BYTES - 16);
  if (wv == 0 && lane_id_() < 4) xst[lane_id_()] = 0u;
  __syncthreads();
  const XcdBarrier xb = xcd_barrier_post(wv, (unsigned*)(p.ws + WS_BAR), xst);
#define GSYNC() xcd_barrier(wv, xb)
  unsigned char* ws = p.ws;
  float* stats = (float*)(ws + WS_STATS);
  bf16_t* tb = (bf16_t*)(ws + WS_TB); bf16_t* Hb = (bf16_t*)(ws + WS_BIG); bf16_t* ob = (bf16_t*)(ws + WS_O);
  init_phase(wv, p);
  for (int L = 0; L < 4; ++L) {
    convert_phase(wv, p, L, lds);
    if (L == 0) grid.sync(); else GSYNC();
    const int kind = L % 3, slot = L / 3;
    for (int s = 0; s < 3; ++s) {
      const int lnp = L * 3 + s - 1;
      const float* stp = lnp >= 0 ? stats + (size_t)lnp * MTOK * 2 : nullptr;
      pg8::Gemm gr; float scale;
      if (s != 1) {
        pg8::Gemm g; g.A = tb; g.Bt = (const bf16_t*)(ws + (s == 0 ? W_GU1 : W_GU2)); g.M = MTOK; g.N = 5632; g.K = DM;
        pg8::StaticOrder S; S.init(g.M, g.N, gridDim.x, blockIdx.x);
        EpiUp E; E.H = Hb; E.stats = stp; E.c1 = (const float*)(ws + (s == 0 ? C_GU1 : C_GU2)); E.c2 = E.c1 + 5632;
        pg8::gemm_phase(wv, lds, g, S, E);
        GSYNC();
        gr.A = Hb; gr.Bt = (const bf16_t*)(ws + (s == 0 ? W_D1 : W_D2)); gr.M = MTOK; gr.N = DM; gr.K = DFF; scale = 0.5f;
      } else {
        pg8::Gemm g; g.A = tb; g.Bt = (const bf16_t*)(ws + W_IN); g.M = MTOK; g.N = kind == 0 ? 2816 : (kind == 1 ? 4096 : 1280); g.K = DM;
        pg8::StaticOrder S; S.init(g.M, g.N, gridDim.x, blockIdx.x);
        EpiIn E; E.mode = kind == 1 ? 1 : 0; E.h = Hb; E.ld = g.N; E.stats = stp; E.c1 = (const float*)(ws + C_IN); E.c2 = E.c1 + 4096; E.lbv = (const float*)(ws + C_LBV);
        E.hq = (bf16_t*)(ws + HG_Q); E.hk = (bf16_t*)(ws + HG_K); E.hv = (bf16_t*)(ws + HG_V); E.hg = (bf16_t*)(ws + HG_G); E.hlf = (_Float16*)(ws + HG_LF);
        pg8::gemm_phase(wv, lds, g, S, E);
        GSYNC();
#if !SKIP_MIXERS
        if (kind == 0) {
#ifndef NO_CMP
          nsa_compress_phase(wv, p, lds);
#endif
          GSYNC();
#ifndef NO_NSA
          nsa_attn_phase(wv, p, lds);
#endif
        }
        else if (kind == 1) {
#ifndef NO_HGRN
          hgrn_scan_phase(wv, p, lds);
#endif
          GSYNC(); hgrn_norm_phase(wv, p, slot); }
        else {
#ifndef NO_SWA
          swa_attn_phase(wv, p, slot, lds);
#endif
        }
#endif
        GSYNC();
        gr.A = ob; gr.Bt = (const bf16_t*)(ws + W_OUT); gr.M = MTOK; gr.N = DM; gr.K = DM; scale = 1.0f;
      }
      pg8::StaticOrder S2; S2.init(gr.M, gr.N, gridDim.x, blockIdx.x);
      EpiRes R; R.T = p.out; R.Tin = lnp >= 0 ? p.out : p.x; R.stats_prev = stp; R.g = p.ln_gain + (size_t)(lnp >= 0 ? lnp : 0) * DM; R.b = p.ln_bias + (size_t)(lnp >= 0 ? lnp : 0) * DM;
      R.stats_new = stats + (size_t)(lnp + 1) * MTOK * 2; R.tb = tb; R.scale = scale;
      pg8::gemm_phase(wv, lds, gr, S2, R);
      GSYNC();
    }
  }
  final_ln(wv, p, stats + (size_t)11 * MTOK * 2, p.ln_gain + 11 * DM, p.ln_bias + 11 * DM);
}

extern "C" void kernel_launch(void* const* d_in, const int* in_sizes, int n_in, void* d_out, int out_size, void* d_ws, size_t ws_size, hipStream_t stream) {
  static int grid = 0;
  if (grid == 0) {
    if (n_in != 22 || ws_size < WS_END) { fprintf(stderr, "kernel_launch: unexpected n_in %d / ws_size %zu (need %zu)\n", n_in, ws_size, (size_t)WS_END); grid = -1; return; }
    int dev = 0, cus = 0, per_cu = 0;
    hipGetDevice(&dev); hipDeviceGetAttribute(&cus, hipDeviceAttributeMultiprocessorCount, dev);
    if (hipFuncSetAttribute((const void*)mega_fwd, hipFuncAttributeMaxDynamicSharedMemorySize, LDS_BYTES) != hipSuccess) { fprintf(stderr, "hipFuncSetAttribute failed\n"); grid = -1; return; }
    hipOccupancyMaxActiveBlocksPerMultiprocessor(&per_cu, (const void*)mega_fwd, 512, LDS_BYTES);
    if (per_cu < 1) { fprintf(stderr, "occupancy query says %d blocks/CU\n", per_cu); per_cu = 1; }
    (void)hipGetLastError();
    grid = cus * 1;
  }
  if (grid < 0) return;
  if (hipMemsetAsync((char*)d_ws + WS_BAR, 0, 16384, stream) != hipSuccess) { fprintf(stderr, "memset failed\n"); return; }
  P p{};
  const float** pp = (const float**)&p;
  for (int i = 0; i < 22; ++i) pp[i] = (const float*)d_in[i];
  p.out = (float*)d_out; p.ws = (unsigned char*)d_ws;
  void* args[] = {&p};
  hipError_t e = hipLaunchCooperativeKernel((const void*)mega_fwd, dim3(grid), dim3(512), args, LDS_BYTES, stream);
  if (e != hipSuccess) fprintf(stderr, "cooperative launch failed: %s (grid %d)\n", hipGetErrorString(e), grid);
}
```

```cpp
#include <hip/hip_runtime.h>
#include <hip/hip_cooperative_groups.h>
#include <cstdio>
namespace cg = cooperative_groups;

typedef unsigned short bf16_t;
typedef short bf16x8 __attribute__((ext_vector_type(8)));
typedef short s16x4 __attribute__((ext_vector_type(4)));
typedef float f32x4 __attribute__((ext_vector_type(4)));
typedef float f32x16 __attribute__((ext_vector_type(16)));
typedef unsigned u32x2 __attribute__((ext_vector_type(2)));
typedef unsigned u32x4 __attribute__((ext_vector_type(4)));
#define LAS __attribute__((address_space(3)))
#define DI __device__ __forceinline__

constexpr int MTOK = 32768, DM = 1024, DFF = 2816, SEQ = 4096, NB = 8;
constexpr float ALPHA = 1.681792830507429f;
constexpr size_t MiB = 1ull << 20;
constexpr size_t W_GU1 = 0, W_D1 = 11534336, W_GU2 = 17301504, W_D2 = 28835840, W_IN = 34603008, W_OUT = 42991616,
                 W_W1T = 45088768, W_W2T = 46137344, W_C = 46170112;
constexpr size_t C_GU1 = W_C, C_GU2 = C_GU1 + 2 * 5632 * 4, C_IN = C_GU2 + 2 * 5632 * 4, C_POSB = C_IN + 2 * 4096 * 4,
                 C_LBV = C_POSB + 2 * 256 * 4, C_BTAB = C_LBV + 1024 * 4, C_END = C_BTAB + 16 * 132 * 4;
constexpr size_t WS_TB = 48 * MiB, WS_BIG = 112 * MiB, WS_O = 432 * MiB, WS_MISC = 496 * MiB;
constexpr size_t WS_STATS = WS_MISC, WS_SUMSQ = WS_STATS + 3 * MiB, WS_KC = WS_SUMSQ + 1 * MiB, WS_VC = WS_KC + 1 * MiB, WS_BAR = WS_VC + 1 * MiB, WS_END = WS_BAR + 16384;
static_assert(C_END <= 48 * MiB, "weights region");
constexpr int LDS_BYTES = 144 * 1024;

struct P {
  const float *x, *rel_bias, *ln_gain, *ln_bias, *f1g, *f1u, *f1d, *f2g, *f2u, *f2d, *nsa_win, *nsa_wout, *nsa_pos, *nsa_w1, *nsa_w2,
      *hg_win, *hg_wout, *hg_gain, *hg_lb, *swa_win, *swa_wout, *swa_sinks;
  float* out; unsigned char* ws;
  int rep_nsa, rep_conv, rep_cmp, rep_misc, rep_down, rep_hg;
};

DI unsigned pk2(float a, float b) { typedef __bf16 bf2 __attribute__((ext_vector_type(2))); bf2 v; v[0] = (__bf16)a; v[1] = (__bf16)b; return __builtin_bit_cast(unsigned, v); }
DI bf16_t f2bf(float a) { return __builtin_bit_cast(unsigned short, (__bf16)a); }
DI float bf2f(bf16_t v) { return __uint_as_float(((unsigned)v) << 16); }
DI int lane_id_() { int l; asm volatile("v_mbcnt_lo_u32_b32 %0, -1, 0\n\tv_mbcnt_hi_u32_b32 %0, -1, %0" : "=v"(l)); return l; }
DI float sigmoidf_(float v) { return __builtin_amdgcn_rcpf(1.0f + __builtin_amdgcn_exp2f(-1.4426950408889634f * v)); }


#define XB_TMO      128
#define XB_XCNT(j)  (256  + 64 * (j))
#define XB_XSUB(j)  (1280 + 64 * (j))
#define XB_XGEN(j)  (2304 + 64 * (j))
#define XB_TOP      3328
#define XB_TOPGEN   3392
#define XCD_BAR_WORDS 3456
#define XB_SPIN_CAP (1u << 20)
DI unsigned xb_ld(unsigned* p)              { return __hip_atomic_load(p, __ATOMIC_RELAXED, __HIP_MEMORY_SCOPE_AGENT); }
DI unsigned xb_add(unsigned* p, unsigned v) { return __hip_atomic_fetch_add(p, v, __ATOMIC_RELAXED, __HIP_MEMORY_SCOPE_AGENT); }
DI unsigned xb_xcc_id() { return (unsigned)__builtin_amdgcn_s_getreg((3 << 11) | 20) & 0xFu; }
#define XB_SPIN(cond, bar) do { unsigned _sp = 0; while (cond) { __builtin_amdgcn_s_sleep(1); \
    if ((++_sp & 255u) == 0u) { if (xb_ld(&(bar)[XB_TMO])) break; if (_sp > XB_SPIN_CAP) { atomicAdd(&(bar)[XB_TMO], 1u); break; } } } } while (0)
struct XcdBarrier { unsigned* bar; unsigned x; volatile LAS unsigned* st; };
DI XcdBarrier xcd_barrier_post(int wv, unsigned* bar, volatile LAS unsigned* st) {
  XcdBarrier b; b.bar = bar; b.x = xb_xcc_id(); b.st = st;
  if (wv == 0 && lane_id_() == 0) (void)xb_add(&bar[XB_XCNT(b.x)], 1u);
  return b;
}
DI void xcd_barrier_complete(unsigned* bar, unsigned x, unsigned& nloc, unsigned& nx) {
  const unsigned G = gridDim.x * gridDim.y * gridDim.z;
  unsigned sum, cnt, mine, sp = 0u;
  for (;;) {
    sum = 0u; cnt = 0u; mine = 0u;
#pragma unroll 1
    for (unsigned j = 0; j < 16; ++j) { const unsigned c = xb_ld(&bar[XB_XCNT(j)]); sum += c; cnt += (c > 0u) ? 1u : 0u; mine = (j == x) ? c : mine; }
    if (sum == G) break;
    __builtin_amdgcn_s_sleep(1);
    if ((++sp & 255u) == 0u) { if (xb_ld(&bar[XB_TMO])) break; if (sp > XB_SPIN_CAP) { atomicAdd(&bar[XB_TMO], 1u); break; } }
  }
  nloc = mine > 0u ? mine : 1u; nx = cnt > 0u ? cnt : 1u;
}
DI void xcd_barrier(int wv, const XcdBarrier& b) {
  asm volatile("s_waitcnt vmcnt(0)" ::: "memory");
  __syncthreads();
  if (wv == 0 && lane_id_() == 0) {
    unsigned* bar = b.bar;
    __builtin_amdgcn_s_waitcnt(0);
    unsigned nloc = b.st[0], nx = b.st[1];
    if (nloc == 0u) { xcd_barrier_complete(bar, b.x, nloc, nx); b.st[0] = nloc; b.st[1] = nx; }
    const unsigned old = xb_add(&bar[XB_XSUB(b.x)], 1u);
    const unsigned gen = old / nloc;
    if (old + 1u == (gen + 1u) * nloc) {
      __builtin_amdgcn_fence(__ATOMIC_RELEASE, "agent");
      asm volatile("s_waitcnt vmcnt(0)" ::: "memory");
      const unsigned og = xb_add(&bar[XB_TOP], 1u);
      const unsigned tg = og / nx;
      if (og + 1u == (tg + 1u) * nx) xb_add(&bar[XB_TOPGEN], 1u);
      else XB_SPIN(xb_ld(&bar[XB_TOPGEN]) == tg, bar);
      __builtin_amdgcn_fence(__ATOMIC_ACQUIRE, "agent");
      xb_add(&bar[XB_XGEN(b.x)], 1u);
      asm volatile("s_waitcnt vmcnt(0)" ::: "memory");
    } else {
      XB_SPIN(xb_ld(&bar[XB_XGEN(b.x)]) == gen, bar);
      __builtin_amdgcn_fence(__ATOMIC_ACQUIRE, "agent");
      asm volatile("s_waitcnt vmcnt(0)" ::: "memory");
    }
  }
  __syncthreads();
}

namespace pg8 {
constexpr int BM = 256, BK = 64, HALF = 128, HTB = HALF * BK * 2, STAGE_BYTES = 8 * HTB, NXCD = 8, WGM = 8;
DI int lds_byte(int r, int c) { const int st = (r >> 4) * 2 + (c >> 5), rr = r & 15, cc = c & 31, ob = rr * 64 + cc * 2; return st * 1024 + (ob ^ (((ob >> 9) & 1) << 5)); }
DI void stage_rc(int b, int& R, int& C) { const int st = b / 1024, sb = b % 1024, swz = sb ^ (((sb >> 9) & 1) << 5); R = (st >> 1) * 16 + swz / 64; C = (st & 1) * 32 + (swz % 64) / 2; }
struct Unit { int pm, pn; };
struct Gemm { const bf16_t* A; const bf16_t* Bt; int M, N, K; };
struct StaticOrder {
  int nM, nN, nwg, G, c;
  DI void init(int M, int N, int G_, int c_) { nM = M / BM; nN = N / BM; nwg = nM * nN; G = G_; c = c_; }
  DI bool next(int i, Unit& u) const {
    const long L = (long)i * G + c; if (L >= nwg) return false;
    int wgid = (int)L; { const int q = nwg / NXCD, r = nwg % NXCD, xcd = wgid % NXCD, off = wgid / NXCD; wgid = (xcd < r ? xcd * (q + 1) : r * (q + 1) + (xcd - r) * q) + off; }
    const int nig = WGM * nN, gid = wgid / nig, fm = gid * WGM, gsz = (nM - fm) < WGM ? (nM - fm) : WGM;
    u.pm = fm + ((wgid % nig) % gsz); u.pn = (wgid % nig) / gsz; return true;
  }
};
template <class Epi>
DI void gemm_phase(int wv, LAS unsigned char* lds, const Gemm g, const StaticOrder& S, const Epi& E) {
  int tid_ = wv * 64 + lane_id_(); asm volatile("" : "+v"(tid_)); const int tid = tid_, wid = __builtin_amdgcn_readfirstlane(tid >> 6), lane = tid & 63, wr = wid >> 2, wc = wid & 3, fr = lane & 15, fq = lane >> 4;
  const int K = g.K, nt = K / BK;
  unsigned voffA[2];
#pragma unroll
  for (int i = 0; i < 2; ++i) { int R, C; stage_rc(tid * 16 + i * 8192, R, C); voffA[i] = (unsigned)(R * K + C) * 2u; }
  const size_t kstep = (size_t)(BK * 2), hstep = (size_t)HALF * K * 2, tstep = 2 * hstep;
  const unsigned ldsw = (unsigned)wid * 1024u;
  const int aoff = lds_byte(wr * 64 + fr, fq * 8), boff = lds_byte(wc * 32 + fr, fq * 8);
#define PG8_SA(b, h) (((b) * 2 + (h)) * HTB)
#define PG8_SB(b, h) ((4 + (b) * 2 + (h)) * HTB)
#define PG8_STAGE(bufoff, gbase, voff) do { _Pragma("unroll") for (int _i = 0; _i < 2; ++_i) \
    __builtin_amdgcn_global_load_lds((const unsigned*)((const char*)(gbase) + (voff)[_i]), (LAS unsigned*)(lds + (bufoff) + ldsw + _i * 8192), 16, 0, 0); } while (0)
#define PG8_LDA(dst, b, h) do { _Pragma("unroll") for (int m = 0; m < 4; ++m) _Pragma("unroll") for (int k = 0; k < 2; ++k) dst[m][k] = *(const LAS bf16x8*)(lds + PG8_SA(b, h) + aoff + m * 2048 + k * 1024); } while (0)
#define PG8_LDB(dst, b, h) do { _Pragma("unroll") for (int n = 0; n < 2; ++n) _Pragma("unroll") for (int k = 0; k < 2; ++k) dst[n][k] = *(const LAS bf16x8*)(lds + PG8_SB(b, h) + boff + n * 2048 + k * 1024); } while (0)
#define PG8_MMA(ai, bj, At, Bt) do { __builtin_amdgcn_s_setprio(1); _Pragma("unroll") for (int m = 0; m < 4; ++m) _Pragma("unroll") for (int n = 0; n < 2; ++n) _Pragma("unroll") for (int k = 0; k < 2; ++k) \
    acc[ai][bj][m][n] = __builtin_amdgcn_mfma_f32_16x16x32_bf16(Bt[n][k], At[m][k], acc[ai][bj][m][n], 0, 0, 0); __builtin_amdgcn_s_setprio(0); } while (0)
#define PG8_WAIT_V(n) asm volatile("s_waitcnt vmcnt(" #n ")" ::: "memory")
#define PG8_WAIT_L(n) asm volatile("s_waitcnt lgkmcnt(" #n ")" ::: "memory")
#define PG8_BAR __builtin_amdgcn_s_barrier()
#define PG8_SCHED __builtin_amdgcn_sched_barrier(0)
  Unit cur, nxt; int ui = 0;
  if (!S.next(0, cur)) return;
  f32x4 acc[2][2][4][2];
#pragma unroll
  for (int a = 0; a < 2; ++a)
#pragma unroll
    for (int b = 0; b < 2; ++b)
#pragma unroll
      for (int m = 0; m < 4; ++m)
#pragma unroll
        for (int n = 0; n < 2; ++n) acc[a][b][m][n] = (f32x4){0.f, 0.f, 0.f, 0.f};
  bf16x8 At[4][2], B0[2][2], B1[2][2];
  const char* cA = (const char*)g.A + (size_t)cur.pm * tstep; const char* cB = (const char*)g.Bt + (size_t)cur.pn * tstep;
  PG8_STAGE(PG8_SB(0, 0), cB, voffA); PG8_STAGE(PG8_SA(0, 0), cA, voffA); PG8_STAGE(PG8_SB(0, 1), cB + hstep, voffA); PG8_STAGE(PG8_SA(0, 1), cA + hstep, voffA);
  if (wr == 1) PG8_BAR;
  PG8_WAIT_V(4); PG8_BAR;
  PG8_STAGE(PG8_SB(1, 0), cB + kstep, voffA); PG8_STAGE(PG8_SA(1, 0), cA + kstep, voffA); PG8_STAGE(PG8_SB(1, 1), cB + hstep + kstep, voffA);
  PG8_WAIT_V(6); PG8_BAR;
  for (;;) {
    const bool has_next = S.next(ui + 1, nxt);
    const char* nA = has_next ? (const char*)g.A + (size_t)nxt.pm * tstep : cA; const char* nB = has_next ? (const char*)g.Bt + (size_t)nxt.pn * tstep : cB;
    for (int t = 0; t < nt; t += 2) {
      const bool last = (t == nt - 2);
      const char* a1 = cA + (size_t)(t + 1) * kstep;
      const char* a2 = last ? nA : cA + (size_t)(t + 2) * kstep; const char* b2 = last ? nB : cB + (size_t)(t + 2) * kstep;
      const char* a3 = a2 + kstep; const char* b3 = b2 + kstep;
      PG8_LDB(B0, 0, 0); PG8_SCHED; PG8_LDA(At, 0, 0); PG8_STAGE(PG8_SA(1, 1), a1 + hstep, voffA);
      PG8_WAIT_L(8); PG8_BAR; PG8_WAIT_L(0); PG8_MMA(0, 0, At, B0); PG8_BAR; PG8_SCHED;
      PG8_LDB(B1, 0, 1); PG8_STAGE(PG8_SB(0, 0), b2, voffA);
      PG8_BAR; PG8_WAIT_L(0); PG8_MMA(0, 1, At, B1); PG8_BAR;
      PG8_LDA(At, 0, 1); PG8_STAGE(PG8_SA(0, 0), a2, voffA);
      PG8_BAR; PG8_WAIT_L(0); PG8_MMA(1, 0, At, B0); PG8_BAR; PG8_SCHED;
      PG8_STAGE(PG8_SB(0, 1), b2 + hstep, voffA);
      PG8_WAIT_V(6); PG8_BAR; PG8_MMA(1, 1, At, B1); PG8_BAR;
      PG8_LDB(B0, 1, 0); PG8_SCHED; PG8_LDA(At, 1, 0); PG8_STAGE(PG8_SA(0, 1), a2 + hstep, voffA);
      PG8_WAIT_L(8); PG8_BAR; PG8_WAIT_L(0); PG8_MMA(0, 0, At, B0); PG8_BAR; PG8_SCHED;
      PG8_LDB(B1, 1, 1); PG8_STAGE(PG8_SB(1, 0), b3, voffA);
      PG8_BAR; PG8_WAIT_L(0); PG8_MMA(0, 1, At, B1); PG8_BAR;
      PG8_LDA(At, 1, 1); PG8_STAGE(PG8_SA(1, 0), a3, voffA);
      PG8_BAR; PG8_WAIT_L(0); PG8_MMA(1, 0, At, B0); PG8_BAR; PG8_SCHED;
      PG8_STAGE(PG8_SB(1, 1), b3 + hstep, voffA);
      PG8_WAIT_V(6); PG8_BAR; PG8_MMA(1, 1, At, B1); PG8_BAR;
    }
    E(acc, cur, wr, wc, fr, fq);
    if (!has_next) break;
#pragma unroll
    for (int a = 0; a < 2; ++a)
#pragma unroll
      for (int b = 0; b < 2; ++b)
#pragma unroll
        for (int m = 0; m < 4; ++m)
#pragma unroll
          for (int n = 0; n < 2; ++n) acc[a][b][m][n] = (f32x4){0.f, 0.f, 0.f, 0.f};
    cur = nxt; cA = nA; cB = nB; ++ui;
  }
  PG8_WAIT_V(0);
  if (wr == 0) PG8_BAR;
  PG8_BAR;
}
}
DI void row_affine(const float* stats, int row, float& a, float& bb, float& mu, float& rstd) {
  if (stats) { const float s = stats[2 * row], ss = stats[2 * row + 1]; mu = s * (1.0f / 1024.0f); const float var = fmaxf(ss * (1.0f / 1024.0f) - mu * mu, 0.f); rstd = rsqrtf(var + 1e-5f); a = rstd; bb = -rstd * mu; }
  else { a = 1.f; bb = 0.f; mu = 0.f; rstd = 1.f; }
}
struct EpiUp {
  bf16_t* H; const float* stats; const float* c1; const float* c2;
  DI void operator()(const f32x4 (&acc)[2][2][4][2], const pg8::Unit& u, int wr, int wc, int fr, int fq) const {
    const int colg = u.pn * 256 + wc * 32 + 8 * fq, hcol = u.pn * 128 + wc * 32 + 8 * fq;
    f32x4 c1g[2], c2g[2], c1u[2], c2u[2];
#pragma unroll
    for (int n = 0; n < 2; ++n) { c1g[n] = *(const f32x4*)(c1 + colg + 4 * n); c2g[n] = *(const f32x4*)(c2 + colg + 4 * n); c1u[n] = *(const f32x4*)(c1 + colg + 128 + 4 * n); c2u[n] = *(const f32x4*)(c2 + colg + 128 + 4 * n); }
#pragma unroll
    for (int ai = 0; ai < 2; ++ai)
#pragma unroll
      for (int m = 0; m < 4; ++m) {
        const int row = u.pm * 256 + ai * 128 + wr * 64 + m * 16 + fr; float a, bb, mu, rstd; row_affine(stats, row, a, bb, mu, rstd);
        u32x4 w;
#pragma unroll
        for (int n = 0; n < 2; ++n) {
          const f32x4 gv = acc[ai][0][m][n] * a + c1g[n] * bb + c2g[n], uv = acc[ai][1][m][n] * a + c1u[n] * bb + c2u[n];
          float h[4];
#pragma unroll
          for (int j = 0; j < 4; ++j) h[j] = gv[j] * sigmoidf_(gv[j]) * uv[j];
          w[2 * n] = pk2(h[0], h[1]); w[2 * n + 1] = pk2(h[2], h[3]);
        }
        *(u32x4*)(H + (size_t)row * DFF + hcol) = w;
        asm volatile("" ::: "memory");
      }
  }
};
struct EpiRes {
  float* T; const float* Tin; const float* stats_prev; const float* g; const float* b; float* stats_new; bf16_t* tb; float scale;
  DI void operator()(const f32x4 (&acc)[2][2][4][2], const pg8::Unit& u, int wr, int wc, int fr, int fq) const {
    const int col0 = u.pn * 256 + wc * 32 + 8 * fq;
    f32x4 gv[2][2], bv[2][2];
#pragma unroll
    for (int bj = 0; bj < 2; ++bj)
#pragma unroll
      for (int n = 0; n < 2; ++n) { gv[bj][n] = *(const f32x4*)(g + col0 + bj * 128 + 4 * n); bv[bj][n] = *(const f32x4*)(b + col0 + bj * 128 + 4 * n); }
#pragma unroll
    for (int ai = 0; ai < 2; ++ai)
#pragma unroll
      for (int m = 0; m < 4; ++m) {
        const int row = u.pm * 256 + ai * 128 + wr * 64 + m * 16 + fr; float a, bb, mu, rstd; row_affine(stats_prev, row, a, bb, mu, rstd);
        float rs = 0.f, rq = 0.f;
#pragma unroll
        for (int bj = 0; bj < 2; ++bj) {
          u32x4 w;
#pragma unroll
          for (int n = 0; n < 2; ++n) {
            const size_t off = (size_t)row * DM + col0 + bj * 128 + 4 * n;
            f32x4 tp = *(const f32x4*)(Tin + off);
            if (stats_prev) tp = (tp - mu) * rstd * gv[bj][n] + bv[bj][n];
            const f32x4 tn = tp * ALPHA + acc[ai][bj][m][n] * scale;
            *(f32x4*)(T + off) = tn;
            w[2 * n] = pk2(tn[0], tn[1]); w[2 * n + 1] = pk2(tn[2], tn[3]);
            rs += tn[0] + tn[1] + tn[2] + tn[3]; rq += tn[0] * tn[0] + tn[1] * tn[1] + tn[2] * tn[2] + tn[3] * tn[3];
          }
          *(u32x4*)(tb + (size_t)row * DM + col0 + bj * 128) = w;
        }
        rs += __shfl_xor(rs, 16); rs += __shfl_xor(rs, 32); rq += __shfl_xor(rq, 16); rq += __shfl_xor(rq, 32);
        if (fq == 0) { atomicAdd(stats_new + 2 * row, rs); atomicAdd(stats_new + 2 * row + 1, rq); }
        asm volatile("" ::: "memory");
      }
  }
};
struct EpiIn {
  int mode; bf16_t* h; int ld; const float* stats; const float* c1; const float* c2; const float* lbv;
  bf16_t *hq, *hk, *hv, *hg; _Float16* hlf;
  template <int SECT>
  DI void body(const f32x4 (&acc)[2][2][4][2], const pg8::Unit& u, int wr, int wc, int fr, int fq) const {
    const int col0 = u.pn * 256 + wc * 32 + 8 * fq;
#pragma unroll
    for (int ai = 0; ai < 2; ++ai)
#pragma unroll
      for (int m = 0; m < 4; ++m) {
        const int row = u.pm * 256 + ai * 128 + wr * 64 + m * 16 + fr; float a, bb, mu, rstd; row_affine(stats, row, a, bb, mu, rstd);
#pragma unroll
        for (int bj = 0; bj < 2; ++bj) {
          const int col = col0 + bj * 128;
          f32x4 v[2];
#pragma unroll
          for (int n = 0; n < 2; ++n) v[n] = acc[ai][bj][m][n] * a + (*(const f32x4*)(c1 + col + 4 * n)) * bb + *(const f32x4*)(c2 + col + 4 * n);
          if (SECT < 0) { u32x4 w; w[0] = pk2(v[0][0], v[0][1]); w[1] = pk2(v[0][2], v[0][3]); w[2] = pk2(v[1][0], v[1][1]); w[3] = pk2(v[1][2], v[1][3]); *(u32x4*)(h + (size_t)row * ld + col) = w; }
          else {
            const int cc = col & 1023; const size_t off = (size_t)row * 1024 + cc;
            if (SECT == 0 || SECT == 3) { u32x4 w;
#pragma unroll
              for (int n = 0; n < 2; ++n) { w[2 * n] = pk2(v[n][0] * sigmoidf_(v[n][0]), v[n][1] * sigmoidf_(v[n][1])); w[2 * n + 1] = pk2(v[n][2] * sigmoidf_(v[n][2]), v[n][3] * sigmoidf_(v[n][3])); }
              *(u32x4*)((SECT == 0 ? hq : hg) + off) = w; }
            else if (SECT == 1) {
              typedef _Float16 h8 __attribute__((ext_vector_type(8))); h8 lf; u32x4 w;
#pragma unroll
              for (int n = 0; n < 2; ++n) { const f32x4 lb = *(const f32x4*)(lbv + cc + 4 * n); float kk[4];
#pragma unroll
                for (int j = 0; j < 4; ++j) { kk[j] = (1.0f - lb[j]) * __builtin_amdgcn_rcpf(1.0f + __builtin_amdgcn_exp2f(1.4426950408889634f * v[n][j])); lf[4 * n + j] = (_Float16)__logf(1.0f - kk[j]); }
                w[2 * n] = pk2(kk[0], kk[1]); w[2 * n + 1] = pk2(kk[2], kk[3]); }
              *(u32x4*)(hk + off) = w; *(h8*)(hlf + off) = lf;
            }
            else { u32x4 w; w[0] = pk2(v[0][0], v[0][1]); w[1] = pk2(v[0][2], v[0][3]); w[2] = pk2(v[1][0], v[1][1]); w[3] = pk2(v[1][2], v[1][3]); *(u32x4*)(hv + off) = w; }
          }
        }
        asm volatile("" ::: "memory");
      }
  }
  DI void operator()(const f32x4 (&acc)[2][2][4][2], const pg8::Unit& u, int wr, int wc, int fr, int fq) const {
    if (mode == 0) body<-1>(acc, u, wr, wc, fr, fq);
    else { const int sect = u.pn >> 2;
      if (sect == 0) body<0>(acc, u, wr, wc, fr, fq); else if (sect == 1) body<1>(acc, u, wr, wc, fr, fq); else if (sect == 2) body<2>(acc, u, wr, wc, fr, fq); else body<3>(acc, u, wr, wc, fr, fq); }
  }
};

DI void conv_strip(int wv, LAS unsigned char* lds, const float* src, int ldn, int K, int n0, int nvalid, bf16_t* dst, int dstrow0, const float* g, const float* b, float* c1, float* c2, bool perm = true) {
  LAS bf16_t* tile = (LAS bf16_t*)lds;
  LAS float* red = (LAS float*)(lds + 64 * 72 * 2);
  int tid_ = wv * 64 + lane_id_(); asm volatile("" : "+v"(tid_)); const int tid = tid_, kr = tid >> 4, nc = (tid & 15) * 4;
  const bool colok = (n0 + nc) < nvalid;
  float s1[4] = {0.f, 0.f, 0.f, 0.f}, s2[4] = {0.f, 0.f, 0.f, 0.f};
  for (int k0 = 0; k0 < K; k0 += 64) {
    f32x4 w[2];
#pragma unroll
    for (int rr = 0; rr < 2; ++rr) { const int k = k0 + kr + rr * 32; w[rr] = colok ? *(const f32x4*)(src + (size_t)k * ldn + n0 + nc) : (f32x4){0.f, 0.f, 0.f, 0.f}; }
    __syncthreads();
#pragma unroll
    for (int rr = 0; rr < 2; ++rr) { const int k = k0 + kr + rr * 32; const float gk = g ? g[k] : 1.0f, bk = b ? b[k] : 0.0f;
#pragma unroll
      for (int j = 0; j < 4; ++j) { const bf16_t v = f2bf(w[rr][j] * gk); tile[(nc + j) * 72 + kr + rr * 32] = v; s1[j] += bf2f(v); s2[j] += bk * w[rr][j]; } }
    __syncthreads();
    { const int n = tid >> 3, kc = (tid & 7) * 8; const int cc = n & 31, slot = (n & 32) + (perm ? 16 * ((cc >> 2) & 1) + 4 * (cc >> 3) + (cc & 3) : cc);
      *(u32x4*)(dst + (size_t)(dstrow0 + slot) * K + k0 + kc) = *(const LAS u32x4*)(tile + n * 72 + kc); }
  }
  if (c1) {
    __syncthreads();
#pragma unroll
    for (int j = 0; j < 4; ++j) { red[kr * 64 + nc + j] = s1[j]; red[2048 + kr * 64 + nc + j] = s2[j]; }
    __syncthreads();
    if (tid < 128) { const int n = tid & 63, which = tid >> 6; float s = 0.f; for (int i = 0; i < 32; ++i) s += red[which * 2048 + i * 64 + n]; (which ? c2 : c1)[dstrow0 + n] = s; }
  }
  __syncthreads();
}

DI void convert_phase(int wv, const P& p, int L, LAS unsigned char* lds) {
  const int kind = L % 3, slot = L / 3;
  const int nin = kind == 0 ? 44 : (kind == 1 ? 64 : 20);
  const int njobs = 208 + nin + 16 + (kind == 0 ? 6 : 0);
  unsigned char* ws = p.ws;
  for (int j = blockIdx.x; j < njobs; j += gridDim.x) {
    if (j < 208) {
      const int f = j / 104, jj = j % 104;
      const float* lg = p.ln_gain + (size_t)(L * 3 + (f == 0 ? -1 : 1)) * DM; const float* lbias = p.ln_bias + (size_t)(L * 3 + (f == 0 ? -1 : 1)) * DM;
      const bool fold = !(L == 0 && f == 0);
      float* cbase = (float*)(ws + (f == 0 ? C_GU1 : C_GU2));
      if (jj < 88) {
        const int up = jj / 44, s = jj % 44, n0 = s * 64;
        const float* src = (f == 0 ? (up ? p.f1u : p.f1g) : (up ? p.f2u : p.f2g)) + (size_t)L * DM * DFF;
        conv_strip(wv, lds, src, DFF, DM, n0, DFF, (bf16_t*)(ws + (f == 0 ? W_GU1 : W_GU2)), (n0 >> 7) * 256 + (n0 & 127) + up * 128, fold ? lg : nullptr, fold ? lbias : nullptr, cbase, cbase + 5632);
      } else {
        const int s = jj - 88;
        const float* src = (f == 0 ? p.f1d : p.f2d) + (size_t)L * DFF * DM;
        conv_strip(wv, lds, src, DM, DFF, s * 64, DM, (bf16_t*)(ws + (f == 0 ? W_D1 : W_D2)), s * 64, nullptr, nullptr, nullptr, nullptr);
      }
    } else if (j < 208 + nin) {
      const int s = j - 208; const float* lg = p.ln_gain + (size_t)(L * 3) * DM; const float* lbias = p.ln_bias + (size_t)(L * 3) * DM;
      const float* src = kind == 0 ? p.nsa_win + (size_t)slot * DM * 2608 : (kind == 1 ? p.hg_win + (size_t)slot * DM * 4096 : p.swa_win + (size_t)slot * DM * 1280);
      const int ldn = kind == 0 ? 2608 : (kind == 1 ? 4096 : 1280);
      float* cbase = (float*)(ws + C_IN);
      conv_strip(wv, lds, src, ldn, DM, s * 64, ldn, (bf16_t*)(ws + W_IN), s * 64, lg, lbias, cbase, cbase + 4096);
    } else if (j < 208 + nin + 16) {
      const int s = j - 208 - nin;
      const float* src = kind == 0 ? p.nsa_wout + (size_t)slot * DM * DM : (kind == 1 ? p.hg_wout + (size_t)slot * DM * DM : p.swa_wout + (size_t)slot * DM * DM);
      conv_strip(wv, lds, src, DM, DM, s * 64, DM, (bf16_t*)(ws + W_OUT), s * 64, nullptr, nullptr, nullptr, nullptr);
    } else {
      const int s = j - 208 - nin - 16;
      if (s < 4) { const int kv = s >> 1, st = s & 1; float* pb = (float*)(ws + C_POSB) + kv * 256;
        conv_strip(wv, lds, p.nsa_w1 + ((size_t)slot * 2 + kv) * 2048 * 128, 128, 2048, st * 64, 128, (bf16_t*)(ws + W_W1T) + (size_t)kv * 128 * 2048, st * 64, nullptr, p.nsa_pos + ((size_t)slot * 2 + kv) * 2048, pb + 128, pb, false); }
      else { const int kv = s - 4; conv_strip(wv, lds, p.nsa_w2 + ((size_t)slot * 2 + kv) * 128 * 64, 64, 128, 0, 64, (bf16_t*)(ws + W_W2T) + (size_t)kv * 64 * 128, 0, nullptr, nullptr, nullptr, nullptr, false); }
    }
  }
}

DI void init_phase(int wv, const P& p) {
  int tid_ = wv * 64 + lane_id_(); asm volatile("" : "+v"(tid_)); const size_t gtid = (size_t)blockIdx.x * 512 + tid_, gsz = (size_t)gridDim.x * 512;
  for (size_t i = gtid; i < (4 * MiB) / 16; i += gsz) ((f32x4*)(p.ws + WS_STATS))[i] = (f32x4){0.f, 0.f, 0.f, 0.f};
  for (size_t i = gtid; i < (size_t)MTOK * DM / 4; i += gsz) { const f32x4 v = ((const f32x4*)p.x)[i]; u32x2 w; w.x = pk2(v[0], v[1]); w.y = pk2(v[2], v[3]); ((u32x2*)(p.ws + WS_TB))[i] = w; }
  if (gtid < 16 * 132) { const int hd = (int)gtid / 132, d = (int)gtid % 132; int bk;
    if (d < 16) bk = d; else { const float v = logf((float)d / 16.0f) / 2.0794415416798357f * 16.0f; bk = 16 + (int)v; if (bk > 31 || d >= 128) bk = 31; }
    ((float*)(p.ws + C_BTAB))[gtid] = p.rel_bias[bk * 16 + hd]; }
  if (gtid < 1024) { const float a0 = p.hg_lb[gtid], a1 = p.hg_lb[1024 + gtid], a2 = p.hg_lb[2048 + gtid], a3 = p.hg_lb[3072 + gtid];
    const float mx = fmaxf(fmaxf(a0, a1), fmaxf(a2, a3)); const float e0 = expf(a0 - mx), e1 = expf(a1 - mx), e2 = expf(a2 - mx), e3 = expf(a3 - mx);
    ((float*)(p.ws + C_LBV))[gtid] = e1 / (e0 + e1 + e2 + e3); }
}

DI void final_ln(int wv, const P& p, const float* stats, const float* g, const float* b) {
  int tid_ = wv * 64 + lane_id_(); asm volatile("" : "+v"(tid_)); const size_t gtid = (size_t)blockIdx.x * 512 + tid_, gsz = (size_t)gridDim.x * 512;
  for (size_t i = gtid; i < (size_t)MTOK * DM / 4; i += gsz) {
    const int row = (int)(i >> 8), c = (int)(i & 255) * 4; float a, bb, mu, rstd; row_affine(stats, row, a, bb, mu, rstd);
    const f32x4 v = ((const f32x4*)p.out)[i]; ((f32x4*)p.out)[i] = (v - mu) * rstd * (*(const f32x4*)(g + c)) + *(const f32x4*)(b + c);
  }
}
#define MFMA32(a, b, c) __builtin_amdgcn_mfma_f32_32x32x16_bf16((a), (b), (c), 0, 0, 0)
#define MFMA16(a, b, c) __builtin_amdgcn_mfma_f32_16x16x32_bf16((a), (b), (c), 0, 0, 0)
DI int crow(int reg, int h) { return (reg & 3) + 8 * (reg >> 2) + 4 * h; }
constexpr int KS_STRIDE = 72;

struct KVRegs { u32x4 k; bf16x8 v; };
DI void kv_load(KVRegs& r, const bf16_t* kg, const bf16_t* vg, size_t ldg, int tid) {
  asm volatile("" : "+v"(tid));
  const int key = tid >> 3, d8 = (tid & 7) * 8;
  r.k = *(const u32x4*)(kg + (size_t)key * ldg + d8); r.v = *(const bf16x8*)(vg + (size_t)key * ldg + d8);
}
DI void kv_store(const KVRegs& r, LAS bf16_t* Ks, LAS bf16_t* Vt, int vstride, int vcol0, int tid) {
  asm volatile("" : "+v"(tid));
  const int key = tid >> 3, d8 = (tid & 7) * 8;
  *(LAS u32x4*)(Ks + key * KS_STRIDE + d8) = r.k;
#pragma unroll
  for (int i = 0; i < 8; ++i) Vt[(d8 + i) * vstride + vcol0 + key] = (bf16_t)r.v[i];
}
DI void attn_scores(const LAS bf16_t* Ks, const bf16x8 (&qf)[4], int r, int h, f32x16 (&s)[2]) {
#pragma unroll
  for (int sub = 0; sub < 2; ++sub) {
    f32x16 a;
#pragma unroll
    for (int i = 0; i < 16; ++i) a[i] = 0.f;
#pragma unroll
    for (int ks = 0; ks < 4; ++ks) { const bf16x8 kf = *(const LAS bf16x8*)(Ks + (sub * 32 + r) * KS_STRIDE + ks * 16 + 8 * h); a = MFMA32(kf, qf[ks], a); }
    s[sub] = a;
  }
}
constexpr float QK_SCALE2 = 0.125f * 1.4426950408889634f;
DI void attn_logits(f32x16 (&s)[2], int t, int tw, int nt, int h, int base, int stride, int dmax, bool ok, const LAS float* btl) {
  const int dmin = tw - (base + 63 * stride), dmaxw = tw + nt - 1 - base;
  const bool far = dmin >= 128, interior = dmin >= 0 && dmaxw < dmax;
  const float bfar = btl[128];
  if (far && interior) {
#pragma unroll
    for (int sub = 0; sub < 2; ++sub)
#pragma unroll
      for (int reg = 0; reg < 16; ++reg) s[sub][reg] = ok ? s[sub][reg] * QK_SCALE2 + bfar : -1e30f;
  } else {
#pragma unroll
    for (int sub = 0; sub < 2; ++sub)
#pragma unroll
      for (int reg = 0; reg < 16; ++reg) {
        const int kk = sub * 32 + crow(reg, h); const int d = t - (base + kk * stride);
        const bool valid = (d >= 0) && (d < dmax) && ok;
        float bias; if (far) bias = bfar; else { const int di = d < 0 ? 0 : (d > 128 ? 128 : d); bias = btl[di]; }
        s[sub][reg] = valid ? s[sub][reg] * QK_SCALE2 + bias : -1e30f;
      }
  }
}
DI void attn_pv(const LAS bf16_t* Vt, int vstride, const f32x16 (&p)[2], f32x16 (&O)[2], int r, int h) {
#pragma unroll
  for (int sub = 0; sub < 2; ++sub)
#pragma unroll
    for (int s2 = 0; s2 < 2; ++s2) {
      u32x4 pp;
#pragma unroll
      for (int j = 0; j < 4; ++j) pp[j] = pk2(p[sub][8 * s2 + 2 * j], p[sub][8 * s2 + 2 * j + 1]);
      const bf16x8 pf = __builtin_bit_cast(bf16x8, pp);
#pragma unroll
      for (int dt = 0; dt < 2; ++dt) {
        const LAS bf16_t* vp = Vt + (dt * 32 + r) * vstride + sub * 32 + 16 * s2 + 4 * h;
        const s16x4 lo = *(const LAS s16x4*)vp, hi = *(const LAS s16x4*)(vp + 8);
        const bf16x8 vf = __builtin_shufflevector(lo, hi, 0, 1, 2, 3, 4, 5, 6, 7);
        O[dt] = MFMA32(vf, pf, O[dt]);
      }
    }
}
template <bool WITH_O>
DI void attn_online(f32x16 (&s)[2], float& m, float& l, f32x16 (&O)[2]) {
  float mx = -1e30f;
#pragma unroll
  for (int sub = 0; sub < 2; ++sub)
#pragma unroll
    for (int reg = 0; reg < 16; ++reg) mx = fmaxf(mx, s[sub][reg]);
  mx = fmaxf(mx, __shfl_xor(mx, 32));
  const float mn = fmaxf(m, mx);
  const bool grow = mn > m;
  float ls = 0.f;
#pragma unroll
  for (int sub = 0; sub < 2; ++sub)
#pragma unroll
    for (int reg = 0; reg < 16; ++reg) { const float e = __builtin_amdgcn_exp2f(s[sub][reg] - mn); s[sub][reg] = e; ls += e; }
  if (__any(grow)) {
    const float al = __builtin_amdgcn_exp2f(m - mn); m = mn;
    l = l * al + ls;
    if (WITH_O) {
#pragma unroll
      for (int dt = 0; dt < 2; ++dt)
#pragma unroll
        for (int reg = 0; reg < 16; ++reg) O[dt][reg] *= al;
    }
  } else l += ls;
}
DI void attn_tile(const LAS bf16_t* Ks, const LAS bf16_t* Vt, int vstride, const bf16x8 (&qf)[4], f32x16 (&O)[2], float& m, float& l,
                  int t, int tw, int nt, int r, int h, int base, int stride, int dmax, bool ok, const LAS float* btl) {
  f32x16 s[2];
  attn_scores(Ks, qf, r, h, s);
  attn_logits(s, t, tw, nt, h, base, stride, dmax, ok, btl);
  attn_online<true>(s, m, l, O);
  attn_pv(Vt, vstride, s, O, r, h);
}
DI void zero_o(f32x16 (&O)[2]) {
#pragma unroll
  for (int dt = 0; dt < 2; ++dt)
#pragma unroll
    for (int reg = 0; reg < 16; ++reg) O[dt][reg] = 0.f;
}

DI void nsa_compress_phase(int wv, const P& p, LAS unsigned char* lds) {
  const bf16_t* hb = (const bf16_t*)(p.ws + WS_BIG); const int ld = 2816;
  int tid_ = wv * 64 + lane_id_(); asm volatile("" : "+v"(tid_)); const int tid = tid_, wid = wv, lane = tid & 63, fr = lane & 15, fq = lane >> 4;
  const int pw = wid & 3, half = wid >> 2;
  LAS bf16_t* hid = (LAS bf16_t*)lds + pw * 16 * 136;
  LAS f32x4* part = (LAS f32x4*)(lds + 32768) + pw * 8 * 64;
  for (int base = blockIdx.x * 4; base < 1024; base += gridDim.x * 4) {
    const int task = base + pw;
    const int kv = task >> 9, b = (task >> 6) & 7, g = (task >> 4) & 3, n0 = (task & 15) * 16;
    const bf16_t* w1t = (const bf16_t*)(p.ws + W_W1T) + (size_t)kv * 128 * 2048; const bf16_t* w2t = (const bf16_t*)(p.ws + W_W2T) + (size_t)kv * 64 * 128;
    const float* posb = (const float*)(p.ws + C_POSB) + kv * 256;
    const int colb = 1024 + kv * 256 + g * 64;
    int n = n0 + fr; if (n > 254) n = 254;
    f32x4 acc[8];
#pragma unroll
    for (int i = 0; i < 8; ++i) acc[i] = (f32x4){0.f, 0.f, 0.f, 0.f};
#pragma unroll 2
    for (int l = 16 * half; l < 16 * half + 16; ++l) {
#pragma unroll
      for (int dk = 0; dk < 2; ++dk) {
        const bf16x8 af = *(const bf16x8*)(hb + (size_t)(b * SEQ + 16 * n + l) * ld + colb + dk * 32 + fq * 8);
#pragma unroll
        for (int nt = 0; nt < 8; ++nt) { const bf16x8 bfr = *(const bf16x8*)(w1t + (size_t)(nt * 16 + fr) * 2048 + l * 64 + dk * 32 + fq * 8); acc[nt] = MFMA16(af, bfr, acc[nt]); }
      }
    }
    if (half) {
#pragma unroll
      for (int nt = 0; nt < 8; ++nt) part[nt * 64 + lane] = acc[nt];
    }
    __syncthreads();
    if (!half) {
#pragma unroll
      for (int nt = 0; nt < 8; ++nt) { const float pbv = posb[nt * 16 + fr]; const f32x4 o2 = part[nt * 64 + lane];
#pragma unroll
        for (int j = 0; j < 4; ++j) { const float v = acc[nt][j] + o2[j] + pbv; const float u = 0.7978845608028654f * (v + 0.044715f * v * v * v); const float th = 1.0f - 2.0f * __builtin_amdgcn_rcpf(1.0f + __expf(2.0f * u));
          hid[(4 * fq + j) * 136 + nt * 16 + fr] = f2bf(0.5f * v * (1.0f + th)); } }
    }
    __syncthreads();
    if (!half) {
      f32x4 o[4];
#pragma unroll
      for (int i = 0; i < 4; ++i) o[i] = (f32x4){0.f, 0.f, 0.f, 0.f};
#pragma unroll
      for (int ks = 0; ks < 4; ++ks) { const bf16x8 af = *(const LAS bf16x8*)(hid + fr * 136 + ks * 32 + fq * 8);
#pragma unroll
        for (int nt = 0; nt < 4; ++nt) { const bf16x8 bfr = *(const bf16x8*)(w2t + (size_t)(nt * 16 + fr) * 128 + ks * 32 + fq * 8); o[nt] = MFMA16(af, bfr, o[nt]); } }
      bf16_t* dst = (bf16_t*)(p.ws + (kv ? WS_VC : WS_KC)) + (size_t)((b * 4 + g) * 256) * 64;
#pragma unroll
      for (int nt = 0; nt < 4; ++nt)
#pragma unroll
        for (int j = 0; j < 4; ++j) { const int nn = n0 + 4 * fq + j; dst[(size_t)nn * 64 + nt * 16 + fr] = nn > 254 ? (bf16_t)0 : f2bf(o[nt][j]); }
    }
    __syncthreads();
  }
}

DI void nsa_attn_phase(int wv, const P& p, LAS unsigned char* lds) {
  const bf16_t* hb = (const bf16_t*)(p.ws + WS_BIG); const int ld = 2816;
  bf16_t* ob = (bf16_t*)(p.ws + WS_O);
  LAS bf16_t* KsB[2] = {(LAS bf16_t*)lds, (LAS bf16_t*)(lds + 17920)}; LAS bf16_t* VtB[2] = {(LAS bf16_t*)(lds + 9216), (LAS bf16_t*)(lds + 17920 + 9216)};
  LAS bf16_t* KC = (LAS bf16_t*)(lds + 35840); LAS bf16_t* VCT = (LAS bf16_t*)(lds + 72704);
  LAS float* OUTL = (LAS float*)(lds + 35840);
  LAS float* G4s = (LAS float*)(lds + 105984); LAS float* Lsm = (LAS float*)(lds + 122368); LAS float* BT = (LAS float*)(lds + 138752);
  LAS unsigned* SELM = (LAS unsigned*)(lds + 140864); LAS unsigned* UNI = (LAS unsigned*)(lds + 141376);
  for (int it = blockIdx.x; it < 2048; it += gridDim.x) {
    int tid_ = wv * 64 + lane_id_(); asm volatile("" : "+v"(tid_)); const int tid = tid_, wid = wv, lane = tid & 63, r = lane & 31, h = lane >> 5, tl = r >> 2, hd = r & 3;
    const int c = it & 255, ii = it >> 8, bg = c >> 3, b = bg >> 2, g = bg & 3, j8 = c & 7;
    const int qi = (ii & 1) ? (16 * (ii >> 1) + 15 - j8) : (16 * (ii >> 1) + j8);
    const int t0 = 64 * qi, tw = t0 + 8 * wid, t = tw + tl, head = g * 4 + hd;
    const int nct = (4 * qi + 2) / 64 + 1;
    __syncthreads();
    { KVRegs ka, kb; const bf16_t* kcg = (const bf16_t*)(p.ws + WS_KC) + (size_t)((b * 4 + g) * 256) * 64; const bf16_t* vcg = (const bf16_t*)(p.ws + WS_VC) + (size_t)((b * 4 + g) * 256) * 64;
      kv_load(ka, kcg, vcg, 64, tid); if (nct > 1) kv_load(kb, kcg + 64 * 64, vcg + 64 * 64, 64, tid);
      kv_store(ka, KC, VCT, 260, 0, tid); if (nct > 1) kv_store(kb, KC + 64 * KS_STRIDE, VCT, 260, 64, tid);
      if (nct > 2) { kv_load(ka, kcg + 128 * 64, vcg + 128 * 64, 64, tid); if (nct > 3) kv_load(kb, kcg + 192 * 64, vcg + 192 * 64, 64, tid);
        kv_store(ka, KC + 128 * KS_STRIDE, VCT, 260, 128, tid); if (nct > 3) kv_store(kb, KC + 192 * KS_STRIDE, VCT, 260, 192, tid); } }
    for (int i = tid; i < 4 * 132; i += 512) BT[i] = ((const float*)(p.ws + C_BTAB))[g * 4 * 132 + i] * 1.4426950408889634f;
    if (tid < 128) SELM[tid] = 0u; if (tid < 2) UNI[tid] = 0u;
    bf16x8 qf[4];
#pragma unroll
    for (int ks = 0; ks < 4; ++ks) qf[ks] = *(const bf16x8*)(hb + (size_t)(b * SEQ + t) * ld + head * 64 + ks * 16 + 8 * h);
    const size_t rowoff = (size_t)(b * SEQ + t) * ld;
    const float gc = sigmoidf_(bf2f(hb[rowoff + 2560 + head * 3 + 0])), gs = sigmoidf_(bf2f(hb[rowoff + 2560 + head * 3 + 1])), gw = sigmoidf_(bf2f(hb[rowoff + 2560 + head * 3 + 2]));
    const LAS float* btl = BT + hd * 132;
    KVRegs kvr; { const size_t go = (size_t)(b * SEQ) * ld + g * 64; kv_load(kvr, hb + go + 1536, hb + go + 1792, ld, tid); }
    __syncthreads();
    f32x16 O[2];
    float m = -1e30f, l = 0.f;
#pragma unroll 1
    for (int tile = 0; tile < nct; ++tile) { f32x16 s[2]; attn_scores(KC + tile * 64 * KS_STRIDE, qf, r, h, s); attn_logits(s, t, tw, 8, h, 16 * (tile * 64) + 31, 16, 0x7fffffff, true, btl); attn_online<false>(s, m, l, O); }
    { const float lt = l + __shfl_xor(l, 32); const float inv = (m > -1e29f && lt > 0.f) ? 1.0f / lt : 0.f;
      zero_o(O);
#pragma unroll 1
      for (int tile = 0; tile < nct; ++tile) {
        f32x16 s[2]; attn_scores(KC + tile * 64 * KS_STRIDE, qf, r, h, s); attn_logits(s, t, tw, 8, h, 16 * (tile * 64) + 31, 16, 0x7fffffff, true, btl);
        LAS float* gp = G4s + (8 * wid + tl) * 64 + 16 * tile + h; asm volatile("" : "+v"(gp));
#pragma unroll
        for (int sub = 0; sub < 2; ++sub) {
#pragma unroll
          for (int reg = 0; reg < 16; ++reg) { const float v = s[sub][reg]; s[sub][reg] = v > -1e29f ? __builtin_amdgcn_exp2f(v - m) * inv : 0.f; }
#pragma unroll
          for (int lg = 0; lg < 4; ++lg) { float G = s[sub][4 * lg] + s[sub][4 * lg + 1] + s[sub][4 * lg + 2] + s[sub][4 * lg + 3], Lv = s[sub][4 * lg + 3];
            G += __shfl_xor(G, 1); G += __shfl_xor(G, 2); Lv += __shfl_xor(Lv, 1); Lv += __shfl_xor(Lv, 2);
            if (hd == 0) { gp[8 * sub + 2 * lg] = G; gp[4096 + 8 * sub + 2 * lg] = Lv; } }
        }
        attn_pv(VCT + tile * 64, 260, s, O, r, h);
      }
    }
    __syncthreads();
#pragma unroll
    for (int dt = 0; dt < 2; ++dt)
#pragma unroll
      for (int reg = 0; reg < 16; ++reg) OUTL[(dt * 16 + reg) * 512 + tid] = gc * O[dt][reg];
    if (qi < 16) { const unsigned long long full = (qi == 63) ? ~0ull : ((1ull << (qi + 1)) - 1ull);
      int tsel = tid; asm volatile("" : "+v"(tsel));
      if (tsel < 64) { SELM[2 * tsel] = (unsigned)full; SELM[2 * tsel + 1] = (unsigned)(full >> 32); } if (tsel == 0) { UNI[0] = (unsigned)full; UNI[1] = (unsigned)(full >> 32); } }
    else {
      int tsel = tid; asm volatile("" : "+v"(tsel));
      const int tok = tsel >> 3, jj = tsel & 7, hiJ = qi - 2;
#pragma unroll
      for (int e = 0; e < 8; ++e) { const int j = jj * 8 + e; if (j >= 1 && j <= hiJ) G4s[tok * 64 + j] += Lsm[tok * 64 + j - 1]; }
      __syncthreads();
      float mine[8]; int cnt[8];
#pragma unroll
      for (int e = 0; e < 8; ++e) { const int j = jj * 8 + e; mine[e] = (j >= 1 && j <= hiJ) ? G4s[tok * 64 + j] : 0.f; cnt[e] = 0; }
      for (int j2 = 1; j2 <= hiJ; ++j2) { const float v = G4s[tok * 64 + j2];
#pragma unroll
        for (int e = 0; e < 8; ++e) { const int j = jj * 8 + e; cnt[e] += (v > mine[e] || (v == mine[e] && j2 < j)) ? 1 : 0; } }
      unsigned long long bits = 0ull;
#pragma unroll
      for (int e = 0; e < 8; ++e) { const int j = jj * 8 + e; if (j >= 1 && j <= hiJ && cnt[e] < 13) bits |= 1ull << j; }
      if (jj == 0) bits |= 1ull | (1ull << qi) | (1ull << (qi - 1));
      const unsigned blo = (unsigned)bits, bhi = (unsigned)(bits >> 32);
      if (blo) { atomicOr((unsigned*)&SELM[2 * tok], blo); atomicOr((unsigned*)&UNI[0], blo); }
      if (bhi) { atomicOr((unsigned*)&SELM[2 * tok + 1], bhi); atomicOr((unsigned*)&UNI[1], bhi); }
    }
    __syncthreads();
    int buf = 0;
    { const unsigned long long selm = (unsigned long long)SELM[2 * (8 * wid + tl)] | ((unsigned long long)SELM[2 * (8 * wid + tl) + 1] << 32);
      unsigned long long rem = (unsigned long long)UNI[0] | ((unsigned long long)UNI[1] << 32);
      m = -1e30f; l = 0.f; zero_o(O);
      const int jw0 = qi > 8 ? qi - 8 : 0;
#pragma unroll 1
      while (rem) {
        const int j = __builtin_ctzll(rem); rem &= rem - 1ull;
        kv_store(kvr, KsB[buf], VtB[buf], 68, 0, tid);
        __syncthreads();
        { const bool more = rem != 0ull; const int jn = more ? __builtin_ctzll(rem) : jw0;
          const size_t go = (size_t)(b * SEQ + jn * 64) * ld + g * 64; kv_load(kvr, hb + go + (more ? 1536 : 2048), hb + go + (more ? 1792 : 2304), ld, tid); }
        attn_tile(KsB[buf], VtB[buf], 68, qf, O, m, l, t, tw, 8, r, h, j * 64, 1, 0x7fffffff, ((selm >> j) & 1ull) != 0ull, btl);
        buf ^= 1;
      }
      const float lt = l + __shfl_xor(l, 32); const float sc = lt > 0.f ? gs / lt : 0.f;
#pragma unroll
      for (int dt = 0; dt < 2; ++dt)
#pragma unroll
        for (int reg = 0; reg < 16; ++reg) OUTL[(dt * 16 + reg) * 512 + tid] += sc * O[dt][reg];
    }
    { m = -1e30f; l = 0.f; zero_o(O);
#pragma unroll 1
      for (int j = (qi > 8 ? qi - 8 : 0); j <= qi; ++j) {
        kv_store(kvr, KsB[buf], VtB[buf], 68, 0, tid);
        __syncthreads();
        if (j < qi) { const size_t go = (size_t)(b * SEQ + (j + 1) * 64) * ld + g * 64; kv_load(kvr, hb + go + 2048, hb + go + 2304, ld, tid); }
        attn_tile(KsB[buf], VtB[buf], 68, qf, O, m, l, t, tw, 8, r, h, j * 64, 1, 512, true, btl);
        buf ^= 1;
      }
      const float lt = l + __shfl_xor(l, 32); const float sc = lt > 0.f ? gw / lt : 0.f;
#pragma unroll
      for (int dt = 0; dt < 2; ++dt)
#pragma unroll
        for (int reg = 0; reg < 16; ++reg) O[dt][reg] = OUTL[(dt * 16 + reg) * 512 + tid] + sc * O[dt][reg];
    }
    bf16_t* op = ob + (size_t)(b * SEQ + t) * DM + head * 64;
#pragma unroll
    for (int dt = 0; dt < 2; ++dt)
#pragma unroll
      for (int i4 = 0; i4 < 4; ++i4) { u32x2 w; w.x = pk2(O[dt][4 * i4], O[dt][4 * i4 + 1]); w.y = pk2(O[dt][4 * i4 + 2], O[dt][4 * i4 + 3]); *(u32x2*)(op + dt * 32 + 8 * i4 + 4 * h) = w; }
  }
}

DI void swa_attn_phase(int wv, const P& p, int slot, LAS unsigned char* lds) {
  const bf16_t* hb = (const bf16_t*)(p.ws + WS_BIG); const int ld = 1280;
  bf16_t* ob = (bf16_t*)(p.ws + WS_O);
  LAS bf16_t* KsB[2] = {(LAS bf16_t*)lds, (LAS bf16_t*)(lds + 17920)}; LAS bf16_t* VtB[2] = {(LAS bf16_t*)(lds + 9216), (LAS bf16_t*)(lds + 17920 + 9216)};
  LAS float* BT = (LAS float*)(lds + 35840);
  int tid_ = wv * 64 + lane_id_(); asm volatile("" : "+v"(tid_)); const int tid = tid_, wid = tid >> 6, lane = tid & 63, r = lane & 31, h = lane >> 5, tl = r >> 3, hd = r & 7;
  int buf = 0;
  for (int it = blockIdx.x; it < 2048; it += gridDim.x) {
    const int b = it >> 8, kv = (it >> 7) & 1, t0 = (it & 127) * 32;
    const int tw = t0 + 4 * wid, t = tw + tl, head = kv * 8 + hd;
    const int lo = t0 - 127, first = lo <= 0 ? 0 : (lo >> 6), last = (t0 + 31) >> 6;
    KVRegs kvr; { const size_t go = (size_t)(b * SEQ + first * 64) * ld + kv * 64; kv_load(kvr, hb + go + 1024, hb + go + 1152, ld, tid); }
    __syncthreads();
    for (int i = tid; i < 8 * 132; i += 512) BT[i] = ((const float*)(p.ws + C_BTAB))[kv * 8 * 132 + i] * 1.4426950408889634f;
    const size_t rowoff = (size_t)(b * SEQ + t) * ld;
    bf16x8 qf[4];
#pragma unroll
    for (int ks = 0; ks < 4; ++ks) qf[ks] = *(const bf16x8*)(hb + rowoff + head * 64 + ks * 16 + 8 * h);
    const LAS float* btl = BT + hd * 132;
    float m = p.swa_sinks[slot * 16 + head] * 1.4426950408889634f, l = (h == 0) ? 1.0f : 0.0f;
    f32x16 O[2]; zero_o(O);
#pragma unroll 1
    for (int j = first; j <= last; ++j) {
      kv_store(kvr, KsB[buf], VtB[buf], 68, 0, tid);
      __syncthreads();
      if (j < last) { const size_t go = (size_t)(b * SEQ + (j + 1) * 64) * ld + kv * 64; kv_load(kvr, hb + go + 1024, hb + go + 1152, ld, tid); }
      attn_tile(KsB[buf], VtB[buf], 68, qf, O, m, l, t, tw, 4, r, h, j * 64, 1, 128, true, btl);
      buf ^= 1;
    }
    const float lt = l + __shfl_xor(l, 32); const float sc = 1.0f / lt;
    bf16_t* op = ob + (size_t)(b * SEQ + t) * DM + head * 64;
#pragma unroll
    for (int dt = 0; dt < 2; ++dt)
#pragma unroll
      for (int i4 = 0; i4 < 4; ++i4) { u32x2 w; w.x = pk2(sc * O[dt][4 * i4], sc * O[dt][4 * i4 + 1]); w.y = pk2(sc * O[dt][4 * i4 + 2], sc * O[dt][4 * i4 + 3]); *(u32x2*)(op + dt * 32 + 8 * i4 + 4 * h) = w; }
  }
}
constexpr size_t HG_Q = WS_BIG, HG_K = WS_BIG + 64 * MiB, HG_V = WS_BIG + 128 * MiB, HG_G = WS_BIG + 192 * MiB, HG_LF = WS_BIG + 256 * MiB;
DI void hgrn_scan_phase(int wv, const P& p, LAS unsigned char* lds, float* sumsq) {
  const bf16_t* hq = (const bf16_t*)(p.ws + HG_Q); const bf16_t* hk = (const bf16_t*)(p.ws + HG_K); const bf16_t* hv = (const bf16_t*)(p.ws + HG_V);
  const _Float16* hlf = (const _Float16*)(p.ws + HG_LF);
  bf16_t* oraw = (bf16_t*)(p.ws + WS_TB);
  LAS bf16_t* Q = (LAS bf16_t*)lds; LAS bf16_t* Kr = (LAS bf16_t*)(lds + 17408); LAS float* BC = (LAS float*)(lds + 34816); LAS bf16_t* KDT = (LAS bf16_t*)(lds + 68608);
  LAS bf16_t* VT = (LAS bf16_t*)(lds + 87040); LAS bf16_t* ST = (LAS bf16_t*)(lds + 91648); LAS bf16_t* AB = (LAS bf16_t*)(lds + 100352);
  LAS float* SEG = (LAS float*)(lds + 109568); LAS float* DEC = (LAS float*)(lds + 111616); LAS _Float16* LF = (LAS _Float16*)(lds + 112128);
  int tid_ = wv * 64 + lane_id_(); asm volatile("" : "+v"(tid_)); const int tid = tid_, wid = tid >> 6, lane = tid & 63, fr = lane & 15, fq = lane >> 4;
  for (int it = blockIdx.x; it < 256; it += gridDim.x) {
    const int b = it >> 5, hh = (it >> 2) & 7, vq = it & 3;
    __syncthreads();
    for (int i = tid; i < 32 * 136 / 2; i += 512) ((LAS unsigned*)ST)[i] = 0u;
    f32x4 sreg[2]; sreg[0] = (f32x4){0.f, 0.f, 0.f, 0.f}; sreg[1] = sreg[0];
    u32x4 pq[2], pkk[2], plf[2], pv;
    const size_t gb = (size_t)(b * SEQ) * 1024 + hh * 128;
    auto prefetch = [&](int c) {
#pragma unroll
      for (int i = 0; i < 2; ++i) { const int idx = tid + 512 * i, row = idx >> 4, c8 = (idx & 15) * 8; const size_t off = gb + (size_t)(c * 64 + row) * 1024 + c8;
        pq[i] = *(const u32x4*)(hq + off); pkk[i] = *(const u32x4*)(hk + off); plf[i] = *(const u32x4*)(hlf + off); }
      if (tid < 256) { const int row = tid >> 2, c8 = (tid & 3) * 8; pv = *(const u32x4*)(hv + gb + (size_t)(c * 64 + row) * 1024 + vq * 32 + c8); }
    };
    prefetch(0);
    for (int c = 0; c < 64; ++c) {
      __syncthreads();
#pragma unroll
      for (int i = 0; i < 2; ++i) { const int idx = tid + 512 * i, row = idx >> 4, c8 = (idx & 15) * 8;
        *(LAS u32x4*)(Q + row * 136 + c8) = pq[i]; *(LAS u32x4*)(Kr + row * 136 + c8) = pkk[i]; *(LAS u32x4*)(LF + row * 128 + c8) = plf[i]; }
      if (tid < 256) { const int row = tid >> 2, c8 = (tid & 3) * 8; const bf16x8 vv = __builtin_bit_cast(bf16x8, pv);
#pragma unroll
        for (int i = 0; i < 8; ++i) VT[(c8 + i) * 72 + row] = (bf16_t)vv[i]; }
      if (c + 1 < 64) prefetch(c + 1);
      __syncthreads();
      const int kx = tid & 127, seg = tid >> 7;
      float bl[16];
      { float run = 0.f;
#pragma unroll
        for (int i = 0; i < 16; ++i) { run += (float)LF[(16 * seg + i) * 128 + kx]; bl[i] = run; }
        SEG[seg * 128 + kx] = run; }
      __syncthreads();
      { float pre = 0.f, blast = 0.f;
#pragma unroll
        for (int s2 = 0; s2 < 4; ++s2) { const float v = SEG[s2 * 128 + kx]; blast += v; if (s2 < seg) pre += v; }
        u32x4 w0, w1; float kd[16];
#pragma unroll
        for (int i = 0; i < 16; ++i) { const float bc = pre + bl[i]; BC[(16 * seg + i) * 132 + kx] = bc; kd[i] = bf2f(Kr[(16 * seg + i) * 136 + kx]) * __expf(blast - bc); }
#pragma unroll
        for (int j = 0; j < 4; ++j) { w0[j] = pk2(kd[2 * j], kd[2 * j + 1]); w1[j] = pk2(kd[8 + 2 * j], kd[8 + 2 * j + 1]); }
        *(LAS u32x4*)(KDT + kx * 72 + 16 * seg) = w0; *(LAS u32x4*)(KDT + kx * 72 + 16 * seg + 8) = w1;
        if (seg == 0) DEC[kx] = __expf(blast); }
      __syncthreads();
      const int mt = wid >> 1, vt = wid & 1;
      f32x4 oacc = (f32x4){0.f, 0.f, 0.f, 0.f}, a0 = oacc, a1 = oacc;
      const int J0 = 2 * vt;
#pragma unroll
      for (int ks = 0; ks < 4; ++ks) {
        const int kb = 32 * ks + 8 * fq, trow = 16 * mt + fr;
        const bf16x8 qv = *(const LAS bf16x8*)(Q + trow * 136 + kb);
        const f32x4 bc0 = *(const LAS f32x4*)(BC + trow * 132 + kb), bc1 = *(const LAS f32x4*)(BC + trow * 132 + kb + 4);
        const f32x4 r0 = *(const LAS f32x4*)(BC + (16 * mt) * 132 + kb), r1 = *(const LAS f32x4*)(BC + (16 * mt) * 132 + kb + 4);
        u32x4 ai, aq;
#pragma unroll
        for (int j = 0; j < 4; ++j) {
          const float q0 = bf2f((bf16_t)qv[2 * j]), q1 = bf2f((bf16_t)qv[2 * j + 1]);
          const float b0 = j < 2 ? bc0[2 * j] : bc1[2 * j - 4], b1 = j < 2 ? bc0[2 * j + 1] : bc1[2 * j - 3];
          const float rr0 = j < 2 ? r0[2 * j] : r1[2 * j - 4], rr1 = j < 2 ? r0[2 * j + 1] : r1[2 * j - 3];
          ai[j] = pk2(q0 * __expf(b0), q1 * __expf(b1)); aq[j] = pk2(q0 * __expf(b0 - rr0), q1 * __expf(b1 - rr1));
        }
        const bf16x8 sb = *(const LAS bf16x8*)(ST + (16 * vt + fr) * 136 + kb);
        oacc = MFMA16(__builtin_bit_cast(bf16x8, ai), sb, oacc);
#pragma unroll
        for (int jj = 0; jj < 2; ++jj) {
          const int J = J0 + jj; if (J > mt) continue;
          const int srow = 16 * J + fr;
          const bf16x8 kv = *(const LAS bf16x8*)(Kr + srow * 136 + kb);
          const f32x4 c0 = *(const LAS f32x4*)(BC + srow * 132 + kb), c1 = *(const LAS f32x4*)(BC + srow * 132 + kb + 4);
          u32x4 bk;
#pragma unroll
          for (int j = 0; j < 4; ++j) {
            const float k0 = bf2f((bf16_t)kv[2 * j]), k1 = bf2f((bf16_t)kv[2 * j + 1]);
            const float b0 = j < 2 ? c0[2 * j] : c1[2 * j - 4], b1 = j < 2 ? c0[2 * j + 1] : c1[2 * j - 3];
            const float rr0 = j < 2 ? r0[2 * j] : r1[2 * j - 4], rr1 = j < 2 ? r0[2 * j + 1] : r1[2 * j - 3];
            bk[j] = pk2(k0 * __expf(fminf(rr0 - b0, 80.f)), k1 * __expf(fminf(rr1 - b1, 80.f)));
          }
          if (jj == 0) a0 = MFMA16(__builtin_bit_cast(bf16x8, aq), __builtin_bit_cast(bf16x8, bk), a0);
          else a1 = MFMA16(__builtin_bit_cast(bf16x8, aq), __builtin_bit_cast(bf16x8, bk), a1);
        }
      }
#pragma unroll
      for (int jj = 0; jj < 2; ++jj) { const int J = J0 + jj;
#pragma unroll
        for (int reg = 0; reg < 4; ++reg) { const int tt = 16 * mt + 4 * fq + reg, ss = 16 * J + fr; const float v = jj == 0 ? a0[reg] : a1[reg];
          AB[tt * 72 + ss] = (J <= mt && ss <= tt) ? f2bf(v) : (bf16_t)0; } }
      __syncthreads();
#pragma unroll
      for (int k2 = 0; k2 < 2; ++k2) {
        const bf16x8 af = *(const LAS bf16x8*)(AB + (16 * mt + fr) * 72 + 32 * k2 + 8 * fq);
        const bf16x8 vb = *(const LAS bf16x8*)(VT + (16 * vt + fr) * 72 + 32 * k2 + 8 * fq);
        oacc = MFMA16(af, vb, oacc);
      }
#pragma unroll
      for (int reg = 0; reg < 4; ++reg) {
        const int tok = b * SEQ + c * 64 + 16 * mt + 4 * fq + reg; const float v = oacc[reg];
        oraw[(size_t)tok * 1024 + hh * 128 + vq * 32 + 16 * vt + fr] = f2bf(v);
        float sq = v * v; sq += __shfl_xor(sq, 1); sq += __shfl_xor(sq, 2); sq += __shfl_xor(sq, 4); sq += __shfl_xor(sq, 8);
        if (fr == 0) atomicAdd(sumsq + (size_t)tok * 8 + hh, sq);
      }
      { const f32x4 dc = *(const LAS f32x4*)(DEC + 16 * wid + 4 * fq);
        sreg[0] *= dc; sreg[1] *= dc;
#pragma unroll
        for (int k2 = 0; k2 < 2; ++k2) {
          const bf16x8 af = *(const LAS bf16x8*)(KDT + (16 * wid + fr) * 72 + 32 * k2 + 8 * fq);
#pragma unroll
          for (int v2 = 0; v2 < 2; ++v2) { const bf16x8 vb = *(const LAS bf16x8*)(VT + (16 * v2 + fr) * 72 + 32 * k2 + 8 * fq); sreg[v2] = MFMA16(af, vb, sreg[v2]); }
        }
#pragma unroll
        for (int v2 = 0; v2 < 2; ++v2) { u32x2 w; w.x = pk2(sreg[v2][0], sreg[v2][1]); w.y = pk2(sreg[v2][2], sreg[v2][3]); *(LAS u32x2*)(ST + (16 * v2 + fr) * 136 + 16 * wid + 4 * fq) = w; }
      }
    }
  }
}
DI void hgrn_norm_phase(int wv, const P& p, int slot) {
  const bf16_t* oraw = (const bf16_t*)(p.ws + WS_TB); const bf16_t* hg = (const bf16_t*)(p.ws + HG_G); const float* sumsq = (const float*)(p.ws + WS_SUMSQ);
  bf16_t* ob = (bf16_t*)(p.ws + WS_O); const float* gain = p.hg_gain + slot * 128;
  int tid_ = wv * 64 + lane_id_(); asm volatile("" : "+v"(tid_)); const size_t gtid = (size_t)blockIdx.x * 512 + tid_, gsz = (size_t)gridDim.x * 512;
  for (size_t i = gtid; i < (size_t)MTOK * 1024 / 8; i += gsz) {
    const size_t e = i * 8; const int row = (int)(e >> 10), col = (int)(e & 1023), hh = col >> 7, vv = col & 127;
    const float rs = rsqrtf(sumsq[(size_t)row * 8 + hh] * (1.0f / 128.0f) + 1e-6f);
    const bf16x8 o8 = *(const bf16x8*)(oraw + e), g8 = *(const bf16x8*)(hg + e);
    u32x4 w;
#pragma unroll
    for (int j = 0; j < 4; ++j) w[j] = pk2(bf2f((bf16_t)o8[2 * j]) * rs * gain[vv + 2 * j] * bf2f((bf16_t)g8[2 * j]), bf2f((bf16_t)o8[2 * j + 1]) * rs * gain[vv + 2 * j + 1] * bf2f((bf16_t)g8[2 * j + 1]));
    *(u32x4*)(ob + e) = w;
  }
}
#define REP_NSA 1
#define REP_CONV 1
#define REP_CMP 1
#define REP_MISC 1
#define REP_DOWN 1
#define REP_HG 1
#ifndef SKIP_MIXERS
#define SKIP_MIXERS 0
#endif
__global__ void __launch_bounds__(512, 2) mega_fwd(P p) {
  extern __shared__ __attribute__((aligned(16))) unsigned char lds_raw[];
  LAS unsigned char* lds = (LAS unsigned char*)lds_raw;
  cg::grid_group grid = cg::this_grid();
  const int wv = __builtin_amdgcn_readfirstlane((int)(threadIdx.x >> 6));
  volatile LAS unsigned* xst = (volatile LAS unsigned*)(lds + LDS_BYTES - 16);
  if (wv == 0 && lane_id_() < 4) xst[lane_id_()] = 0u;
  __syncthreads();
  const XcdBarrier xb = xcd_barrier_post(wv, (unsigned*)(p.ws + WS_BAR), xst);
#define GSYNC() xcd_barrier(wv, xb)
  unsigned char* ws = p.ws;
  float* stats = (float*)(ws + WS_STATS);
  bf16_t* tb = (bf16_t*)(ws + WS_TB); bf16_t* Hb = (bf16_t*)(ws + WS_BIG); bf16_t* ob = (bf16_t*)(ws + WS_O);
  init_phase(wv, p);
  for (int L = 0; L < 4; ++L) {
    for (int rep = 0; rep < p.rep_conv; ++rep) convert_phase(wv, p, L, lds);
    if (L == 0) grid.sync(); else GSYNC();
    const int kind = L % 3, slot = L / 3;
    for (int s = 0; s < 3; ++s) {
      const int lnp = L * 3 + s - 1;
      const float* stp = lnp >= 0 ? stats + (size_t)lnp * MTOK * 2 : nullptr;
      pg8::Gemm gr; float scale;
      if (s != 1) {
        pg8::Gemm g; g.A = tb; g.Bt = (const bf16_t*)(ws + (s == 0 ? W_GU1 : W_GU2)); g.M = MTOK; g.N = 5632; g.K = DM;
        pg8::StaticOrder S; S.init(g.M, g.N, gridDim.x, blockIdx.x);
        EpiUp E; E.H = Hb; E.stats = stp; E.c1 = (const float*)(ws + (s == 0 ? C_GU1 : C_GU2)); E.c2 = E.c1 + 5632;
        pg8::gemm_phase(wv, lds, g, S, E);
        GSYNC();
        gr.A = Hb; gr.Bt = (const bf16_t*)(ws + (s == 0 ? W_D1 : W_D2)); gr.M = MTOK; gr.N = DM; gr.K = DFF; scale = 0.5f;
      } else {
        pg8::Gemm g; g.A = tb; g.Bt = (const bf16_t*)(ws + W_IN); g.M = MTOK; g.N = kind == 0 ? 2816 : (kind == 1 ? 4096 : 1280); g.K = DM;
        pg8::StaticOrder S; S.init(g.M, g.N, gridDim.x, blockIdx.x);
        EpiIn E; E.mode = kind == 1 ? 1 : 0; E.h = Hb; E.ld = g.N; E.stats = stp; E.c1 = (const float*)(ws + C_IN); E.c2 = E.c1 + 4096; E.lbv = (const float*)(ws + C_LBV);
        E.hq = (bf16_t*)(ws + HG_Q); E.hk = (bf16_t*)(ws + HG_K); E.hv = (bf16_t*)(ws + HG_V); E.hg = (bf16_t*)(ws + HG_G); E.hlf = (_Float16*)(ws + HG_LF);
        pg8::gemm_phase(wv, lds, g, S, E);
        GSYNC();
#if !SKIP_MIXERS
        if (kind == 0) {
          for (int rep = 0; rep < p.rep_cmp; ++rep) nsa_compress_phase(wv, p, lds);
          GSYNC();
          for (int rep = 0; rep < p.rep_nsa; ++rep) { if (rep) GSYNC(); nsa_attn_phase(wv, p, lds); }
        }
        else if (kind == 1) {
          for (int rep = p.rep_hg - 1; rep >= 0; --rep) hgrn_scan_phase(wv, p, lds, (float*)(ws + (rep ? WS_KC : WS_SUMSQ)));
          GSYNC(); hgrn_norm_phase(wv, p, slot); }
        else {
          for (int rep = 0; rep < p.rep_misc; ++rep) swa_attn_phase(wv, p, slot, lds);
        }
#endif
        GSYNC();
        gr.A = ob; gr.Bt = (const bf16_t*)(ws + W_OUT); gr.M = MTOK; gr.N = DM; gr.K = DM; scale = 1.0f;
      }
      pg8::StaticOrder S2; S2.init(gr.M, gr.N, gridDim.x, blockIdx.x);
      EpiRes R; R.T = p.out; R.Tin = lnp >= 0 ? p.out : p.x; R.stats_prev = stp; R.g = p.ln_gain + (size_t)(lnp >= 0 ? lnp : 0) * DM; R.b = p.ln_bias + (size_t)(lnp >= 0 ? lnp : 0) * DM;
      R.stats_new = stats + (size_t)(lnp + 1) * MTOK * 2; R.tb = tb; R.scale = scale;
      for (int rep = (s != 1 ? p.rep_down : 1) - 1; rep >= 0; --rep) {
        if (rep) { R.T = (float*)(ws + WS_BIG + 192 * MiB); R.tb = (bf16_t*)(ws + WS_O); R.stats_new = (float*)(ws + WS_KC); }
        else { R.T = p.out; R.tb = tb; R.stats_new = stats + (size_t)(lnp + 1) * MTOK * 2; }
        pg8::gemm_phase(wv, lds, gr, S2, R);
        GSYNC();
      }
    }
  }
  final_ln(wv, p, stats + (size_t)11 * MTOK * 2, p.ln_gain + 11 * DM, p.ln_bias + 11 * DM);
}

extern "C" void kernel_launch(void* const* d_in, const int* in_sizes, int n_in, void* d_out, int out_size, void* d_ws, size_t ws_size, hipStream_t stream) {
  static int grid = 0;
  if (grid == 0) {
    if (n_in != 22 || ws_size < WS_END) { fprintf(stderr, "kernel_launch: unexpected n_in %d / ws_size %zu (need %zu)\n", n_in, ws_size, (size_t)WS_END); grid = -1; return; }
    int dev = 0, cus = 0, per_cu = 0;
    hipGetDevice(&dev); hipDeviceGetAttribute(&cus, hipDeviceAttributeMultiprocessorCount, dev);
    if (hipFuncSetAttribute((const void*)mega_fwd, hipFuncAttributeMaxDynamicSharedMemorySize, LDS_BYTES) != hipSuccess) { fprintf(stderr, "hipFuncSetAttribute failed\n"); grid = -1; return; }
    hipOccupancyMaxActiveBlocksPerMultiprocessor(&per_cu, (const void*)mega_fwd, 512, LDS_BYTES);
    if (per_cu < 1) { fprintf(stderr, "occupancy query says %d blocks/CU\n", per_cu); per_cu = 1; }
    (void)hipGetLastError();
    grid = cus * 1;
  }
  if (grid < 0) return;
  if (hipMemsetAsync((char*)d_ws + WS_BAR, 0, 16384, stream) != hipSuccess) { fprintf(stderr, "memset failed\n"); return; }
  P p{};
  const float** pp = (const float**)&p;
  for (int i = 0; i < 22; ++i) pp[i] = (const float*)d_in[i];
  p.out = (float*)d_out; p.ws = (unsigned char*)d_ws;
  p.rep_nsa = REP_NSA; p.rep_conv = REP_CONV; p.rep_cmp = REP_CMP; p.rep_misc = REP_MISC; p.rep_down = REP_DOWN; p.rep_hg = REP_HG;
  void* args[] = {&p};
  hipError_t e = hipLaunchCooperativeKernel((const void*)mega_fwd, dim3(grid), dim3(512), args, LDS_BYTES, stream);
  if (e != hipSuccess) fprintf(stderr, "cooperative launch failed: %s (grid %d)\n", hipGetErrorString(e), grid);
}
```

```cpp
#include <hip/hip_runtime.h>
#include <hip/hip_cooperative_groups.h>
#include <cstdio>
namespace cg = cooperative_groups;

typedef unsigned short bf16_t;
typedef short bf16x8 __attribute__((ext_vector_type(8)));
typedef short s16x4 __attribute__((ext_vector_type(4)));
typedef float f32x4 __attribute__((ext_vector_type(4)));
typedef float f32x16 __attribute__((ext_vector_type(16)));
typedef unsigned u32x2 __attribute__((ext_vector_type(2)));
typedef unsigned u32x4 __attribute__((ext_vector_type(4)));
#define LAS __attribute__((address_space(3)))
#define DI __device__ __forceinline__

constexpr int MTOK = 32768, DM = 1024, DFF = 2816, SEQ = 4096, NB = 8;
constexpr float ALPHA = 1.681792830507429f;
constexpr size_t MiB = 1ull << 20;
constexpr size_t W_GU1 = 0, W_D1 = 11534336, W_GU2 = 17301504, W_D2 = 28835840, W_IN = 34603008, W_OUT = 42991616,
                 W_W1T = 45088768, W_W2T = 46137344, W_C = 46170112;
constexpr size_t C_GU1 = W_C, C_GU2 = C_GU1 + 2 * 5632 * 4, C_IN = C_GU2 + 2 * 5632 * 4, C_POSB = C_IN + 2 * 4096 * 4,
                 C_LBV = C_POSB + 2 * 256 * 4, C_BTAB = C_LBV + 1024 * 4, C_END = C_BTAB + 16 * 132 * 4;
constexpr size_t WS_TB = 48 * MiB, WS_BIG = 112 * MiB, WS_O = 432 * MiB, WS_MISC = 496 * MiB;
constexpr size_t WS_DSTATS = WS_MISC, WS_STATS = WS_DSTATS + 262144, WS_SUMSQ = WS_STATS + 3 * MiB, WS_KC = WS_SUMSQ + 1 * MiB, WS_VC = WS_KC + 1 * MiB, WS_BAR = WS_VC + 1 * MiB,
                 WS_G13 = WS_BAR + 16384, WS_B13 = WS_G13 + 13 * 4096, WS_END = WS_B13 + 13 * 4096;
static_assert(C_END <= 48 * MiB, "weights region");
constexpr int LDS_BYTES = 144 * 1024;

struct P {
  const float *x, *rel_bias, *ln_gain, *ln_bias, *f1g, *f1u, *f1d, *f2g, *f2u, *f2d, *nsa_win, *nsa_wout, *nsa_pos, *nsa_w1, *nsa_w2,
      *hg_win, *hg_wout, *hg_gain, *hg_lb, *swa_win, *swa_wout, *swa_sinks;
  float* out; unsigned char* ws;
  int rep_nsa, rep_conv, rep_cmp, rep_misc, rep_down, rep_hg, rep_epi, rep_pad;
};

DI unsigned pk2(float a, float b) { typedef __bf16 bf2 __attribute__((ext_vector_type(2))); bf2 v; v[0] = (__bf16)a; v[1] = (__bf16)b; return __builtin_bit_cast(unsigned, v); }
DI bf16_t f2bf(float a) { return __builtin_bit_cast(unsigned short, (__bf16)a); }
DI float bf2f(bf16_t v) { return __uint_as_float(((unsigned)v) << 16); }
DI int lane_id_() { int l; asm volatile("v_mbcnt_lo_u32_b32 %0, -1, 0\n\tv_mbcnt_hi_u32_b32 %0, -1, %0" : "=v"(l)); return l; }
DI float sigmoidf_(float v) { return __builtin_amdgcn_rcpf(1.0f + __builtin_amdgcn_exp2f(-1.4426950408889634f * v)); }


#define XB_TMO      128
#define XB_XCNT(j)  (256  + 64 * (j))
#define XB_XSUB(j)  (1280 + 64 * (j))
#define XB_XGEN(j)  (2304 + 64 * (j))
#define XB_TOP      3328
#define XB_TOPGEN   3392
#define XCD_BAR_WORDS 3456
#define XB_SPIN_CAP (1u << 20)
DI unsigned xb_ld(unsigned* p)              { return __hip_atomic_load(p, __ATOMIC_RELAXED, __HIP_MEMORY_SCOPE_AGENT); }
DI unsigned xb_add(unsigned* p, unsigned v) { return __hip_atomic_fetch_add(p, v, __ATOMIC_RELAXED, __HIP_MEMORY_SCOPE_AGENT); }
DI unsigned xb_xcc_id() { return (unsigned)__builtin_amdgcn_s_getreg((3 << 11) | 20) & 0xFu; }
#define XB_SPIN(cond, bar) do { unsigned _sp = 0; while (cond) { __builtin_amdgcn_s_sleep(1); \
    if ((++_sp & 255u) == 0u) { if (xb_ld(&(bar)[XB_TMO])) break; if (_sp > XB_SPIN_CAP) { atomicAdd(&(bar)[XB_TMO], 1u); break; } } } } while (0)
struct XcdBarrier { unsigned* bar; unsigned x; volatile LAS unsigned* st; };
DI XcdBarrier xcd_barrier_post(int wv, unsigned* bar, volatile LAS unsigned* st) {
  XcdBarrier b; b.bar = bar; b.x = xb_xcc_id(); b.st = st;
  if (wv == 0 && lane_id_() == 0) (void)xb_add(&bar[XB_XCNT(b.x)], 1u);
  return b;
}
DI void xcd_barrier_complete(unsigned* bar, unsigned x, unsigned& nloc, unsigned& nx) {
  const unsigned G = gridDim.x * gridDim.y * gridDim.z;
  unsigned sum, cnt, mine, sp = 0u;
  for (;;) {
    sum = 0u; cnt = 0u; mine = 0u;
#pragma unroll 1
    for (unsigned j = 0; j < 16; ++j) { const unsigned c = xb_ld(&bar[XB_XCNT(j)]); sum += c; cnt += (c > 0u) ? 1u : 0u; mine = (j == x) ? c : mine; }
    if (sum == G) break;
    __builtin_amdgcn_s_sleep(1);
    if ((++sp & 255u) == 0u) { if (xb_ld(&bar[XB_TMO])) break; if (sp > XB_SPIN_CAP) { atomicAdd(&bar[XB_TMO], 1u); break; } }
  }
  nloc = mine > 0u ? mine : 1u; nx = cnt > 0u ? cnt : 1u;
}
DI void xcd_barrier(int wv, const XcdBarrier& b) {
  asm volatile("s_waitcnt vmcnt(0)" ::: "memory");
  __syncthreads();
  if (wv == 0 && lane_id_() == 0) {
    unsigned* bar = b.bar;
    __builtin_amdgcn_s_waitcnt(0);
    unsigned nloc = b.st[0], nx = b.st[1];
    if (nloc == 0u) { xcd_barrier_complete(bar, b.x, nloc, nx); b.st[0] = nloc; b.st[1] = nx; }
    const unsigned old = xb_add(&bar[XB_XSUB(b.x)], 1u);
    const unsigned gen = old / nloc;
    if (old + 1u == (gen + 1u) * nloc) {
      __builtin_amdgcn_fence(__ATOMIC_RELEASE, "agent");
      asm volatile("s_waitcnt vmcnt(0)" ::: "memory");
      const unsigned og = xb_add(&bar[XB_TOP], 1u);
      const unsigned tg = og / nx;
      if (og + 1u == (tg + 1u) * nx) xb_add(&bar[XB_TOPGEN], 1u);
      else XB_SPIN(xb_ld(&bar[XB_TOPGEN]) == tg, bar);
      __builtin_amdgcn_fence(__ATOMIC_ACQUIRE, "agent");
      xb_add(&bar[XB_XGEN(b.x)], 1u);
      asm volatile("s_waitcnt vmcnt(0)" ::: "memory");
    } else {
      XB_SPIN(xb_ld(&bar[XB_XGEN(b.x)]) == gen, bar);
      __builtin_amdgcn_fence(__ATOMIC_ACQUIRE, "agent");
      asm volatile("s_waitcnt vmcnt(0)" ::: "memory");
    }
  }
  __syncthreads();
}

namespace pg8 {
constexpr int BM = 256, BK = 64, HALF = 128, HTB = HALF * BK * 2, STAGE_BYTES = 8 * HTB, NXCD = 8, WGM = 8;
DI int lds_byte(int r, int c) { const int st = (r >> 4) * 2 + (c >> 5), rr = r & 15, cc = c & 31, ob = rr * 64 + cc * 2; return st * 1024 + (ob ^ (((ob >> 9) & 1) << 5)); }
DI void stage_rc(int b, int& R, int& C) { const int st = b / 1024, sb = b % 1024, swz = sb ^ (((sb >> 9) & 1) << 5); R = (st >> 1) * 16 + swz / 64; C = (st & 1) * 32 + (swz % 64) / 2; }
struct Unit { int pm, pn; };
struct Gemm { const bf16_t* A; const bf16_t* Bt; int M, N, K; };
struct StaticOrder {
  int nM, nN, nwg, G, c;
  DI void init(int M, int N, int G_, int c_) { nM = M / BM; nN = N / BM; nwg = nM * nN; G = G_; c = c_; }
  DI bool next(int i, Unit& u) const {
    const long L = (long)i * G + c; if (L >= nwg) return false;
    int wgid = (int)L; { const int q = nwg / NXCD, r = nwg % NXCD, xcd = wgid % NXCD, off = wgid / NXCD; wgid = (xcd < r ? xcd * (q + 1) : r * (q + 1) + (xcd - r) * q) + off; }
    const int nig = WGM * nN, gid = wgid / nig, fm = gid * WGM, gsz = (nM - fm) < WGM ? (nM - fm) : WGM;
    u.pm = fm + ((wgid % nig) % gsz); u.pn = (wgid % nig) / gsz; return true;
  }
};
template <class Epi>
DI void gemm_phase(int wv, LAS unsigned char* lds, const Gemm g, const StaticOrder& S, const Epi& E) {
  int tid_ = wv * 64 + lane_id_(); asm volatile("" : "+v"(tid_)); const int tid = tid_, wid = __builtin_amdgcn_readfirstlane(tid >> 6), lane = tid & 63, wr = wid >> 2, wc = wid & 3, fr = lane & 15, fq = lane >> 4;
  const int K = g.K, nt = K / BK;
  unsigned voffA[2];
#pragma unroll
  for (int i = 0; i < 2; ++i) { int R, C; stage_rc(tid * 16 + i * 8192, R, C); voffA[i] = (unsigned)(R * K + C) * 2u; }
  const size_t kstep = (size_t)(BK * 2), hstep = (size_t)HALF * K * 2, tstep = 2 * hstep;
  const unsigned ldsw = (unsigned)wid * 1024u;
  const int aoff = lds_byte(wr * 64 + fr, fq * 8), boff = lds_byte(wc * 32 + fr, fq * 8);
#define PG8_SA(b, h) (((b) * 2 + (h)) * HTB)
#define PG8_SB(b, h) ((4 + (b) * 2 + (h)) * HTB)
#define PG8_STAGE(bufoff, gbase, voff) do { _Pragma("unroll") for (int _i = 0; _i < 2; ++_i) \
    __builtin_amdgcn_global_load_lds((const unsigned*)((const char*)(gbase) + (voff)[_i]), (LAS unsigned*)(lds + (bufoff) + ldsw + _i * 8192), 16, 0, 0); } while (0)
#define PG8_LDA(dst, b, h) do { _Pragma("unroll") for (int m = 0; m < 4; ++m) _Pragma("unroll") for (int k = 0; k < 2; ++k) dst[m][k] = *(const LAS bf16x8*)(lds + PG8_SA(b, h) + aoff + m * 2048 + k * 1024); } while (0)
#define PG8_LDB(dst, b, h) do { _Pragma("unroll") for (int n = 0; n < 2; ++n) _Pragma("unroll") for (int k = 0; k < 2; ++k) dst[n][k] = *(const LAS bf16x8*)(lds + PG8_SB(b, h) + boff + n * 2048 + k * 1024); } while (0)
#define PG8_MMA(ai, bj, At, Bt) do { __builtin_amdgcn_s_setprio(1); _Pragma("unroll") for (int m = 0; m < 4; ++m) _Pragma("unroll") for (int n = 0; n < 2; ++n) _Pragma("unroll") for (int k = 0; k < 2; ++k) \
    acc[ai][bj][m][n] = __builtin_amdgcn_mfma_f32_16x16x32_bf16(Bt[n][k], At[m][k], acc[ai][bj][m][n], 0, 0, 0); __builtin_amdgcn_s_setprio(0); } while (0)
#define PG8_WAIT_V(n) asm volatile("s_waitcnt vmcnt(" #n ")" ::: "memory")
#define PG8_WAIT_L(n) asm volatile("s_waitcnt lgkmcnt(" #n ")" ::: "memory")
#define PG8_BAR __builtin_amdgcn_s_barrier()
#define PG8_SCHED __builtin_amdgcn_sched_barrier(0)
  Unit cur, nxt; int ui = 0;
  if (!S.next(0, cur)) return;
  f32x4 acc[2][2][4][2];
#pragma unroll
  for (int a = 0; a < 2; ++a)
#pragma unroll
    for (int b = 0; b < 2; ++b)
#pragma unroll
      for (int m = 0; m < 4; ++m)
#pragma unroll
        for (int n = 0; n < 2; ++n) acc[a][b][m][n] = (f32x4){0.f, 0.f, 0.f, 0.f};
  bf16x8 At[4][2], B0[2][2], B1[2][2];
  const char* cA = (const char*)g.A + (size_t)cur.pm * tstep; const char* cB = (const char*)g.Bt + (size_t)cur.pn * tstep;
  PG8_STAGE(PG8_SB(0, 0), cB, voffA); PG8_STAGE(PG8_SA(0, 0), cA, voffA); PG8_STAGE(PG8_SB(0, 1), cB + hstep, voffA); PG8_STAGE(PG8_SA(0, 1), cA + hstep, voffA);
  if (wr == 1) PG8_BAR;
  PG8_WAIT_V(4); PG8_BAR;
  PG8_STAGE(PG8_SB(1, 0), cB + kstep, voffA); PG8_STAGE(PG8_SA(1, 0), cA + kstep, voffA); PG8_STAGE(PG8_SB(1, 1), cB + hstep + kstep, voffA);
  PG8_WAIT_V(6); PG8_BAR;
  for (;;) {
    const bool has_next = S.next(ui + 1, nxt);
    const char* nA = has_next ? (const char*)g.A + (size_t)nxt.pm * tstep : cA; const char* nB = has_next ? (const char*)g.Bt + (size_t)nxt.pn * tstep : cB;
    for (int t = 0; t < nt; t += 2) {
      const bool last = (t == nt - 2);
      const char* a1 = cA + (size_t)(t + 1) * kstep;
      const char* a2 = last ? nA : cA + (size_t)(t + 2) * kstep; const char* b2 = last ? nB : cB + (size_t)(t + 2) * kstep;
      const char* a3 = a2 + kstep; const char* b3 = b2 + kstep;
      PG8_LDB(B0, 0, 0); PG8_SCHED; PG8_LDA(At, 0, 0); PG8_STAGE(PG8_SA(1, 1), a1 + hstep, voffA);
      PG8_WAIT_L(8); PG8_BAR; PG8_WAIT_L(0); PG8_MMA(0, 0, At, B0); PG8_BAR; PG8_SCHED;
      PG8_LDB(B1, 0, 1); PG8_STAGE(PG8_SB(0, 0), b2, voffA);
      PG8_BAR; PG8_WAIT_L(0); PG8_MMA(0, 1, At, B1); PG8_BAR;
      PG8_LDA(At, 0, 1); PG8_STAGE(PG8_SA(0, 0), a2, voffA);
      PG8_BAR; PG8_WAIT_L(0); PG8_MMA(1, 0, At, B0); PG8_BAR; PG8_SCHED;
      PG8_STAGE(PG8_SB(0, 1), b2 + hstep, voffA);
      PG8_WAIT_V(6); PG8_BAR; PG8_MMA(1, 1, At, B1); PG8_BAR;
      PG8_LDB(B0, 1, 0); PG8_SCHED; PG8_LDA(At, 1, 0); PG8_STAGE(PG8_SA(0, 1), a2 + hstep, voffA);
      PG8_WAIT_L(8); PG8_BAR; PG8_WAIT_L(0); PG8_MMA(0, 0, At, B0); PG8_BAR; PG8_SCHED;
      PG8_LDB(B1, 1, 1); PG8_STAGE(PG8_SB(1, 0), b3, voffA);
      PG8_BAR; PG8_WAIT_L(0); PG8_MMA(0, 1, At, B1); PG8_BAR;
      PG8_LDA(At, 1, 1); PG8_STAGE(PG8_SA(1, 0), a3, voffA);
      PG8_BAR; PG8_WAIT_L(0); PG8_MMA(1, 0, At, B0); PG8_BAR; PG8_SCHED;
      PG8_STAGE(PG8_SB(1, 1), b3 + hstep, voffA);
      PG8_WAIT_V(6); PG8_BAR; PG8_MMA(1, 1, At, B1); PG8_BAR;
    }
    for (int r_ = 0; r_ < E.reps; ++r_) E(acc, cur, wr, wc, fr, fq);
    if (!has_next) break;
#pragma unroll
    for (int a = 0; a < 2; ++a)
#pragma unroll
      for (int b = 0; b < 2; ++b)
#pragma unroll
        for (int m = 0; m < 4; ++m)
#pragma unroll
          for (int n = 0; n < 2; ++n) acc[a][b][m][n] = (f32x4){0.f, 0.f, 0.f, 0.f};
    cur = nxt; cA = nA; cB = nB; ++ui;
  }
  PG8_WAIT_V(0);
  if (wr == 0) PG8_BAR;
  PG8_BAR;
}
}
DI void row_affine(const float* stats, int row, float& a, float& bb, float& mu, float& rstd) {
  const float s = stats[2 * row], ss = stats[2 * row + 1]; mu = s * (1.0f / 1024.0f); const float var = fmaxf(ss * (1.0f / 1024.0f) - mu * mu, 0.f); rstd = rsqrtf(var + 1e-5f); a = rstd; bb = -rstd * mu;
}
struct EpiUp {
  bf16_t* H; const float* stats; const float* c1; const float* c2; int reps;
  DI void operator()(const f32x4 (&acc)[2][2][4][2], const pg8::Unit& u, int wr, int wc, int fr, int fq) const {
    const int colg = u.pn * 256 + wc * 32 + 8 * fq, hcol = u.pn * 128 + wc * 32 + 8 * fq;
    f32x4 c1g[2], c2g[2], c1u[2], c2u[2];
#pragma unroll
    for (int n = 0; n < 2; ++n) { c1g[n] = *(const f32x4*)(c1 + colg + 4 * n); c2g[n] = *(const f32x4*)(c2 + colg + 4 * n); c1u[n] = *(const f32x4*)(c1 + colg + 128 + 4 * n); c2u[n] = *(const f32x4*)(c2 + colg + 128 + 4 * n); }
    float ra[8], rb[8];
#pragma unroll
    for (int i = 0; i < 8; ++i) { float mu, rstd; row_affine(stats, u.pm * 256 + (i >> 2) * 128 + wr * 64 + (i & 3) * 16 + fr, ra[i], rb[i], mu, rstd); }
#pragma unroll
    for (int ai = 0; ai < 2; ++ai)
#pragma unroll
      for (int m = 0; m < 4; ++m) {
        const int row = u.pm * 256 + ai * 128 + wr * 64 + m * 16 + fr; const float a = ra[ai * 4 + m], bb = rb[ai * 4 + m];
        u32x4 w;
#pragma unroll
        for (int n = 0; n < 2; ++n) {
          const f32x4 gv = acc[ai][0][m][n] * a + c1g[n] * bb + c2g[n], uv = acc[ai][1][m][n] * a + c1u[n] * bb + c2u[n];
          float h[4];
#pragma unroll
          for (int j = 0; j < 4; ++j) h[j] = gv[j] * sigmoidf_(gv[j]) * uv[j];
          w[2 * n] = pk2(h[0], h[1]); w[2 * n + 1] = pk2(h[2], h[3]);
        }
        *(u32x4*)(H + (size_t)row * DFF + hcol) = w;
        asm volatile("" ::: "memory");
      }
  }
};
struct EpiRes {
  float* T; const float* Tin; const float* stats_prev; const float* g; const float* b; float* stats_new; bf16_t* tb; float scale; int reps;
  DI void operator()(const f32x4 (&acc)[2][2][4][2], const pg8::Unit& u, int wr, int wc, int fr, int fq) const {
    const int col0 = u.pn * 256 + wc * 32 + 8 * fq;
    float rmu[8], rrs[8];
#pragma unroll
    for (int i = 0; i < 8; ++i) { float a, bb; row_affine(stats_prev, u.pm * 256 + (i >> 2) * 128 + wr * 64 + (i & 3) * 16 + fr, a, bb, rmu[i], rrs[i]); }
#pragma unroll
    for (int ai = 0; ai < 2; ++ai)
#pragma unroll
      for (int mp = 0; mp < 2; ++mp) {
        f32x4 tpv[2][2][2];
#pragma unroll
        for (int mm = 0; mm < 2; ++mm)
#pragma unroll
          for (int bj = 0; bj < 2; ++bj)
#pragma unroll
            for (int n = 0; n < 2; ++n) tpv[mm][bj][n] = *(const f32x4*)(Tin + (size_t)(u.pm * 256 + ai * 128 + wr * 64 + (2 * mp + mm) * 16 + fr) * DM + col0 + bj * 128 + 4 * n);
#pragma unroll
        for (int mm = 0; mm < 2; ++mm) {
          const int m = 2 * mp + mm, row = u.pm * 256 + ai * 128 + wr * 64 + m * 16 + fr; const float mu = rmu[ai * 4 + m], rstd = rrs[ai * 4 + m];
          float rs = 0.f, rq = 0.f;
#pragma unroll
          for (int bj = 0; bj < 2; ++bj) {
            u32x4 w;
#pragma unroll
            for (int n = 0; n < 2; ++n) {
              const size_t off = (size_t)row * DM + col0 + bj * 128 + 4 * n;
              f32x4 tp = tpv[mm][bj][n];
              tp = (tp - mu) * rstd * (*(const f32x4*)(g + col0 + bj * 128 + 4 * n)) + *(const f32x4*)(b + col0 + bj * 128 + 4 * n);
              const f32x4 tn = tp * ALPHA + acc[ai][bj][m][n] * scale;
              *(f32x4*)(T + off) = tn;
              w[2 * n] = pk2(tn[0], tn[1]); w[2 * n + 1] = pk2(tn[2], tn[3]);
              rs += tn[0] + tn[1] + tn[2] + tn[3]; rq += tn[0] * tn[0] + tn[1] * tn[1] + tn[2] * tn[2] + tn[3] * tn[3];
            }
            *(u32x4*)(tb + (size_t)row * DM + col0 + bj * 128) = w;
          }
          rs += __shfl_xor(rs, 16); rs += __shfl_xor(rs, 32); rq += __shfl_xor(rq, 16); rq += __shfl_xor(rq, 32);
          if (fq == 0) { atomicAdd(stats_new + 2 * row, rs); atomicAdd(stats_new + 2 * row + 1, rq); }
        }
        asm volatile("" ::: "memory");
      }
  }
};
struct EpiIn {
  int mode; bf16_t* h; int ld; const float* stats; const float* c1; const float* c2; const float* lbv;
  bf16_t *hq, *hk, *hv, *hg; _Float16* hlf; int reps;
  template <int SECT>
  DI void body(const f32x4 (&acc)[2][2][4][2], const pg8::Unit& u, int wr, int wc, int fr, int fq) const {
    const int col0 = u.pn * 256 + wc * 32 + 8 * fq;
#pragma unroll
    for (int ai = 0; ai < 2; ++ai)
#pragma unroll
      for (int m = 0; m < 4; ++m) {
        const int row = u.pm * 256 + ai * 128 + wr * 64 + m * 16 + fr; float a, bb, mu, rstd; row_affine(stats, row, a, bb, mu, rstd);
#pragma unroll
        for (int bj = 0; bj < 2; ++bj) {
          const int col = col0 + bj * 128;
          f32x4 v[2];
#pragma unroll
          for (int n = 0; n < 2; ++n) v[n] = acc[ai][bj][m][n] * a + (*(const f32x4*)(c1 + col + 4 * n)) * bb + *(const f32x4*)(c2 + col + 4 * n);
          if (SECT < 0) { u32x4 w; w[0] = pk2(v[0][0], v[0][1]); w[1] = pk2(v[0][2], v[0][3]); w[2] = pk2(v[1][0], v[1][1]); w[3] = pk2(v[1][2], v[1][3]); *(u32x4*)(h + (size_t)row * ld + col) = w; }
          else {
            const int cc = col & 1023; const size_t off = (size_t)row * 1024 + cc;
            if (SECT == 0 || SECT == 3) { u32x4 w;
#pragma unroll
              for (int n = 0; n < 2; ++n) { w[2 * n] = pk2(v[n][0] * sigmoidf_(v[n][0]), v[n][1] * sigmoidf_(v[n][1])); w[2 * n + 1] = pk2(v[n][2] * sigmoidf_(v[n][2]), v[n][3] * sigmoidf_(v[n][3])); }
              *(u32x4*)((SECT == 0 ? hq : hg) + off) = w; }
            else if (SECT == 1) {
              typedef _Float16 h8 __attribute__((ext_vector_type(8))); h8 lf; u32x4 w;
#pragma unroll
              for (int n = 0; n < 2; ++n) { const f32x4 lb = *(const f32x4*)(lbv + cc + 4 * n); float kk[4];
#pragma unroll
                for (int j = 0; j < 4; ++j) { kk[j] = (1.0f - lb[j]) * __builtin_amdgcn_rcpf(1.0f + __builtin_amdgcn_exp2f(1.4426950408889634f * v[n][j])); lf[4 * n + j] = (_Float16)__logf(1.0f - kk[j]); }
                w[2 * n] = pk2(kk[0], kk[1]); w[2 * n + 1] = pk2(kk[2], kk[3]); }
              *(u32x4*)(hk + off) = w; *(h8*)(hlf + off) = lf;
            }
            else { u32x4 w; w[0] = pk2(v[0][0], v[0][1]); w[1] = pk2(v[0][2], v[0][3]); w[2] = pk2(v[1][0], v[1][1]); w[3] = pk2(v[1][2], v[1][3]); *(u32x4*)(hv + off) = w; }
          }
        }
        asm volatile("" ::: "memory");
      }
  }
  DI void operator()(const f32x4 (&acc)[2][2][4][2], const pg8::Unit& u, int wr, int wc, int fr, int fq) const {
    if (mode == 0) body<-1>(acc, u, wr, wc, fr, fq);
    else { const int sect = u.pn >> 2;
      if (sect == 0) body<0>(acc, u, wr, wc, fr, fq); else if (sect == 1) body<1>(acc, u, wr, wc, fr, fq); else if (sect == 2) body<2>(acc, u, wr, wc, fr, fq); else body<3>(acc, u, wr, wc, fr, fq); }
  }
};

DI void conv_strip(int wv, LAS unsigned char* lds, const float* src, int ldn, int K, int n0, int nvalid, bf16_t* dst, int dstrow0, const float* g, const float* b, float* c1, float* c2, bool perm = true) {
  LAS bf16_t* tile = (LAS bf16_t*)lds;
  LAS float* red = (LAS float*)(lds + 64 * 72 * 2);
  int tid_ = wv * 64 + lane_id_(); asm volatile("" : "+v"(tid_)); const int tid = tid_, kr = tid >> 4, nc = (tid & 15) * 4;
  const bool colok = (n0 + nc) < nvalid;
  float s1[4] = {0.f, 0.f, 0.f, 0.f}, s2[4] = {0.f, 0.f, 0.f, 0.f};
  for (int k0 = 0; k0 < K; k0 += 64) {
    f32x4 w[2];
#pragma unroll
    for (int rr = 0; rr < 2; ++rr) { const int k = k0 + kr + rr * 32; w[rr] = colok ? *(const f32x4*)(src + (size_t)k * ldn + n0 + nc) : (f32x4){0.f, 0.f, 0.f, 0.f}; }
    __syncthreads();
#pragma unroll
    for (int rr = 0; rr < 2; ++rr) { const int k = k0 + kr + rr * 32; const float gk = g ? g[k] : 1.0f, bk = b ? b[k] : 0.0f;
#pragma unroll
      for (int j = 0; j < 4; ++j) { const bf16_t v = f2bf(w[rr][j] * gk); tile[(nc + j) * 72 + kr + rr * 32] = v; s1[j] += bf2f(v); s2[j] += bk * w[rr][j]; } }
    __syncthreads();
    { const int n = tid >> 3, kc = (tid & 7) * 8; const int cc = n & 31, slot = (n & 32) + (perm ? 16 * ((cc >> 2) & 1) + 4 * (cc >> 3) + (cc & 3) : cc);
      *(u32x4*)(dst + (size_t)(dstrow0 + slot) * K + k0 + kc) = *(const LAS u32x4*)(tile + n * 72 + kc); }
  }
  if (c1) {
    __syncthreads();
#pragma unroll
    for (int j = 0; j < 4; ++j) { red[kr * 64 + nc + j] = s1[j]; red[2048 + kr * 64 + nc + j] = s2[j]; }
    __syncthreads();
    if (tid < 128) { const int n = tid & 63, which = tid >> 6; float s = 0.f; for (int i = 0; i < 32; ++i) s += red[which * 2048 + i * 64 + n]; (which ? c2 : c1)[dstrow0 + n] = s; }
  }
  __syncthreads();
}

DI void convert_phase(int wv, const P& p_, int L, LAS unsigned char* lds) {
  P p = p_; { size_t z_ = 0; asm volatile("" : "+s"(z_)); p.ws = p_.ws + z_; }
  const int kind = L % 3, slot = L / 3;
  const int nin = kind == 0 ? 44 : (kind == 1 ? 64 : 20);
  const int njobs = 208 + nin + 16 + (kind == 0 ? 6 : 0);
  unsigned char* ws = p.ws;
  for (int j = blockIdx.x; j < njobs; j += gridDim.x) {
    if (j < 208) {
      const int f = j / 104, jj = j % 104;
      const float* lg = p.ln_gain + (size_t)(L * 3 + (f == 0 ? -1 : 1)) * DM; const float* lbias = p.ln_bias + (size_t)(L * 3 + (f == 0 ? -1 : 1)) * DM;
      const bool fold = !(L == 0 && f == 0);
      float* cbase = (float*)(ws + (f == 0 ? C_GU1 : C_GU2));
      if (jj < 88) {
        const int up = jj / 44, s = jj % 44, n0 = s * 64;
        const float* src = (f == 0 ? (up ? p.f1u : p.f1g) : (up ? p.f2u : p.f2g)) + (size_t)L * DM * DFF;
        conv_strip(wv, lds, src, DFF, DM, n0, DFF, (bf16_t*)(ws + (f == 0 ? W_GU1 : W_GU2)), (n0 >> 7) * 256 + (n0 & 127) + up * 128, fold ? lg : nullptr, fold ? lbias : nullptr, cbase, cbase + 5632);
      } else {
        const int s = jj - 88;
        const float* src = (f == 0 ? p.f1d : p.f2d) + (size_t)L * DFF * DM;
        conv_strip(wv, lds, src, DM, DFF, s * 64, DM, (bf16_t*)(ws + (f == 0 ? W_D1 : W_D2)), s * 64, nullptr, nullptr, nullptr, nullptr);
      }
    } else if (j < 208 + nin) {
      const int s = j - 208; const float* lg = p.ln_gain + (size_t)(L * 3) * DM; const float* lbias = p.ln_bias + (size_t)(L * 3) * DM;
      const float* src = kind == 0 ? p.nsa_win + (size_t)slot * DM * 2608 : (kind == 1 ? p.hg_win + (size_t)slot * DM * 4096 : p.swa_win + (size_t)slot * DM * 1280);
      const int ldn = kind == 0 ? 2608 : (kind == 1 ? 4096 : 1280);
      float* cbase = (float*)(ws + C_IN);
      conv_strip(wv, lds, src, ldn, DM, s * 64, ldn, (bf16_t*)(ws + W_IN), s * 64, lg, lbias, cbase, cbase + 4096);
    } else if (j < 208 + nin + 16) {
      const int s = j - 208 - nin;
      const float* src = kind == 0 ? p.nsa_wout + (size_t)slot * DM * DM : (kind == 1 ? p.hg_wout + (size_t)slot * DM * DM : p.swa_wout + (size_t)slot * DM * DM);
      conv_strip(wv, lds, src, DM, DM, s * 64, DM, (bf16_t*)(ws + W_OUT), s * 64, nullptr, nullptr, nullptr, nullptr);
    } else {
      const int s = j - 208 - nin - 16;
      if (s < 4) { const int kv = s >> 1, st = s & 1; float* pb = (float*)(ws + C_POSB) + kv * 256;
        conv_strip(wv, lds, p.nsa_w1 + ((size_t)slot * 2 + kv) * 2048 * 128, 128, 2048, st * 64, 128, (bf16_t*)(ws + W_W1T) + (size_t)kv * 128 * 2048, st * 64, nullptr, p.nsa_pos + ((size_t)slot * 2 + kv) * 2048, pb + 128, pb, false); }
      else { const int kv = s - 4; conv_strip(wv, lds, p.nsa_w2 + ((size_t)slot * 2 + kv) * 128 * 64, 64, 128, 0, 64, (bf16_t*)(ws + W_W2T) + (size_t)kv * 64 * 128, 0, nullptr, nullptr, nullptr, nullptr, false); }
    }
  }
}

DI void init_phase(int wv, const P& p_) {
  P p = p_; { size_t z_ = 0; asm volatile("" : "+s"(z_)); p.ws = p_.ws + z_; }
  int tid_ = wv * 64 + lane_id_(); asm volatile("" : "+v"(tid_)); const size_t gtid = (size_t)blockIdx.x * 512 + tid_, gsz = (size_t)gridDim.x * 512;
  for (size_t i = gtid; i < (4 * MiB) / 16; i += gsz) ((f32x4*)(p.ws + WS_STATS))[i] = (f32x4){0.f, 0.f, 0.f, 0.f};
  for (size_t i = gtid; i < (size_t)MTOK; i += gsz) { ((float*)(p.ws + WS_DSTATS))[2 * i] = 0.f; ((float*)(p.ws + WS_DSTATS))[2 * i + 1] = 1024.0f * (1.0f - 1e-5f); }
  if (gtid < 13 * 1024) { ((float*)(p.ws + WS_G13))[gtid] = gtid < 1024 ? 1.0f : p.ln_gain[gtid - 1024]; ((float*)(p.ws + WS_B13))[gtid] = gtid < 1024 ? 0.0f : p.ln_bias[gtid - 1024]; }
  for (size_t i = gtid; i < (size_t)MTOK * DM / 4; i += gsz) { const f32x4 v = ((const f32x4*)p.x)[i]; u32x2 w; w.x = pk2(v[0], v[1]); w.y = pk2(v[2], v[3]); ((u32x2*)(p.ws + WS_TB))[i] = w; }
  if (gtid < 16 * 132) { const int hd = (int)gtid / 132, d = (int)gtid % 132; int bk;
    if (d < 16) bk = d; else { const float v = logf((float)d / 16.0f) / 2.0794415416798357f * 16.0f; bk = 16 + (int)v; if (bk > 31 || d >= 128) bk = 31; }
    ((float*)(p.ws + C_BTAB))[gtid] = p.rel_bias[bk * 16 + hd]; }
  if (gtid < 1024) { const float a0 = p.hg_lb[gtid], a1 = p.hg_lb[1024 + gtid], a2 = p.hg_lb[2048 + gtid], a3 = p.hg_lb[3072 + gtid];
    const float mx = fmaxf(fmaxf(a0, a1), fmaxf(a2, a3)); const float e0 = expf(a0 - mx), e1 = expf(a1 - mx), e2 = expf(a2 - mx), e3 = expf(a3 - mx);
    ((float*)(p.ws + C_LBV))[gtid] = e1 / (e0 + e1 + e2 + e3); }
}

DI void final_ln(int wv, const P& p_, const float* stats, const float* g, const float* b) {
  P p = p_; { size_t z_ = 0; asm volatile("" : "+s"(z_)); p.ws = p_.ws + z_; }
  int tid_ = wv * 64 + lane_id_(); asm volatile("" : "+v"(tid_)); const size_t gtid = (size_t)blockIdx.x * 512 + tid_, gsz = (size_t)gridDim.x * 512;
  for (size_t i = gtid; i < (size_t)MTOK * DM / 4; i += gsz) {
    const int row = (int)(i >> 8), c = (int)(i & 255) * 4; float a, bb, mu, rstd; row_affine(stats, row, a, bb, mu, rstd);
    const f32x4 v = ((const f32x4*)p.out)[i]; ((f32x4*)p.out)[i] = (v - mu) * rstd * (*(const f32x4*)(g + c)) + *(const f32x4*)(b + c);
  }
}
#define MFMA32(a, b, c) __builtin_amdgcn_mfma_f32_32x32x16_bf16((a), (b), (c), 0, 0, 0)
#define MFMA16(a, b, c) __builtin_amdgcn_mfma_f32_16x16x32_bf16((a), (b), (c), 0, 0, 0)
DI int crow(int reg, int h) { return (reg & 3) + 8 * (reg >> 2) + 4 * h; }
constexpr int KS_STRIDE = 72;

struct KVRegs { u32x4 k; bf16x8 v; };
DI void kv_load(KVRegs& r, const bf16_t* kg, const bf16_t* vg, size_t ldg, int tid) {
  asm volatile("" : "+v"(tid));
  const int key = tid >> 3, d8 = (tid & 7) * 8;
  r.k = *(const u32x4*)(kg + (size_t)key * ldg + d8); r.v = *(const bf16x8*)(vg + (size_t)key * ldg + d8);
}
DI void kv_store(const KVRegs& r, LAS bf16_t* Ks, LAS bf16_t* Vt, int vstride, int vcol0, int tid) {
  asm volatile("" : "+v"(tid));
  const int key = tid >> 3, d8 = (tid & 7) * 8;
  *(LAS u32x4*)(Ks + key * KS_STRIDE + d8) = r.k;
#pragma unroll
  for (int i = 0; i < 8; ++i) Vt[(d8 + i) * vstride + vcol0 + key] = (bf16_t)r.v[i];
}
DI void attn_scores(const LAS bf16_t* Ks, const bf16x8 (&qf)[4], int r, int h, f32x16 (&s)[2]) {
#pragma unroll
  for (int sub = 0; sub < 2; ++sub) {
    f32x16 a;
#pragma unroll
    for (int i = 0; i < 16; ++i) a[i] = 0.f;
#pragma unroll
    for (int ks = 0; ks < 4; ++ks) { const bf16x8 kf = *(const LAS bf16x8*)(Ks + (sub * 32 + r) * KS_STRIDE + ks * 16 + 8 * h); a = MFMA32(kf, qf[ks], a); }
    s[sub] = a;
  }
}
constexpr float QK_SCALE2 = 0.125f * 1.4426950408889634f;
DI void attn_logits(f32x16 (&s)[2], int t, int tw, int nt, int h, int base, int stride, int dmax, bool ok, const LAS float* btl) {
  const int dmin = tw - (base + 63 * stride), dmaxw = tw + nt - 1 - base;
  const bool far = dmin >= 128, interior = dmin >= 0 && dmaxw < dmax;
  const float bfar = btl[128];
  if (far && interior) {
#pragma unroll
    for (int sub = 0; sub < 2; ++sub)
#pragma unroll
      for (int reg = 0; reg < 16; ++reg) s[sub][reg] = ok ? s[sub][reg] * QK_SCALE2 + bfar : -1e30f;
  } else if (far) {
#pragma unroll
    for (int sub = 0; sub < 2; ++sub)
#pragma unroll
      for (int reg = 0; reg < 16; ++reg) {
        const int kk = sub * 32 + crow(reg, h); const int d = t - (base + kk * stride);
        const bool valid = (d >= 0) && (d < dmax) && ok;
        s[sub][reg] = valid ? s[sub][reg] * QK_SCALE2 + bfar : -1e30f;
      }
  } else {
#pragma unroll
    for (int sub = 0; sub < 2; ++sub)
#pragma unroll
      for (int reg = 0; reg < 16; ++reg) {
        const int kk = sub * 32 + crow(reg, h); const int d = t - (base + kk * stride);
        const bool valid = (d >= 0) && (d < dmax) && ok;
        const int di = d < 0 ? 0 : (d > 128 ? 128 : d);
        const float bsv = btl[di];
        const float x = s[sub][reg] * QK_SCALE2 + bsv;
        s[sub][reg] = valid ? x : -1e30f;
      }
  }
}
DI void attn_pv(const LAS bf16_t* Vt, int vstride, const f32x16 (&p)[2], f32x16 (&O)[2], int r, int h) {
#pragma unroll
  for (int sub = 0; sub < 2; ++sub)
#pragma unroll
    for (int s2 = 0; s2 < 2; ++s2) {
      u32x4 pp;
#pragma unroll
      for (int j = 0; j < 4; ++j) pp[j] = pk2(p[sub][8 * s2 + 2 * j], p[sub][8 * s2 + 2 * j + 1]);
      const bf16x8 pf = __builtin_bit_cast(bf16x8, pp);
#pragma unroll
      for (int dt = 0; dt < 2; ++dt) {
        const LAS bf16_t* vp = Vt + (dt * 32 + r) * vstride + sub * 32 + 16 * s2 + 4 * h;
        const s16x4 lo = *(const LAS s16x4*)vp, hi = *(const LAS s16x4*)(vp + 8);
        const bf16x8 vf = __builtin_shufflevector(lo, hi, 0, 1, 2, 3, 4, 5, 6, 7);
        O[dt] = MFMA32(vf, pf, O[dt]);
      }
    }
}
template <bool WITH_O>
DI void attn_online(f32x16 (&s)[2], float& m, float& l, f32x16 (&O)[2]) {
  float mx = -1e30f;
#pragma unroll
  for (int sub = 0; sub < 2; ++sub)
#pragma unroll
    for (int reg = 0; reg < 16; ++reg) mx = fmaxf(mx, s[sub][reg]);
  mx = fmaxf(mx, __shfl_xor(mx, 32));
  const float mn = fmaxf(m, mx);
  const bool grow = mn > m;
  float ls = 0.f;
#pragma unroll
  for (int sub = 0; sub < 2; ++sub)
#pragma unroll
    for (int reg = 0; reg < 16; ++reg) { const float e = __builtin_amdgcn_exp2f(s[sub][reg] - mn); s[sub][reg] = e; ls += e; }
  if (__any(grow)) {
    const float al = __builtin_amdgcn_exp2f(m - mn); m = mn;
    l = l * al + ls;
    if (WITH_O) {
#pragma unroll
      for (int dt = 0; dt < 2; ++dt)
#pragma unroll
        for (int reg = 0; reg < 16; ++reg) O[dt][reg] *= al;
    }
  } else l += ls;
}
DI void attn_tile(const LAS bf16_t* Ks, const LAS bf16_t* Vt, int vstride, const bf16x8 (&qf)[4], f32x16 (&O)[2], float& m, float& l,
                  int t, int tw, int nt, int r, int h, int base, int stride, int dmax, bool ok, const LAS float* btl) {
  f32x16 s[2];
  attn_scores(Ks, qf, r, h, s);
  attn_logits(s, t, tw, nt, h, base, stride, dmax, ok, btl);
  attn_online<true>(s, m, l, O);
  attn_pv(Vt, vstride, s, O, r, h);
}
DI void zero_o(f32x16 (&O)[2]) {
#pragma unroll
  for (int dt = 0; dt < 2; ++dt)
#pragma unroll
    for (int reg = 0; reg < 16; ++reg) O[dt][reg] = 0.f;
}

DI void nsa_compress_phase(int wv, const P& p_, LAS unsigned char* lds) {
  P p = p_; { size_t z_ = 0; asm volatile("" : "+s"(z_)); p.ws = p_.ws + z_; }
  const bf16_t* hb = (const bf16_t*)(p.ws + WS_BIG); const int ld = 2816;
  int tid_ = wv * 64 + lane_id_(); asm volatile("" : "+v"(tid_)); const int tid = tid_, wid = wv, lane = tid & 63, fr = lane & 15, fq = lane >> 4;
  const int pw = wid & 3, half = wid >> 2;
  LAS bf16_t* hid = (LAS bf16_t*)lds + pw * 16 * 136;
  LAS f32x4* part = (LAS f32x4*)(lds + 32768) + pw * 8 * 64;
  for (int base = blockIdx.x * 4; base < 1024; base += gridDim.x * 4) {
    const int task = base + pw;
    const int kv = task >> 9, b = (task >> 6) & 7, g = (task >> 4) & 3, n0 = (task & 15) * 16;
    const bf16_t* w1t = (const bf16_t*)(p.ws + W_W1T) + (size_t)kv * 128 * 2048; const bf16_t* w2t = (const bf16_t*)(p.ws + W_W2T) + (size_t)kv * 64 * 128;
    const float* posb = (const float*)(p.ws + C_POSB) + kv * 256;
    const int colb = 1024 + kv * 256 + g * 64;
    int n = n0 + fr; if (n > 254) n = 254;
    f32x4 acc[8];
#pragma unroll
    for (int i = 0; i < 8; ++i) acc[i] = (f32x4){0.f, 0.f, 0.f, 0.f};
#pragma unroll 2
    for (int l = 16 * half; l < 16 * half + 16; ++l) {
#pragma unroll
      for (int dk = 0; dk < 2; ++dk) {
        const bf16x8 af = *(const bf16x8*)(hb + (size_t)(b * SEQ + 16 * n + l) * ld + colb + dk * 32 + fq * 8);
#pragma unroll
        for (int nt = 0; nt < 8; ++nt) { const bf16x8 bfr = *(const bf16x8*)(w1t + (size_t)(nt * 16 + fr) * 2048 + l * 64 + dk * 32 + fq * 8); acc[nt] = MFMA16(af, bfr, acc[nt]); }
      }
    }
    if (half) {
#pragma unroll
      for (int nt = 0; nt < 8; ++nt) part[nt * 64 + lane] = acc[nt];
    }
    __syncthreads();
    if (!half) {
#pragma unroll
      for (int nt = 0; nt < 8; ++nt) { const float pbv = posb[nt * 16 + fr]; const f32x4 o2 = part[nt * 64 + lane];
#pragma unroll
        for (int j = 0; j < 4; ++j) { const float v = acc[nt][j] + o2[j] + pbv; const float u = 0.7978845608028654f * (v + 0.044715f * v * v * v); const float th = 1.0f - 2.0f * __builtin_amdgcn_rcpf(1.0f + __expf(2.0f * u));
          hid[(4 * fq + j) * 136 + nt * 16 + fr] = f2bf(0.5f * v * (1.0f + th)); } }
    }
    __syncthreads();
    if (!half) {
      f32x4 o[4];
#pragma unroll
      for (int i = 0; i < 4; ++i) o[i] = (f32x4){0.f, 0.f, 0.f, 0.f};
#pragma unroll
      for (int ks = 0; ks < 4; ++ks) { const bf16x8 af = *(const LAS bf16x8*)(hid + fr * 136 + ks * 32 + fq * 8);
#pragma unroll
        for (int nt = 0; nt < 4; ++nt) { const bf16x8 bfr = *(const bf16x8*)(w2t + (size_t)(nt * 16 + fr) * 128 + ks * 32 + fq * 8); o[nt] = MFMA16(af, bfr, o[nt]); } }
      bf16_t* dst = (bf16_t*)(p.ws + (kv ? WS_VC : WS_KC)) + (size_t)((b * 4 + g) * 256) * 64;
#pragma unroll
      for (int nt = 0; nt < 4; ++nt)
#pragma unroll
        for (int j = 0; j < 4; ++j) { const int nn = n0 + 4 * fq + j; dst[(size_t)nn * 64 + nt * 16 + fr] = nn > 254 ? (bf16_t)0 : f2bf(o[nt][j]); }
    }
    __syncthreads();
  }
}

DI void nsa_attn_phase(int wv, const P& p_, LAS unsigned char* lds) {
  P p = p_; { size_t z_ = 0; asm volatile("" : "+s"(z_)); p.ws = p_.ws + z_; }
  const bf16_t* hb = (const bf16_t*)(p.ws + WS_BIG); const int ld = 2816;
  bf16_t* ob = (bf16_t*)(p.ws + WS_O);
  LAS bf16_t* KsB[2] = {(LAS bf16_t*)lds, (LAS bf16_t*)(lds + 17920)}; LAS bf16_t* VtB[2] = {(LAS bf16_t*)(lds + 9216), (LAS bf16_t*)(lds + 17920 + 9216)};
  LAS bf16_t* KC = (LAS bf16_t*)(lds + 35840); LAS bf16_t* VCT = (LAS bf16_t*)(lds + 72704);
  LAS float* OUTL = (LAS float*)(lds + 35840);
  LAS float* G4s = (LAS float*)(lds + 105984); LAS float* Lsm = (LAS float*)(lds + 122368); LAS float* BT = (LAS float*)(lds + 138752);
  LAS unsigned* SELM = (LAS unsigned*)(lds + 140864); LAS unsigned* UNI = (LAS unsigned*)(lds + 141376);
  for (int it = blockIdx.x; it < 2048; it += gridDim.x) {
    int tid_ = wv * 64 + lane_id_(); asm volatile("" : "+v"(tid_)); const int tid = tid_, wid = wv, lane = tid & 63, r = lane & 31, h = lane >> 5, tl = r >> 2, hd = r & 3;
    const int c = it & 255, ii = it >> 8, bg = c >> 3, b = bg >> 2, g = bg & 3, j8 = c & 7;
    const int qi = (ii & 1) ? (16 * (ii >> 1) + 15 - j8) : (16 * (ii >> 1) + j8);
    const int t0 = 64 * qi, tw = t0 + 8 * wid, t = tw + tl, head = g * 4 + hd;
    const int nct = (4 * qi + 2) / 64 + 1;
    __syncthreads();
    { KVRegs ka, kb; const bf16_t* kcg = (const bf16_t*)(p.ws + WS_KC) + (size_t)((b * 4 + g) * 256) * 64; const bf16_t* vcg = (const bf16_t*)(p.ws + WS_VC) + (size_t)((b * 4 + g) * 256) * 64;
      kv_load(ka, kcg, vcg, 64, tid); if (nct > 1) kv_load(kb, kcg + 64 * 64, vcg + 64 * 64, 64, tid);
      kv_store(ka, KC, VCT, 260, 0, tid); if (nct > 1) kv_store(kb, KC + 64 * KS_STRIDE, VCT, 260, 64, tid);
      if (nct > 2) { kv_load(ka, kcg + 128 * 64, vcg + 128 * 64, 64, tid); if (nct > 3) kv_load(kb, kcg + 192 * 64, vcg + 192 * 64, 64, tid);
        kv_store(ka, KC + 128 * KS_STRIDE, VCT, 260, 128, tid); if (nct > 3) kv_store(kb, KC + 192 * KS_STRIDE, VCT, 260, 192, tid); } }
    for (int i = tid; i < 4 * 132; i += 512) BT[i] = ((const float*)(p.ws + C_BTAB))[g * 4 * 132 + i] * 1.4426950408889634f;
    if (tid < 128) SELM[tid] = 0u; if (tid < 2) UNI[tid] = 0u;
    bf16x8 qf[4];
#pragma unroll
    for (int ks = 0; ks < 4; ++ks) qf[ks] = *(const bf16x8*)(hb + (size_t)(b * SEQ + t) * ld + head * 64 + ks * 16 + 8 * h);
    const size_t rowoff = (size_t)(b * SEQ + t) * ld;
    const float gc = sigmoidf_(bf2f(hb[rowoff + 2560 + head * 3 + 0])), gs = sigmoidf_(bf2f(hb[rowoff + 2560 + head * 3 + 1])), gw = sigmoidf_(bf2f(hb[rowoff + 2560 + head * 3 + 2]));
    const LAS float* btl = BT + hd * 132;
    KVRegs kvr; { const size_t go = (size_t)(b * SEQ) * ld + g * 64; kv_load(kvr, hb + go + 1536, hb + go + 1792, ld, tid); }
    __syncthreads();
    f32x16 O[2];
    float m = -1e30f, l = 0.f;
#pragma unroll 1
    for (int tile = 0; tile < nct; ++tile) { f32x16 s[2]; attn_scores(KC + tile * 64 * KS_STRIDE, qf, r, h, s); attn_logits(s, t, tw, 8, h, 16 * (tile * 64) + 31, 16, 0x7fffffff, true, btl); attn_online<false>(s, m, l, O); }
    { const float lt = l + __shfl_xor(l, 32); const float inv = (m > -1e29f && lt > 0.f) ? 1.0f / lt : 0.f;
      zero_o(O);
#pragma unroll 1
      for (int tile = 0; tile < nct; ++tile) {
        f32x16 s[2]; attn_scores(KC + tile * 64 * KS_STRIDE, qf, r, h, s); attn_logits(s, t, tw, 8, h, 16 * (tile * 64) + 31, 16, 0x7fffffff, true, btl);
        LAS float* gp = G4s + (8 * wid + tl) * 64 + 16 * tile + h; asm volatile("" : "+v"(gp));
#pragma unroll
        for (int sub = 0; sub < 2; ++sub) {
#pragma unroll
          for (int reg = 0; reg < 16; ++reg) { const float v = s[sub][reg]; s[sub][reg] = v > -1e29f ? __builtin_amdgcn_exp2f(v - m) * inv : 0.f; }
#pragma unroll
          for (int lg = 0; lg < 4; ++lg) { float G = s[sub][4 * lg] + s[sub][4 * lg + 1] + s[sub][4 * lg + 2] + s[sub][4 * lg + 3], Lv = s[sub][4 * lg + 3];
            G += __shfl_xor(G, 1); G += __shfl_xor(G, 2); Lv += __shfl_xor(Lv, 1); Lv += __shfl_xor(Lv, 2);
            if (hd == 0) { gp[8 * sub + 2 * lg] = G; gp[4096 + 8 * sub + 2 * lg] = Lv; } }
        }
        attn_pv(VCT + tile * 64, 260, s, O, r, h);
      }
    }
    __syncthreads();
#pragma unroll
    for (int dt = 0; dt < 2; ++dt)
#pragma unroll
      for (int reg = 0; reg < 16; ++reg) OUTL[(dt * 16 + reg) * 512 + tid] = gc * O[dt][reg];
    if (qi < 16) { const unsigned long long full = (qi == 63) ? ~0ull : ((1ull << (qi + 1)) - 1ull);
      int tsel = tid; asm volatile("" : "+v"(tsel));
      if (tsel < 64) { SELM[2 * tsel] = (unsigned)full; SELM[2 * tsel + 1] = (unsigned)(full >> 32); } if (tsel == 0) { UNI[0] = (unsigned)full; UNI[1] = (unsigned)(full >> 32); } }
    else {
      int tsel = tid; asm volatile("" : "+v"(tsel));
      const int tok = tsel >> 3, jj = tsel & 7, hiJ = qi - 2;
#pragma unroll
      for (int e = 0; e < 8; ++e) { const int j = jj * 8 + e; if (j >= 1 && j <= hiJ) G4s[tok * 64 + j] += Lsm[tok * 64 + j - 1]; }
      __syncthreads();
      float mine[8]; int cnt[8];
#pragma unroll
      for (int e = 0; e < 8; ++e) { const int j = jj * 8 + e; mine[e] = (j >= 1 && j <= hiJ) ? G4s[tok * 64 + j] : 0.f; cnt[e] = 0; }
      for (int j2 = 1; j2 <= hiJ; ++j2) { const float v = G4s[tok * 64 + j2];
#pragma unroll
        for (int e = 0; e < 8; ++e) { const int j = jj * 8 + e; cnt[e] += (v > mine[e] || (v == mine[e] && j2 < j)) ? 1 : 0; } }
      unsigned long long bits = 0ull;
#pragma unroll
      for (int e = 0; e < 8; ++e) { const int j = jj * 8 + e; if (j >= 1 && j <= hiJ && cnt[e] < 13) bits |= 1ull << j; }
      if (jj == 0) bits |= 1ull | (1ull << qi) | (1ull << (qi - 1));
      const unsigned blo = (unsigned)bits, bhi = (unsigned)(bits >> 32);
      if (blo) { atomicOr((unsigned*)&SELM[2 * tok], blo); atomicOr((unsigned*)&UNI[0], blo); }
      if (bhi) { atomicOr((unsigned*)&SELM[2 * tok + 1], bhi); atomicOr((unsigned*)&UNI[1], bhi); }
    }
    __syncthreads();
    int buf = 0;
    { const unsigned long long selm = (unsigned long long)SELM[2 * (8 * wid + tl)] | ((unsigned long long)SELM[2 * (8 * wid + tl) + 1] << 32);
      unsigned long long rem = (unsigned long long)UNI[0] | ((unsigned long long)UNI[1] << 32);
      m = -1e30f; l = 0.f; zero_o(O);
      const int jw0 = qi > 8 ? qi - 8 : 0;
#pragma unroll 1
      while (rem) {
        const int j = __builtin_ctzll(rem); rem &= rem - 1ull;
        kv_store(kvr, KsB[buf], VtB[buf], 68, 0, tid);
        __syncthreads();
        { const bool more = rem != 0ull; const int jn = more ? __builtin_ctzll(rem) : jw0;
          const size_t go = (size_t)(b * SEQ + jn * 64) * ld + g * 64; kv_load(kvr, hb + go + (more ? 1536 : 2048), hb + go + (more ? 1792 : 2304), ld, tid); }
        attn_tile(KsB[buf], VtB[buf], 68, qf, O, m, l, t, tw, 8, r, h, j * 64, 1, 0x7fffffff, ((selm >> j) & 1ull) != 0ull, btl);
        buf ^= 1;
      }
      const float lt = l + __shfl_xor(l, 32); const float sc = lt > 0.f ? gs / lt : 0.f;
#pragma unroll
      for (int dt = 0; dt < 2; ++dt)
#pragma unroll
        for (int reg = 0; reg < 16; ++reg) OUTL[(dt * 16 + reg) * 512 + tid] += sc * O[dt][reg];
    }
    { m = -1e30f; l = 0.f; zero_o(O);
#pragma unroll 1
      for (int j = (qi > 8 ? qi - 8 : 0); j <= qi; ++j) {
        kv_store(kvr, KsB[buf], VtB[buf], 68, 0, tid);
        __syncthreads();
        if (j < qi) { const size_t go = (size_t)(b * SEQ + (j + 1) * 64) * ld + g * 64; kv_load(kvr, hb + go + 2048, hb + go + 2304, ld, tid); }
        attn_tile(KsB[buf], VtB[buf], 68, qf, O, m, l, t, tw, 8, r, h, j * 64, 1, 512, true, btl);
        buf ^= 1;
      }
      const float lt = l + __shfl_xor(l, 32); const float sc = lt > 0.f ? gw / lt : 0.f;
#pragma unroll
      for (int dt = 0; dt < 2; ++dt)
#pragma unroll
        for (int reg = 0; reg < 16; ++reg) O[dt][reg] = OUTL[(dt * 16 + reg) * 512 + tid] + sc * O[dt][reg];
    }
    bf16_t* op = ob + (size_t)(b * SEQ + t) * DM + head * 64;
#pragma unroll
    for (int dt = 0; dt < 2; ++dt)
#pragma unroll
      for (int i4 = 0; i4 < 4; ++i4) { u32x2 w; w.x = pk2(O[dt][4 * i4], O[dt][4 * i4 + 1]); w.y = pk2(O[dt][4 * i4 + 2], O[dt][4 * i4 + 3]); *(u32x2*)(op + dt * 32 + 8 * i4 + 4 * h) = w; }
  }
}

DI void swa_attn_phase(int wv, const P& p_, int slot, LAS unsigned char* lds) {
  P p = p_; { size_t z_ = 0; asm volatile("" : "+s"(z_)); p.ws = p_.ws + z_; }
  const bf16_t* hb = (const bf16_t*)(p.ws + WS_BIG); const int ld = 1280;
  bf16_t* ob = (bf16_t*)(p.ws + WS_O);
  LAS bf16_t* KsB[2] = {(LAS bf16_t*)lds, (LAS bf16_t*)(lds + 17920)}; LAS bf16_t* VtB[2] = {(LAS bf16_t*)(lds + 9216), (LAS bf16_t*)(lds + 17920 + 9216)};
  LAS float* BT = (LAS float*)(lds + 35840);
  int tid_ = wv * 64 + lane_id_(); asm volatile("" : "+v"(tid_)); const int tid = tid_, wid = tid >> 6, lane = tid & 63, r = lane & 31, h = lane >> 5, tl = r >> 3, hd = r & 7;
  int buf = 0;
  for (int it = blockIdx.x; it < 2048; it += gridDim.x) {
    const int b = it >> 8, kv = (it >> 7) & 1, t0 = (it & 127) * 32;
    const int tw = t0 + 4 * wid, t = tw + tl, head = kv * 8 + hd;
    const int lo = t0 - 127, first = lo <= 0 ? 0 : (lo >> 6), last = (t0 + 31) >> 6;
    KVRegs kvr; { const size_t go = (size_t)(b * SEQ + first * 64) * ld + kv * 64; kv_load(kvr, hb + go + 1024, hb + go + 1152, ld, tid); }
    __syncthreads();
    for (int i = tid; i < 8 * 132; i += 512) BT[i] = ((const float*)(p.ws + C_BTAB))[kv * 8 * 132 + i] * 1.4426950408889634f;
    const size_t rowoff = (size_t)(b * SEQ + t) * ld;
    bf16x8 qf[4];
#pragma unroll
    for (int ks = 0; ks < 4; ++ks) qf[ks] = *(const bf16x8*)(hb + rowoff + head * 64 + ks * 16 + 8 * h);
    const LAS float* btl = BT + hd * 132;
    float m = p.swa_sinks[slot * 16 + head] * 1.4426950408889634f, l = (h == 0) ? 1.0f : 0.0f;
    f32x16 O[2]; zero_o(O);
#pragma unroll 1
    for (int j = first; j <= last; ++j) {
      kv_store(kvr, KsB[buf], VtB[buf], 68, 0, tid);
      __syncthreads();
      if (j < last) { const size_t go = (size_t)(b * SEQ + (j + 1) * 64) * ld + kv * 64; kv_load(kvr, hb + go + 1024, hb + go + 1152, ld, tid); }
      attn_tile(KsB[buf], VtB[buf], 68, qf, O, m, l, t, tw, 4, r, h, j * 64, 1, 128, true, btl);
      buf ^= 1;
    }
    const float lt = l + __shfl_xor(l, 32); const float sc = 1.0f / lt;
    bf16_t* op = ob + (size_t)(b * SEQ + t) * DM + head * 64;
#pragma unroll
    for (int dt = 0; dt < 2; ++dt)
#pragma unroll
      for (int i4 = 0; i4 < 4; ++i4) { u32x2 w; w.x = pk2(sc * O[dt][4 * i4], sc * O[dt][4 * i4 + 1]); w.y = pk2(sc * O[dt][4 * i4 + 2], sc * O[dt][4 * i4 + 3]); *(u32x2*)(op + dt * 32 + 8 * i4 + 4 * h) = w; }
  }
}
constexpr size_t HG_Q = WS_BIG, HG_K = WS_BIG + 64 * MiB, HG_V = WS_BIG + 128 * MiB, HG_G = WS_BIG + 192 * MiB, HG_LF = WS_BIG + 256 * MiB;
DI void hgrn_scan_phase(int wv, const P& p_, LAS unsigned char* lds, float* sumsq) {
  P p = p_; { size_t z_ = 0; asm volatile("" : "+s"(z_)); p.ws = p_.ws + z_; }
  const bf16_t* hq = (const bf16_t*)(p.ws + HG_Q); const bf16_t* hk = (const bf16_t*)(p.ws + HG_K); const bf16_t* hv = (const bf16_t*)(p.ws + HG_V);
  const _Float16* hlf = (const _Float16*)(p.ws + HG_LF);
  bf16_t* oraw = (bf16_t*)(p.ws + WS_TB);
  LAS bf16_t* Q = (LAS bf16_t*)lds; LAS bf16_t* Kr = (LAS bf16_t*)(lds + 17408); LAS float* BC = (LAS float*)(lds + 34816); LAS bf16_t* KDT = (LAS bf16_t*)(lds + 68608);
  LAS bf16_t* VT = (LAS bf16_t*)(lds + 87040); LAS bf16_t* ST = (LAS bf16_t*)(lds + 91648); LAS bf16_t* AB = (LAS bf16_t*)(lds + 100352);
  LAS float* SEG = (LAS float*)(lds + 109568); LAS float* DEC = (LAS float*)(lds + 111616); LAS _Float16* LF = (LAS _Float16*)(lds + 112128);
  int tid_ = wv * 64 + lane_id_(); asm volatile("" : "+v"(tid_)); const int tid = tid_, wid = tid >> 6, lane = tid & 63, fr = lane & 15, fq = lane >> 4;
  for (int it = blockIdx.x; it < 256; it += gridDim.x) {
    const int b = it >> 5, hh = (it >> 2) & 7, vq = it & 3;
    __syncthreads();
    for (int i = tid; i < 32 * 136 / 2; i += 512) ((LAS unsigned*)ST)[i] = 0u;
    f32x4 sreg[2]; sreg[0] = (f32x4){0.f, 0.f, 0.f, 0.f}; sreg[1] = sreg[0];
    u32x4 pq[2], pkk[2], plf[2], pv;
    const size_t gb = (size_t)(b * SEQ) * 1024 + hh * 128;
    auto prefetch = [&](int c) {
#pragma unroll
      for (int i = 0; i < 2; ++i) { const int idx = tid + 512 * i, row = idx >> 4, c8 = (idx & 15) * 8; const size_t off = gb + (size_t)(c * 64 + row) * 1024 + c8;
        pq[i] = *(const u32x4*)(hq + off); pkk[i] = *(const u32x4*)(hk + off); plf[i] = *(const u32x4*)(hlf + off); }
      if (tid < 256) { const int row = tid >> 2, c8 = (tid & 3) * 8; pv = *(const u32x4*)(hv + gb + (size_t)(c * 64 + row) * 1024 + vq * 32 + c8); }
    };
    prefetch(0);
    for (int c = 0; c < 64; ++c) {
      __syncthreads();
#pragma unroll
      for (int i = 0; i < 2; ++i) { const int idx = tid + 512 * i, row = idx >> 4, c8 = (idx & 15) * 8;
        *(LAS u32x4*)(Q + row * 136 + c8) = pq[i]; *(LAS u32x4*)(Kr + row * 136 + c8) = pkk[i]; *(LAS u32x4*)(LF + row * 128 + c8) = plf[i]; }
      if (tid < 256) { const int row = tid >> 2, c8 = (tid & 3) * 8; const bf16x8 vv = __builtin_bit_cast(bf16x8, pv);
#pragma unroll
        for (int i = 0; i < 8; ++i) VT[(c8 + i) * 72 + row] = (bf16_t)vv[i]; }
      if (c + 1 < 64) prefetch(c + 1);
      __syncthreads();
      const int kx = tid & 127, seg = tid >> 7;
      float bl[16];
      { float run = 0.f;
#pragma unroll
        for (int i = 0; i < 16; ++i) { run += (float)LF[(16 * seg + i) * 128 + kx]; bl[i] = run; }
        SEG[seg * 128 + kx] = run; }
      __syncthreads();
      { float pre = 0.f, blast = 0.f;
#pragma unroll
        for (int s2 = 0; s2 < 4; ++s2) { const float v = SEG[s2 * 128 + kx]; blast += v; if (s2 < seg) pre += v; }
        u32x4 w0, w1; float kd[16];
#pragma unroll
        for (int i = 0; i < 16; ++i) { const float bc = pre + bl[i]; BC[(16 * seg + i) * 132 + kx] = bc; kd[i] = bf2f(Kr[(16 * seg + i) * 136 + kx]) * __expf(blast - bc); }
#pragma unroll
        for (int j = 0; j < 4; ++j) { w0[j] = pk2(kd[2 * j], kd[2 * j + 1]); w1[j] = pk2(kd[8 + 2 * j], kd[8 + 2 * j + 1]); }
        *(LAS u32x4*)(KDT + kx * 72 + 16 * seg) = w0; *(LAS u32x4*)(KDT + kx * 72 + 16 * seg + 8) = w1;
        if (seg == 0) DEC[kx] = __expf(blast); }
      __syncthreads();
      const int mt = wid >> 1, vt = wid & 1;
      f32x4 oacc = (f32x4){0.f, 0.f, 0.f, 0.f}, a0 = oacc, a1 = oacc;
      const int J0 = 2 * vt;
#pragma unroll
      for (int ks = 0; ks < 4; ++ks) {
        const int kb = 32 * ks + 8 * fq, trow = 16 * mt + fr;
        const bf16x8 qv = *(const LAS bf16x8*)(Q + trow * 136 + kb);
        const f32x4 bc0 = *(const LAS f32x4*)(BC + trow * 132 + kb), bc1 = *(const LAS f32x4*)(BC + trow * 132 + kb + 4);
        const f32x4 r0 = *(const LAS f32x4*)(BC + (16 * mt) * 132 + kb), r1 = *(const LAS f32x4*)(BC + (16 * mt) * 132 + kb + 4);
        u32x4 ai, aq;
#pragma unroll
        for (int j = 0; j < 4; ++j) {
          const float q0 = bf2f((bf16_t)qv[2 * j]), q1 = bf2f((bf16_t)qv[2 * j + 1]);
          const float b0 = j < 2 ? bc0[2 * j] : bc1[2 * j - 4], b1 = j < 2 ? bc0[2 * j + 1] : bc1[2 * j - 3];
          const float rr0 = j < 2 ? r0[2 * j] : r1[2 * j - 4], rr1 = j < 2 ? r0[2 * j + 1] : r1[2 * j - 3];
          ai[j] = pk2(q0 * __expf(b0), q1 * __expf(b1)); aq[j] = pk2(q0 * __expf(b0 - rr0), q1 * __expf(b1 - rr1));
        }
        const bf16x8 sb = *(const LAS bf16x8*)(ST + (16 * vt + fr) * 136 + kb);
        oacc = MFMA16(__builtin_bit_cast(bf16x8, ai), sb, oacc);
#pragma unroll
        for (int jj = 0; jj < 2; ++jj) {
          const int J = J0 + jj; if (J > mt) continue;
          const int srow = 16 * J + fr;
          const bf16x8 kv = *(const LAS bf16x8*)(Kr + srow * 136 + kb);
          const f32x4 c0 = *(const LAS f32x4*)(BC + srow * 132 + kb), c1 = *(const LAS f32x4*)(BC + srow * 132 + kb + 4);
          u32x4 bk;
#pragma unroll
          for (int j = 0; j < 4; ++j) {
            const float k0 = bf2f((bf16_t)kv[2 * j]), k1 = bf2f((bf16_t)kv[2 * j + 1]);
            const float b0 = j < 2 ? c0[2 * j] : c1[2 * j - 4], b1 = j < 2 ? c0[2 * j + 1] : c1[2 * j - 3];
            const float rr0 = j < 2 ? r0[2 * j] : r1[2 * j - 4], rr1 = j < 2 ? r0[2 * j + 1] : r1[2 * j - 3];
            bk[j] = pk2(k0 * __expf(fminf(rr0 - b0, 80.f)), k1 * __expf(fminf(rr1 - b1, 80.f)));
          }
          if (jj == 0) a0 = MFMA16(__builtin_bit_cast(bf16x8, aq), __builtin_bit_cast(bf16x8, bk), a0);
          else a1 = MFMA16(__builtin_bit_cast(bf16x8, aq), __builtin_bit_cast(bf16x8, bk), a1);
        }
      }
#pragma unroll
      for (int jj = 0; jj < 2; ++jj) { const int J = J0 + jj;
#pragma unroll
        for (int reg = 0; reg < 4; ++reg) { const int tt = 16 * mt + 4 * fq + reg, ss = 16 * J + fr; const float v = jj == 0 ? a0[reg] : a1[reg];
          AB[tt * 72 + ss] = (J <= mt && ss <= tt) ? f2bf(v) : (bf16_t)0; } }
      __syncthreads();
#pragma unroll
      for (int k2 = 0; k2 < 2; ++k2) {
        const bf16x8 af = *(const LAS bf16x8*)(AB + (16 * mt + fr) * 72 + 32 * k2 + 8 * fq);
        const bf16x8 vb = *(const LAS bf16x8*)(VT + (16 * vt + fr) * 72 + 32 * k2 + 8 * fq);
        oacc = MFMA16(af, vb, oacc);
      }
#pragma unroll
      for (int reg = 0; reg < 4; ++reg) {
        const int tok = b * SEQ + c * 64 + 16 * mt + 4 * fq + reg; const float v = oacc[reg];
        oraw[(size_t)tok * 1024 + hh * 128 + vq * 32 + 16 * vt + fr] = f2bf(v);
        float sq = v * v; sq += __shfl_xor(sq, 1); sq += __shfl_xor(sq, 2); sq += __shfl_xor(sq, 4); sq += __shfl_xor(sq, 8);
        if (fr == 0) atomicAdd(sumsq + (size_t)tok * 8 + hh, sq);
      }
      { const f32x4 dc = *(const LAS f32x4*)(DEC + 16 * wid + 4 * fq);
        sreg[0] *= dc; sreg[1] *= dc;
#pragma unroll
        for (int k2 = 0; k2 < 2; ++k2) {
          const bf16x8 af = *(const LAS bf16x8*)(KDT + (16 * wid + fr) * 72 + 32 * k2 + 8 * fq);
#pragma unroll
          for (int v2 = 0; v2 < 2; ++v2) { const bf16x8 vb = *(const LAS bf16x8*)(VT + (16 * v2 + fr) * 72 + 32 * k2 + 8 * fq); sreg[v2] = MFMA16(af, vb, sreg[v2]); }
        }
#pragma unroll
        for (int v2 = 0; v2 < 2; ++v2) { u32x2 w; w.x = pk2(sreg[v2][0], sreg[v2][1]); w.y = pk2(sreg[v2][2], sreg[v2][3]); *(LAS u32x2*)(ST + (16 * v2 + fr) * 136 + 16 * wid + 4 * fq) = w; }
      }
    }
  }
}
DI void hgrn_norm_phase(int wv, const P& p_, int slot) {
  P p = p_; { size_t z_ = 0; asm volatile("" : "+s"(z_)); p.ws = p_.ws + z_; }
  const bf16_t* oraw = (const bf16_t*)(p.ws + WS_TB); const bf16_t* hg = (const bf16_t*)(p.ws + HG_G); const float* sumsq = (const float*)(p.ws + WS_SUMSQ);
  bf16_t* ob = (bf16_t*)(p.ws + WS_O); const float* gain = p.hg_gain + slot * 128;
  int tid_ = wv * 64 + lane_id_(); asm volatile("" : "+v"(tid_)); const size_t gtid = (size_t)blockIdx.x * 512 + tid_, gsz = (size_t)gridDim.x * 512;
  for (size_t i = gtid; i < (size_t)MTOK * 1024 / 8; i += gsz) {
    const size_t e = i * 8; const int row = (int)(e >> 10), col = (int)(e & 1023), hh = col >> 7, vv = col & 127;
    const float rs = rsqrtf(sumsq[(size_t)row * 8 + hh] * (1.0f / 128.0f) + 1e-6f);
    const bf16x8 o8 = *(const bf16x8*)(oraw + e), g8 = *(const bf16x8*)(hg + e);
    u32x4 w;
#pragma unroll
    for (int j = 0; j < 4; ++j) w[j] = pk2(bf2f((bf16_t)o8[2 * j]) * rs * gain[vv + 2 * j] * bf2f((bf16_t)g8[2 * j]), bf2f((bf16_t)o8[2 * j + 1]) * rs * gain[vv + 2 * j + 1] * bf2f((bf16_t)g8[2 * j + 1]));
    *(u32x4*)(ob + e) = w;
  }
}
#define REP_NSA 1
#define REP_CONV 1
#define REP_CMP 1
#define REP_MISC 1
#define REP_DOWN 1
#define REP_HG 1
#define REP_EPI 1
#ifndef SKIP_MIXERS
#define SKIP_MIXERS 0
#endif
__global__ void __launch_bounds__(512, 2) mega_fwd(P p) {
  extern __shared__ __attribute__((aligned(16))) unsigned char lds_raw[];
  LAS unsigned char* lds = (LAS unsigned char*)lds_raw;
  cg::grid_group grid = cg::this_grid();
  const int wv = __builtin_amdgcn_readfirstlane((int)(threadIdx.x >> 6));
  volatile LAS unsigned* xst = (volatile LAS unsigned*)(lds + LDS_BYTES - 16);
  if (wv == 0 && lane_id_() < 4) xst[lane_id_()] = 0u;
  __syncthreads();
  const XcdBarrier xb = xcd_barrier_post(wv, (unsigned*)(p.ws + WS_BAR), xst);
#define GSYNC() xcd_barrier(wv, xb)
  unsigned char* ws = p.ws;
  init_phase(wv, p);
  for (int L = 0; L < 4; ++L) {
    { size_t z_ = 0; asm volatile("" : "+s"(z_)); ws = p.ws + z_; }
    for (int rep = 0; rep < p.rep_conv; ++rep) convert_phase(wv, p, L, lds);
    if (L == 0) grid.sync(); else GSYNC();
    const int kind = L % 3, slot = L / 3;
    for (int s = 0; s < 3; ++s) {
      { size_t z_ = 0; asm volatile("" : "+s"(z_)); ws = p.ws + z_; }
      float* stats = (float*)(ws + WS_STATS); bf16_t* tb = (bf16_t*)(ws + WS_TB); bf16_t* Hb = (bf16_t*)(ws + WS_BIG); bf16_t* ob = (bf16_t*)(ws + WS_O);
      const int lnp = L * 3 + s - 1;
      const float* stp = (const float*)(ws + WS_DSTATS) + (size_t)(lnp + 1) * MTOK * 2;
      pg8::Gemm gr; float scale;
      if (s != 1) {
        pg8::Gemm g; g.A = tb; g.Bt = (const bf16_t*)(ws + (s == 0 ? W_GU1 : W_GU2)); g.M = MTOK; g.N = 5632; g.K = DM;
        pg8::StaticOrder S; S.init(g.M, g.N, gridDim.x, blockIdx.x);
        EpiUp E; E.reps = p.rep_epi; E.H = Hb; E.stats = stp; E.c1 = (const float*)(ws + (s == 0 ? C_GU1 : C_GU2)); E.c2 = E.c1 + 5632;
        pg8::gemm_phase(wv, lds, g, S, E);
        GSYNC();
        gr.A = Hb; gr.Bt = (const bf16_t*)(ws + (s == 0 ? W_D1 : W_D2)); gr.M = MTOK; gr.N = DM; gr.K = DFF; scale = 0.5f;
      } else {
        pg8::Gemm g; g.A = tb; g.Bt = (const bf16_t*)(ws + W_IN); g.M = MTOK; g.N = kind == 0 ? 2816 : (kind == 1 ? 4096 : 1280); g.K = DM;
        pg8::StaticOrder S; S.init(g.M, g.N, gridDim.x, blockIdx.x);
        EpiIn E; E.reps = 1; E.mode = kind == 1 ? 1 : 0; E.h = Hb; E.ld = g.N; E.stats = stp; E.c1 = (const float*)(ws + C_IN); E.c2 = E.c1 + 4096; E.lbv = (const float*)(ws + C_LBV);
        E.hq = (bf16_t*)(ws + HG_Q); E.hk = (bf16_t*)(ws + HG_K); E.hv = (bf16_t*)(ws + HG_V); E.hg = (bf16_t*)(ws + HG_G); E.hlf = (_Float16*)(ws + HG_LF);
        pg8::gemm_phase(wv, lds, g, S, E);
        GSYNC();
#if !SKIP_MIXERS
        if (kind == 0) {
          for (int rep = 0; rep < p.rep_cmp; ++rep) nsa_compress_phase(wv, p, lds);
          GSYNC();
          for (int rep = 0; rep < p.rep_nsa; ++rep) { if (rep) GSYNC(); nsa_attn_phase(wv, p, lds); }
        }
        else if (kind == 1) {
          for (int rep = p.rep_hg - 1; rep >= 0; --rep) hgrn_scan_phase(wv, p, lds, (float*)(ws + (rep ? WS_KC : WS_SUMSQ)));
          GSYNC(); hgrn_norm_phase(wv, p, slot); }
        else {
          for (int rep = 0; rep < p.rep_misc; ++rep) swa_attn_phase(wv, p, slot, lds);
        }
#endif
        GSYNC();
        gr.A = ob; gr.Bt = (const bf16_t*)(ws + W_OUT); gr.M = MTOK; gr.N = DM; gr.K = DM; scale = 1.0f;
      }
      pg8::StaticOrder S2; S2.init(gr.M, gr.N, gridDim.x, blockIdx.x);
      EpiRes R; R.reps = 1; R.T = p.out; R.Tin = lnp >= 0 ? p.out : p.x; R.stats_prev = stp; R.g = (const float*)(ws + WS_G13) + (size_t)(lnp + 1) * DM; R.b = (const float*)(ws + WS_B13) + (size_t)(lnp + 1) * DM;
      R.stats_new = stats + (size_t)(lnp + 1) * MTOK * 2; R.tb = tb; R.scale = scale;
      for (int rep = (s != 1 ? p.rep_down : 1) - 1; rep >= 0; --rep) {
        if (rep) { R.T = (float*)(ws + WS_BIG + 192 * MiB); R.tb = (bf16_t*)(ws + WS_O); R.stats_new = (float*)(ws + WS_KC); }
        else { R.T = p.out; R.tb = tb; R.stats_new = stats + (size_t)(lnp + 1) * MTOK * 2; }
        pg8::gemm_phase(wv, lds, gr, S2, R);
        GSYNC();
      }
    }
  }
  final_ln(wv, p, (float*)(ws + WS_STATS) + (size_t)11 * MTOK * 2, p.ln_gain + 11 * DM, p.ln_bias + 11 * DM);
}

extern "C" void kernel_launch(void* const* d_in, const int* in_sizes, int n_in, void* d_out, int out_size, void* d_ws, size_t ws_size, hipStream_t stream) {
  static int grid = 0;
  if (grid == 0) {
    if (n_in != 22 || ws_size < WS_END) { fprintf(stderr, "kernel_launch: unexpected n_in %d / ws_size %zu (need %zu)\n", n_in, ws_size, (size_t)WS_END); grid = -1; return; }
    int dev = 0, cus = 0, per_cu = 0;
    hipGetDevice(&dev); hipDeviceGetAttribute(&cus, hipDeviceAttributeMultiprocessorCount, dev);
    if (hipFuncSetAttribute((const void*)mega_fwd, hipFuncAttributeMaxDynamicSharedMemorySize, LDS_BYTES) != hipSuccess) { fprintf(stderr, "hipFuncSetAttribute failed\n"); grid = -1; return; }
    hipOccupancyMaxActiveBlocksPerMultiprocessor(&per_cu, (const void*)mega_fwd, 512, LDS_BYTES);
    if (per_cu < 1) { fprintf(stderr, "occupancy query says %d blocks/CU\n", per_cu); per_cu = 1; }
    (void)hipGetLastError();
    grid = cus * 1;
  }
  if (grid < 0) return;
  if (hipMemsetAsync((char*)d_ws + WS_BAR, 0, 16384, stream) != hipSuccess) { fprintf(stderr, "memset failed\n"); return; }
  P p{};
  const float** pp = (const float**)&p;
  for (int i = 0; i < 22; ++i) pp[i] = (const float*)d_in[i];
  p.out = (float*)d_out; p.ws = (unsigned char*)d_ws;
  p.rep_nsa = REP_NSA; p.rep_conv = REP_CONV; p.rep_cmp = REP_CMP; p.rep_misc = REP_MISC; p.rep_down = REP_DOWN; p.rep_hg = REP_HG; p.rep_epi = REP_EPI; p.rep_pad = 0;
  void* args[] = {&p};
  hipError_t e = hipLaunchCooperativeKernel((const void*)mega_fwd, dim3(grid), dim3(512), args, LDS_BYTES, stream);
  if (e != hipSuccess) fprintf(stderr, "cooperative launch failed: %s (grid %d)\n", hipGetErrorString(e), grid);
}
```

```cpp
#include <hip/hip_runtime.h>
#include <hip/hip_cooperative_groups.h>
#include <cstdio>
namespace cg = cooperative_groups;

typedef unsigned short bf16_t;
typedef short bf16x8 __attribute__((ext_vector_type(8)));
typedef short s16x4 __attribute__((ext_vector_type(4)));
typedef float f32x4 __attribute__((ext_vector_type(4)));
typedef float f32x16 __attribute__((ext_vector_type(16)));
typedef unsigned u32x2 __attribute__((ext_vector_type(2)));
typedef unsigned u32x4 __attribute__((ext_vector_type(4)));
#define LAS __attribute__((address_space(3)))
#define DI __device__ __forceinline__

constexpr int MTOK = 32768, DM = 1024, DFF = 2816, SEQ = 4096, NB = 8;
constexpr float ALPHA = 1.681792830507429f;
constexpr size_t MiB = 1ull << 20;
constexpr size_t W_GU1 = 0, W_D1 = 11534336, W_GU2 = 17301504, W_D2 = 28835840, W_IN = 34603008, W_OUT = 42991616,
                 W_W1T = 45088768, W_W2T = 46137344, W_C = 46170112;
constexpr size_t C_GU1 = W_C, C_GU2 = C_GU1 + 2 * 5632 * 4, C_IN = C_GU2 + 2 * 5632 * 4, C_POSB = C_IN + 2 * 4096 * 4,
                 C_LBV = C_POSB + 2 * 256 * 4, C_BTAB = C_LBV + 1024 * 4, C_END = C_BTAB + 16 * 132 * 4;
constexpr size_t WS_TB = 48 * MiB, WS_BIG = 112 * MiB, WS_O = 432 * MiB, WS_MISC = 496 * MiB;
constexpr size_t WS_DSTATS = WS_MISC, WS_STATS = WS_DSTATS + 262144, WS_SUMSQ = WS_STATS + 3 * MiB, WS_KC = WS_SUMSQ + 1 * MiB, WS_VC = WS_KC + 1 * MiB, WS_BAR = WS_VC + 1 * MiB,
                 WS_G13 = WS_BAR + 16384, WS_B13 = WS_G13 + 13 * 4096, WS_END = WS_B13 + 13 * 4096;
static_assert(C_END <= 48 * MiB, "weights region");
constexpr int LDS_BYTES = 144 * 1024;

struct P {
  const float *x, *rel_bias, *ln_gain, *ln_bias, *f1g, *f1u, *f1d, *f2g, *f2u, *f2d, *nsa_win, *nsa_wout, *nsa_pos, *nsa_w1, *nsa_w2,
      *hg_win, *hg_wout, *hg_gain, *hg_lb, *swa_win, *swa_wout, *swa_sinks;
  float* out; unsigned char* ws;
  int rep_nsa, rep_conv, rep_cmp, rep_misc, rep_down, rep_hg, rep_epi, rep_pad;
};

DI unsigned pk2(float a, float b) { typedef __bf16 bf2 __attribute__((ext_vector_type(2))); bf2 v; v[0] = (__bf16)a; v[1] = (__bf16)b; return __builtin_bit_cast(unsigned, v); }
DI bf16_t f2bf(float a) { return __builtin_bit_cast(unsigned short, (__bf16)a); }
DI float bf2f(bf16_t v) { return __uint_as_float(((unsigned)v) << 16); }
DI int lane_id_() { int l; asm volatile("v_mbcnt_lo_u32_b32 %0, -1, 0\n\tv_mbcnt_hi_u32_b32 %0, -1, %0" : "=v"(l)); return l; }
DI void lds_barrier() { asm volatile("s_waitcnt lgkmcnt(0)\n\ts_barrier" ::: "memory"); }
DI float sigmoidf_(float v) { return __builtin_amdgcn_rcpf(1.0f + __builtin_amdgcn_exp2f(-1.4426950408889634f * v)); }


#define XB_TMO      128
#define XB_XCNT(j)  (256  + 64 * (j))
#define XB_XSUB(j)  (1280 + 64 * (j))
#define XB_XGEN(j)  (2304 + 64 * (j))
#define XB_TOP      3328
#define XB_TOPGEN   3392
#define XCD_BAR_WORDS 3456
#define XB_SPIN_CAP (1u << 20)
DI unsigned xb_ld(unsigned* p)              { return __hip_atomic_load(p, __ATOMIC_RELAXED, __HIP_MEMORY_SCOPE_AGENT); }
DI unsigned xb_add(unsigned* p, unsigned v) { return __hip_atomic_fetch_add(p, v, __ATOMIC_RELAXED, __HIP_MEMORY_SCOPE_AGENT); }
DI unsigned xb_xcc_id() { return (unsigned)__builtin_amdgcn_s_getreg((3 << 11) | 20) & 0xFu; }
#define XB_SPIN(cond, bar) do { unsigned _sp = 0; while (cond) { __builtin_amdgcn_s_sleep(1); \
    if ((++_sp & 255u) == 0u) { if (xb_ld(&(bar)[XB_TMO])) break; if (_sp > XB_SPIN_CAP) { atomicAdd(&(bar)[XB_TMO], 1u); break; } } } } while (0)
struct XcdBarrier { unsigned* bar; unsigned x; volatile LAS unsigned* st; };
DI XcdBarrier xcd_barrier_post(int wv, unsigned* bar, volatile LAS unsigned* st) {
  XcdBarrier b; b.bar = bar; b.x = xb_xcc_id(); b.st = st;
  if (wv == 0 && lane_id_() == 0) (void)xb_add(&bar[XB_XCNT(b.x)], 1u);
  return b;
}
DI void xcd_barrier_complete(unsigned* bar, unsigned x, unsigned& nloc, unsigned& nx) {
  const unsigned G = gridDim.x * gridDim.y * gridDim.z;
  unsigned sum, cnt, mine, sp = 0u;
  for (;;) {
    sum = 0u; cnt = 0u; mine = 0u;
#pragma unroll 1
    for (unsigned j = 0; j < 16; ++j) { const unsigned c = xb_ld(&bar[XB_XCNT(j)]); sum += c; cnt += (c > 0u) ? 1u : 0u; mine = (j == x) ? c : mine; }
    if (sum == G) break;
    __builtin_amdgcn_s_sleep(1);
    if ((++sp & 255u) == 0u) { if (xb_ld(&bar[XB_TMO])) break; if (sp > XB_SPIN_CAP) { atomicAdd(&bar[XB_TMO], 1u); break; } }
  }
  nloc = mine > 0u ? mine : 1u; nx = cnt > 0u ? cnt : 1u;
}
DI void xcd_barrier(int wv, const XcdBarrier& b) {
  asm volatile("s_waitcnt vmcnt(0)" ::: "memory");
  __syncthreads();
  if (wv == 0 && lane_id_() == 0) {
    unsigned* bar = b.bar;
    __builtin_amdgcn_s_waitcnt(0);
    unsigned nloc = b.st[0], nx = b.st[1];
    if (nloc == 0u) { xcd_barrier_complete(bar, b.x, nloc, nx); b.st[0] = nloc; b.st[1] = nx; }
    const unsigned old = xb_add(&bar[XB_XSUB(b.x)], 1u);
    const unsigned gen = old / nloc;
    if (old + 1u == (gen + 1u) * nloc) {
      __builtin_amdgcn_fence(__ATOMIC_RELEASE, "agent");
      asm volatile("s_waitcnt vmcnt(0)" ::: "memory");
      const unsigned og = xb_add(&bar[XB_TOP], 1u);
      const unsigned tg = og / nx;
      if (og + 1u == (tg + 1u) * nx) xb_add(&bar[XB_TOPGEN], 1u);
      else XB_SPIN(xb_ld(&bar[XB_TOPGEN]) == tg, bar);
      __builtin_amdgcn_fence(__ATOMIC_ACQUIRE, "agent");
      xb_add(&bar[XB_XGEN(b.x)], 1u);
      asm volatile("s_waitcnt vmcnt(0)" ::: "memory");
    } else {
      XB_SPIN(xb_ld(&bar[XB_XGEN(b.x)]) == gen, bar);
      __builtin_amdgcn_fence(__ATOMIC_ACQUIRE, "agent");
      asm volatile("s_waitcnt vmcnt(0)" ::: "memory");
    }
  }
  __syncthreads();
}

namespace pg8 {
constexpr int BM = 256, BK = 64, HALF = 128, HTB = HALF * BK * 2, STAGE_BYTES = 8 * HTB, NXCD = 8, WGM = 8;
DI int lds_byte(int r, int c) { const int st = (r >> 4) * 2 + (c >> 5), rr = r & 15, cc = c & 31, ob = rr * 64 + cc * 2; return st * 1024 + (ob ^ (((ob >> 9) & 1) << 5)); }
DI void stage_rc(int b, int& R, int& C) { const int st = b / 1024, sb = b % 1024, swz = sb ^ (((sb >> 9) & 1) << 5); R = (st >> 1) * 16 + swz / 64; C = (st & 1) * 32 + (swz % 64) / 2; }
struct Unit { int pm, pn; };
struct Gemm { const bf16_t* A; const bf16_t* Bt; int M, N, K; };
struct StaticOrder {
  int nM, nN, nwg, G, c;
  DI void init(int M, int N, int G_, int c_) { nM = M / BM; nN = N / BM; nwg = nM * nN; G = G_; c = c_; }
  DI bool next(int i, Unit& u) const {
    const long L = (long)i * G + c; if (L >= nwg) return false;
    int wgid = (int)L; { const int q = nwg / NXCD, r = nwg % NXCD, xcd = wgid % NXCD, off = wgid / NXCD; wgid = (xcd < r ? xcd * (q + 1) : r * (q + 1) + (xcd - r) * q) + off; }
    const int nig = WGM * nN, gid = wgid / nig, fm = gid * WGM, gsz = (nM - fm) < WGM ? (nM - fm) : WGM;
    u.pm = fm + ((wgid % nig) % gsz); u.pn = (wgid % nig) / gsz; return true;
  }
};
template <class Epi>
DI void gemm_phase(int wv, LAS unsigned char* lds, const Gemm g, const StaticOrder& S, const Epi& E) {
  int tid_ = wv * 64 + lane_id_(); asm volatile("" : "+v"(tid_)); const int tid = tid_, wid = __builtin_amdgcn_readfirstlane(tid >> 6), lane = tid & 63, wr = wid >> 2, wc = wid & 3, fr = lane & 15, fq = lane >> 4;
  const int K = g.K, nt = K / BK;
  unsigned voffA[2];
#pragma unroll
  for (int i = 0; i < 2; ++i) { int R, C; stage_rc(tid * 16 + i * 8192, R, C); voffA[i] = (unsigned)(R * K + C) * 2u; }
  const size_t kstep = (size_t)(BK * 2), hstep = (size_t)HALF * K * 2, tstep = 2 * hstep;
  const unsigned ldsw = (unsigned)wid * 1024u;
  const int aoff = lds_byte(wr * 64 + fr, fq * 8), boff = lds_byte(wc * 32 + fr, fq * 8);
#define PG8_SA(b, h) (((b) * 2 + (h)) * HTB)
#define PG8_SB(b, h) ((4 + (b) * 2 + (h)) * HTB)
#define PG8_STAGE(bufoff, gbase, voff) do { _Pragma("unroll") for (int _i = 0; _i < 2; ++_i) \
    __builtin_amdgcn_global_load_lds((const unsigned*)((const char*)(gbase) + (voff)[_i]), (LAS unsigned*)(lds + (bufoff) + ldsw + _i * 8192), 16, 0, 0); } while (0)
#define PG8_LDA(dst, b, h) do { _Pragma("unroll") for (int m = 0; m < 4; ++m) _Pragma("unroll") for (int k = 0; k < 2; ++k) dst[m][k] = *(const LAS bf16x8*)(lds + PG8_SA(b, h) + aoff + m * 2048 + k * 1024); } while (0)
#define PG8_LDB(dst, b, h) do { _Pragma("unroll") for (int n = 0; n < 2; ++n) _Pragma("unroll") for (int k = 0; k < 2; ++k) dst[n][k] = *(const LAS bf16x8*)(lds + PG8_SB(b, h) + boff + n * 2048 + k * 1024); } while (0)
#define PG8_MMA(ai, bj, At, Bt) do { __builtin_amdgcn_s_setprio(1); _Pragma("unroll") for (int m = 0; m < 4; ++m) _Pragma("unroll") for (int n = 0; n < 2; ++n) _Pragma("unroll") for (int k = 0; k < 2; ++k) \
    acc[ai][bj][m][n] = __builtin_amdgcn_mfma_f32_16x16x32_bf16(Bt[n][k], At[m][k], acc[ai][bj][m][n], 0, 0, 0); __builtin_amdgcn_s_setprio(0); } while (0)
#define PG8_WAIT_V(n) asm volatile("s_waitcnt vmcnt(" #n ")" ::: "memory")
#define PG8_WAIT_L(n) asm volatile("s_waitcnt lgkmcnt(" #n ")" ::: "memory")
#define PG8_BAR __builtin_amdgcn_s_barrier()
#define PG8_SCHED __builtin_amdgcn_sched_barrier(0)
  Unit cur, nxt; int ui = 0;
  if (!S.next(0, cur)) return;
  f32x4 acc[2][2][4][2];
#pragma unroll
  for (int a = 0; a < 2; ++a)
#pragma unroll
    for (int b = 0; b < 2; ++b)
#pragma unroll
      for (int m = 0; m < 4; ++m)
#pragma unroll
        for (int n = 0; n < 2; ++n) acc[a][b][m][n] = (f32x4){0.f, 0.f, 0.f, 0.f};
  bf16x8 At[4][2], B0[2][2], B1[2][2];
  const char* cA = (const char*)g.A + (size_t)cur.pm * tstep; const char* cB = (const char*)g.Bt + (size_t)cur.pn * tstep;
  PG8_STAGE(PG8_SB(0, 0), cB, voffA); PG8_STAGE(PG8_SA(0, 0), cA, voffA); PG8_STAGE(PG8_SB(0, 1), cB + hstep, voffA); PG8_STAGE(PG8_SA(0, 1), cA + hstep, voffA);
  if (wr == 1) PG8_BAR;
  PG8_WAIT_V(4); PG8_BAR;
  PG8_STAGE(PG8_SB(1, 0), cB + kstep, voffA); PG8_STAGE(PG8_SA(1, 0), cA + kstep, voffA); PG8_STAGE(PG8_SB(1, 1), cB + hstep + kstep, voffA);
  PG8_WAIT_V(6); PG8_BAR;
  for (;;) {
    const bool has_next = S.next(ui + 1, nxt);
    const char* nA = has_next ? (const char*)g.A + (size_t)nxt.pm * tstep : cA; const char* nB = has_next ? (const char*)g.Bt + (size_t)nxt.pn * tstep : cB;
    for (int t = 0; t < nt; t += 2) {
      const bool last = (t == nt - 2);
      const char* a1 = cA + (size_t)(t + 1) * kstep;
      const char* a2 = last ? nA : cA + (size_t)(t + 2) * kstep; const char* b2 = last ? nB : cB + (size_t)(t + 2) * kstep;
      const char* a3 = a2 + kstep; const char* b3 = b2 + kstep;
      PG8_LDB(B0, 0, 0); PG8_SCHED; PG8_LDA(At, 0, 0); PG8_STAGE(PG8_SA(1, 1), a1 + hstep, voffA);
      PG8_WAIT_L(8); PG8_BAR; PG8_WAIT_L(0); PG8_MMA(0, 0, At, B0); PG8_BAR; PG8_SCHED;
      PG8_LDB(B1, 0, 1); PG8_STAGE(PG8_SB(0, 0), b2, voffA);
      PG8_BAR; PG8_WAIT_L(0); PG8_MMA(0, 1, At, B1); PG8_BAR;
      PG8_LDA(At, 0, 1); PG8_STAGE(PG8_SA(0, 0), a2, voffA);
      PG8_BAR; PG8_WAIT_L(0); PG8_MMA(1, 0, At, B0); PG8_BAR; PG8_SCHED;
      PG8_STAGE(PG8_SB(0, 1), b2 + hstep, voffA);
      PG8_WAIT_V(6); PG8_BAR; PG8_MMA(1, 1, At, B1); PG8_BAR;
      PG8_LDB(B0, 1, 0); PG8_SCHED; PG8_LDA(At, 1, 0); PG8_STAGE(PG8_SA(0, 1), a2 + hstep, voffA);
      PG8_WAIT_L(8); PG8_BAR; PG8_WAIT_L(0); PG8_MMA(0, 0, At, B0); PG8_BAR; PG8_SCHED;
      PG8_LDB(B1, 1, 1); PG8_STAGE(PG8_SB(1, 0), b3, voffA);
      PG8_BAR; PG8_WAIT_L(0); PG8_MMA(0, 1, At, B1); PG8_BAR;
      PG8_LDA(At, 1, 1); PG8_STAGE(PG8_SA(1, 0), a3, voffA);
      PG8_BAR; PG8_WAIT_L(0); PG8_MMA(1, 0, At, B0); PG8_BAR; PG8_SCHED;
      PG8_STAGE(PG8_SB(1, 1), b3 + hstep, voffA);
      PG8_WAIT_V(6); PG8_BAR; PG8_MMA(1, 1, At, B1); PG8_BAR;
    }
    for (int r_ = 0; r_ < E.reps; ++r_) E(acc, cur, wr, wc, fr, fq);
    if (!has_next) break;
#pragma unroll
    for (int a = 0; a < 2; ++a)
#pragma unroll
      for (int b = 0; b < 2; ++b)
#pragma unroll
        for (int m = 0; m < 4; ++m)
#pragma unroll
          for (int n = 0; n < 2; ++n) acc[a][b][m][n] = (f32x4){0.f, 0.f, 0.f, 0.f};
    cur = nxt; cA = nA; cB = nB; ++ui;
  }
  PG8_WAIT_V(0);
  if (wr == 0) PG8_BAR;
  PG8_BAR;
}
}
DI void row_affine(const float* stats, int row, float& a, float& bb, float& mu, float& rstd) {
  const float s = stats[2 * row], ss = stats[2 * row + 1]; mu = s * (1.0f / 1024.0f); const float var = fmaxf(ss * (1.0f / 1024.0f) - mu * mu, 0.f); rstd = rsqrtf(var + 1e-5f); a = rstd; bb = -rstd * mu;
}
struct EpiUp {
  bf16_t* H; const float* stats; const float* c1; const float* c2; int reps;
  DI void operator()(const f32x4 (&acc)[2][2][4][2], const pg8::Unit& u, int wr, int wc, int fr, int fq) const {
    const int colg = u.pn * 256 + wc * 32 + 8 * fq, hcol = u.pn * 128 + wc * 32 + 8 * fq;
    f32x4 c1g[2], c2g[2], c1u[2], c2u[2];
#pragma unroll
    for (int n = 0; n < 2; ++n) { c1g[n] = *(const f32x4*)(c1 + colg + 4 * n); c2g[n] = *(const f32x4*)(c2 + colg + 4 * n); c1u[n] = *(const f32x4*)(c1 + colg + 128 + 4 * n); c2u[n] = *(const f32x4*)(c2 + colg + 128 + 4 * n); }
    float ra[8], rb[8];
#pragma unroll
    for (int i = 0; i < 8; ++i) { float mu, rstd; row_affine(stats, u.pm * 256 + (i >> 2) * 128 + wr * 64 + (i & 3) * 16 + fr, ra[i], rb[i], mu, rstd); }
#pragma unroll
    for (int ai = 0; ai < 2; ++ai)
#pragma unroll
      for (int m = 0; m < 4; ++m) {
        const int row = u.pm * 256 + ai * 128 + wr * 64 + m * 16 + fr; const float a = ra[ai * 4 + m], bb = rb[ai * 4 + m];
        u32x4 w;
#pragma unroll
        for (int n = 0; n < 2; ++n) {
          const f32x4 gv = acc[ai][0][m][n] * a + c1g[n] * bb + c2g[n], uv = acc[ai][1][m][n] * a + c1u[n] * bb + c2u[n];
          float h[4];
#pragma unroll
          for (int j = 0; j < 4; ++j) h[j] = gv[j] * sigmoidf_(gv[j]) * uv[j];
          w[2 * n] = pk2(h[0], h[1]); w[2 * n + 1] = pk2(h[2], h[3]);
        }
        *(u32x4*)(H + (size_t)row * DFF + hcol) = w;
        asm volatile("" ::: "memory");
      }
  }
};
struct EpiRes {
  float* T; const float* Tin; const float* stats_prev; const float* g; const float* b; float* stats_new; bf16_t* tb; float scale; int reps;
  DI void operator()(const f32x4 (&acc)[2][2][4][2], const pg8::Unit& u, int wr, int wc, int fr, int fq) const {
    const int col0 = u.pn * 256 + wc * 32 + 8 * fq;
    float rmu[8], rrs[8];
#pragma unroll
    for (int i = 0; i < 8; ++i) { float a, bb; row_affine(stats_prev, u.pm * 256 + (i >> 2) * 128 + wr * 64 + (i & 3) * 16 + fr, a, bb, rmu[i], rrs[i]); }
#pragma unroll
    for (int ai = 0; ai < 2; ++ai)
#pragma unroll
      for (int mp = 0; mp < 2; ++mp) {
        f32x4 tpv[2][2][2];
#pragma unroll
        for (int mm = 0; mm < 2; ++mm)
#pragma unroll
          for (int bj = 0; bj < 2; ++bj)
#pragma unroll
            for (int n = 0; n < 2; ++n) tpv[mm][bj][n] = *(const f32x4*)(Tin + (size_t)(u.pm * 256 + ai * 128 + wr * 64 + (2 * mp + mm) * 16 + fr) * DM + col0 + bj * 128 + 4 * n);
#pragma unroll
        for (int mm = 0; mm < 2; ++mm) {
          const int m = 2 * mp + mm, row = u.pm * 256 + ai * 128 + wr * 64 + m * 16 + fr; const float mu = rmu[ai * 4 + m], rstd = rrs[ai * 4 + m];
          float rs = 0.f, rq = 0.f;
#pragma unroll
          for (int bj = 0; bj < 2; ++bj) {
            u32x4 w;
#pragma unroll
            for (int n = 0; n < 2; ++n) {
              const size_t off = (size_t)row * DM + col0 + bj * 128 + 4 * n;
              f32x4 tp = tpv[mm][bj][n];
              tp = (tp - mu) * rstd * (*(const f32x4*)(g + col0 + bj * 128 + 4 * n)) + *(const f32x4*)(b + col0 + bj * 128 + 4 * n);
              const f32x4 tn = tp * ALPHA + acc[ai][bj][m][n] * scale;
              *(f32x4*)(T + off) = tn;
              w[2 * n] = pk2(tn[0], tn[1]); w[2 * n + 1] = pk2(tn[2], tn[3]);
              rs += tn[0] + tn[1] + tn[2] + tn[3]; rq += tn[0] * tn[0] + tn[1] * tn[1] + tn[2] * tn[2] + tn[3] * tn[3];
            }
            *(u32x4*)(tb + (size_t)row * DM + col0 + bj * 128) = w;
          }
          rs += __shfl_xor(rs, 16); rs += __shfl_xor(rs, 32); rq += __shfl_xor(rq, 16); rq += __shfl_xor(rq, 32);
          if (fq == 0) { atomicAdd(stats_new + 2 * row, rs); atomicAdd(stats_new + 2 * row + 1, rq); }
        }
        asm volatile("" ::: "memory");
      }
  }
};
struct EpiIn {
  int mode; bf16_t* h; int ld; const float* stats; const float* c1; const float* c2; const float* lbv;
  bf16_t *hq, *hk, *hv, *hg; _Float16* hlf; int reps;
  template <int SECT>
  DI void body(const f32x4 (&acc)[2][2][4][2], const pg8::Unit& u, int wr, int wc, int fr, int fq) const {
    const int col0 = u.pn * 256 + wc * 32 + 8 * fq;
#pragma unroll
    for (int ai = 0; ai < 2; ++ai)
#pragma unroll
      for (int m = 0; m < 4; ++m) {
        const int row = u.pm * 256 + ai * 128 + wr * 64 + m * 16 + fr; float a, bb, mu, rstd; row_affine(stats, row, a, bb, mu, rstd);
#pragma unroll
        for (int bj = 0; bj < 2; ++bj) {
          const int col = col0 + bj * 128;
          f32x4 v[2];
#pragma unroll
          for (int n = 0; n < 2; ++n) v[n] = acc[ai][bj][m][n] * a + (*(const f32x4*)(c1 + col + 4 * n)) * bb + *(const f32x4*)(c2 + col + 4 * n);
          if (SECT < 0) { u32x4 w; w[0] = pk2(v[0][0], v[0][1]); w[1] = pk2(v[0][2], v[0][3]); w[2] = pk2(v[1][0], v[1][1]); w[3] = pk2(v[1][2], v[1][3]); *(u32x4*)(h + (size_t)row * ld + col) = w; }
          else {
            const int cc = col & 1023; const size_t off = (size_t)row * 1024 + cc;
            if (SECT == 0 || SECT == 3) { u32x4 w;
#pragma unroll
              for (int n = 0; n < 2; ++n) { w[2 * n] = pk2(v[n][0] * sigmoidf_(v[n][0]), v[n][1] * sigmoidf_(v[n][1])); w[2 * n + 1] = pk2(v[n][2] * sigmoidf_(v[n][2]), v[n][3] * sigmoidf_(v[n][3])); }
              *(u32x4*)((SECT == 0 ? hq : hg) + off) = w; }
            else if (SECT == 1) {
              typedef _Float16 h8 __attribute__((ext_vector_type(8))); h8 lf; u32x4 w;
#pragma unroll
              for (int n = 0; n < 2; ++n) { const f32x4 lb = *(const f32x4*)(lbv + cc + 4 * n); float kk[4];
#pragma unroll
                for (int j = 0; j < 4; ++j) { kk[j] = (1.0f - lb[j]) * __builtin_amdgcn_rcpf(1.0f + __builtin_amdgcn_exp2f(1.4426950408889634f * v[n][j])); lf[4 * n + j] = (_Float16)__logf(1.0f - kk[j]); }
                w[2 * n] = pk2(kk[0], kk[1]); w[2 * n + 1] = pk2(kk[2], kk[3]); }
              *(u32x4*)(hk + off) = w; *(h8*)(hlf + off) = lf;
            }
            else { u32x4 w; w[0] = pk2(v[0][0], v[0][1]); w[1] = pk2(v[0][2], v[0][3]); w[2] = pk2(v[1][0], v[1][1]); w[3] = pk2(v[1][2], v[1][3]); *(u32x4*)(hv + off) = w; }
          }
        }
        asm volatile("" ::: "memory");
      }
  }
  DI void operator()(const f32x4 (&acc)[2][2][4][2], const pg8::Unit& u, int wr, int wc, int fr, int fq) const {
    if (mode == 0) body<-1>(acc, u, wr, wc, fr, fq);
    else { const int sect = u.pn >> 2;
      if (sect == 0) body<0>(acc, u, wr, wc, fr, fq); else if (sect == 1) body<1>(acc, u, wr, wc, fr, fq); else if (sect == 2) body<2>(acc, u, wr, wc, fr, fq); else body<3>(acc, u, wr, wc, fr, fq); }
  }
};

DI void conv_strip(int wv, LAS unsigned char* lds, const float* src, int ldn, int K, int n0, int nvalid, bf16_t* dst, int dstrow0, const float* g, const float* b, float* c1, float* c2, bool perm = true) {
  LAS bf16_t* tile = (LAS bf16_t*)lds;
  LAS float* red = (LAS float*)(lds + 64 * 72 * 2);
  int tid_ = wv * 64 + lane_id_(); asm volatile("" : "+v"(tid_)); const int tid = tid_, kr = tid >> 4, nc = (tid & 15) * 4;
  const bool colok = (n0 + nc) < nvalid;
  float s1[4] = {0.f, 0.f, 0.f, 0.f}, s2[4] = {0.f, 0.f, 0.f, 0.f};
  f32x4 w[2];
#pragma unroll
  for (int rr = 0; rr < 2; ++rr) w[rr] = colok ? *(const f32x4*)(src + (size_t)(kr + rr * 32) * ldn + n0 + nc) : (f32x4){0.f, 0.f, 0.f, 0.f};
  for (int k0 = 0; k0 < K; k0 += 64) {
    lds_barrier();
#pragma unroll
    for (int rr = 0; rr < 2; ++rr) { const int k = k0 + kr + rr * 32; const float gk = g ? g[k] : 1.0f, bk = b ? b[k] : 0.0f;
#pragma unroll
      for (int j = 0; j < 4; ++j) { const bf16_t v = f2bf(w[rr][j] * gk); tile[(nc + j) * 72 + kr + rr * 32] = v; s1[j] += bf2f(v); s2[j] += bk * w[rr][j]; } }
    if (k0 + 64 < K) {
#pragma unroll
      for (int rr = 0; rr < 2; ++rr) w[rr] = colok ? *(const f32x4*)(src + (size_t)(k0 + 64 + kr + rr * 32) * ldn + n0 + nc) : (f32x4){0.f, 0.f, 0.f, 0.f};
    }
    lds_barrier();
    { const int n = tid >> 3, kc = (tid & 7) * 8; const int cc = n & 31, slot = (n & 32) + (perm ? 16 * ((cc >> 2) & 1) + 4 * (cc >> 3) + (cc & 3) : cc);
      *(u32x4*)(dst + (size_t)(dstrow0 + slot) * K + k0 + kc) = *(const LAS u32x4*)(tile + n * 72 + kc); }
  }
  if (c1) {
    __syncthreads();
#pragma unroll
    for (int j = 0; j < 4; ++j) { red[kr * 64 + nc + j] = s1[j]; red[2048 + kr * 64 + nc + j] = s2[j]; }
    __syncthreads();
    if (tid < 128) { const int n = tid & 63, which = tid >> 6; float s = 0.f; for (int i = 0; i < 32; ++i) s += red[which * 2048 + i * 64 + n]; (which ? c2 : c1)[dstrow0 + n] = s; }
  }
  __syncthreads();
}

DI void convert_phase(int wv, const P& p_, int L, LAS unsigned char* lds) {
  P p = p_; { size_t z_ = 0; asm volatile("" : "+s"(z_)); p.ws = p_.ws + z_; }
  const int kind = L % 3, slot = L / 3;
  const int nin = kind == 0 ? 44 : (kind == 1 ? 64 : 20);
  const int njobs = 208 + nin + 16 + (kind == 0 ? 6 : 0);
  unsigned char* ws = p.ws;
  for (int j = blockIdx.x; j < njobs; j += gridDim.x) {
    if (j < 208) {
      const int f = j / 104, jj = j % 104;
      const float* lg = p.ln_gain + (size_t)(L * 3 + (f == 0 ? -1 : 1)) * DM; const float* lbias = p.ln_bias + (size_t)(L * 3 + (f == 0 ? -1 : 1)) * DM;
      const bool fold = !(L == 0 && f == 0);
      float* cbase = (float*)(ws + (f == 0 ? C_GU1 : C_GU2));
      if (jj < 88) {
        const int up = jj / 44, s = jj % 44, n0 = s * 64;
        const float* src = (f == 0 ? (up ? p.f1u : p.f1g) : (up ? p.f2u : p.f2g)) + (size_t)L * DM * DFF;
        conv_strip(wv, lds, src, DFF, DM, n0, DFF, (bf16_t*)(ws + (f == 0 ? W_GU1 : W_GU2)), (n0 >> 7) * 256 + (n0 & 127) + up * 128, fold ? lg : nullptr, fold ? lbias : nullptr, cbase, cbase + 5632);
      } else {
        const int s = jj - 88;
        const float* src = (f == 0 ? p.f1d : p.f2d) + (size_t)L * DFF * DM;
        conv_strip(wv, lds, src, DM, DFF, s * 64, DM, (bf16_t*)(ws + (f == 0 ? W_D1 : W_D2)), s * 64, nullptr, nullptr, nullptr, nullptr);
      }
    } else if (j < 208 + nin) {
      const int s = j - 208; const float* lg = p.ln_gain + (size_t)(L * 3) * DM; const float* lbias = p.ln_bias + (size_t)(L * 3) * DM;
      const float* src = kind == 0 ? p.nsa_win + (size_t)slot * DM * 2608 : (kind == 1 ? p.hg_win + (size_t)slot * DM * 4096 : p.swa_win + (size_t)slot * DM * 1280);
      const int ldn = kind == 0 ? 2608 : (kind == 1 ? 4096 : 1280);
      float* cbase = (float*)(ws + C_IN);
      conv_strip(wv, lds, src, ldn, DM, s * 64, ldn, (bf16_t*)(ws + W_IN), s * 64, lg, lbias, cbase, cbase + 4096);
    } else if (j < 208 + nin + 16) {
      const int s = j - 208 - nin;
      const float* src = kind == 0 ? p.nsa_wout + (size_t)slot * DM * DM : (kind == 1 ? p.hg_wout + (size_t)slot * DM * DM : p.swa_wout + (size_t)slot * DM * DM);
      conv_strip(wv, lds, src, DM, DM, s * 64, DM, (bf16_t*)(ws + W_OUT), s * 64, nullptr, nullptr, nullptr, nullptr);
    } else {
      const int s = j - 208 - nin - 16;
      if (s < 4) { const int kv = s >> 1, st = s & 1; float* pb = (float*)(ws + C_POSB) + kv * 256;
        conv_strip(wv, lds, p.nsa_w1 + ((size_t)slot * 2 + kv) * 2048 * 128, 128, 2048, st * 64, 128, (bf16_t*)(ws + W_W1T) + (size_t)kv * 128 * 2048, st * 64, nullptr, p.nsa_pos + ((size_t)slot * 2 + kv) * 2048, pb + 128, pb, false); }
      else { const int kv = s - 4; conv_strip(wv, lds, p.nsa_w2 + ((size_t)slot * 2 + kv) * 128 * 64, 64, 128, 0, 64, (bf16_t*)(ws + W_W2T) + (size_t)kv * 64 * 128, 0, nullptr, nullptr, nullptr, nullptr, false); }
    }
  }
}

DI void init_phase(int wv, const P& p_) {
  P p = p_; { size_t z_ = 0; asm volatile("" : "+s"(z_)); p.ws = p_.ws + z_; }
  int tid_ = wv * 64 + lane_id_(); asm volatile("" : "+v"(tid_)); const size_t gtid = (size_t)blockIdx.x * 512 + tid_, gsz = (size_t)gridDim.x * 512;
  for (size_t i = gtid; i < (4 * MiB) / 16; i += gsz) ((f32x4*)(p.ws + WS_STATS))[i] = (f32x4){0.f, 0.f, 0.f, 0.f};
  for (size_t i = gtid; i < (size_t)MTOK; i += gsz) { ((float*)(p.ws + WS_DSTATS))[2 * i] = 0.f; ((float*)(p.ws + WS_DSTATS))[2 * i + 1] = 1024.0f * (1.0f - 1e-5f); }
  if (gtid < 13 * 1024) { ((float*)(p.ws + WS_G13))[gtid] = gtid < 1024 ? 1.0f : p.ln_gain[gtid - 1024]; ((float*)(p.ws + WS_B13))[gtid] = gtid < 1024 ? 0.0f : p.ln_bias[gtid - 1024]; }
  for (size_t i = gtid; i < (size_t)MTOK * DM / 4; i += gsz) { const f32x4 v = ((const f32x4*)p.x)[i]; u32x2 w; w.x = pk2(v[0], v[1]); w.y = pk2(v[2], v[3]); ((u32x2*)(p.ws + WS_TB))[i] = w; }
  if (gtid < 16 * 132) { const int hd = (int)gtid / 132, d = (int)gtid % 132; int bk;
    if (d < 16) bk = d; else { const float v = logf((float)d / 16.0f) / 2.0794415416798357f * 16.0f; bk = 16 + (int)v; if (bk > 31 || d >= 128) bk = 31; }
    ((float*)(p.ws + C_BTAB))[gtid] = p.rel_bias[bk * 16 + hd]; }
  if (gtid < 1024) { const float a0 = p.hg_lb[gtid], a1 = p.hg_lb[1024 + gtid], a2 = p.hg_lb[2048 + gtid], a3 = p.hg_lb[3072 + gtid];
    const float mx = fmaxf(fmaxf(a0, a1), fmaxf(a2, a3)); const float e0 = expf(a0 - mx), e1 = expf(a1 - mx), e2 = expf(a2 - mx), e3 = expf(a3 - mx);
    ((float*)(p.ws + C_LBV))[gtid] = e1 / (e0 + e1 + e2 + e3); }
}

DI void final_ln(int wv, const P& p_, const float* stats, const float* g, const float* b) {
  P p = p_; { size_t z_ = 0; asm volatile("" : "+s"(z_)); p.ws = p_.ws + z_; }
  int tid_ = wv * 64 + lane_id_(); asm volatile("" : "+v"(tid_)); const size_t gtid = (size_t)blockIdx.x * 512 + tid_, gsz = (size_t)gridDim.x * 512;
  for (size_t i = gtid; i < (size_t)MTOK * DM / 4; i += gsz) {
    const int row = (int)(i >> 8), c = (int)(i & 255) * 4; float a, bb, mu, rstd; row_affine(stats, row, a, bb, mu, rstd);
    const f32x4 v = ((const f32x4*)p.out)[i]; ((f32x4*)p.out)[i] = (v - mu) * rstd * (*(const f32x4*)(g + c)) + *(const f32x4*)(b + c);
  }
}
#define MFMA32(a, b, c) __builtin_amdgcn_mfma_f32_32x32x16_bf16((a), (b), (c), 0, 0, 0)
#define MFMA16(a, b, c) __builtin_amdgcn_mfma_f32_16x16x32_bf16((a), (b), (c), 0, 0, 0)
DI int crow(int reg, int h) { return (reg & 3) + 8 * (reg >> 2) + 4 * h; }
constexpr int KS_STRIDE = 72;

struct KVRegs { u32x4 k; bf16x8 v; };
DI void kv_load(KVRegs& r, const bf16_t* kg, const bf16_t* vg, size_t ldg, int tid) {
  asm volatile("" : "+v"(tid));
  const int key = tid >> 3, d8 = (tid & 7) * 8;
  r.k = *(const u32x4*)(kg + (size_t)key * ldg + d8); r.v = *(const bf16x8*)(vg + (size_t)key * ldg + d8);
}
DI void kv_store(const KVRegs& r, LAS bf16_t* Ks, LAS bf16_t* Vt, int vstride, int vcol0, int tid) {
  asm volatile("" : "+v"(tid));
  const int key = tid >> 3, d8 = (tid & 7) * 8;
  *(LAS u32x4*)(Ks + key * KS_STRIDE + d8) = r.k;
  const u32x4 vd = __builtin_bit_cast(u32x4, r.v);
  const bool odd = key & 1;
  const unsigned s0 = odd ? vd[0] : vd[2], s1 = odd ? vd[1] : vd[3];
  const unsigned x0 = (unsigned)__builtin_amdgcn_update_dpp(0, (int)s0, 0x128, 0xf, 0xf, false), x1 = (unsigned)__builtin_amdgcn_update_dpp(0, (int)s1, 0x128, 0xf, 0xf, false);
  const unsigned m0 = odd ? vd[2] : vd[0], m1 = odd ? vd[3] : vd[1];
  const unsigned lo0 = odd ? x0 : m0, hi0 = odd ? m0 : x0, lo1 = odd ? x1 : m1, hi1 = odd ? m1 : x1;
  LAS unsigned* vp = (LAS unsigned*)(Vt + (d8 + (odd ? 4 : 0)) * vstride + vcol0 + (key & ~1));
  const int rs = vstride >> 1;
  vp[0] = (lo0 & 0xffffu) | (hi0 << 16); vp[rs] = (lo0 >> 16) | (hi0 & 0xffff0000u);
  vp[2 * rs] = (lo1 & 0xffffu) | (hi1 << 16); vp[3 * rs] = (lo1 >> 16) | (hi1 & 0xffff0000u);
}
DI void attn_scores(const LAS bf16_t* Ks, const bf16x8 (&qf)[4], int r, int h, f32x16 (&s)[2]) {
#pragma unroll
  for (int sub = 0; sub < 2; ++sub) {
    f32x16 a;
#pragma unroll
    for (int i = 0; i < 16; ++i) a[i] = 0.f;
#pragma unroll
    for (int ks = 0; ks < 4; ++ks) { const bf16x8 kf = *(const LAS bf16x8*)(Ks + (sub * 32 + r) * KS_STRIDE + ks * 16 + 8 * h); a = MFMA32(kf, qf[ks], a); }
    s[sub] = a;
  }
}
constexpr float QK_SCALE2 = 0.125f * 1.4426950408889634f;
DI void attn_logits(f32x16 (&s)[2], int t, int tw, int nt, int h, int base, int stride, int dmax, bool ok, const LAS float* btl) {
  const int dmin = tw - (base + 63 * stride), dmaxw = tw + nt - 1 - base;
  const bool far = dmin >= 128, interior = dmin >= 0 && dmaxw < dmax;
  const float bfar = btl[128];
  if (far && interior) {
#pragma unroll
    for (int sub = 0; sub < 2; ++sub)
#pragma unroll
      for (int reg = 0; reg < 16; ++reg) s[sub][reg] = ok ? s[sub][reg] * QK_SCALE2 + bfar : -1e30f;
  } else if (far) {
#pragma unroll
    for (int sub = 0; sub < 2; ++sub)
#pragma unroll
      for (int reg = 0; reg < 16; ++reg) {
        const int kk = sub * 32 + crow(reg, h); const int d = t - (base + kk * stride);
        const bool valid = (d >= 0) && (d < dmax) && ok;
        s[sub][reg] = valid ? s[sub][reg] * QK_SCALE2 + bfar : -1e30f;
      }
  } else {
#pragma unroll
    for (int sub = 0; sub < 2; ++sub)
#pragma unroll
      for (int reg = 0; reg < 16; ++reg) {
        const int kk = sub * 32 + crow(reg, h); const int d = t - (base + kk * stride);
        const bool valid = (d >= 0) && (d < dmax) && ok;
        const int di = d < 0 ? 0 : (d > 128 ? 128 : d);
        const float bsv = btl[di];
        const float x = s[sub][reg] * QK_SCALE2 + bsv;
        s[sub][reg] = valid ? x : -1e30f;
      }
  }
}
DI void attn_pv(const LAS bf16_t* Vt, int vstride, const f32x16 (&p)[2], f32x16 (&O)[2], int r, int h) {
#pragma unroll
  for (int sub = 0; sub < 2; ++sub)
#pragma unroll
    for (int s2 = 0; s2 < 2; ++s2) {
      u32x4 pp;
#pragma unroll
      for (int j = 0; j < 4; ++j) pp[j] = pk2(p[sub][8 * s2 + 2 * j], p[sub][8 * s2 + 2 * j + 1]);
      const bf16x8 pf = __builtin_bit_cast(bf16x8, pp);
#pragma unroll
      for (int dt = 0; dt < 2; ++dt) {
        const LAS bf16_t* vp = Vt + (dt * 32 + r) * vstride + sub * 32 + 16 * s2 + 4 * h;
        const s16x4 lo = *(const LAS s16x4*)vp, hi = *(const LAS s16x4*)(vp + 8);
        const bf16x8 vf = __builtin_shufflevector(lo, hi, 0, 1, 2, 3, 4, 5, 6, 7);
        O[dt] = MFMA32(vf, pf, O[dt]);
      }
    }
}
template <bool WITH_O>
DI void attn_online(f32x16 (&s)[2], float& m, float& l, f32x16 (&O)[2]) {
  float mx = -1e30f;
#pragma unroll
  for (int sub = 0; sub < 2; ++sub)
#pragma unroll
    for (int reg = 0; reg < 16; ++reg) mx = fmaxf(mx, s[sub][reg]);
  mx = fmaxf(mx, __shfl_xor(mx, 32));
  const float mn = fmaxf(m, mx);
  const bool grow = mn > m;
  float ls = 0.f;
#pragma unroll
  for (int sub = 0; sub < 2; ++sub)
#pragma unroll
    for (int reg = 0; reg < 16; ++reg) { const float e = __builtin_amdgcn_exp2f(s[sub][reg] - mn); s[sub][reg] = e; ls += e; }
  if (__any(grow)) {
    const float al = __builtin_amdgcn_exp2f(m - mn); m = mn;
    l = l * al + ls;
    if (WITH_O) {
#pragma unroll
      for (int dt = 0; dt < 2; ++dt)
#pragma unroll
        for (int reg = 0; reg < 16; ++reg) O[dt][reg] *= al;
    }
  } else l += ls;
}
DI void attn_tile(const LAS bf16_t* Ks, const LAS bf16_t* Vt, int vstride, const bf16x8 (&qf)[4], f32x16 (&O)[2], float& m, float& l,
                  int t, int tw, int nt, int r, int h, int base, int stride, int dmax, bool ok, const LAS float* btl) {
  f32x16 s[2];
  attn_scores(Ks, qf, r, h, s);
  const int dmin = tw - (base + 63 * stride), dmaxw = tw + nt - 1 - base;
  float mn, ls = 0.f;
  if (dmin >= 128 && dmaxw < dmax) {
    const float cl = ok ? QK_SCALE2 : 0.f, bl = ok ? btl[128] : -1e30f;
    float mr = -3e38f;
#pragma unroll
    for (int sub = 0; sub < 2; ++sub)
#pragma unroll
      for (int reg = 0; reg < 16; ++reg) mr = fmaxf(mr, s[sub][reg]);
    float mx = mr * cl + bl; mx = fmaxf(mx, __shfl_xor(mx, 32));
    mn = fmaxf(m, mx);
    const float off = bl - mn;
#pragma unroll
    for (int sub = 0; sub < 2; ++sub)
#pragma unroll
      for (int reg = 0; reg < 16; ++reg) { const float e = __builtin_amdgcn_exp2f(s[sub][reg] * cl + off); s[sub][reg] = e; ls += e; }
  } else {
    attn_logits(s, t, tw, nt, h, base, stride, dmax, ok, btl);
    float mx = -1e30f;
#pragma unroll
    for (int sub = 0; sub < 2; ++sub)
#pragma unroll
      for (int reg = 0; reg < 16; ++reg) mx = fmaxf(mx, s[sub][reg]);
    mx = fmaxf(mx, __shfl_xor(mx, 32));
    mn = fmaxf(m, mx);
#pragma unroll
    for (int sub = 0; sub < 2; ++sub)
#pragma unroll
      for (int reg = 0; reg < 16; ++reg) { const float e = __builtin_amdgcn_exp2f(s[sub][reg] - mn); s[sub][reg] = e; ls += e; }
  }
  if (__any(mn > m)) {
    const float al = __builtin_amdgcn_exp2f(m - mn); m = mn;
    l = l * al + ls;
#pragma unroll
    for (int dt = 0; dt < 2; ++dt)
#pragma unroll
      for (int reg = 0; reg < 16; ++reg) O[dt][reg] *= al;
  } else l += ls;
  attn_pv(Vt, vstride, s, O, r, h);
}
DI void zero_o(f32x16 (&O)[2]) {
#pragma unroll
  for (int dt = 0; dt < 2; ++dt)
#pragma unroll
    for (int reg = 0; reg < 16; ++reg) O[dt][reg] = 0.f;
}

DI void nsa_compress_phase(int wv, const P& p_, LAS unsigned char* lds) {
  P p = p_; { size_t z_ = 0; asm volatile("" : "+s"(z_)); p.ws = p_.ws + z_; }
  const bf16_t* hb = (const bf16_t*)(p.ws + WS_BIG); const int ld = 2816;
  int tid_ = wv * 64 + lane_id_(); asm volatile("" : "+v"(tid_)); const int tid = tid_, wid = wv, lane = tid & 63, fr = lane & 15, fq = lane >> 4;
  const int pw = wid & 3, half = wid >> 2;
  LAS bf16_t* hid = (LAS bf16_t*)lds + pw * 16 * 136;
  LAS f32x4* part = (LAS f32x4*)(lds + 32768) + pw * 8 * 64;
  for (int base = blockIdx.x * 4; base < 1024; base += gridDim.x * 4) {
    const int task = base + pw;
    const int kv = task >> 9, b = (task >> 6) & 7, g = (task >> 4) & 3, n0 = (task & 15) * 16;
    const bf16_t* w1t = (const bf16_t*)(p.ws + W_W1T) + (size_t)kv * 128 * 2048; const bf16_t* w2t = (const bf16_t*)(p.ws + W_W2T) + (size_t)kv * 64 * 128;
    const float* posb = (const float*)(p.ws + C_POSB) + kv * 256;
    const int colb = 1024 + kv * 256 + g * 64;
    int n = n0 + fr; if (n > 254) n = 254;
    f32x4 acc[8];
#pragma unroll
    for (int i = 0; i < 8; ++i) acc[i] = (f32x4){0.f, 0.f, 0.f, 0.f};
#pragma unroll 2
    for (int l = 16 * half; l < 16 * half + 16; ++l) {
#pragma unroll
      for (int dk = 0; dk < 2; ++dk) {
        const bf16x8 af = *(const bf16x8*)(hb + (size_t)(b * SEQ + 16 * n + l) * ld + colb + dk * 32 + fq * 8);
#pragma unroll
        for (int nt = 0; nt < 8; ++nt) { const bf16x8 bfr = *(const bf16x8*)(w1t + (size_t)(nt * 16 + fr) * 2048 + l * 64 + dk * 32 + fq * 8); acc[nt] = MFMA16(af, bfr, acc[nt]); }
      }
    }
    if (half) {
#pragma unroll
      for (int nt = 0; nt < 8; ++nt) part[nt * 64 + lane] = acc[nt];
    }
    __syncthreads();
    if (!half) {
#pragma unroll
      for (int nt = 0; nt < 8; ++nt) { const float pbv = posb[nt * 16 + fr]; const f32x4 o2 = part[nt * 64 + lane];
#pragma unroll
        for (int j = 0; j < 4; ++j) { const float v = acc[nt][j] + o2[j] + pbv; const float u = 0.7978845608028654f * (v + 0.044715f * v * v * v); const float th = 1.0f - 2.0f * __builtin_amdgcn_rcpf(1.0f + __expf(2.0f * u));
          hid[(4 * fq + j) * 136 + nt * 16 + fr] = f2bf(0.5f * v * (1.0f + th)); } }
    }
    __syncthreads();
    if (!half) {
      f32x4 o[4];
#pragma unroll
      for (int i = 0; i < 4; ++i) o[i] = (f32x4){0.f, 0.f, 0.f, 0.f};
#pragma unroll
      for (int ks = 0; ks < 4; ++ks) { const bf16x8 af = *(const LAS bf16x8*)(hid + fr * 136 + ks * 32 + fq * 8);
#pragma unroll
        for (int nt = 0; nt < 4; ++nt) { const bf16x8 bfr = *(const bf16x8*)(w2t + (size_t)(nt * 16 + fr) * 128 + ks * 32 + fq * 8); o[nt] = MFMA16(af, bfr, o[nt]); } }
      bf16_t* dst = (bf16_t*)(p.ws + (kv ? WS_VC : WS_KC)) + (size_t)((b * 4 + g) * 256) * 64;
#pragma unroll
      for (int nt = 0; nt < 4; ++nt)
#pragma unroll
        for (int j = 0; j < 4; ++j) { const int nn = n0 + 4 * fq + j; dst[(size_t)nn * 64 + nt * 16 + fr] = nn > 254 ? (bf16_t)0 : f2bf(o[nt][j]); }
    }
    __syncthreads();
  }
}

DI void nsa_attn_phase(int wv, const P& p_, LAS unsigned char* lds) {
  P p = p_; { size_t z_ = 0; asm volatile("" : "+s"(z_)); p.ws = p_.ws + z_; }
  const bf16_t* hb = (const bf16_t*)(p.ws + WS_BIG); const int ld = 2816;
  bf16_t* ob = (bf16_t*)(p.ws + WS_O);
  LAS bf16_t* KsB[2] = {(LAS bf16_t*)lds, (LAS bf16_t*)(lds + 17920)}; LAS bf16_t* VtB[2] = {(LAS bf16_t*)(lds + 9216), (LAS bf16_t*)(lds + 17920 + 9216)};
  LAS bf16_t* KC = (LAS bf16_t*)(lds + 35840); LAS bf16_t* VCT = (LAS bf16_t*)(lds + 72704);
  LAS float* OUTL = (LAS float*)(lds + 35840);
  LAS float* G4s = (LAS float*)(lds + 105984); LAS float* Lsm = (LAS float*)(lds + 122368); LAS float* BT = (LAS float*)(lds + 138752);
  LAS unsigned* SELM = (LAS unsigned*)(lds + 140864); LAS unsigned* UNI = (LAS unsigned*)(lds + 141376);
  for (int it = blockIdx.x; it < 2048; it += gridDim.x) {
    int tid_ = wv * 64 + lane_id_(); asm volatile("" : "+v"(tid_)); const int tid = tid_, wid = wv, lane = tid & 63, r = lane & 31, h = lane >> 5, tl = r >> 2, hd = r & 3;
    const int c = it & 255, ii = it >> 8, bg = c >> 3, b = bg >> 2, g = bg & 3, j8 = c & 7;
    const int qi = (ii & 1) ? (16 * (ii >> 1) + 15 - j8) : (16 * (ii >> 1) + j8);
    const int t0 = 64 * qi, tw = t0 + 8 * wid, t = tw + tl, head = g * 4 + hd;
    const int nct = (4 * qi + 2) / 64 + 1;
    __syncthreads();
    { KVRegs ka, kb; const bf16_t* kcg = (const bf16_t*)(p.ws + WS_KC) + (size_t)((b * 4 + g) * 256) * 64; const bf16_t* vcg = (const bf16_t*)(p.ws + WS_VC) + (size_t)((b * 4 + g) * 256) * 64;
      kv_load(ka, kcg, vcg, 64, tid); if (nct > 1) kv_load(kb, kcg + 64 * 64, vcg + 64 * 64, 64, tid);
      kv_store(ka, KC, VCT, 260, 0, tid); if (nct > 1) kv_store(kb, KC + 64 * KS_STRIDE, VCT, 260, 64, tid);
      if (nct > 2) { kv_load(ka, kcg + 128 * 64, vcg + 128 * 64, 64, tid); if (nct > 3) kv_load(kb, kcg + 192 * 64, vcg + 192 * 64, 64, tid);
        kv_store(ka, KC + 128 * KS_STRIDE, VCT, 260, 128, tid); if (nct > 3) kv_store(kb, KC + 192 * KS_STRIDE, VCT, 260, 192, tid); } }
    for (int i = tid; i < 4 * 132; i += 512) BT[i] = ((const float*)(p.ws + C_BTAB))[g * 4 * 132 + i] * 1.4426950408889634f;
    if (tid < 128) SELM[tid] = 0u; if (tid < 2) UNI[tid] = 0u;
    bf16x8 qf[4];
#pragma unroll
    for (int ks = 0; ks < 4; ++ks) qf[ks] = *(const bf16x8*)(hb + (size_t)(b * SEQ + t) * ld + head * 64 + ks * 16 + 8 * h);
    const size_t rowoff = (size_t)(b * SEQ + t) * ld;
    const float gc = sigmoidf_(bf2f(hb[rowoff + 2560 + head * 3 + 0])), gs = sigmoidf_(bf2f(hb[rowoff + 2560 + head * 3 + 1])), gw = sigmoidf_(bf2f(hb[rowoff + 2560 + head * 3 + 2]));
    const LAS float* btl = BT + hd * 132;
    KVRegs kvr; { const size_t go = (size_t)(b * SEQ) * ld + g * 64; kv_load(kvr, hb + go + 1536, hb + go + 1792, ld, tid); }
    __syncthreads();
    f32x16 O[2];
    float m = -1e30f, l = 0.f;
#pragma unroll 1
    for (int tile = 0; tile < nct; ++tile) { f32x16 s[2]; attn_scores(KC + tile * 64 * KS_STRIDE, qf, r, h, s); attn_logits(s, t, tw, 8, h, 16 * (tile * 64) + 31, 16, 0x7fffffff, true, btl); attn_online<false>(s, m, l, O); }
    { const float lt = l + __shfl_xor(l, 32); const float inv = (m > -1e29f && lt > 0.f) ? 1.0f / lt : 0.f;
      zero_o(O);
#pragma unroll 1
      for (int tile = 0; tile < nct; ++tile) {
        f32x16 s[2]; attn_scores(KC + tile * 64 * KS_STRIDE, qf, r, h, s); attn_logits(s, t, tw, 8, h, 16 * (tile * 64) + 31, 16, 0x7fffffff, true, btl);
        LAS float* gp = G4s + (8 * wid + tl) * 64 + 16 * tile + h; asm volatile("" : "+v"(gp));
#pragma unroll
        for (int sub = 0; sub < 2; ++sub) {
#pragma unroll
          for (int reg = 0; reg < 16; ++reg) { const float v = s[sub][reg]; s[sub][reg] = v > -1e29f ? __builtin_amdgcn_exp2f(v - m) * inv : 0.f; }
#pragma unroll
          for (int lg = 0; lg < 4; ++lg) { float G = s[sub][4 * lg] + s[sub][4 * lg + 1] + s[sub][4 * lg + 2] + s[sub][4 * lg + 3], Lv = s[sub][4 * lg + 3];
            G += __shfl_xor(G, 1); G += __shfl_xor(G, 2); Lv += __shfl_xor(Lv, 1); Lv += __shfl_xor(Lv, 2);
            if (hd == 0) { gp[8 * sub + 2 * lg] = G; gp[4096 + 8 * sub + 2 * lg] = Lv; } }
        }
        attn_pv(VCT + tile * 64, 260, s, O, r, h);
      }
    }
    __syncthreads();
#pragma unroll
    for (int dt = 0; dt < 2; ++dt)
#pragma unroll
      for (int reg = 0; reg < 16; ++reg) OUTL[(dt * 16 + reg) * 512 + tid] = gc * O[dt][reg];
    if (qi < 16) { const unsigned long long full = (qi == 63) ? ~0ull : ((1ull << (qi + 1)) - 1ull);
      int tsel = tid; asm volatile("" : "+v"(tsel));
      if (tsel < 64) { SELM[2 * tsel] = (unsigned)full; SELM[2 * tsel + 1] = (unsigned)(full >> 32); } if (tsel == 0) { UNI[0] = (unsigned)full; UNI[1] = (unsigned)(full >> 32); } }
    else {
      int tsel = tid; asm volatile("" : "+v"(tsel));
      const int tok = tsel >> 3, jj = tsel & 7, hiJ = qi - 2;
#pragma unroll
      for (int e = 0; e < 8; ++e) { const int j = jj * 8 + e; if (j >= 1 && j <= hiJ) G4s[tok * 64 + j] += Lsm[tok * 64 + j - 1]; }
      __syncthreads();
      float mine[8]; int cnt[8];
#pragma unroll
      for (int e = 0; e < 8; ++e) { const int j = jj * 8 + e; mine[e] = (j >= 1 && j <= hiJ) ? G4s[tok * 64 + j] : 0.f; cnt[e] = 0; }
      for (int j2 = 1; j2 <= hiJ; ++j2) { const float v = G4s[tok * 64 + j2];
#pragma unroll
        for (int e = 0; e < 8; ++e) { const int j = jj * 8 + e; cnt[e] += (v > mine[e] || (v == mine[e] && j2 < j)) ? 1 : 0; } }
      unsigned long long bits = 0ull;
#pragma unroll
      for (int e = 0; e < 8; ++e) { const int j = jj * 8 + e; if (j >= 1 && j <= hiJ && cnt[e] < 13) bits |= 1ull << j; }
      if (jj == 0) bits |= 1ull | (1ull << qi) | (1ull << (qi - 1));
      const unsigned blo = (unsigned)bits, bhi = (unsigned)(bits >> 32);
      if (blo) { atomicOr((unsigned*)&SELM[2 * tok], blo); atomicOr((unsigned*)&UNI[0], blo); }
      if (bhi) { atomicOr((unsigned*)&SELM[2 * tok + 1], bhi); atomicOr((unsigned*)&UNI[1], bhi); }
    }
    __syncthreads();
    int buf = 0;
    { const unsigned long long selm = (unsigned long long)SELM[2 * (8 * wid + tl)] | ((unsigned long long)SELM[2 * (8 * wid + tl) + 1] << 32);
      unsigned long long rem = (unsigned long long)UNI[0] | ((unsigned long long)UNI[1] << 32);
      m = -1e30f; l = 0.f; zero_o(O);
      const int jw0 = qi > 8 ? qi - 8 : 0;
#pragma unroll 1
      while (rem) {
        const int j = __builtin_ctzll(rem); rem &= rem - 1ull;
        kv_store(kvr, KsB[buf], VtB[buf], 68, 0, tid);
        __syncthreads();
        { const bool more = rem != 0ull; const int jn = more ? __builtin_ctzll(rem) : jw0;
          const size_t go = (size_t)(b * SEQ + jn * 64) * ld + g * 64; kv_load(kvr, hb + go + (more ? 1536 : 2048), hb + go + (more ? 1792 : 2304), ld, tid); }
        attn_tile(KsB[buf], VtB[buf], 68, qf, O, m, l, t, tw, 8, r, h, j * 64, 1, 0x7fffffff, ((selm >> j) & 1ull) != 0ull, btl);
        buf ^= 1;
      }
      const float lt = l + __shfl_xor(l, 32); const float sc = lt > 0.f ? gs / lt : 0.f;
#pragma unroll
      for (int dt = 0; dt < 2; ++dt)
#pragma unroll
        for (int reg = 0; reg < 16; ++reg) OUTL[(dt * 16 + reg) * 512 + tid] += sc * O[dt][reg];
    }
    { m = -1e30f; l = 0.f; zero_o(O);
#pragma unroll 1
      for (int j = (qi > 8 ? qi - 8 : 0); j <= qi; ++j) {
        kv_store(kvr, KsB[buf], VtB[buf], 68, 0, tid);
        __syncthreads();
        if (j < qi) { const size_t go = (size_t)(b * SEQ + (j + 1) * 64) * ld + g * 64; kv_load(kvr, hb + go + 2048, hb + go + 2304, ld, tid); }
        attn_tile(KsB[buf], VtB[buf], 68, qf, O, m, l, t, tw, 8, r, h, j * 64, 1, 512, true, btl);
        buf ^= 1;
      }
      const float lt = l + __shfl_xor(l, 32); const float sc = lt > 0.f ? gw / lt : 0.f;
#pragma unroll
      for (int dt = 0; dt < 2; ++dt)
#pragma unroll
        for (int reg = 0; reg < 16; ++reg) O[dt][reg] = OUTL[(dt * 16 + reg) * 512 + tid] + sc * O[dt][reg];
    }
    bf16_t* op = ob + (size_t)(b * SEQ + t) * DM + head * 64;
#pragma unroll
    for (int dt = 0; dt < 2; ++dt)
#pragma unroll
      for (int i4 = 0; i4 < 4; ++i4) { u32x2 w; w.x = pk2(O[dt][4 * i4], O[dt][4 * i4 + 1]); w.y = pk2(O[dt][4 * i4 + 2], O[dt][4 * i4 + 3]); *(u32x2*)(op + dt * 32 + 8 * i4 + 4 * h) = w; }
  }
}

DI void swa_attn_phase(int wv, const P& p_, int slot, LAS unsigned char* lds) {
  P p = p_; { size_t z_ = 0; asm volatile("" : "+s"(z_)); p.ws = p_.ws + z_; }
  const bf16_t* hb = (const bf16_t*)(p.ws + WS_BIG); const int ld = 1280;
  bf16_t* ob = (bf16_t*)(p.ws + WS_O);
  LAS bf16_t* KsB[2] = {(LAS bf16_t*)lds, (LAS bf16_t*)(lds + 17920)}; LAS bf16_t* VtB[2] = {(LAS bf16_t*)(lds + 9216), (LAS bf16_t*)(lds + 17920 + 9216)};
  LAS float* BT = (LAS float*)(lds + 35840);
  int tid_ = wv * 64 + lane_id_(); asm volatile("" : "+v"(tid_)); const int tid = tid_, wid = tid >> 6, lane = tid & 63, r = lane & 31, h = lane >> 5, tl = r >> 3, hd = r & 7;
  int buf = 0;
  for (int it = blockIdx.x; it < 2048; it += gridDim.x) {
    const int b = it >> 8, kv = (it >> 7) & 1, t0 = (it & 127) * 32;
    const int tw = t0 + 4 * wid, t = tw + tl, head = kv * 8 + hd;
    const int lo = t0 - 127, first = lo <= 0 ? 0 : (lo >> 6), last = (t0 + 31) >> 6;
    KVRegs kvr; { const size_t go = (size_t)(b * SEQ + first * 64) * ld + kv * 64; kv_load(kvr, hb + go + 1024, hb + go + 1152, ld, tid); }
    __syncthreads();
    for (int i = tid; i < 8 * 132; i += 512) BT[i] = ((const float*)(p.ws + C_BTAB))[kv * 8 * 132 + i] * 1.4426950408889634f;
    const size_t rowoff = (size_t)(b * SEQ + t) * ld;
    bf16x8 qf[4];
#pragma unroll
    for (int ks = 0; ks < 4; ++ks) qf[ks] = *(const bf16x8*)(hb + rowoff + head * 64 + ks * 16 + 8 * h);
    const LAS float* btl = BT + hd * 132;
    float m = p.swa_sinks[slot * 16 + head] * 1.4426950408889634f, l = (h == 0) ? 1.0f : 0.0f;
    f32x16 O[2]; zero_o(O);
#pragma unroll 1
    for (int j = first; j <= last; ++j) {
      kv_store(kvr, KsB[buf], VtB[buf], 68, 0, tid);
      __syncthreads();
      if (j < last) { const size_t go = (size_t)(b * SEQ + (j + 1) * 64) * ld + kv * 64; kv_load(kvr, hb + go + 1024, hb + go + 1152, ld, tid); }
      attn_tile(KsB[buf], VtB[buf], 68, qf, O, m, l, t, tw, 4, r, h, j * 64, 1, 128, true, btl);
      buf ^= 1;
    }
    const float lt = l + __shfl_xor(l, 32); const float sc = 1.0f / lt;
    bf16_t* op = ob + (size_t)(b * SEQ + t) * DM + head * 64;
#pragma unroll
    for (int dt = 0; dt < 2; ++dt)
#pragma unroll
      for (int i4 = 0; i4 < 4; ++i4) { u32x2 w; w.x = pk2(sc * O[dt][4 * i4], sc * O[dt][4 * i4 + 1]); w.y = pk2(sc * O[dt][4 * i4 + 2], sc * O[dt][4 * i4 + 3]); *(u32x2*)(op + dt * 32 + 8 * i4 + 4 * h) = w; }
  }
}
constexpr size_t HG_Q = WS_BIG, HG_K = WS_BIG + 64 * MiB, HG_V = WS_BIG + 128 * MiB, HG_G = WS_BIG + 192 * MiB, HG_LF = WS_BIG + 256 * MiB;
DI void hgrn_scan_phase(int wv, const P& p_, LAS unsigned char* lds, float* sumsq) {
  P p = p_; { size_t z_ = 0; asm volatile("" : "+s"(z_)); p.ws = p_.ws + z_; }
  const bf16_t* hq = (const bf16_t*)(p.ws + HG_Q); const bf16_t* hk = (const bf16_t*)(p.ws + HG_K); const bf16_t* hv = (const bf16_t*)(p.ws + HG_V);
  const _Float16* hlf = (const _Float16*)(p.ws + HG_LF);
  bf16_t* oraw = (bf16_t*)(p.ws + WS_TB);
  LAS bf16_t* Q = (LAS bf16_t*)lds; LAS bf16_t* Kr = (LAS bf16_t*)(lds + 17408); LAS float* BC = (LAS float*)(lds + 34816); LAS bf16_t* KDT = (LAS bf16_t*)(lds + 68608);
  LAS bf16_t* VT = (LAS bf16_t*)(lds + 87040); LAS bf16_t* ST = (LAS bf16_t*)(lds + 91648); LAS bf16_t* AB = (LAS bf16_t*)(lds + 100352);
  LAS float* SEG = (LAS float*)(lds + 109568); LAS float* DEC = (LAS float*)(lds + 111616); LAS _Float16* LF = (LAS _Float16*)(lds + 112128);
  int tid_ = wv * 64 + lane_id_(); asm volatile("" : "+v"(tid_)); const int tid = tid_, wid = tid >> 6, lane = tid & 63, fr = lane & 15, fq = lane >> 4;
  for (int it = blockIdx.x; it < 256; it += gridDim.x) {
    const int b = it >> 5, hh = (it >> 2) & 7, vq = it & 3;
    __syncthreads();
    for (int i = tid; i < 32 * 136 / 2; i += 512) ((LAS unsigned*)ST)[i] = 0u;
    f32x4 sreg[2]; sreg[0] = (f32x4){0.f, 0.f, 0.f, 0.f}; sreg[1] = sreg[0];
    u32x4 pq[2], pkk[2], plf[2], pv;
    const size_t gb = (size_t)(b * SEQ) * 1024 + hh * 128;
    auto prefetch = [&](int c) {
#pragma unroll
      for (int i = 0; i < 2; ++i) { const int idx = tid + 512 * i, row = idx >> 4, c8 = (idx & 15) * 8; const size_t off = gb + (size_t)(c * 64 + row) * 1024 + c8;
        pq[i] = *(const u32x4*)(hq + off); pkk[i] = *(const u32x4*)(hk + off); plf[i] = *(const u32x4*)(hlf + off); }
      if (tid < 256) { const int row = tid >> 2, c8 = (tid & 3) * 8; pv = *(const u32x4*)(hv + gb + (size_t)(c * 64 + row) * 1024 + vq * 32 + c8); }
    };
    prefetch(0);
    for (int c = 0; c < 64; ++c) {
      lds_barrier();
#pragma unroll
      for (int i = 0; i < 2; ++i) { const int idx = tid + 512 * i, row = idx >> 4, c8 = (idx & 15) * 8;
        *(LAS u32x4*)(Q + row * 136 + c8) = pq[i]; *(LAS u32x4*)(Kr + row * 136 + c8) = pkk[i]; *(LAS u32x4*)(LF + row * 128 + c8) = plf[i]; }
      if (tid < 256) { const int row = tid >> 2, c8 = (tid & 3) * 8; const bf16x8 vv = __builtin_bit_cast(bf16x8, pv);
#pragma unroll
        for (int i = 0; i < 8; ++i) VT[(c8 + i) * 72 + row] = (bf16_t)vv[i]; }
      if (c + 1 < 64) prefetch(c + 1);
      lds_barrier();
      const int kx = tid & 127, seg = tid >> 7;
      float bl[16];
      { float run = 0.f;
#pragma unroll
        for (int i = 0; i < 16; ++i) { run += (float)LF[(16 * seg + i) * 128 + kx]; bl[i] = run; }
        SEG[seg * 128 + kx] = run; }
      lds_barrier();
      { float pre = 0.f, blast = 0.f;
#pragma unroll
        for (int s2 = 0; s2 < 4; ++s2) { const float v = SEG[s2 * 128 + kx]; blast += v; if (s2 < seg) pre += v; }
        u32x4 w0, w1; float kd[16];
#pragma unroll
        for (int i = 0; i < 16; ++i) { const float bc = pre + bl[i]; BC[(16 * seg + i) * 132 + kx] = bc; kd[i] = bf2f(Kr[(16 * seg + i) * 136 + kx]) * __expf(blast - bc); }
#pragma unroll
        for (int j = 0; j < 4; ++j) { w0[j] = pk2(kd[2 * j], kd[2 * j + 1]); w1[j] = pk2(kd[8 + 2 * j], kd[8 + 2 * j + 1]); }
        *(LAS u32x4*)(KDT + kx * 72 + 16 * seg) = w0; *(LAS u32x4*)(KDT + kx * 72 + 16 * seg + 8) = w1;
        if (seg == 0) DEC[kx] = __expf(blast); }
      lds_barrier();
      const int mt = wid >> 1, vt = wid & 1;
      f32x4 oacc = (f32x4){0.f, 0.f, 0.f, 0.f}, a0 = oacc, a1 = oacc;
      const int J0 = 2 * vt;
#pragma unroll
      for (int ks = 0; ks < 4; ++ks) {
        const int kb = 32 * ks + 8 * fq, trow = 16 * mt + fr;
        const bf16x8 qv = *(const LAS bf16x8*)(Q + trow * 136 + kb);
        const f32x4 bc0 = *(const LAS f32x4*)(BC + trow * 132 + kb), bc1 = *(const LAS f32x4*)(BC + trow * 132 + kb + 4);
        const f32x4 r0 = *(const LAS f32x4*)(BC + (16 * mt) * 132 + kb), r1 = *(const LAS f32x4*)(BC + (16 * mt) * 132 + kb + 4);
        u32x4 ai, aq;
#pragma unroll
        for (int j = 0; j < 4; ++j) {
          const float q0 = bf2f((bf16_t)qv[2 * j]), q1 = bf2f((bf16_t)qv[2 * j + 1]);
          const float b0 = j < 2 ? bc0[2 * j] : bc1[2 * j - 4], b1 = j < 2 ? bc0[2 * j + 1] : bc1[2 * j - 3];
          const float rr0 = j < 2 ? r0[2 * j] : r1[2 * j - 4], rr1 = j < 2 ? r0[2 * j + 1] : r1[2 * j - 3];
          ai[j] = pk2(q0 * __expf(b0), q1 * __expf(b1)); aq[j] = pk2(q0 * __expf(b0 - rr0), q1 * __expf(b1 - rr1));
        }
        const bf16x8 sb = *(const LAS bf16x8*)(ST + (16 * vt + fr) * 136 + kb);
        oacc = MFMA16(__builtin_bit_cast(bf16x8, ai), sb, oacc);
#pragma unroll
        for (int jj = 0; jj < 2; ++jj) {
          const int J = J0 + jj; if (J > mt) continue;
          const int srow = 16 * J + fr;
          const bf16x8 kv = *(const LAS bf16x8*)(Kr + srow * 136 + kb);
          const f32x4 c0 = *(const LAS f32x4*)(BC + srow * 132 + kb), c1 = *(const LAS f32x4*)(BC + srow * 132 + kb + 4);
          u32x4 bk;
#pragma unroll
          for (int j = 0; j < 4; ++j) {
            const float k0 = bf2f((bf16_t)kv[2 * j]), k1 = bf2f((bf16_t)kv[2 * j + 1]);
            const float b0 = j < 2 ? c0[2 * j] : c1[2 * j - 4], b1 = j < 2 ? c0[2 * j + 1] : c1[2 * j - 3];
            const float rr0 = j < 2 ? r0[2 * j] : r1[2 * j - 4], rr1 = j < 2 ? r0[2 * j + 1] : r1[2 * j - 3];
            bk[j] = pk2(k0 * __expf(fminf(rr0 - b0, 80.f)), k1 * __expf(fminf(rr1 - b1, 80.f)));
          }
          if (jj == 0) a0 = MFMA16(__builtin_bit_cast(bf16x8, aq), __builtin_bit_cast(bf16x8, bk), a0);
          else a1 = MFMA16(__builtin_bit_cast(bf16x8, aq), __builtin_bit_cast(bf16x8, bk), a1);
        }
      }
#pragma unroll
      for (int jj = 0; jj < 2; ++jj) { const int J = J0 + jj;
#pragma unroll
        for (int reg = 0; reg < 4; ++reg) { const int tt = 16 * mt + 4 * fq + reg, ss = 16 * J + fr; const float v = jj == 0 ? a0[reg] : a1[reg];
          AB[tt * 72 + ss] = (J <= mt && ss <= tt) ? f2bf(v) : (bf16_t)0; } }
      lds_barrier();
#pragma unroll
      for (int k2 = 0; k2 < 2; ++k2) {
        const bf16x8 af = *(const LAS bf16x8*)(AB + (16 * mt + fr) * 72 + 32 * k2 + 8 * fq);
        const bf16x8 vb = *(const LAS bf16x8*)(VT + (16 * vt + fr) * 72 + 32 * k2 + 8 * fq);
        oacc = MFMA16(af, vb, oacc);
      }
#pragma unroll
      for (int reg = 0; reg < 4; ++reg) {
        const int tok = b * SEQ + c * 64 + 16 * mt + 4 * fq + reg; const float v = oacc[reg];
        oraw[(size_t)tok * 1024 + hh * 128 + vq * 32 + 16 * vt + fr] = f2bf(v);
        float sq = v * v; sq += __shfl_xor(sq, 1); sq += __shfl_xor(sq, 2); sq += __shfl_xor(sq, 4); sq += __shfl_xor(sq, 8);
        if (fr == 0) atomicAdd(sumsq + (size_t)tok * 8 + hh, sq);
      }
      { const f32x4 dc = *(const LAS f32x4*)(DEC + 16 * wid + 4 * fq);
        sreg[0] *= dc; sreg[1] *= dc;
#pragma unroll
        for (int k2 = 0; k2 < 2; ++k2) {
          const bf16x8 af = *(const LAS bf16x8*)(KDT + (16 * wid + fr) * 72 + 32 * k2 + 8 * fq);
#pragma unroll
          for (int v2 = 0; v2 < 2; ++v2) { const bf16x8 vb = *(const LAS bf16x8*)(VT + (16 * v2 + fr) * 72 + 32 * k2 + 8 * fq); sreg[v2] = MFMA16(af, vb, sreg[v2]); }
        }
#pragma unroll
        for (int v2 = 0; v2 < 2; ++v2) { u32x2 w; w.x = pk2(sreg[v2][0], sreg[v2][1]); w.y = pk2(sreg[v2][2], sreg[v2][3]); *(LAS u32x2*)(ST + (16 * v2 + fr) * 136 + 16 * wid + 4 * fq) = w; }
      }
    }
  }
}
DI void hgrn_norm_phase(int wv, const P& p_, int slot) {
  P p = p_; { size_t z_ = 0; asm volatile("" : "+s"(z_)); p.ws = p_.ws + z_; }
  const bf16_t* oraw = (const bf16_t*)(p.ws + WS_TB); const bf16_t* hg = (const bf16_t*)(p.ws + HG_G); const float* sumsq = (const float*)(p.ws + WS_SUMSQ);
  bf16_t* ob = (bf16_t*)(p.ws + WS_O); const float* gain = p.hg_gain + slot * 128;
  int tid_ = wv * 64 + lane_id_(); asm volatile("" : "+v"(tid_)); const size_t gtid = (size_t)blockIdx.x * 512 + tid_, gsz = (size_t)gridDim.x * 512;
  for (size_t i = gtid; i < (size_t)MTOK * 1024 / 8; i += gsz) {
    const size_t e = i * 8; const int row = (int)(e >> 10), col = (int)(e & 1023), hh = col >> 7, vv = col & 127;
    const float rs = rsqrtf(sumsq[(size_t)row * 8 + hh] * (1.0f / 128.0f) + 1e-6f);
    const bf16x8 o8 = *(const bf16x8*)(oraw + e), g8 = *(const bf16x8*)(hg + e);
    u32x4 w;
#pragma unroll
    for (int j = 0; j < 4; ++j) w[j] = pk2(bf2f((bf16_t)o8[2 * j]) * rs * gain[vv + 2 * j] * bf2f((bf16_t)g8[2 * j]), bf2f((bf16_t)o8[2 * j + 1]) * rs * gain[vv + 2 * j + 1] * bf2f((bf16_t)g8[2 * j + 1]));
    *(u32x4*)(ob + e) = w;
  }
}
#define REP_NSA 1
#define REP_CONV 1
#define REP_CMP 1
#define REP_MISC 1
#define REP_DOWN 1
#define REP_HG 1
#define REP_EPI 1
#ifndef SKIP_MIXERS
#define SKIP_MIXERS 0
#endif
__global__ void __launch_bounds__(512, 2) mega_fwd(P p) {
  extern __shared__ __attribute__((aligned(16))) unsigned char lds_raw[];
  LAS unsigned char* lds = (LAS unsigned char*)lds_raw;
  cg::grid_group grid = cg::this_grid();
  const int wv = __builtin_amdgcn_readfirstlane((int)(threadIdx.x >> 6));
  volatile LAS unsigned* xst = (volatile LAS unsigned*)(lds + LDS_BYTES - 16);
  if (wv == 0 && lane_id_() < 4) xst[lane_id_()] = 0u;
  __syncthreads();
  const XcdBarrier xb = xcd_barrier_post(wv, (unsigned*)(p.ws + WS_BAR), xst);
#define GSYNC() xcd_barrier(wv, xb)
  unsigned char* ws = p.ws;
  init_phase(wv, p);
  for (int L = 0; L < 4; ++L) {
    { size_t z_ = 0; asm volatile("" : "+s"(z_)); ws = p.ws + z_; }
    for (int rep = 0; rep < p.rep_conv; ++rep) convert_phase(wv, p, L, lds);
    if (L == 0) grid.sync(); else GSYNC();
    const int kind = L % 3, slot = L / 3;
    for (int s = 0; s < 3; ++s) {
      { size_t z_ = 0; asm volatile("" : "+s"(z_)); ws = p.ws + z_; }
      float* stats = (float*)(ws + WS_STATS); bf16_t* tb = (bf16_t*)(ws + WS_TB); bf16_t* Hb = (bf16_t*)(ws + WS_BIG); bf16_t* ob = (bf16_t*)(ws + WS_O);
      const int lnp = L * 3 + s - 1;
      const float* stp = (const float*)(ws + WS_DSTATS) + (size_t)(lnp + 1) * MTOK * 2;
      pg8::Gemm gr; float scale;
      if (s != 1) {
        pg8::Gemm g; g.A = tb; g.Bt = (const bf16_t*)(ws + (s == 0 ? W_GU1 : W_GU2)); g.M = MTOK; g.N = 5632; g.K = DM;
        pg8::StaticOrder S; S.init(g.M, g.N, gridDim.x, blockIdx.x);
        EpiUp E; E.reps = p.rep_epi; E.H = Hb; E.stats = stp; E.c1 = (const float*)(ws + (s == 0 ? C_GU1 : C_GU2)); E.c2 = E.c1 + 5632;
        pg8::gemm_phase(wv, lds, g, S, E);
        GSYNC();
        gr.A = Hb; gr.Bt = (const bf16_t*)(ws + (s == 0 ? W_D1 : W_D2)); gr.M = MTOK; gr.N = DM; gr.K = DFF; scale = 0.5f;
      } else {
        pg8::Gemm g; g.A = tb; g.Bt = (const bf16_t*)(ws + W_IN); g.M = MTOK; g.N = kind == 0 ? 2816 : (kind == 1 ? 4096 : 1280); g.K = DM;
        pg8::StaticOrder S; S.init(g.M, g.N, gridDim.x, blockIdx.x);
        EpiIn E; E.reps = 1; E.mode = kind == 1 ? 1 : 0; E.h = Hb; E.ld = g.N; E.stats = stp; E.c1 = (const float*)(ws + C_IN); E.c2 = E.c1 + 4096; E.lbv = (const float*)(ws + C_LBV);
        E.hq = (bf16_t*)(ws + HG_Q); E.hk = (bf16_t*)(ws + HG_K); E.hv = (bf16_t*)(ws + HG_V); E.hg = (bf16_t*)(ws + HG_G); E.hlf = (_Float16*)(ws + HG_LF);
        pg8::gemm_phase(wv, lds, g, S, E);
        GSYNC();
#if !SKIP_MIXERS
        if (kind == 0) {
          for (int rep = 0; rep < p.rep_cmp; ++rep) nsa_compress_phase(wv, p, lds);
          GSYNC();
          for (int rep = 0; rep < p.rep_nsa; ++rep) { if (rep) GSYNC(); nsa_attn_phase(wv, p, lds); }
        }
        else if (kind == 1) {
          for (int rep = p.rep_hg - 1; rep >= 0; --rep) hgrn_scan_phase(wv, p, lds, (float*)(ws + (rep ? WS_KC : WS_SUMSQ)));
          GSYNC(); hgrn_norm_phase(wv, p, slot); }
        else {
          for (int rep = 0; rep < p.rep_misc; ++rep) swa_attn_phase(wv, p, slot, lds);
        }
#endif
        GSYNC();
        gr.A = ob; gr.Bt = (const bf16_t*)(ws + W_OUT); gr.M = MTOK; gr.N = DM; gr.K = DM; scale = 1.0f;
      }
      pg8::StaticOrder S2; S2.init(gr.M, gr.N, gridDim.x, blockIdx.x);
      EpiRes R; R.reps = 1; R.T = p.out; R.Tin = lnp >= 0 ? p.out : p.x; R.stats_prev = stp; R.g = (const float*)(ws + WS_G13) + (size_t)(lnp + 1) * DM; R.b = (const float*)(ws + WS_B13) + (size_t)(lnp + 1) * DM;
      R.stats_new = stats + (size_t)(lnp + 1) * MTOK * 2; R.tb = tb; R.scale = scale;
      for (int rep = (s != 1 ? p.rep_down : 1) - 1; rep >= 0; --rep) {
        if (rep) { R.T = (float*)(ws + WS_BIG + 192 * MiB); R.tb = (bf16_t*)(ws + WS_O); R.stats_new = (float*)(ws + WS_KC); }
        else { R.T = p.out; R.tb = tb; R.stats_new = stats + (size_t)(lnp + 1) * MTOK * 2; }
        pg8::gemm_phase(wv, lds, gr, S2, R);
        GSYNC();
      }
    }
  }
  final_ln(wv, p, (float*)(ws + WS_STATS) + (size_t)11 * MTOK * 2, p.ln_gain + 11 * DM, p.ln_bias + 11 * DM);
}

extern "C" void kernel_launch(void* const* d_in, const int* in_sizes, int n_in, void* d_out, int out_size, void* d_ws, size_t ws_size, hipStream_t stream) {
  static int grid = 0;
  if (grid == 0) {
    if (n_in != 22 || ws_size < WS_END) { fprintf(stderr, "kernel_launch: unexpected n_in %d / ws_size %zu (need %zu)\n", n_in, ws_size, (size_t)WS_END); grid = -1; return; }
    int dev = 0, cus = 0, per_cu = 0;
    hipGetDevice(&dev); hipDeviceGetAttribute(&cus, hipDeviceAttributeMultiprocessorCount, dev);
    if (hipFuncSetAttribute((const void*)mega_fwd, hipFuncAttributeMaxDynamicSharedMemorySize, LDS_BYTES) != hipSuccess) { fprintf(stderr, "hipFuncSetAttribute failed\n"); grid = -1; return; }
    hipOccupancyMaxActiveBlocksPerMultiprocessor(&per_cu, (const void*)mega_fwd, 512, LDS_BYTES);
    if (per_cu < 1) { fprintf(stderr, "occupancy query says %d blocks/CU\n", per_cu); per_cu = 1; }
    (void)hipGetLastError();
    grid = cus * 1;
  }
  if (grid < 0) return;
  if (hipMemsetAsync((char*)d_ws + WS_BAR, 0, 16384, stream) != hipSuccess) { fprintf(stderr, "memset failed\n"); return; }
  P p{};
  const float** pp = (const float**)&p;
  for (int i = 0; i < 22; ++i) pp[i] = (const float*)d_in[i];
  p.out = (float*)d_out; p.ws = (unsigned char*)d_ws;
  p.rep_nsa = REP_NSA; p.rep_conv = REP_CONV; p.rep_cmp = REP_CMP; p.rep_misc = REP_MISC; p.rep_down = REP_DOWN; p.rep_hg = REP_HG; p.rep_epi = REP_EPI; p.rep_pad = 0;
  void* args[] = {&p};
  hipError_t e = hipLaunchCooperativeKernel((const void*)mega_fwd, dim3(grid), dim3(512), args, LDS_BYTES, stream);
  if (e != hipSuccess) fprintf(stderr, "cooperative launch failed: %s (grid %d)\n", hipGetErrorString(e), grid);
}
```

```cpp
#include <hip/hip_runtime.h>
#include <hip/hip_cooperative_groups.h>
#include <cstdio>
namespace cg = cooperative_groups;

typedef unsigned short bf16_t;
typedef short bf16x8 __attribute__((ext_vector_type(8)));
typedef short s16x4 __attribute__((ext_vector_type(4)));
typedef float f32x4 __attribute__((ext_vector_type(4)));
typedef float f32x16 __attribute__((ext_vector_type(16)));
typedef unsigned u32x2 __attribute__((ext_vector_type(2)));
typedef unsigned u32x4 __attribute__((ext_vector_type(4)));
#define LAS __attribute__((address_space(3)))
#define DI __device__ __forceinline__

constexpr int MTOK = 32768, DM = 1024, DFF = 2816, SEQ = 4096, NB = 8;
constexpr float ALPHA = 1.681792830507429f;
constexpr size_t MiB = 1ull << 20;
constexpr size_t W_GU1 = 0, W_D1 = 11534336, W_GU2 = 17301504, W_D2 = 28835840, W_IN = 34603008, W_OUT = 42991616,
                 W_W1T = 45088768, W_W2T = 46137344, W_C = 46170112;
constexpr size_t C_GU1 = W_C, C_GU2 = C_GU1 + 2 * 5632 * 4, C_IN = C_GU2 + 2 * 5632 * 4, C_POSB = C_IN + 2 * 4096 * 4,
                 C_LBV = C_POSB + 2 * 256 * 4, C_BTAB = C_LBV + 1024 * 4, C_END = C_BTAB + 16 * 132 * 4;
constexpr size_t WS_TB = 48 * MiB, WS_BIG = 112 * MiB, WS_O = 432 * MiB, WS_MISC = 496 * MiB;
constexpr size_t WS_DSTATS = WS_MISC, WS_STATS = WS_DSTATS + 262144, WS_SUMSQ = WS_STATS + 3 * MiB, WS_KC = WS_SUMSQ + 1 * MiB, WS_VC = WS_KC + 1 * MiB, WS_BAR = WS_VC + 1 * MiB,
                 WS_G13 = WS_BAR + 16384, WS_B13 = WS_G13 + 13 * 4096, WS_END = WS_B13 + 13 * 4096;
static_assert(C_END <= 48 * MiB, "weights region");
constexpr int LDS_BYTES = 144 * 1024;

struct P {
  const float *x, *rel_bias, *ln_gain, *ln_bias, *f1g, *f1u, *f1d, *f2g, *f2u, *f2d, *nsa_win, *nsa_wout, *nsa_pos, *nsa_w1, *nsa_w2,
      *hg_win, *hg_wout, *hg_gain, *hg_lb, *swa_win, *swa_wout, *swa_sinks;
  float* out; unsigned char* ws;
  int rep_nsa, rep_conv, rep_cmp, rep_misc, rep_down, rep_hg, rep_epi, rep_pad;
};

DI unsigned pk2(float a, float b) { typedef __bf16 bf2 __attribute__((ext_vector_type(2))); bf2 v; v[0] = (__bf16)a; v[1] = (__bf16)b; return __builtin_bit_cast(unsigned, v); }
DI bf16_t f2bf(float a) { return __builtin_bit_cast(unsigned short, (__bf16)a); }
DI float bf2f(bf16_t v) { return __uint_as_float(((unsigned)v) << 16); }
DI int lane_id_() { int l; asm volatile("v_mbcnt_lo_u32_b32 %0, -1, 0\n\tv_mbcnt_hi_u32_b32 %0, -1, %0" : "=v"(l)); return l; }
DI void lds_barrier() { asm volatile("s_waitcnt lgkmcnt(0)\n\ts_barrier" ::: "memory"); }
DI float sigmoidf_(float v) { return __builtin_amdgcn_rcpf(1.0f + __builtin_amdgcn_exp2f(-1.4426950408889634f * v)); }


#define XB_TMO      128
#define XB_XCNT(j)  (256  + 64 * (j))
#define XB_XSUB(j)  (1280 + 64 * (j))
#define XB_XGEN(j)  (2304 + 64 * (j))
#define XB_TOP      3328
#define XB_TOPGEN   3392
#define XCD_BAR_WORDS 3456
#define XB_SPIN_CAP (1u << 20)
DI unsigned xb_ld(unsigned* p)              { return __hip_atomic_load(p, __ATOMIC_RELAXED, __HIP_MEMORY_SCOPE_AGENT); }
DI unsigned xb_add(unsigned* p, unsigned v) { return __hip_atomic_fetch_add(p, v, __ATOMIC_RELAXED, __HIP_MEMORY_SCOPE_AGENT); }
DI unsigned xb_xcc_id() { return (unsigned)__builtin_amdgcn_s_getreg((3 << 11) | 20) & 0xFu; }
#define XB_SPIN(cond, bar) do { unsigned _sp = 0; while (cond) { __builtin_amdgcn_s_sleep(1); \
    if ((++_sp & 255u) == 0u) { if (xb_ld(&(bar)[XB_TMO])) break; if (_sp > XB_SPIN_CAP) { atomicAdd(&(bar)[XB_TMO], 1u); break; } } } } while (0)
struct XcdBarrier { unsigned* bar; unsigned x; volatile LAS unsigned* st; };
DI XcdBarrier xcd_barrier_post(int wv, unsigned* bar, volatile LAS unsigned* st) {
  XcdBarrier b; b.bar = bar; b.x = xb_xcc_id(); b.st = st;
  if (wv == 0 && lane_id_() == 0) (void)xb_add(&bar[XB_XCNT(b.x)], 1u);
  return b;
}
DI void xcd_barrier_complete(unsigned* bar, unsigned x, unsigned& nloc, unsigned& nx) {
  const unsigned G = gridDim.x * gridDim.y * gridDim.z;
  unsigned sum, cnt, mine, sp = 0u;
  for (;;) {
    sum = 0u; cnt = 0u; mine = 0u;
#pragma unroll 1
    for (unsigned j = 0; j < 16; ++j) { const unsigned c = xb_ld(&bar[XB_XCNT(j)]); sum += c; cnt += (c > 0u) ? 1u : 0u; mine = (j == x) ? c : mine; }
    if (sum == G) break;
    __builtin_amdgcn_s_sleep(1);
    if ((++sp & 255u) == 0u) { if (xb_ld(&bar[XB_TMO])) break; if (sp > XB_SPIN_CAP) { atomicAdd(&bar[XB_TMO], 1u); break; } }
  }
  nloc = mine > 0u ? mine : 1u; nx = cnt > 0u ? cnt : 1u;
}
DI void xcd_barrier(int wv, const XcdBarrier& b) {
  asm volatile("s_waitcnt vmcnt(0)" ::: "memory");
  __syncthreads();
  if (wv == 0 && lane_id_() == 0) {
    unsigned* bar = b.bar;
    __builtin_amdgcn_s_waitcnt(0);
    unsigned nloc = b.st[0], nx = b.st[1];
    if (nloc == 0u) { xcd_barrier_complete(bar, b.x, nloc, nx); b.st[0] = nloc; b.st[1] = nx; }
    const unsigned old = xb_add(&bar[XB_XSUB(b.x)], 1u);
    const unsigned gen = old / nloc;
    if (old + 1u == (gen + 1u) * nloc) {
      __builtin_amdgcn_fence(__ATOMIC_RELEASE, "agent");
      asm volatile("s_waitcnt vmcnt(0)" ::: "memory");
      const unsigned og = xb_add(&bar[XB_TOP], 1u);
      const unsigned tg = og / nx;
      if (og + 1u == (tg + 1u) * nx) xb_add(&bar[XB_TOPGEN], 1u);
      else XB_SPIN(xb_ld(&bar[XB_TOPGEN]) == tg, bar);
      __builtin_amdgcn_fence(__ATOMIC_ACQUIRE, "agent");
      xb_add(&bar[XB_XGEN(b.x)], 1u);
      asm volatile("s_waitcnt vmcnt(0)" ::: "memory");
    } else {
      XB_SPIN(xb_ld(&bar[XB_XGEN(b.x)]) == gen, bar);
      __builtin_amdgcn_fence(__ATOMIC_ACQUIRE, "agent");
      asm volatile("s_waitcnt vmcnt(0)" ::: "memory");
    }
  }
  __syncthreads();
}

namespace pg8 {
constexpr int BM = 256, BK = 64, HALF = 128, HTB = HALF * BK * 2, STAGE_BYTES = 8 * HTB, NXCD = 8, WGM = 8;
DI int lds_byte(int r, int c) { const int st = (r >> 4) * 2 + (c >> 5), rr = r & 15, cc = c & 31, ob = rr * 64 + cc * 2; return st * 1024 + (ob ^ (((ob >> 9) & 1) << 5)); }
DI void stage_rc(int b, int& R, int& C) { const int st = b / 1024, sb = b % 1024, swz = sb ^ (((sb >> 9) & 1) << 5); R = (st >> 1) * 16 + swz / 64; C = (st & 1) * 32 + (swz % 64) / 2; }
struct Unit { int pm, pn; };
struct Gemm { const bf16_t* A; const bf16_t* Bt; int M, N, K; };
struct StaticOrder {
  int nM, nN, nwg, G, c;
  DI void init(int M, int N, int G_, int c_) { nM = M / BM; nN = N / BM; nwg = nM * nN; G = G_; c = c_; }
  DI bool next(int i, Unit& u) const {
    const long L = (long)i * G + c; if (L >= nwg) return false;
    int wgid = (int)L; { const int q = nwg / NXCD, r = nwg % NXCD, xcd = wgid % NXCD, off = wgid / NXCD; wgid = (xcd < r ? xcd * (q + 1) : r * (q + 1) + (xcd - r) * q) + off; }
    const int nig = WGM * nN, gid = wgid / nig, fm = gid * WGM, gsz = (nM - fm) < WGM ? (nM - fm) : WGM;
    u.pm = fm + ((wgid % nig) % gsz); u.pn = (wgid % nig) / gsz; return true;
  }
};
template <class Epi>
DI void gemm_phase(int wv, LAS unsigned char* lds, const Gemm g, const StaticOrder& S, const Epi& E) {
  int tid_ = wv * 64 + lane_id_(); asm volatile("" : "+v"(tid_)); const int tid = tid_, wid = __builtin_amdgcn_readfirstlane(tid >> 6), lane = tid & 63, wr = wid >> 2, wc = wid & 3, fr = lane & 15, fq = lane >> 4;
  const int K = g.K, nt = K / BK;
  unsigned voffA[2];
#pragma unroll
  for (int i = 0; i < 2; ++i) { int R, C; stage_rc(tid * 16 + i * 8192, R, C); voffA[i] = (unsigned)(R * K + C) * 2u; }
  const size_t kstep = (size_t)(BK * 2), hstep = (size_t)HALF * K * 2, tstep = 2 * hstep;
  const unsigned ldsw = (unsigned)wid * 1024u;
  const int aoff = lds_byte(wr * 64 + fr, fq * 8), boff = lds_byte(wc * 32 + fr, fq * 8);
#define PG8_SA(b, h) (((b) * 2 + (h)) * HTB)
#define PG8_SB(b, h) ((4 + (b) * 2 + (h)) * HTB)
#define PG8_STAGE(bufoff, gbase, voff) do { _Pragma("unroll") for (int _i = 0; _i < 2; ++_i) \
    __builtin_amdgcn_global_load_lds((const unsigned*)((const char*)(gbase) + (voff)[_i]), (LAS unsigned*)(lds + (bufoff) + ldsw + _i * 8192), 16, 0, 0); } while (0)
#define PG8_LDA(dst, b, h) do { _Pragma("unroll") for (int m = 0; m < 4; ++m) _Pragma("unroll") for (int k = 0; k < 2; ++k) dst[m][k] = *(const LAS bf16x8*)(lds + PG8_SA(b, h) + aoff + m * 2048 + k * 1024); } while (0)
#define PG8_LDB(dst, b, h) do { _Pragma("unroll") for (int n = 0; n < 2; ++n) _Pragma("unroll") for (int k = 0; k < 2; ++k) dst[n][k] = *(const LAS bf16x8*)(lds + PG8_SB(b, h) + boff + n * 2048 + k * 1024); } while (0)
#define PG8_MMA(ai, bj, At, Bt) do { __builtin_amdgcn_s_setprio(1); _Pragma("unroll") for (int m = 0; m < 4; ++m) _Pragma("unroll") for (int n = 0; n < 2; ++n) _Pragma("unroll") for (int k = 0; k < 2; ++k) \
    acc[ai][bj][m][n] = __builtin_amdgcn_mfma_f32_16x16x32_bf16(Bt[n][k], At[m][k], acc[ai][bj][m][n], 0, 0, 0); __builtin_amdgcn_s_setprio(0); } while (0)
#define PG8_WAIT_V(n) asm volatile("s_waitcnt vmcnt(" #n ")" ::: "memory")
#define PG8_WAIT_L(n) asm volatile("s_waitcnt lgkmcnt(" #n ")" ::: "memory")
#define PG8_BAR __builtin_amdgcn_s_barrier()
#define PG8_SCHED __builtin_amdgcn_sched_barrier(0)
  Unit cur, nxt; int ui = 0;
  if (!S.next(0, cur)) return;
  f32x4 acc[2][2][4][2];
#pragma unroll
  for (int a = 0; a < 2; ++a)
#pragma unroll
    for (int b = 0; b < 2; ++b)
#pragma unroll
      for (int m = 0; m < 4; ++m)
#pragma unroll
        for (int n = 0; n < 2; ++n) acc[a][b][m][n] = (f32x4){0.f, 0.f, 0.f, 0.f};
  bf16x8 At[4][2], B0[2][2], B1[2][2];
  const char* cA = (const char*)g.A + (size_t)cur.pm * tstep; const char* cB = (const char*)g.Bt + (size_t)cur.pn * tstep;
  PG8_STAGE(PG8_SB(0, 0), cB, voffA); PG8_STAGE(PG8_SA(0, 0), cA, voffA); PG8_STAGE(PG8_SB(0, 1), cB + hstep, voffA); PG8_STAGE(PG8_SA(0, 1), cA + hstep, voffA);
  if (wr == 1) PG8_BAR;
  PG8_WAIT_V(4); PG8_BAR;
  PG8_STAGE(PG8_SB(1, 0), cB + kstep, voffA); PG8_STAGE(PG8_SA(1, 0), cA + kstep, voffA); PG8_STAGE(PG8_SB(1, 1), cB + hstep + kstep, voffA);
  PG8_WAIT_V(6); PG8_BAR;
  for (;;) {
    const bool has_next = S.next(ui + 1, nxt);
    const char* nA = has_next ? (const char*)g.A + (size_t)nxt.pm * tstep : cA; const char* nB = has_next ? (const char*)g.Bt + (size_t)nxt.pn * tstep : cB;
    for (int t = 0; t < nt; t += 2) {
      const bool last = (t == nt - 2);
      const char* a1 = cA + (size_t)(t + 1) * kstep;
      const char* a2 = last ? nA : cA + (size_t)(t + 2) * kstep; const char* b2 = last ? nB : cB + (size_t)(t + 2) * kstep;
      const char* a3 = a2 + kstep; const char* b3 = b2 + kstep;
      PG8_LDB(B0, 0, 0); PG8_SCHED; PG8_LDA(At, 0, 0); PG8_STAGE(PG8_SA(1, 1), a1 + hstep, voffA);
      PG8_WAIT_L(8); PG8_BAR; PG8_WAIT_L(0); PG8_MMA(0, 0, At, B0); PG8_BAR; PG8_SCHED;
      PG8_LDB(B1, 0, 1); PG8_STAGE(PG8_SB(0, 0), b2, voffA);
      PG8_BAR; PG8_WAIT_L(0); PG8_MMA(0, 1, At, B1); PG8_BAR;
      PG8_LDA(At, 0, 1); PG8_STAGE(PG8_SA(0, 0), a2, voffA);
      PG8_BAR; PG8_WAIT_L(0); PG8_MMA(1, 0, At, B0); PG8_BAR; PG8_SCHED;
      PG8_STAGE(PG8_SB(0, 1), b2 + hstep, voffA);
      PG8_WAIT_V(6); PG8_BAR; PG8_MMA(1, 1, At, B1); PG8_BAR;
      PG8_LDB(B0, 1, 0); PG8_SCHED; PG8_LDA(At, 1, 0); PG8_STAGE(PG8_SA(0, 1), a2 + hstep, voffA);
      PG8_WAIT_L(8); PG8_BAR; PG8_WAIT_L(0); PG8_MMA(0, 0, At, B0); PG8_BAR; PG8_SCHED;
      PG8_LDB(B1, 1, 1); PG8_STAGE(PG8_SB(1, 0), b3, voffA);
      PG8_BAR; PG8_WAIT_L(0); PG8_MMA(0, 1, At, B1); PG8_BAR;
      PG8_LDA(At, 1, 1); PG8_STAGE(PG8_SA(1, 0), a3, voffA);
      PG8_BAR; PG8_WAIT_L(0); PG8_MMA(1, 0, At, B0); PG8_BAR; PG8_SCHED;
      PG8_STAGE(PG8_SB(1, 1), b3 + hstep, voffA);
      PG8_WAIT_V(6); PG8_BAR; PG8_MMA(1, 1, At, B1); PG8_BAR;
    }
    for (int r_ = 0; r_ < E.reps; ++r_) E(acc, cur, wr, wc, fr, fq);
    if (!has_next) break;
#pragma unroll
    for (int a = 0; a < 2; ++a)
#pragma unroll
      for (int b = 0; b < 2; ++b)
#pragma unroll
        for (int m = 0; m < 4; ++m)
#pragma unroll
          for (int n = 0; n < 2; ++n) acc[a][b][m][n] = (f32x4){0.f, 0.f, 0.f, 0.f};
    cur = nxt; cA = nA; cB = nB; ++ui;
  }
  PG8_WAIT_V(0);
  if (wr == 0) PG8_BAR;
  PG8_BAR;
}
}
DI void row_affine(const float* stats, int row, float& a, float& bb, float& mu, float& rstd) {
  const float s = stats[2 * row], ss = stats[2 * row + 1]; mu = s * (1.0f / 1024.0f); const float var = fmaxf(ss * (1.0f / 1024.0f) - mu * mu, 0.f); rstd = rsqrtf(var + 1e-5f); a = rstd; bb = -rstd * mu;
}
struct EpiUp {
  bf16_t* H; const float* stats; const float* c1; const float* c2; int reps;
  DI void operator()(const f32x4 (&acc)[2][2][4][2], const pg8::Unit& u, int wr, int wc, int fr, int fq) const {
    const int colg = u.pn * 256 + wc * 32 + 8 * fq, hcol = u.pn * 128 + wc * 32 + 8 * fq;
    f32x4 c1g[2], c2g[2], c1u[2], c2u[2];
#pragma unroll
    for (int n = 0; n < 2; ++n) { c1g[n] = *(const f32x4*)(c1 + colg + 4 * n); c2g[n] = *(const f32x4*)(c2 + colg + 4 * n); c1u[n] = *(const f32x4*)(c1 + colg + 128 + 4 * n); c2u[n] = *(const f32x4*)(c2 + colg + 128 + 4 * n); }
    float ra[8], rb[8];
#pragma unroll
    for (int i = 0; i < 8; ++i) { float mu, rstd; row_affine(stats, u.pm * 256 + (i >> 2) * 128 + wr * 64 + (i & 3) * 16 + fr, ra[i], rb[i], mu, rstd); }
#pragma unroll
    for (int ai = 0; ai < 2; ++ai)
#pragma unroll
      for (int m = 0; m < 4; ++m) {
        const int row = u.pm * 256 + ai * 128 + wr * 64 + m * 16 + fr; const float a = ra[ai * 4 + m], bb = rb[ai * 4 + m];
        u32x4 w;
#pragma unroll
        for (int n = 0; n < 2; ++n) {
          const f32x4 gv = acc[ai][0][m][n] * a + c1g[n] * bb + c2g[n], uv = acc[ai][1][m][n] * a + c1u[n] * bb + c2u[n];
          float h[4];
#pragma unroll
          for (int j = 0; j < 4; ++j) h[j] = gv[j] * sigmoidf_(gv[j]) * uv[j];
          w[2 * n] = pk2(h[0], h[1]); w[2 * n + 1] = pk2(h[2], h[3]);
        }
        *(u32x4*)(H + (size_t)row * DFF + hcol) = w;
        asm volatile("" ::: "memory");
      }
  }
};
struct EpiRes {
  float* T; const float* Tin; const float* stats_prev; const float* g; const float* b; float* stats_new; bf16_t* tb; float scale; int reps;
  DI void operator()(const f32x4 (&acc)[2][2][4][2], const pg8::Unit& u, int wr, int wc, int fr, int fq) const {
    const int col0 = u.pn * 256 + wc * 32 + 8 * fq;
    float rmu[8], rrs[8];
#pragma unroll
    for (int i = 0; i < 8; ++i) { float a, bb; row_affine(stats_prev, u.pm * 256 + (i >> 2) * 128 + wr * 64 + (i & 3) * 16 + fr, a, bb, rmu[i], rrs[i]); }
#pragma unroll
    for (int ai = 0; ai < 2; ++ai)
#pragma unroll
      for (int mp = 0; mp < 2; ++mp) {
        f32x4 tpv[2][2][2];
#pragma unroll
        for (int mm = 0; mm < 2; ++mm)
#pragma unroll
          for (int bj = 0; bj < 2; ++bj)
#pragma unroll
            for (int n = 0; n < 2; ++n) tpv[mm][bj][n] = *(const f32x4*)(Tin + (size_t)(u.pm * 256 + ai * 128 + wr * 64 + (2 * mp + mm) * 16 + fr) * DM + col0 + bj * 128 + 4 * n);
#pragma unroll
        for (int mm = 0; mm < 2; ++mm) {
          const int m = 2 * mp + mm, row = u.pm * 256 + ai * 128 + wr * 64 + m * 16 + fr; const float mu = rmu[ai * 4 + m], rstd = rrs[ai * 4 + m];
          float rs = 0.f, rq = 0.f;
#pragma unroll
          for (int bj = 0; bj < 2; ++bj) {
            u32x4 w;
#pragma unroll
            for (int n = 0; n < 2; ++n) {
              const size_t off = (size_t)row * DM + col0 + bj * 128 + 4 * n;
              f32x4 tp = tpv[mm][bj][n];
              tp = (tp - mu) * rstd * (*(const f32x4*)(g + col0 + bj * 128 + 4 * n)) + *(const f32x4*)(b + col0 + bj * 128 + 4 * n);
              const f32x4 tn = tp * ALPHA + acc[ai][bj][m][n] * scale;
              *(f32x4*)(T + off) = tn;
              w[2 * n] = pk2(tn[0], tn[1]); w[2 * n + 1] = pk2(tn[2], tn[3]);
              rs += tn[0] + tn[1] + tn[2] + tn[3]; rq += tn[0] * tn[0] + tn[1] * tn[1] + tn[2] * tn[2] + tn[3] * tn[3];
            }
            *(u32x4*)(tb + (size_t)row * DM + col0 + bj * 128) = w;
          }
          rs += __shfl_xor(rs, 16); rs += __shfl_xor(rs, 32); rq += __shfl_xor(rq, 16); rq += __shfl_xor(rq, 32);
          if (fq == 0) { atomicAdd(stats_new + 2 * row, rs); atomicAdd(stats_new + 2 * row + 1, rq); }
        }
        asm volatile("" ::: "memory");
      }
  }
};
struct EpiIn {
  int mode; bf16_t* h; int ld; const float* stats; const float* c1; const float* c2; const float* lbv;
  bf16_t *hq, *hk, *hv, *hg; _Float16* hlf; int reps;
  template <int SECT>
  DI void body(const f32x4 (&acc)[2][2][4][2], const pg8::Unit& u, int wr, int wc, int fr, int fq) const {
    const int col0 = u.pn * 256 + wc * 32 + 8 * fq;
#pragma unroll
    for (int ai = 0; ai < 2; ++ai)
#pragma unroll
      for (int m = 0; m < 4; ++m) {
        const int row = u.pm * 256 + ai * 128 + wr * 64 + m * 16 + fr; float a, bb, mu, rstd; row_affine(stats, row, a, bb, mu, rstd);
#pragma unroll
        for (int bj = 0; bj < 2; ++bj) {
          const int col = col0 + bj * 128;
          f32x4 v[2];
#pragma unroll
          for (int n = 0; n < 2; ++n) v[n] = acc[ai][bj][m][n] * a + (*(const f32x4*)(c1 + col + 4 * n)) * bb + *(const f32x4*)(c2 + col + 4 * n);
          if (SECT < 0) { u32x4 w; w[0] = pk2(v[0][0], v[0][1]); w[1] = pk2(v[0][2], v[0][3]); w[2] = pk2(v[1][0], v[1][1]); w[3] = pk2(v[1][2], v[1][3]); *(u32x4*)(h + (size_t)row * ld + col) = w; }
          else {
            const int cc = col & 1023; const size_t off = (size_t)row * 1024 + cc;
            if (SECT == 0 || SECT == 3) { u32x4 w;
#pragma unroll
              for (int n = 0; n < 2; ++n) { w[2 * n] = pk2(v[n][0] * sigmoidf_(v[n][0]), v[n][1] * sigmoidf_(v[n][1])); w[2 * n + 1] = pk2(v[n][2] * sigmoidf_(v[n][2]), v[n][3] * sigmoidf_(v[n][3])); }
              *(u32x4*)((SECT == 0 ? hq : hg) + off) = w; }
            else if (SECT == 1) {
              typedef _Float16 h8 __attribute__((ext_vector_type(8))); h8 lf; u32x4 w;
#pragma unroll
              for (int n = 0; n < 2; ++n) { const f32x4 lb = *(const f32x4*)(lbv + cc + 4 * n); float kk[4];
#pragma unroll
                for (int j = 0; j < 4; ++j) { kk[j] = (1.0f - lb[j]) * __builtin_amdgcn_rcpf(1.0f + __builtin_amdgcn_exp2f(1.4426950408889634f * v[n][j])); lf[4 * n + j] = (_Float16)fmaxf(__logf(1.0f - kk[j]), -60.0f); }
                w[2 * n] = pk2(kk[0], kk[1]); w[2 * n + 1] = pk2(kk[2], kk[3]); }
              *(u32x4*)(hk + off) = w; *(h8*)(hlf + off) = lf;
            }
            else { u32x4 w; w[0] = pk2(v[0][0], v[0][1]); w[1] = pk2(v[0][2], v[0][3]); w[2] = pk2(v[1][0], v[1][1]); w[3] = pk2(v[1][2], v[1][3]); *(u32x4*)(hv + off) = w; }
          }
        }
        asm volatile("" ::: "memory");
      }
  }
  DI void operator()(const f32x4 (&acc)[2][2][4][2], const pg8::Unit& u, int wr, int wc, int fr, int fq) const {
    if (mode == 0) body<-1>(acc, u, wr, wc, fr, fq);
    else { const int sect = u.pn >> 2;
      if (sect == 0) body<0>(acc, u, wr, wc, fr, fq); else if (sect == 1) body<1>(acc, u, wr, wc, fr, fq); else if (sect == 2) body<2>(acc, u, wr, wc, fr, fq); else body<3>(acc, u, wr, wc, fr, fq); }
  }
};

DI void conv_strip(int wv, LAS unsigned char* lds, const float* src, int ldn, int K, int n0, int nvalid, bf16_t* dst, int dstrow0, const float* g, const float* b, float* c1, float* c2, bool perm = true, int kbeg = 0, int kend = -1) {
  if (kend < 0) kend = K;
  LAS bf16_t* tile = (LAS bf16_t*)lds;
  LAS float* red = (LAS float*)(lds + 64 * 72 * 2);
  int tid_ = wv * 64 + lane_id_(); asm volatile("" : "+v"(tid_)); const int tid = tid_, kr = tid >> 4, nc = (tid & 15) * 4;
  const bool colok = (n0 + nc) < nvalid;
  float s1[4] = {0.f, 0.f, 0.f, 0.f}, s2[4] = {0.f, 0.f, 0.f, 0.f};
  f32x4 w[2];
#pragma unroll
  for (int rr = 0; rr < 2; ++rr) w[rr] = colok ? *(const f32x4*)(src + (size_t)(kbeg + kr + rr * 32) * ldn + n0 + nc) : (f32x4){0.f, 0.f, 0.f, 0.f};
  for (int k0 = kbeg; k0 < kend; k0 += 64) {
    lds_barrier();
#pragma unroll
    for (int rr = 0; rr < 2; ++rr) { const int k = k0 + kr + rr * 32; const float gk = g ? g[k] : 1.0f, bk = b ? b[k] : 0.0f;
#pragma unroll
      for (int j = 0; j < 4; ++j) { const bf16_t v = f2bf(w[rr][j] * gk); tile[(nc + j) * 72 + kr + rr * 32] = v; s1[j] += bf2f(v); s2[j] += bk * w[rr][j]; } }
    if (k0 + 64 < kend) {
#pragma unroll
      for (int rr = 0; rr < 2; ++rr) w[rr] = colok ? *(const f32x4*)(src + (size_t)(k0 + 64 + kr + rr * 32) * ldn + n0 + nc) : (f32x4){0.f, 0.f, 0.f, 0.f};
    }
    lds_barrier();
    { const int n = tid >> 3, kc = (tid & 7) * 8; const int cc = n & 31, slot = (n & 32) + (perm ? 16 * ((cc >> 2) & 1) + 4 * (cc >> 3) + (cc & 3) : cc);
      *(u32x4*)(dst + (size_t)(dstrow0 + slot) * K + k0 + kc) = *(const LAS u32x4*)(tile + n * 72 + kc); }
  }
  if (c1) {
    __syncthreads();
#pragma unroll
    for (int j = 0; j < 4; ++j) { red[kr * 64 + nc + j] = s1[j]; red[2048 + kr * 64 + nc + j] = s2[j]; }
    __syncthreads();
    if (tid < 128) { const int n = tid & 63, which = tid >> 6; float s = 0.f; for (int i = 0; i < 32; ++i) s += red[which * 2048 + i * 64 + n]; (which ? c2 : c1)[dstrow0 + n] = s; }
  }
  __syncthreads();
}

DI void convert_phase(int wv, const P& p_, int L, LAS unsigned char* lds) {
  P p = p_; { size_t z_ = 0; asm volatile("" : "+s"(z_)); p.ws = p_.ws + z_; }
  const int kind = L % 3, slot = L / 3;
  const int nin = kind == 0 ? 44 : (kind == 1 ? 64 : 20);
  const int njobs = 272 + nin + 16 + (kind == 0 ? 6 : 0);
  unsigned char* ws = p.ws;
  for (int j = blockIdx.x; j < njobs; j += gridDim.x) {
    if (j < 272) {
      const int f = j / 136, jj = j % 136;
      const float* lg = p.ln_gain + (size_t)(L * 3 + (f == 0 ? -1 : 1)) * DM; const float* lbias = p.ln_bias + (size_t)(L * 3 + (f == 0 ? -1 : 1)) * DM;
      const bool fold = !(L == 0 && f == 0);
      float* cbase = (float*)(ws + (f == 0 ? C_GU1 : C_GU2));
      if (jj < 88) {
        const int up = jj / 44, s = jj % 44, n0 = s * 64;
        const float* src = (f == 0 ? (up ? p.f1u : p.f1g) : (up ? p.f2u : p.f2g)) + (size_t)L * DM * DFF;
        conv_strip(wv, lds, src, DFF, DM, n0, DFF, (bf16_t*)(ws + (f == 0 ? W_GU1 : W_GU2)), (n0 >> 7) * 256 + (n0 & 127) + up * 128, fold ? lg : nullptr, fold ? lbias : nullptr, cbase, cbase + 5632);
      } else {
        const int s = (jj - 88) / 3, kc = (jj - 88) % 3;
        const float* src = (f == 0 ? p.f1d : p.f2d) + (size_t)L * DFF * DM;
        conv_strip(wv, lds, src, DM, DFF, s * 64, DM, (bf16_t*)(ws + (f == 0 ? W_D1 : W_D2)), s * 64, nullptr, nullptr, nullptr, nullptr, true, kc * 960, kc == 2 ? DFF : kc * 960 + 960);
      }
    } else if (j < 272 + nin) {
      const int s = j - 272; const float* lg = p.ln_gain + (size_t)(L * 3) * DM; const float* lbias = p.ln_bias + (size_t)(L * 3) * DM;
      const float* src = kind == 0 ? p.nsa_win + (size_t)slot * DM * 2608 : (kind == 1 ? p.hg_win + (size_t)slot * DM * 4096 : p.swa_win + (size_t)slot * DM * 1280);
      const int ldn = kind == 0 ? 2608 : (kind == 1 ? 4096 : 1280);
      float* cbase = (float*)(ws + C_IN);
      conv_strip(wv, lds, src, ldn, DM, s * 64, ldn, (bf16_t*)(ws + W_IN), s * 64, lg, lbias, cbase, cbase + 4096);
    } else if (j < 272 + nin + 16) {
      const int s = j - 272 - nin;
      const float* src = kind == 0 ? p.nsa_wout + (size_t)slot * DM * DM : (kind == 1 ? p.hg_wout + (size_t)slot * DM * DM : p.swa_wout + (size_t)slot * DM * DM);
      conv_strip(wv, lds, src, DM, DM, s * 64, DM, (bf16_t*)(ws + W_OUT), s * 64, nullptr, nullptr, nullptr, nullptr);
    } else {
      const int s = j - 272 - nin - 16;
      if (s < 4) { const int kv = s >> 1, st = s & 1; float* pb = (float*)(ws + C_POSB) + kv * 256;
        conv_strip(wv, lds, p.nsa_w1 + ((size_t)slot * 2 + kv) * 2048 * 128, 128, 2048, st * 64, 128, (bf16_t*)(ws + W_W1T) + (size_t)kv * 128 * 2048, st * 64, nullptr, p.nsa_pos + ((size_t)slot * 2 + kv) * 2048, pb + 128, pb, false); }
      else { const int kv = s - 4; conv_strip(wv, lds, p.nsa_w2 + ((size_t)slot * 2 + kv) * 128 * 64, 64, 128, 0, 64, (bf16_t*)(ws + W_W2T) + (size_t)kv * 64 * 128, 0, nullptr, nullptr, nullptr, nullptr, false); }
    }
  }
}

DI void init_phase(int wv, const P& p_) {
  P p = p_; { size_t z_ = 0; asm volatile("" : "+s"(z_)); p.ws = p_.ws + z_; }
  int tid_ = wv * 64 + lane_id_(); asm volatile("" : "+v"(tid_)); const size_t gtid = (size_t)blockIdx.x * 512 + tid_, gsz = (size_t)gridDim.x * 512;
  for (size_t i = gtid; i < (4 * MiB) / 16; i += gsz) ((f32x4*)(p.ws + WS_STATS))[i] = (f32x4){0.f, 0.f, 0.f, 0.f};
  for (size_t i = gtid; i < (size_t)MTOK; i += gsz) { ((float*)(p.ws + WS_DSTATS))[2 * i] = 0.f; ((float*)(p.ws + WS_DSTATS))[2 * i + 1] = 1024.0f * (1.0f - 1e-5f); }
  if (gtid < 13 * 1024) { ((float*)(p.ws + WS_G13))[gtid] = gtid < 1024 ? 1.0f : p.ln_gain[gtid - 1024]; ((float*)(p.ws + WS_B13))[gtid] = gtid < 1024 ? 0.0f : p.ln_bias[gtid - 1024]; }
  for (size_t i = gtid; i < (size_t)MTOK * DM / 4; i += gsz) { const f32x4 v = ((const f32x4*)p.x)[i]; u32x2 w; w.x = pk2(v[0], v[1]); w.y = pk2(v[2], v[3]); ((u32x2*)(p.ws + WS_TB))[i] = w; }
  if (gtid < 16 * 132) { const int hd = (int)gtid / 132, d = (int)gtid % 132; int bk;
    if (d < 16) bk = d; else { const float v = logf((float)d / 16.0f) / 2.0794415416798357f * 16.0f; bk = 16 + (int)v; if (bk > 31 || d >= 128) bk = 31; }
    ((float*)(p.ws + C_BTAB))[gtid] = p.rel_bias[bk * 16 + hd]; }
  if (gtid < 1024) { const float a0 = p.hg_lb[gtid], a1 = p.hg_lb[1024 + gtid], a2 = p.hg_lb[2048 + gtid], a3 = p.hg_lb[3072 + gtid];
    const float mx = fmaxf(fmaxf(a0, a1), fmaxf(a2, a3)); const float e0 = expf(a0 - mx), e1 = expf(a1 - mx), e2 = expf(a2 - mx), e3 = expf(a3 - mx);
    ((float*)(p.ws + C_LBV))[gtid] = e1 / (e0 + e1 + e2 + e3); }
}

DI void final_ln(int wv, const P& p_, const float* stats, const float* g, const float* b) {
  P p = p_; { size_t z_ = 0; asm volatile("" : "+s"(z_)); p.ws = p_.ws + z_; }
  int tid_ = wv * 64 + lane_id_(); asm volatile("" : "+v"(tid_)); const size_t gtid = (size_t)blockIdx.x * 512 + tid_, gsz = (size_t)gridDim.x * 512;
  for (size_t i = gtid; i < (size_t)MTOK * DM / 4; i += gsz) {
    const int row = (int)(i >> 8), c = (int)(i & 255) * 4; float a, bb, mu, rstd; row_affine(stats, row, a, bb, mu, rstd);
    const f32x4 v = ((const f32x4*)p.out)[i]; ((f32x4*)p.out)[i] = (v - mu) * rstd * (*(const f32x4*)(g + c)) + *(const f32x4*)(b + c);
  }
}
#define MFMA32(a, b, c) __builtin_amdgcn_mfma_f32_32x32x16_bf16((a), (b), (c), 0, 0, 0)
#define MFMA16(a, b, c) __builtin_amdgcn_mfma_f32_16x16x32_bf16((a), (b), (c), 0, 0, 0)
DI int crow(int reg, int h) { return (reg & 3) + 8 * (reg >> 2) + 4 * h; }
constexpr int KS_STRIDE = 72;

struct KVRegs { u32x4 k; bf16x8 v; };
DI void kv_load(KVRegs& r, const bf16_t* kg, const bf16_t* vg, size_t ldg, int tid) {
  asm volatile("" : "+v"(tid));
  const int key = tid >> 3, d8 = (tid & 7) * 8;
  r.k = *(const u32x4*)(kg + (size_t)key * ldg + d8); r.v = *(const bf16x8*)(vg + (size_t)key * ldg + d8);
}
DI void kv_store(const KVRegs& r, LAS bf16_t* Ks, LAS bf16_t* Vt, int vstride, int vcol0, int tid) {
  asm volatile("" : "+v"(tid));
  const int key = tid >> 3, d8 = (tid & 7) * 8;
  *(LAS u32x4*)(Ks + key * KS_STRIDE + d8) = r.k;
  const u32x4 vd = __builtin_bit_cast(u32x4, r.v);
  const bool odd = key & 1;
  const unsigned s0 = odd ? vd[0] : vd[2], s1 = odd ? vd[1] : vd[3];
  const unsigned x0 = (unsigned)__builtin_amdgcn_update_dpp(0, (int)s0, 0x128, 0xf, 0xf, false), x1 = (unsigned)__builtin_amdgcn_update_dpp(0, (int)s1, 0x128, 0xf, 0xf, false);
  const unsigned m0 = odd ? vd[2] : vd[0], m1 = odd ? vd[3] : vd[1];
  const unsigned lo0 = odd ? x0 : m0, hi0 = odd ? m0 : x0, lo1 = odd ? x1 : m1, hi1 = odd ? m1 : x1;
  LAS unsigned* vp = (LAS unsigned*)(Vt + (d8 + (odd ? 4 : 0)) * vstride + vcol0 + (key & ~1));
  const int rs = vstride >> 1;
  vp[0] = (lo0 & 0xffffu) | (hi0 << 16); vp[rs] = (lo0 >> 16) | (hi0 & 0xffff0000u);
  vp[2 * rs] = (lo1 & 0xffffu) | (hi1 << 16); vp[3 * rs] = (lo1 >> 16) | (hi1 & 0xffff0000u);
}
DI void attn_scores(const LAS bf16_t* Ks, const bf16x8 (&qf)[4], int r, int h, f32x16 (&s)[2]) {
#pragma unroll
  for (int sub = 0; sub < 2; ++sub) {
    f32x16 a;
#pragma unroll
    for (int i = 0; i < 16; ++i) a[i] = 0.f;
#pragma unroll
    for (int ks = 0; ks < 4; ++ks) { const bf16x8 kf = *(const LAS bf16x8*)(Ks + (sub * 32 + r) * KS_STRIDE + ks * 16 + 8 * h); a = MFMA32(kf, qf[ks], a); }
    s[sub] = a;
  }
}
constexpr float QK_SCALE2 = 0.125f * 1.4426950408889634f;
DI void attn_logits(f32x16 (&s)[2], int t, int tw, int nt, int h, int base, int stride, int dmax, bool ok, const LAS float* btl) {
  const int dmin = tw - (base + 63 * stride), dmaxw = tw + nt - 1 - base;
  const bool far = dmin >= 128, interior = dmin >= 0 && dmaxw < dmax;
  const float bfar = btl[128];
  if (far && interior) {
#pragma unroll
    for (int sub = 0; sub < 2; ++sub)
#pragma unroll
      for (int reg = 0; reg < 16; ++reg) s[sub][reg] = ok ? s[sub][reg] * QK_SCALE2 + bfar : -1e30f;
  } else if (far) {
#pragma unroll
    for (int sub = 0; sub < 2; ++sub)
#pragma unroll
      for (int reg = 0; reg < 16; ++reg) {
        const int kk = sub * 32 + crow(reg, h); const int d = t - (base + kk * stride);
        const bool valid = (d >= 0) && (d < dmax) && ok;
        s[sub][reg] = valid ? s[sub][reg] * QK_SCALE2 + bfar : -1e30f;
      }
  } else {
#pragma unroll
    for (int sub = 0; sub < 2; ++sub)
#pragma unroll
      for (int reg = 0; reg < 16; ++reg) {
        const int kk = sub * 32 + crow(reg, h); const int d = t - (base + kk * stride);
        const bool valid = (d >= 0) && (d < dmax) && ok;
        const int di = d < 0 ? 0 : (d > 128 ? 128 : d);
        const float bsv = btl[di];
        const float x = s[sub][reg] * QK_SCALE2 + bsv;
        s[sub][reg] = valid ? x : -1e30f;
      }
  }
}
DI void attn_pv(const LAS bf16_t* Vt, int vstride, const f32x16 (&p)[2], f32x16 (&O)[2], int r, int h) {
#pragma unroll
  for (int sub = 0; sub < 2; ++sub)
#pragma unroll
    for (int s2 = 0; s2 < 2; ++s2) {
      u32x4 pp;
#pragma unroll
      for (int j = 0; j < 4; ++j) pp[j] = pk2(p[sub][8 * s2 + 2 * j], p[sub][8 * s2 + 2 * j + 1]);
      const bf16x8 pf = __builtin_bit_cast(bf16x8, pp);
#pragma unroll
      for (int dt = 0; dt < 2; ++dt) {
        const LAS bf16_t* vp = Vt + (dt * 32 + r) * vstride + sub * 32 + 16 * s2 + 4 * h;
        const s16x4 lo = *(const LAS s16x4*)vp, hi = *(const LAS s16x4*)(vp + 8);
        const bf16x8 vf = __builtin_shufflevector(lo, hi, 0, 1, 2, 3, 4, 5, 6, 7);
        O[dt] = MFMA32(vf, pf, O[dt]);
      }
    }
}
template <bool WITH_O>
DI void attn_online(f32x16 (&s)[2], float& m, float& l, f32x16 (&O)[2]) {
  float mx = -1e30f;
#pragma unroll
  for (int sub = 0; sub < 2; ++sub)
#pragma unroll
    for (int reg = 0; reg < 16; ++reg) mx = fmaxf(mx, s[sub][reg]);
  mx = fmaxf(mx, __shfl_xor(mx, 32));
  const float mn = fmaxf(m, mx);
  const bool grow = mn > m;
  float ls = 0.f;
#pragma unroll
  for (int sub = 0; sub < 2; ++sub)
#pragma unroll
    for (int reg = 0; reg < 16; ++reg) { const float e = __builtin_amdgcn_exp2f(s[sub][reg] - mn); s[sub][reg] = e; ls += e; }
  if (__any(grow)) {
    const float al = __builtin_amdgcn_exp2f(m - mn); m = mn;
    l = l * al + ls;
    if (WITH_O) {
#pragma unroll
      for (int dt = 0; dt < 2; ++dt)
#pragma unroll
        for (int reg = 0; reg < 16; ++reg) O[dt][reg] *= al;
    }
  } else l += ls;
}
DI void attn_tile(const LAS bf16_t* Ks, const LAS bf16_t* Vt, int vstride, const bf16x8 (&qf)[4], f32x16 (&O)[2], float& m, float& l,
                  int t, int tw, int nt, int r, int h, int base, int stride, int dmax, bool ok, const LAS float* btl) {
  f32x16 s[2];
  attn_scores(Ks, qf, r, h, s);
  const int dmin = tw - (base + 63 * stride), dmaxw = tw + nt - 1 - base;
  float mn, ls = 0.f;
  if (dmin >= 128 && dmaxw < dmax) {
    const float cl = ok ? QK_SCALE2 : 0.f, bl = ok ? btl[128] : -1e30f;
    float mr = -3e38f;
#pragma unroll
    for (int sub = 0; sub < 2; ++sub)
#pragma unroll
      for (int reg = 0; reg < 16; ++reg) mr = fmaxf(mr, s[sub][reg]);
    float mx = mr * cl + bl; mx = fmaxf(mx, __shfl_xor(mx, 32));
    mn = fmaxf(m, mx);
    const float off = bl - mn;
#pragma unroll
    for (int sub = 0; sub < 2; ++sub)
#pragma unroll
      for (int reg = 0; reg < 16; ++reg) { const float e = __builtin_amdgcn_exp2f(s[sub][reg] * cl + off); s[sub][reg] = e; ls += e; }
  } else {
    attn_logits(s, t, tw, nt, h, base, stride, dmax, ok, btl);
    float mx = -1e30f;
#pragma unroll
    for (int sub = 0; sub < 2; ++sub)
#pragma unroll
      for (int reg = 0; reg < 16; ++reg) mx = fmaxf(mx, s[sub][reg]);
    mx = fmaxf(mx, __shfl_xor(mx, 32));
    mn = fmaxf(m, mx);
#pragma unroll
    for (int sub = 0; sub < 2; ++sub)
#pragma unroll
      for (int reg = 0; reg < 16; ++reg) { const float e = __builtin_amdgcn_exp2f(s[sub][reg] - mn); s[sub][reg] = e; ls += e; }
  }
  if (__any(mn > m)) {
    const float al = __builtin_amdgcn_exp2f(m - mn); m = mn;
    l = l * al + ls;
#pragma unroll
    for (int dt = 0; dt < 2; ++dt)
#pragma unroll
      for (int reg = 0; reg < 16; ++reg) O[dt][reg] *= al;
  } else l += ls;
  attn_pv(Vt, vstride, s, O, r, h);
}
DI void zero_o(f32x16 (&O)[2]) {
#pragma unroll
  for (int dt = 0; dt < 2; ++dt)
#pragma unroll
    for (int reg = 0; reg < 16; ++reg) O[dt][reg] = 0.f;
}

DI void nsa_compress_phase(int wv, const P& p_, LAS unsigned char* lds) {
  P p = p_; { size_t z_ = 0; asm volatile("" : "+s"(z_)); p.ws = p_.ws + z_; }
  const bf16_t* hb = (const bf16_t*)(p.ws + WS_BIG); const int ld = 2816;
  int tid_ = wv * 64 + lane_id_(); asm volatile("" : "+v"(tid_)); const int tid = tid_, wid = wv, lane = tid & 63, fr = lane & 15, fq = lane >> 4;
  const int pw = wid & 3, half = wid >> 2;
  LAS bf16_t* hid = (LAS bf16_t*)lds + pw * 16 * 136;
  LAS f32x4* part = (LAS f32x4*)(lds + 32768) + pw * 8 * 64;
  for (int base = blockIdx.x * 4; base < 1024; base += gridDim.x * 4) {
    const int task = base + pw;
    const int kv = task >> 9, b = (task >> 6) & 7, g = (task >> 4) & 3, n0 = (task & 15) * 16;
    const bf16_t* w1t = (const bf16_t*)(p.ws + W_W1T) + (size_t)kv * 128 * 2048; const bf16_t* w2t = (const bf16_t*)(p.ws + W_W2T) + (size_t)kv * 64 * 128;
    const float* posb = (const float*)(p.ws + C_POSB) + kv * 256;
    const int colb = 1024 + kv * 256 + g * 64;
    int n = n0 + fr; if (n > 254) n = 254;
    f32x4 acc[8];
#pragma unroll
    for (int i = 0; i < 8; ++i) acc[i] = (f32x4){0.f, 0.f, 0.f, 0.f};
#pragma unroll 2
    for (int l = 16 * half; l < 16 * half + 16; ++l) {
#pragma unroll
      for (int dk = 0; dk < 2; ++dk) {
        const bf16x8 af = *(const bf16x8*)(hb + (size_t)(b * SEQ + 16 * n + l) * ld + colb + dk * 32 + fq * 8);
#pragma unroll
        for (int nt = 0; nt < 8; ++nt) { const bf16x8 bfr = *(const bf16x8*)(w1t + (size_t)(nt * 16 + fr) * 2048 + l * 64 + dk * 32 + fq * 8); acc[nt] = MFMA16(af, bfr, acc[nt]); }
      }
    }
    if (half) {
#pragma unroll
      for (int nt = 0; nt < 8; ++nt) part[nt * 64 + lane] = acc[nt];
    }
    __syncthreads();
    if (!half) {
#pragma unroll
      for (int nt = 0; nt < 8; ++nt) { const float pbv = posb[nt * 16 + fr]; const f32x4 o2 = part[nt * 64 + lane];
#pragma unroll
        for (int j = 0; j < 4; ++j) { const float v = acc[nt][j] + o2[j] + pbv; const float u = 0.7978845608028654f * (v + 0.044715f * v * v * v); const float th = 1.0f - 2.0f * __builtin_amdgcn_rcpf(1.0f + __expf(2.0f * u));
          hid[(4 * fq + j) * 136 + nt * 16 + fr] = f2bf(0.5f * v * (1.0f + th)); } }
    }
    __syncthreads();
    if (!half) {
      f32x4 o[4];
#pragma unroll
      for (int i = 0; i < 4; ++i) o[i] = (f32x4){0.f, 0.f, 0.f, 0.f};
#pragma unroll
      for (int ks = 0; ks < 4; ++ks) { const bf16x8 af = *(const LAS bf16x8*)(hid + fr * 136 + ks * 32 + fq * 8);
#pragma unroll
        for (int nt = 0; nt < 4; ++nt) { const bf16x8 bfr = *(const bf16x8*)(w2t + (size_t)(nt * 16 + fr) * 128 + ks * 32 + fq * 8); o[nt] = MFMA16(af, bfr, o[nt]); } }
      bf16_t* dst = (bf16_t*)(p.ws + (kv ? WS_VC : WS_KC)) + (size_t)((b * 4 + g) * 256) * 64;
#pragma unroll
      for (int nt = 0; nt < 4; ++nt)
#pragma unroll
        for (int j = 0; j < 4; ++j) { const int nn = n0 + 4 * fq + j; dst[(size_t)nn * 64 + nt * 16 + fr] = nn > 254 ? (bf16_t)0 : f2bf(o[nt][j]); }
    }
    __syncthreads();
  }
}

DI void nsa_attn_phase(int wv, const P& p_, LAS unsigned char* lds) {
  P p = p_; { size_t z_ = 0; asm volatile("" : "+s"(z_)); p.ws = p_.ws + z_; }
  const bf16_t* hb = (const bf16_t*)(p.ws + WS_BIG); const int ld = 2816;
  bf16_t* ob = (bf16_t*)(p.ws + WS_O);
  LAS bf16_t* KsB[2] = {(LAS bf16_t*)lds, (LAS bf16_t*)(lds + 17920)}; LAS bf16_t* VtB[2] = {(LAS bf16_t*)(lds + 9216), (LAS bf16_t*)(lds + 17920 + 9216)};
  LAS bf16_t* KC = (LAS bf16_t*)(lds + 35840); LAS bf16_t* VCT = (LAS bf16_t*)(lds + 72704);
  LAS float* OUTL = (LAS float*)(lds + 35840);
  LAS float* G4s = (LAS float*)(lds + 105984); LAS float* Lsm = (LAS float*)(lds + 122368); LAS float* BT = (LAS float*)(lds + 138752);
  LAS unsigned* SELM = (LAS unsigned*)(lds + 140864); LAS unsigned* UNI = (LAS unsigned*)(lds + 141376);
  for (int it = blockIdx.x; it < 2048; it += gridDim.x) {
    int tid_ = wv * 64 + lane_id_(); asm volatile("" : "+v"(tid_)); const int tid = tid_, wid = wv, lane = tid & 63, r = lane & 31, h = lane >> 5, tl = r >> 2, hd = r & 3;
    const int c = it & 255, ii = it >> 8, bg = c >> 3, b = bg >> 2, g = bg & 3, j8 = c & 7;
    const int qi = (ii & 1) ? (16 * (ii >> 1) + 15 - j8) : (16 * (ii >> 1) + j8);
    const int t0 = 64 * qi, tw = t0 + 8 * wid, t = tw + tl, head = g * 4 + hd;
    const int nct = (4 * qi + 2) / 64 + 1;
    __syncthreads();
    { KVRegs ka, kb; const bf16_t* kcg = (const bf16_t*)(p.ws + WS_KC) + (size_t)((b * 4 + g) * 256) * 64; const bf16_t* vcg = (const bf16_t*)(p.ws + WS_VC) + (size_t)((b * 4 + g) * 256) * 64;
      kv_load(ka, kcg, vcg, 64, tid); if (nct > 1) kv_load(kb, kcg + 64 * 64, vcg + 64 * 64, 64, tid);
      kv_store(ka, KC, VCT, 260, 0, tid); if (nct > 1) kv_store(kb, KC + 64 * KS_STRIDE, VCT, 260, 64, tid);
      if (nct > 2) { kv_load(ka, kcg + 128 * 64, vcg + 128 * 64, 64, tid); if (nct > 3) kv_load(kb, kcg + 192 * 64, vcg + 192 * 64, 64, tid);
        kv_store(ka, KC + 128 * KS_STRIDE, VCT, 260, 128, tid); if (nct > 3) kv_store(kb, KC + 192 * KS_STRIDE, VCT, 260, 192, tid); } }
    for (int i = tid; i < 4 * 132; i += 512) BT[i] = ((const float*)(p.ws + C_BTAB))[g * 4 * 132 + i] * 1.4426950408889634f;
    if (tid < 128) SELM[tid] = 0u; if (tid < 2) UNI[tid] = 0u;
    bf16x8 qf[4];
#pragma unroll
    for (int ks = 0; ks < 4; ++ks) qf[ks] = *(const bf16x8*)(hb + (size_t)(b * SEQ + t) * ld + head * 64 + ks * 16 + 8 * h);
    const size_t rowoff = (size_t)(b * SEQ + t) * ld;
    const float gc = sigmoidf_(bf2f(hb[rowoff + 2560 + head * 3 + 0])), gs = sigmoidf_(bf2f(hb[rowoff + 2560 + head * 3 + 1])), gw = sigmoidf_(bf2f(hb[rowoff + 2560 + head * 3 + 2]));
    const LAS float* btl = BT + hd * 132;
    KVRegs kvr; { const size_t go = (size_t)(b * SEQ) * ld + g * 64; kv_load(kvr, hb + go + 1536, hb + go + 1792, ld, tid); }
    __syncthreads();
    f32x16 O[2];
    float m = -1e30f, l = 0.f;
#pragma unroll 1
    for (int tile = 0; tile < nct; ++tile) { f32x16 s[2]; attn_scores(KC + tile * 64 * KS_STRIDE, qf, r, h, s); attn_logits(s, t, tw, 8, h, 16 * (tile * 64) + 31, 16, 0x7fffffff, true, btl); attn_online<false>(s, m, l, O); }
    { const float lt = l + __shfl_xor(l, 32); const float inv = (m > -1e29f && lt > 0.f) ? 1.0f / lt : 0.f;
      zero_o(O);
#pragma unroll 1
      for (int tile = 0; tile < nct; ++tile) {
        f32x16 s[2]; attn_scores(KC + tile * 64 * KS_STRIDE, qf, r, h, s); attn_logits(s, t, tw, 8, h, 16 * (tile * 64) + 31, 16, 0x7fffffff, true, btl);
        LAS float* gp = G4s + (8 * wid + tl) * 64 + 16 * tile + h; asm volatile("" : "+v"(gp));
#pragma unroll
        for (int sub = 0; sub < 2; ++sub) {
#pragma unroll
          for (int reg = 0; reg < 16; ++reg) { const float v = s[sub][reg]; s[sub][reg] = v > -1e29f ? __builtin_amdgcn_exp2f(v - m) * inv : 0.f; }
#pragma unroll
          for (int lg = 0; lg < 4; ++lg) { float G = s[sub][4 * lg] + s[sub][4 * lg + 1] + s[sub][4 * lg + 2] + s[sub][4 * lg + 3], Lv = s[sub][4 * lg + 3];
            G += __shfl_xor(G, 1); G += __shfl_xor(G, 2); Lv += __shfl_xor(Lv, 1); Lv += __shfl_xor(Lv, 2);
            if (hd == 0) { gp[8 * sub + 2 * lg] = G; gp[4096 + 8 * sub + 2 * lg] = Lv; } }
        }
        attn_pv(VCT + tile * 64, 260, s, O, r, h);
      }
    }
    __syncthreads();
#pragma unroll
    for (int dt = 0; dt < 2; ++dt)
#pragma unroll
      for (int reg = 0; reg < 16; ++reg) OUTL[(dt * 16 + reg) * 512 + tid] = gc * O[dt][reg];
    if (qi < 16) { const unsigned long long full = (qi == 63) ? ~0ull : ((1ull << (qi + 1)) - 1ull);
      int tsel = tid; asm volatile("" : "+v"(tsel));
      if (tsel < 64) { SELM[2 * tsel] = (unsigned)full; SELM[2 * tsel + 1] = (unsigned)(full >> 32); } if (tsel == 0) { UNI[0] = (unsigned)full; UNI[1] = (unsigned)(full >> 32); } }
    else {
      int tsel = tid; asm volatile("" : "+v"(tsel));
      const int tok = tsel >> 3, jj = tsel & 7, hiJ = qi - 2;
#pragma unroll
      for (int e = 0; e < 8; ++e) { const int j = jj * 8 + e; if (j >= 1 && j <= hiJ) G4s[tok * 64 + j] += Lsm[tok * 64 + j - 1]; }
      __syncthreads();
      float mine[8]; int cnt[8];
#pragma unroll
      for (int e = 0; e < 8; ++e) { const int j = jj * 8 + e; mine[e] = (j >= 1 && j <= hiJ) ? G4s[tok * 64 + j] : 0.f; cnt[e] = 0; }
      for (int j2 = 1; j2 <= hiJ; ++j2) { const float v = G4s[tok * 64 + j2];
#pragma unroll
        for (int e = 0; e < 8; ++e) { const int j = jj * 8 + e; cnt[e] += (v > mine[e] || (v == mine[e] && j2 < j)) ? 1 : 0; } }
      unsigned long long bits = 0ull;
#pragma unroll
      for (int e = 0; e < 8; ++e) { const int j = jj * 8 + e; if (j >= 1 && j <= hiJ && cnt[e] < 13) bits |= 1ull << j; }
      if (jj == 0) bits |= 1ull | (1ull << qi) | (1ull << (qi - 1));
      const unsigned blo = (unsigned)bits, bhi = (unsigned)(bits >> 32);
      if (blo) { atomicOr((unsigned*)&SELM[2 * tok], blo); atomicOr((unsigned*)&UNI[0], blo); }
      if (bhi) { atomicOr((unsigned*)&SELM[2 * tok + 1], bhi); atomicOr((unsigned*)&UNI[1], bhi); }
    }
    __syncthreads();
    int buf = 0;
    { const unsigned long long selm = (unsigned long long)SELM[2 * (8 * wid + tl)] | ((unsigned long long)SELM[2 * (8 * wid + tl) + 1] << 32);
      unsigned long long rem = (unsigned long long)UNI[0] | ((unsigned long long)UNI[1] << 32);
      m = -1e30f; l = 0.f; zero_o(O);
      const int jw0 = qi > 8 ? qi - 8 : 0;
#pragma unroll 1
      while (rem) {
        const int j = __builtin_ctzll(rem); rem &= rem - 1ull;
        kv_store(kvr, KsB[buf], VtB[buf], 68, 0, tid);
        __syncthreads();
        { const bool more = rem != 0ull; const int jn = more ? __builtin_ctzll(rem) : jw0;
          const size_t go = (size_t)(b * SEQ + jn * 64) * ld + g * 64; kv_load(kvr, hb + go + (more ? 1536 : 2048), hb + go + (more ? 1792 : 2304), ld, tid); }
        attn_tile(KsB[buf], VtB[buf], 68, qf, O, m, l, t, tw, 8, r, h, j * 64, 1, 0x7fffffff, ((selm >> j) & 1ull) != 0ull, btl);
        buf ^= 1;
      }
      const float lt = l + __shfl_xor(l, 32); const float sc = lt > 0.f ? gs / lt : 0.f;
#pragma unroll
      for (int dt = 0; dt < 2; ++dt)
#pragma unroll
        for (int reg = 0; reg < 16; ++reg) OUTL[(dt * 16 + reg) * 512 + tid] += sc * O[dt][reg];
    }
    { m = -1e30f; l = 0.f; zero_o(O);
#pragma unroll 1
      for (int j = (qi > 8 ? qi - 8 : 0); j <= qi; ++j) {
        kv_store(kvr, KsB[buf], VtB[buf], 68, 0, tid);
        __syncthreads();
        if (j < qi) { const size_t go = (size_t)(b * SEQ + (j + 1) * 64) * ld + g * 64; kv_load(kvr, hb + go + 2048, hb + go + 2304, ld, tid); }
        attn_tile(KsB[buf], VtB[buf], 68, qf, O, m, l, t, tw, 8, r, h, j * 64, 1, 512, true, btl);
        buf ^= 1;
      }
      const float lt = l + __shfl_xor(l, 32); const float sc = lt > 0.f ? gw / lt : 0.f;
#pragma unroll
      for (int dt = 0; dt < 2; ++dt)
#pragma unroll
        for (int reg = 0; reg < 16; ++reg) O[dt][reg] = OUTL[(dt * 16 + reg) * 512 + tid] + sc * O[dt][reg];
    }
    bf16_t* op = ob + (size_t)(b * SEQ + t) * DM + head * 64;
#pragma unroll
    for (int dt = 0; dt < 2; ++dt)
#pragma unroll
      for (int i4 = 0; i4 < 4; ++i4) { u32x2 w; w.x = pk2(O[dt][4 * i4], O[dt][4 * i4 + 1]); w.y = pk2(O[dt][4 * i4 + 2], O[dt][4 * i4 + 3]); *(u32x2*)(op + dt * 32 + 8 * i4 + 4 * h) = w; }
  }
}

DI void swa_attn_phase(int wv, const P& p_, int slot, LAS unsigned char* lds) {
  P p = p_; { size_t z_ = 0; asm volatile("" : "+s"(z_)); p.ws = p_.ws + z_; }
  const bf16_t* hb = (const bf16_t*)(p.ws + WS_BIG); const int ld = 1280;
  bf16_t* ob = (bf16_t*)(p.ws + WS_O);
  LAS bf16_t* KsB[2] = {(LAS bf16_t*)lds, (LAS bf16_t*)(lds + 17920)}; LAS bf16_t* VtB[2] = {(LAS bf16_t*)(lds + 9216), (LAS bf16_t*)(lds + 17920 + 9216)};
  LAS float* BT = (LAS float*)(lds + 35840);
  int tid_ = wv * 64 + lane_id_(); asm volatile("" : "+v"(tid_)); const int tid = tid_, wid = tid >> 6, lane = tid & 63, r = lane & 31, h = lane >> 5, tl = r >> 3, hd = r & 7;
  int buf = 0;
  for (int it = blockIdx.x; it < 2048; it += gridDim.x) {
    const int b = it >> 8, kv = (it >> 7) & 1, t0 = (it & 127) * 32;
    const int tw = t0 + 4 * wid, t = tw + tl, head = kv * 8 + hd;
    const int lo = t0 - 127, first = lo <= 0 ? 0 : (lo >> 6), last = (t0 + 31) >> 6;
    KVRegs kvr; { const size_t go = (size_t)(b * SEQ + first * 64) * ld + kv * 64; kv_load(kvr, hb + go + 1024, hb + go + 1152, ld, tid); }
    __syncthreads();
    for (int i = tid; i < 8 * 132; i += 512) BT[i] = ((const float*)(p.ws + C_BTAB))[kv * 8 * 132 + i] * 1.4426950408889634f;
    const size_t rowoff = (size_t)(b * SEQ + t) * ld;
    bf16x8 qf[4];
#pragma unroll
    for (int ks = 0; ks < 4; ++ks) qf[ks] = *(const bf16x8*)(hb + rowoff + head * 64 + ks * 16 + 8 * h);
    const LAS float* btl = BT + hd * 132;
    float m = p.swa_sinks[slot * 16 + head] * 1.4426950408889634f, l = (h == 0) ? 1.0f : 0.0f;
    f32x16 O[2]; zero_o(O);
#pragma unroll 1
    for (int j = first; j <= last; ++j) {
      kv_store(kvr, KsB[buf], VtB[buf], 68, 0, tid);
      __syncthreads();
      if (j < last) { const size_t go = (size_t)(b * SEQ + (j + 1) * 64) * ld + kv * 64; kv_load(kvr, hb + go + 1024, hb + go + 1152, ld, tid); }
      attn_tile(KsB[buf], VtB[buf], 68, qf, O, m, l, t, tw, 4, r, h, j * 64, 1, 128, true, btl);
      buf ^= 1;
    }
    const float lt = l + __shfl_xor(l, 32); const float sc = 1.0f / lt;
    bf16_t* op = ob + (size_t)(b * SEQ + t) * DM + head * 64;
#pragma unroll
    for (int dt = 0; dt < 2; ++dt)
#pragma unroll
      for (int i4 = 0; i4 < 4; ++i4) { u32x2 w; w.x = pk2(sc * O[dt][4 * i4], sc * O[dt][4 * i4 + 1]); w.y = pk2(sc * O[dt][4 * i4 + 2], sc * O[dt][4 * i4 + 3]); *(u32x2*)(op + dt * 32 + 8 * i4 + 4 * h) = w; }
  }
}
constexpr size_t HG_Q = WS_BIG, HG_K = WS_BIG + 64 * MiB, HG_V = WS_BIG + 128 * MiB, HG_G = WS_BIG + 192 * MiB, HG_LF = WS_BIG + 256 * MiB;
DI void hgrn_scan_phase(int wv, const P& p_, LAS unsigned char* lds, float* sumsq) {
  P p = p_; { size_t z_ = 0; asm volatile("" : "+s"(z_)); p.ws = p_.ws + z_; }
  const bf16_t* hq = (const bf16_t*)(p.ws + HG_Q); const bf16_t* hk = (const bf16_t*)(p.ws + HG_K); const bf16_t* hv = (const bf16_t*)(p.ws + HG_V);
  const _Float16* hlf = (const _Float16*)(p.ws + HG_LF);
  bf16_t* oraw = (bf16_t*)(p.ws + WS_TB);
  LAS bf16_t* Q = (LAS bf16_t*)lds; LAS bf16_t* Kr = (LAS bf16_t*)(lds + 17408); LAS float* BC = (LAS float*)(lds + 34816); LAS bf16_t* KDT = (LAS bf16_t*)(lds + 68608);
  LAS bf16_t* VT = (LAS bf16_t*)(lds + 87040); LAS bf16_t* ST = (LAS bf16_t*)(lds + 91648); LAS bf16_t* AB = (LAS bf16_t*)(lds + 100352);
  LAS float* SEG = (LAS float*)(lds + 109568); LAS float* DEC = (LAS float*)(lds + 111616); LAS _Float16* LF = (LAS _Float16*)(lds + 112128);
  int tid_ = wv * 64 + lane_id_(); asm volatile("" : "+v"(tid_)); const int tid = tid_, wid = tid >> 6, lane = tid & 63, fr = lane & 15, fq = lane >> 4;
  for (int it = blockIdx.x; it < 256; it += gridDim.x) {
    const int b = it >> 5, hh = (it >> 2) & 7, vq = it & 3;
    __syncthreads();
    for (int i = tid; i < 32 * 136 / 2; i += 512) ((LAS unsigned*)ST)[i] = 0u;
    f32x4 sreg[2]; sreg[0] = (f32x4){0.f, 0.f, 0.f, 0.f}; sreg[1] = sreg[0];
    u32x4 pq[2], pkk[2], plf[2], pv;
    const size_t gb = (size_t)(b * SEQ) * 1024 + hh * 128;
    auto prefetch = [&](int c) {
#pragma unroll
      for (int i = 0; i < 2; ++i) { const int idx = tid + 512 * i, row = idx >> 4, c8 = (idx & 15) * 8; const size_t off = gb + (size_t)(c * 64 + row) * 1024 + c8;
        pq[i] = *(const u32x4*)(hq + off); pkk[i] = *(const u32x4*)(hk + off); plf[i] = *(const u32x4*)(hlf + off); }
      if (tid < 256) { const int row = tid >> 2, c8 = (tid & 3) * 8; pv = *(const u32x4*)(hv + gb + (size_t)(c * 64 + row) * 1024 + vq * 32 + c8); }
    };
    prefetch(0);
    for (int c = 0; c < 64; ++c) {
      lds_barrier();
#pragma unroll
      for (int i = 0; i < 2; ++i) { const int idx = tid + 512 * i, row = idx >> 4, c8 = (idx & 15) * 8;
        *(LAS u32x4*)(Q + row * 136 + c8) = pq[i]; *(LAS u32x4*)(Kr + row * 136 + c8) = pkk[i]; *(LAS u32x4*)(LF + row * 128 + c8) = plf[i]; }
      if (tid < 256) { const int row = tid >> 2, c8 = (tid & 3) * 8; const bf16x8 vv = __builtin_bit_cast(bf16x8, pv);
#pragma unroll
        for (int i = 0; i < 8; ++i) VT[(c8 + i) * 72 + row] = (bf16_t)vv[i]; }
      if (c + 1 < 64) prefetch(c + 1);
      lds_barrier();
      const int kx = tid & 127, seg = tid >> 7;
      float bl[16];
      { float run = 0.f;
#pragma unroll
        for (int i = 0; i < 16; ++i) { run += (float)LF[(16 * seg + i) * 128 + kx]; bl[i] = run; }
        SEG[seg * 128 + kx] = run; }
      lds_barrier();
      { float pre = 0.f, blast = 0.f;
#pragma unroll
        for (int s2 = 0; s2 < 4; ++s2) { const float v = SEG[s2 * 128 + kx]; blast += v; if (s2 < seg) pre += v; }
        u32x4 w0, w1; float kd[16];
#pragma unroll
        for (int i = 0; i < 16; ++i) { const float bc = pre + bl[i]; BC[(16 * seg + i) * 132 + kx] = bc; kd[i] = bf2f(Kr[(16 * seg + i) * 136 + kx]) * __expf(blast - bc); }
#pragma unroll
        for (int j = 0; j < 4; ++j) { w0[j] = pk2(kd[2 * j], kd[2 * j + 1]); w1[j] = pk2(kd[8 + 2 * j], kd[8 + 2 * j + 1]); }
        *(LAS u32x4*)(KDT + kx * 72 + 16 * seg) = w0; *(LAS u32x4*)(KDT + kx * 72 + 16 * seg + 8) = w1;
        if (seg == 0) DEC[kx] = __expf(blast); }
      lds_barrier();
      const int mt = wid >> 1, vt = wid & 1;
      f32x4 oacc = (f32x4){0.f, 0.f, 0.f, 0.f}, a0 = oacc, a1 = oacc;
      const int J0 = 2 * vt;
#pragma unroll
      for (int ks = 0; ks < 4; ++ks) {
        const int kb = 32 * ks + 8 * fq, trow = 16 * mt + fr;
        const bf16x8 qv = *(const LAS bf16x8*)(Q + trow * 136 + kb);
        const f32x4 bc0 = *(const LAS f32x4*)(BC + trow * 132 + kb), bc1 = *(const LAS f32x4*)(BC + trow * 132 + kb + 4);
        const f32x4 r0 = *(const LAS f32x4*)(BC + (16 * mt) * 132 + kb), r1 = *(const LAS f32x4*)(BC + (16 * mt) * 132 + kb + 4);
        u32x4 ai, aq;
#pragma unroll
        for (int j = 0; j < 4; ++j) {
          const float q0 = bf2f((bf16_t)qv[2 * j]), q1 = bf2f((bf16_t)qv[2 * j + 1]);
          const float b0 = j < 2 ? bc0[2 * j] : bc1[2 * j - 4], b1 = j < 2 ? bc0[2 * j + 1] : bc1[2 * j - 3];
          const float rr0 = j < 2 ? r0[2 * j] : r1[2 * j - 4], rr1 = j < 2 ? r0[2 * j + 1] : r1[2 * j - 3];
          ai[j] = pk2(q0 * __expf(b0), q1 * __expf(b1)); aq[j] = pk2(q0 * __expf(b0 - rr0), q1 * __expf(b1 - rr1));
        }
        const bf16x8 sb = *(const LAS bf16x8*)(ST + (16 * vt + fr) * 136 + kb);
        oacc = MFMA16(__builtin_bit_cast(bf16x8, ai), sb, oacc);
#pragma unroll
        for (int jj = 0; jj < 2; ++jj) {
          const int J = J0 + jj; if (J > mt) continue;
          const int srow = 16 * J + fr;
          const bf16x8 kv = *(const LAS bf16x8*)(Kr + srow * 136 + kb);
          const f32x4 c0 = *(const LAS f32x4*)(BC + srow * 132 + kb), c1 = *(const LAS f32x4*)(BC + srow * 132 + kb + 4);
          u32x4 bk;
#pragma unroll
          for (int j = 0; j < 4; ++j) {
            const float k0 = bf2f((bf16_t)kv[2 * j]), k1 = bf2f((bf16_t)kv[2 * j + 1]);
            const float b0 = j < 2 ? c0[2 * j] : c1[2 * j - 4], b1 = j < 2 ? c0[2 * j + 1] : c1[2 * j - 3];
            const float rr0 = j < 2 ? r0[2 * j] : r1[2 * j - 4], rr1 = j < 2 ? r0[2 * j + 1] : r1[2 * j - 3];
            bk[j] = pk2(k0 * __expf(fminf(rr0 - b0, 80.f)), k1 * __expf(fminf(rr1 - b1, 80.f)));
          }
          if (jj == 0) a0 = MFMA16(__builtin_bit_cast(bf16x8, aq), __builtin_bit_cast(bf16x8, bk), a0);
          else a1 = MFMA16(__builtin_bit_cast(bf16x8, aq), __builtin_bit_cast(bf16x8, bk), a1);
        }
      }
#pragma unroll
      for (int jj = 0; jj < 2; ++jj) { const int J = J0 + jj;
#pragma unroll
        for (int reg = 0; reg < 4; ++reg) { const int tt = 16 * mt + 4 * fq + reg, ss = 16 * J + fr; const float v = jj == 0 ? a0[reg] : a1[reg];
          AB[tt * 72 + ss] = (J <= mt && ss <= tt) ? f2bf(v) : (bf16_t)0; } }
      lds_barrier();
#pragma unroll
      for (int k2 = 0; k2 < 2; ++k2) {
        const bf16x8 af = *(const LAS bf16x8*)(AB + (16 * mt + fr) * 72 + 32 * k2 + 8 * fq);
        const bf16x8 vb = *(const LAS bf16x8*)(VT + (16 * vt + fr) * 72 + 32 * k2 + 8 * fq);
        oacc = MFMA16(af, vb, oacc);
      }
#pragma unroll
      for (int reg = 0; reg < 4; ++reg) {
        const int tok = b * SEQ + c * 64 + 16 * mt + 4 * fq + reg; const float v = oacc[reg];
        oraw[(size_t)tok * 1024 + hh * 128 + vq * 32 + 16 * vt + fr] = f2bf(v);
        float sq = v * v; sq += __shfl_xor(sq, 1); sq += __shfl_xor(sq, 2); sq += __shfl_xor(sq, 4); sq += __shfl_xor(sq, 8);
        if (fr == 0) atomicAdd(sumsq + (size_t)tok * 8 + hh, sq);
      }
      { const f32x4 dc = *(const LAS f32x4*)(DEC + 16 * wid + 4 * fq);
        sreg[0] *= dc; sreg[1] *= dc;
#pragma unroll
        for (int k2 = 0; k2 < 2; ++k2) {
          const bf16x8 af = *(const LAS bf16x8*)(KDT + (16 * wid + fr) * 72 + 32 * k2 + 8 * fq);
#pragma unroll
          for (int v2 = 0; v2 < 2; ++v2) { const bf16x8 vb = *(const LAS bf16x8*)(VT + (16 * v2 + fr) * 72 + 32 * k2 + 8 * fq); sreg[v2] = MFMA16(af, vb, sreg[v2]); }
        }
#pragma unroll
        for (int v2 = 0; v2 < 2; ++v2) { u32x2 w; w.x = pk2(sreg[v2][0], sreg[v2][1]); w.y = pk2(sreg[v2][2], sreg[v2][3]); *(LAS u32x2*)(ST + (16 * v2 + fr) * 136 + 16 * wid + 4 * fq) = w; }
      }
    }
  }
}
DI void hgrn_norm_phase(int wv, const P& p_, int slot) {
  P p = p_; { size_t z_ = 0; asm volatile("" : "+s"(z_)); p.ws = p_.ws + z_; }
  const bf16_t* oraw = (const bf16_t*)(p.ws + WS_TB); const bf16_t* hg = (const bf16_t*)(p.ws + HG_G); const float* sumsq = (const float*)(p.ws + WS_SUMSQ);
  bf16_t* ob = (bf16_t*)(p.ws + WS_O); const float* gain = p.hg_gain + slot * 128;
  int tid_ = wv * 64 + lane_id_(); asm volatile("" : "+v"(tid_)); const size_t gtid = (size_t)blockIdx.x * 512 + tid_, gsz = (size_t)gridDim.x * 512;
  for (size_t i = gtid; i < (size_t)MTOK * 1024 / 8; i += gsz) {
    const size_t e = i * 8; const int row = (int)(e >> 10), col = (int)(e & 1023), hh = col >> 7, vv = col & 127;
    const float rs = rsqrtf(sumsq[(size_t)row * 8 + hh] * (1.0f / 128.0f) + 1e-6f);
    const bf16x8 o8 = *(const bf16x8*)(oraw + e), g8 = *(const bf16x8*)(hg + e);
    u32x4 w;
#pragma unroll
    for (int j = 0; j < 4; ++j) w[j] = pk2(bf2f((bf16_t)o8[2 * j]) * rs * gain[vv + 2 * j] * bf2f((bf16_t)g8[2 * j]), bf2f((bf16_t)o8[2 * j + 1]) * rs * gain[vv + 2 * j + 1] * bf2f((bf16_t)g8[2 * j + 1]));
    *(u32x4*)(ob + e) = w;
  }
}
#define REP_NSA 1
#define REP_CONV 1
#define REP_CMP 1
#define REP_MISC 1
#define REP_DOWN 1
#define REP_HG 1
#define REP_EPI 1
#ifndef SKIP_MIXERS
#define SKIP_MIXERS 0
#endif
__global__ void __launch_bounds__(512, 2) mega_fwd(P p) {
  extern __shared__ __attribute__((aligned(16))) unsigned char lds_raw[];
  LAS unsigned char* lds = (LAS unsigned char*)lds_raw;
  cg::grid_group grid = cg::this_grid();
  const int wv = __builtin_amdgcn_readfirstlane((int)(threadIdx.x >> 6));
  volatile LAS unsigned* xst = (volatile LAS unsigned*)(lds + LDS_BYTES - 16);
  if (wv == 0 && lane_id_() < 4) xst[lane_id_()] = 0u;
  __syncthreads();
  const XcdBarrier xb = xcd_barrier_post(wv, (unsigned*)(p.ws + WS_BAR), xst);
#define GSYNC() xcd_barrier(wv, xb)
  unsigned char* ws = p.ws;
  init_phase(wv, p);
  for (int L = 0; L < 4; ++L) {
    { size_t z_ = 0; asm volatile("" : "+s"(z_)); ws = p.ws + z_; }
    for (int rep = 0; rep < p.rep_conv; ++rep) convert_phase(wv, p, L, lds);
    if (L == 0) grid.sync(); else GSYNC();
    const int kind = L % 3, slot = L / 3;
    for (int s = 0; s < 3; ++s) {
      { size_t z_ = 0; asm volatile("" : "+s"(z_)); ws = p.ws + z_; }
      float* stats = (float*)(ws + WS_STATS); bf16_t* tb = (bf16_t*)(ws + WS_TB); bf16_t* Hb = (bf16_t*)(ws + WS_BIG); bf16_t* ob = (bf16_t*)(ws + WS_O);
      const int lnp = L * 3 + s - 1;
      const float* stp = (const float*)(ws + WS_DSTATS) + (size_t)(lnp + 1) * MTOK * 2;
      pg8::Gemm gr; float scale;
      if (s != 1) {
        pg8::Gemm g; g.A = tb; g.Bt = (const bf16_t*)(ws + (s == 0 ? W_GU1 : W_GU2)); g.M = MTOK; g.N = 5632; g.K = DM;
        pg8::StaticOrder S; S.init(g.M, g.N, gridDim.x, blockIdx.x);
        EpiUp E; E.reps = p.rep_epi; E.H = Hb; E.stats = stp; E.c1 = (const float*)(ws + (s == 0 ? C_GU1 : C_GU2)); E.c2 = E.c1 + 5632;
        pg8::gemm_phase(wv, lds, g, S, E);
        GSYNC();
        gr.A = Hb; gr.Bt = (const bf16_t*)(ws + (s == 0 ? W_D1 : W_D2)); gr.M = MTOK; gr.N = DM; gr.K = DFF; scale = 0.5f;
      } else {
        pg8::Gemm g; g.A = tb; g.Bt = (const bf16_t*)(ws + W_IN); g.M = MTOK; g.N = kind == 0 ? 2816 : (kind == 1 ? 4096 : 1280); g.K = DM;
        pg8::StaticOrder S; S.init(g.M, g.N, gridDim.x, blockIdx.x);
        EpiIn E; E.reps = 1; E.mode = kind == 1 ? 1 : 0; E.h = Hb; E.ld = g.N; E.stats = stp; E.c1 = (const float*)(ws + C_IN); E.c2 = E.c1 + 4096; E.lbv = (const float*)(ws + C_LBV);
        E.hq = (bf16_t*)(ws + HG_Q); E.hk = (bf16_t*)(ws + HG_K); E.hv = (bf16_t*)(ws + HG_V); E.hg = (bf16_t*)(ws + HG_G); E.hlf = (_Float16*)(ws + HG_LF);
        pg8::gemm_phase(wv, lds, g, S, E);
        GSYNC();
#if !SKIP_MIXERS
        if (kind == 0) {
          for (int rep = 0; rep < p.rep_cmp; ++rep) nsa_compress_phase(wv, p, lds);
          GSYNC();
          for (int rep = 0; rep < p.rep_nsa; ++rep) { if (rep) GSYNC(); nsa_attn_phase(wv, p, lds); }
        }
        else if (kind == 1) {
          for (int rep = p.rep_hg - 1; rep >= 0; --rep) hgrn_scan_phase(wv, p, lds, (float*)(ws + (rep ? WS_KC : WS_SUMSQ)));
          GSYNC(); hgrn_norm_phase(wv, p, slot); }
        else {
          for (int rep = 0; rep < p.rep_misc; ++rep) swa_attn_phase(wv, p, slot, lds);
        }
#endif
        GSYNC();
        gr.A = ob; gr.Bt = (const bf16_t*)(ws + W_OUT); gr.M = MTOK; gr.N = DM; gr.K = DM; scale = 1.0f;
      }
      pg8::StaticOrder S2; S2.init(gr.M, gr.N, gridDim.x, blockIdx.x);
      EpiRes R; R.reps = 1; R.T = p.out; R.Tin = lnp >= 0 ? p.out : p.x; R.stats_prev = stp; R.g = (const float*)(ws + WS_G13) + (size_t)(lnp + 1) * DM; R.b = (const float*)(ws + WS_B13) + (size_t)(lnp + 1) * DM;
      R.stats_new = stats + (size_t)(lnp + 1) * MTOK * 2; R.tb = tb; R.scale = scale;
      for (int rep = (s != 1 ? p.rep_down : 1) - 1; rep >= 0; --rep) {
        if (rep) { R.T = (float*)(ws + WS_BIG + 192 * MiB); R.tb = (bf16_t*)(ws + WS_O); R.stats_new = (float*)(ws + WS_KC); }
        else { R.T = p.out; R.tb = tb; R.stats_new = stats + (size_t)(lnp + 1) * MTOK * 2; }
        pg8::gemm_phase(wv, lds, gr, S2, R);
        GSYNC();
      }
    }
  }
  final_ln(wv, p, (float*)(ws + WS_STATS) + (size_t)11 * MTOK * 2, p.ln_gain + 11 * DM, p.ln_bias + 11 * DM);
}

extern "C" void kernel_launch(void* const* d_in, const int* in_sizes, int n_in, void* d_out, int out_size, void* d_ws, size_t ws_size, hipStream_t stream) {
  static int grid = 0;
  if (grid == 0) {
    if (n_in != 22 || ws_size < WS_END) { fprintf(stderr, "kernel_launch: unexpected n_in %d / ws_size %zu (need %zu)\n", n_in, ws_size, (size_t)WS_END); grid = -1; return; }
    int dev = 0, cus = 0, per_cu = 0;
    hipGetDevice(&dev); hipDeviceGetAttribute(&cus, hipDeviceAttributeMultiprocessorCount, dev);
    if (hipFuncSetAttribute((const void*)mega_fwd, hipFuncAttributeMaxDynamicSharedMemorySize, LDS_BYTES) != hipSuccess) { fprintf(stderr, "hipFuncSetAttribute failed\n"); grid = -1; return; }
    hipOccupancyMaxActiveBlocksPerMultiprocessor(&per_cu, (const void*)mega_fwd, 512, LDS_BYTES);
    if (per_cu < 1) { fprintf(stderr, "occupancy query says %d blocks/CU\n", per_cu); per_cu = 1; }
    (void)hipGetLastError();
    grid = cus * 1;
  }
  if (grid < 0) return;
  if (hipMemsetAsync((char*)d_ws + WS_BAR, 0, 16384, stream) != hipSuccess) { fprintf(stderr, "memset failed\n"); return; }
  P p{};
  const float** pp = (const float**)&p;
  for (int i = 0; i < 22; ++i) pp[i] = (const float*)d_in[i];
  p.out = (float*)d_out; p.ws = (unsigned char*)d_ws;
  p.rep_nsa = REP_NSA; p.rep_conv = REP_CONV; p.rep_cmp = REP_CMP; p.rep_misc = REP_MISC; p.rep_down = REP_DOWN; p.rep_hg = REP_HG; p.rep_epi = REP_EPI; p.rep_pad = 0;
  void* args[] = {&p};
  hipError_t e = hipLaunchCooperativeKernel((const void*)mega_fwd, dim3(grid), dim3(512), args, LDS_BYTES, stream);
  if (e != hipSuccess) fprintf(stderr, "cooperative launch failed: %s (grid %d)\n", hipGetErrorString(e), grid);
}
```

```cpp
#include <hip/hip_runtime.h>
#include <hip/hip_cooperative_groups.h>
#include <cstdio>
namespace cg = cooperative_groups;

typedef unsigned short bf16_t;
typedef short bf16x8 __attribute__((ext_vector_type(8)));
typedef short s16x4 __attribute__((ext_vector_type(4)));
typedef _Float16 half8 __attribute__((ext_vector_type(8)));
typedef float f32x4 __attribute__((ext_vector_type(4)));
typedef float f32x16 __attribute__((ext_vector_type(16)));
typedef unsigned u32x2 __attribute__((ext_vector_type(2)));
typedef unsigned u32x4 __attribute__((ext_vector_type(4)));
#define LAS __attribute__((address_space(3)))
#define DI __device__ __forceinline__

constexpr int MTOK = 32768, DM = 1024, DFF = 2816, SEQ = 4096, NB = 8;
constexpr float ALPHA = 1.681792830507429f;
constexpr size_t MiB = 1ull << 20;
constexpr size_t W_GU1 = 0, W_D1 = 11534336, W_GU2 = 17301504, W_D2 = 28835840, W_IN = 34603008, W_OUT = 42991616,
                 W_W1T = 45088768, W_W2T = 46137344, W_C = 46170112;
constexpr size_t C_GU1 = W_C, C_GU2 = C_GU1 + 2 * 5632 * 4, C_IN = C_GU2 + 2 * 5632 * 4, C_POSB = C_IN + 2 * 4096 * 4,
                 C_LBV = C_POSB + 2 * 256 * 4, C_BTAB = C_LBV + 1024 * 4, C_END = C_BTAB + 16 * 132 * 4;
constexpr size_t WS_TB = 48 * MiB, WS_BIG = 112 * MiB, WS_O = 432 * MiB, WS_MISC = 496 * MiB;
constexpr size_t WS_DSTATS = WS_MISC, WS_STATS = WS_DSTATS + 262144, WS_SUMSQ = WS_STATS + 3 * MiB, WS_KC = WS_SUMSQ + 1 * MiB, WS_VC = WS_KC + 1 * MiB, WS_BAR = WS_VC + 1 * MiB,
                 WS_G13 = WS_BAR + 16384, WS_B13 = WS_G13 + 13 * 4096, WS_END = WS_B13 + 13 * 4096;
static_assert(C_END <= 48 * MiB, "weights region");
constexpr int LDS_BYTES = 144 * 1024;

struct P {
  const float *x, *rel_bias, *ln_gain, *ln_bias, *f1g, *f1u, *f1d, *f2g, *f2u, *f2d, *nsa_win, *nsa_wout, *nsa_pos, *nsa_w1, *nsa_w2,
      *hg_win, *hg_wout, *hg_gain, *hg_lb, *swa_win, *swa_wout, *swa_sinks;
  float* out; unsigned char* ws;
  int rep_nsa, rep_conv, rep_cmp, rep_misc, rep_down, rep_hg, rep_epi, rep_pad;
};

DI unsigned pk2(float a, float b) { typedef __bf16 bf2 __attribute__((ext_vector_type(2))); bf2 v; v[0] = (__bf16)a; v[1] = (__bf16)b; return __builtin_bit_cast(unsigned, v); }
DI unsigned pkh2(float a, float b) { typedef _Float16 h2 __attribute__((ext_vector_type(2))); h2 v; v[0] = (_Float16)a; v[1] = (_Float16)b; return __builtin_bit_cast(unsigned, v); }
DI bf16_t f2h(float a) { return __builtin_bit_cast(unsigned short, (_Float16)a); }
DI float h2f(bf16_t v) { return (float)__builtin_bit_cast(_Float16, v); }
DI bf16_t f2bf(float a) { return __builtin_bit_cast(unsigned short, (__bf16)a); }
DI float bf2f(bf16_t v) { return __uint_as_float(((unsigned)v) << 16); }
DI int lane_id_() { int l; asm volatile("v_mbcnt_lo_u32_b32 %0, -1, 0\n\tv_mbcnt_hi_u32_b32 %0, -1, %0" : "=v"(l)); return l; }
DI void lds_barrier() { asm volatile("s_waitcnt lgkmcnt(0)\n\ts_barrier" ::: "memory"); }
DI float sigmoidf_(float v) { return __builtin_amdgcn_rcpf(1.0f + __builtin_amdgcn_exp2f(-1.4426950408889634f * v)); }


#define XB_TMO      128
#define XB_XCNT(j)  (256  + 64 * (j))
#define XB_XSUB(j)  (1280 + 64 * (j))
#define XB_XGEN(j)  (2304 + 64 * (j))
#define XB_TOP      3328
#define XB_TOPGEN   3392
#define XCD_BAR_WORDS 3456
#define XB_SPIN_CAP (1u << 20)
DI unsigned xb_ld(unsigned* p)              { return __hip_atomic_load(p, __ATOMIC_RELAXED, __HIP_MEMORY_SCOPE_AGENT); }
DI unsigned xb_add(unsigned* p, unsigned v) { return __hip_atomic_fetch_add(p, v, __ATOMIC_RELAXED, __HIP_MEMORY_SCOPE_AGENT); }
DI unsigned xb_xcc_id() { return (unsigned)__builtin_amdgcn_s_getreg((3 << 11) | 20) & 0xFu; }
#define XB_SPIN(cond, bar) do { unsigned _sp = 0; while (cond) { __builtin_amdgcn_s_sleep(1); \
    if ((++_sp & 255u) == 0u) { if (xb_ld(&(bar)[XB_TMO])) break; if (_sp > XB_SPIN_CAP) { atomicAdd(&(bar)[XB_TMO], 1u); break; } } } } while (0)
struct XcdBarrier { unsigned* bar; unsigned x; volatile LAS unsigned* st; };
DI XcdBarrier xcd_barrier_post(int wv, unsigned* bar, volatile LAS unsigned* st) {
  XcdBarrier b; b.bar = bar; b.x = xb_xcc_id(); b.st = st;
  if (wv == 0 && lane_id_() == 0) (void)xb_add(&bar[XB_XCNT(b.x)], 1u);
  return b;
}
DI void xcd_barrier_complete(unsigned* bar, unsigned x, unsigned& nloc, unsigned& nx) {
  const unsigned G = gridDim.x * gridDim.y * gridDim.z;
  unsigned sum, cnt, mine, sp = 0u;
  for (;;) {
    sum = 0u; cnt = 0u; mine = 0u;
#pragma unroll 1
    for (unsigned j = 0; j < 16; ++j) { const unsigned c = xb_ld(&bar[XB_XCNT(j)]); sum += c; cnt += (c > 0u) ? 1u : 0u; mine = (j == x) ? c : mine; }
    if (sum == G) break;
    __builtin_amdgcn_s_sleep(1);
    if ((++sp & 255u) == 0u) { if (xb_ld(&bar[XB_TMO])) break; if (sp > XB_SPIN_CAP) { atomicAdd(&bar[XB_TMO], 1u); break; } }
  }
  nloc = mine > 0u ? mine : 1u; nx = cnt > 0u ? cnt : 1u;
}
DI void xcd_barrier(int wv, const XcdBarrier& b) {
  asm volatile("s_waitcnt vmcnt(0)" ::: "memory");
  __syncthreads();
  if (wv == 0 && lane_id_() == 0) {
    unsigned* bar = b.bar;
    __builtin_amdgcn_s_waitcnt(0);
    unsigned nloc = b.st[0], nx = b.st[1];
    if (nloc == 0u) { xcd_barrier_complete(bar, b.x, nloc, nx); b.st[0] = nloc; b.st[1] = nx; }
    const unsigned old = xb_add(&bar[XB_XSUB(b.x)], 1u);
    const unsigned gen = old / nloc;
    if (old + 1u == (gen + 1u) * nloc) {
      __builtin_amdgcn_fence(__ATOMIC_RELEASE, "agent");
      asm volatile("s_waitcnt vmcnt(0)" ::: "memory");
      const unsigned og = xb_add(&bar[XB_TOP], 1u);
      const unsigned tg = og / nx;
      if (og + 1u == (tg + 1u) * nx) xb_add(&bar[XB_TOPGEN], 1u);
      else XB_SPIN(xb_ld(&bar[XB_TOPGEN]) == tg, bar);
      __builtin_amdgcn_fence(__ATOMIC_ACQUIRE, "agent");
      xb_add(&bar[XB_XGEN(b.x)], 1u);
      asm volatile("s_waitcnt vmcnt(0)" ::: "memory");
    } else {
      XB_SPIN(xb_ld(&bar[XB_XGEN(b.x)]) == gen, bar);
      __builtin_amdgcn_fence(__ATOMIC_ACQUIRE, "agent");
      asm volatile("s_waitcnt vmcnt(0)" ::: "memory");
    }
  }
  __syncthreads();
}

namespace pg8 {
constexpr int BM = 256, BK = 64, HALF = 128, HTB = HALF * BK * 2, STAGE_BYTES = 8 * HTB, NXCD = 8, WGM = 8;
DI int lds_byte(int r, int c) { const int st = (r >> 4) * 2 + (c >> 5), rr = r & 15, cc = c & 31, ob = rr * 64 + cc * 2; return st * 1024 + (ob ^ (((ob >> 9) & 1) << 5)); }
DI void stage_rc(int b, int& R, int& C) { const int st = b / 1024, sb = b % 1024, swz = sb ^ (((sb >> 9) & 1) << 5); R = (st >> 1) * 16 + swz / 64; C = (st & 1) * 32 + (swz % 64) / 2; }
struct Unit { int pm, pn; };
struct Gemm { const bf16_t* A; const bf16_t* Bt; int M, N, K; };
struct StaticOrder {
  int nM, nN, nwg, G, c;
  DI void init(int M, int N, int G_, int c_) { nM = M / BM; nN = N / BM; nwg = nM * nN; G = G_; c = c_; }
  DI bool next(int i, Unit& u) const {
    const long L = (long)i * G + c; if (L >= nwg) return false;
    int wgid = (int)L; { const int q = nwg / NXCD, r = nwg % NXCD, xcd = wgid % NXCD, off = wgid / NXCD; wgid = (xcd < r ? xcd * (q + 1) : r * (q + 1) + (xcd - r) * q) + off; }
    const int nig = WGM * nN, gid = wgid / nig, fm = gid * WGM, gsz = (nM - fm) < WGM ? (nM - fm) : WGM;
    u.pm = fm + ((wgid % nig) % gsz); u.pn = (wgid % nig) / gsz; return true;
  }
};
template <class Epi>
DI void gemm_phase(int wv, LAS unsigned char* lds, const Gemm g, const StaticOrder& S, const Epi& E) {
  int tid_ = wv * 64 + lane_id_(); asm volatile("" : "+v"(tid_)); const int tid = tid_, wid = __builtin_amdgcn_readfirstlane(tid >> 6), lane = tid & 63, wr = wid >> 2, wc = wid & 3, fr = lane & 15, fq = lane >> 4;
  const int K = g.K, nt = K / BK;
  unsigned voffA[2];
#pragma unroll
  for (int i = 0; i < 2; ++i) { int R, C; stage_rc(tid * 16 + i * 8192, R, C); voffA[i] = (unsigned)(R * K + C) * 2u; }
  const size_t kstep = (size_t)(BK * 2), hstep = (size_t)HALF * K * 2, tstep = 2 * hstep;
  const unsigned ldsw = (unsigned)wid * 1024u;
  const int aoff = lds_byte(wr * 64 + fr, fq * 8), boff = lds_byte(wc * 32 + fr, fq * 8);
#define PG8_SA(b, h) (((b) * 2 + (h)) * HTB)
#define PG8_SB(b, h) ((4 + (b) * 2 + (h)) * HTB)
#define PG8_STAGE(bufoff, gbase, voff) do { _Pragma("unroll") for (int _i = 0; _i < 2; ++_i) \
    __builtin_amdgcn_global_load_lds((const unsigned*)((const char*)(gbase) + (voff)[_i]), (LAS unsigned*)(lds + (bufoff) + ldsw + _i * 8192), 16, 0, 0); } while (0)
#define PG8_LDA(dst, b, h) do { _Pragma("unroll") for (int m = 0; m < 4; ++m) _Pragma("unroll") for (int k = 0; k < 2; ++k) dst[m][k] = *(const LAS bf16x8*)(lds + PG8_SA(b, h) + aoff + m * 2048 + k * 1024); } while (0)
#define PG8_LDB(dst, b, h) do { _Pragma("unroll") for (int n = 0; n < 2; ++n) _Pragma("unroll") for (int k = 0; k < 2; ++k) dst[n][k] = *(const LAS bf16x8*)(lds + PG8_SB(b, h) + boff + n * 2048 + k * 1024); } while (0)
#define PG8_MMA(ai, bj, At, Bt) do { __builtin_amdgcn_s_setprio(1); _Pragma("unroll") for (int m = 0; m < 4; ++m) _Pragma("unroll") for (int n = 0; n < 2; ++n) _Pragma("unroll") for (int k = 0; k < 2; ++k) \
    acc[ai][bj][m][n] = __builtin_amdgcn_mfma_f32_16x16x32_f16(__builtin_bit_cast(half8, Bt[n][k]), __builtin_bit_cast(half8, At[m][k]), acc[ai][bj][m][n], 0, 0, 0); __builtin_amdgcn_s_setprio(0); } while (0)
#define PG8_WAIT_V(n) asm volatile("s_waitcnt vmcnt(" #n ")" ::: "memory")
#define PG8_WAIT_L(n) asm volatile("s_waitcnt lgkmcnt(" #n ")" ::: "memory")
#define PG8_BAR __builtin_amdgcn_s_barrier()
#define PG8_SCHED __builtin_amdgcn_sched_barrier(0)
  Unit cur, nxt; int ui = 0;
  if (!S.next(0, cur)) return;
  f32x4 acc[2][2][4][2];
#pragma unroll
  for (int a = 0; a < 2; ++a)
#pragma unroll
    for (int b = 0; b < 2; ++b)
#pragma unroll
      for (int m = 0; m < 4; ++m)
#pragma unroll
        for (int n = 0; n < 2; ++n) acc[a][b][m][n] = (f32x4){0.f, 0.f, 0.f, 0.f};
  bf16x8 At[4][2], B0[2][2], B1[2][2];
  const char* cA = (const char*)g.A + (size_t)cur.pm * tstep; const char* cB = (const char*)g.Bt + (size_t)cur.pn * tstep;
  PG8_STAGE(PG8_SB(0, 0), cB, voffA); PG8_STAGE(PG8_SA(0, 0), cA, voffA); PG8_STAGE(PG8_SB(0, 1), cB + hstep, voffA); PG8_STAGE(PG8_SA(0, 1), cA + hstep, voffA);
  if (wr == 1) PG8_BAR;
  PG8_WAIT_V(4); PG8_BAR;
  PG8_STAGE(PG8_SB(1, 0), cB + kstep, voffA); PG8_STAGE(PG8_SA(1, 0), cA + kstep, voffA); PG8_STAGE(PG8_SB(1, 1), cB + hstep + kstep, voffA);
  PG8_WAIT_V(6); PG8_BAR;
  for (;;) {
    const bool has_next = S.next(ui + 1, nxt);
    const char* nA = has_next ? (const char*)g.A + (size_t)nxt.pm * tstep : cA; const char* nB = has_next ? (const char*)g.Bt + (size_t)nxt.pn * tstep : cB;
    for (int t = 0; t < nt; t += 2) {
      const bool last = (t == nt - 2);
      const char* a1 = cA + (size_t)(t + 1) * kstep;
      const char* a2 = last ? nA : cA + (size_t)(t + 2) * kstep; const char* b2 = last ? nB : cB + (size_t)(t + 2) * kstep;
      const char* a3 = a2 + kstep; const char* b3 = b2 + kstep;
      PG8_LDB(B0, 0, 0); PG8_SCHED; PG8_LDA(At, 0, 0); PG8_STAGE(PG8_SA(1, 1), a1 + hstep, voffA);
      PG8_WAIT_L(8); PG8_BAR; PG8_WAIT_L(0); PG8_MMA(0, 0, At, B0); PG8_BAR; PG8_SCHED;
      PG8_LDB(B1, 0, 1); PG8_STAGE(PG8_SB(0, 0), b2, voffA);
      PG8_BAR; PG8_WAIT_L(0); PG8_MMA(0, 1, At, B1); PG8_BAR;
      PG8_LDA(At, 0, 1); PG8_STAGE(PG8_SA(0, 0), a2, voffA);
      PG8_BAR; PG8_WAIT_L(0); PG8_MMA(1, 0, At, B0); PG8_BAR; PG8_SCHED;
      PG8_STAGE(PG8_SB(0, 1), b2 + hstep, voffA);
      PG8_WAIT_V(6); PG8_BAR; PG8_MMA(1, 1, At, B1); PG8_BAR;
      PG8_LDB(B0, 1, 0); PG8_SCHED; PG8_LDA(At, 1, 0); PG8_STAGE(PG8_SA(0, 1), a2 + hstep, voffA);
      PG8_WAIT_L(8); PG8_BAR; PG8_WAIT_L(0); PG8_MMA(0, 0, At, B0); PG8_BAR; PG8_SCHED;
      PG8_LDB(B1, 1, 1); PG8_STAGE(PG8_SB(1, 0), b3, voffA);
      PG8_BAR; PG8_WAIT_L(0); PG8_MMA(0, 1, At, B1); PG8_BAR;
      PG8_LDA(At, 1, 1); PG8_STAGE(PG8_SA(1, 0), a3, voffA);
      PG8_BAR; PG8_WAIT_L(0); PG8_MMA(1, 0, At, B0); PG8_BAR; PG8_SCHED;
      PG8_STAGE(PG8_SB(1, 1), b3 + hstep, voffA);
      PG8_WAIT_V(6); PG8_BAR; PG8_MMA(1, 1, At, B1); PG8_BAR;
    }
    for (int r_ = 0; r_ < E.reps; ++r_) E(acc, cur, wr, wc, fr, fq);
    if (!has_next) break;
#pragma unroll
    for (int a = 0; a < 2; ++a)
#pragma unroll
      for (int b = 0; b < 2; ++b)
#pragma unroll
        for (int m = 0; m < 4; ++m)
#pragma unroll
          for (int n = 0; n < 2; ++n) acc[a][b][m][n] = (f32x4){0.f, 0.f, 0.f, 0.f};
    cur = nxt; cA = nA; cB = nB; ++ui;
  }
  PG8_WAIT_V(0);
  if (wr == 0) PG8_BAR;
  PG8_BAR;
}
}
DI void row_affine(const float* stats, int row, float& a, float& bb, float& mu, float& rstd) {
  const float s = stats[2 * row], ss = stats[2 * row + 1]; mu = s * (1.0f / 1024.0f); const float var = fmaxf(ss * (1.0f / 1024.0f) - mu * mu, 0.f); rstd = rsqrtf(var + 1e-5f); a = rstd; bb = -rstd * mu;
}
struct EpiUp {
  bf16_t* H; const float* stats; const float* c1; const float* c2; int reps;
  DI void operator()(const f32x4 (&acc)[2][2][4][2], const pg8::Unit& u, int wr, int wc, int fr, int fq) const {
    const int colg = u.pn * 256 + wc * 32 + 8 * fq, hcol = u.pn * 128 + wc * 32 + 8 * fq;
    f32x4 c1g[2], c2g[2], c1u[2], c2u[2];
#pragma unroll
    for (int n = 0; n < 2; ++n) { c1g[n] = *(const f32x4*)(c1 + colg + 4 * n); c2g[n] = *(const f32x4*)(c2 + colg + 4 * n); c1u[n] = *(const f32x4*)(c1 + colg + 128 + 4 * n); c2u[n] = *(const f32x4*)(c2 + colg + 128 + 4 * n); }
    float ra[8], rb[8];
#pragma unroll
    for (int i = 0; i < 8; ++i) { float mu, rstd; row_affine(stats, u.pm * 256 + (i >> 2) * 128 + wr * 64 + (i & 3) * 16 + fr, ra[i], rb[i], mu, rstd); }
#pragma unroll
    for (int ai = 0; ai < 2; ++ai)
#pragma unroll
      for (int m = 0; m < 4; ++m) {
        const int row = u.pm * 256 + ai * 128 + wr * 64 + m * 16 + fr; const float a = ra[ai * 4 + m], bb = rb[ai * 4 + m];
        u32x4 w;
#pragma unroll
        for (int n = 0; n < 2; ++n) {
          const f32x4 gv = acc[ai][0][m][n] * a + c1g[n] * bb + c2g[n], uv = acc[ai][1][m][n] * a + c1u[n] * bb + c2u[n];
          float h[4];
#pragma unroll
          for (int j = 0; j < 4; ++j) h[j] = gv[j] * sigmoidf_(gv[j]) * uv[j];
          w[2 * n] = pkh2(h[0], h[1]); w[2 * n + 1] = pkh2(h[2], h[3]);
        }
        *(u32x4*)(H + (size_t)row * DFF + hcol) = w;
        asm volatile("" ::: "memory");
      }
  }
};
struct EpiRes {
  const float* stats_prev; const float* g; const float* b; float* stats_new; bf16_t* tb; float scale; int reps;
  DI void operator()(const f32x4 (&acc)[2][2][4][2], const pg8::Unit& u, int wr, int wc, int fr, int fq) const {
    const int col0 = u.pn * 256 + wc * 32 + 8 * fq;
    float rmu[8], rrs[8];
#pragma unroll
    for (int i = 0; i < 8; ++i) { float a, bb; row_affine(stats_prev, u.pm * 256 + (i >> 2) * 128 + wr * 64 + (i & 3) * 16 + fr, a, bb, rmu[i], rrs[i]); }
#pragma unroll
    for (int ai = 0; ai < 2; ++ai) {
      half8 tpv[4][2];
#pragma unroll
      for (int m = 0; m < 4; ++m)
#pragma unroll
        for (int bj = 0; bj < 2; ++bj) tpv[m][bj] = *(const half8*)(tb + (size_t)(u.pm * 256 + ai * 128 + wr * 64 + m * 16 + fr) * DM + col0 + bj * 128);
#pragma unroll
      for (int m = 0; m < 4; ++m) {
        const int row = u.pm * 256 + ai * 128 + wr * 64 + m * 16 + fr; const float mu = rmu[ai * 4 + m], rstd = rrs[ai * 4 + m];
        float rs = 0.f, rq = 0.f;
#pragma unroll
        for (int bj = 0; bj < 2; ++bj) {
          u32x4 w;
#pragma unroll
          for (int n = 0; n < 2; ++n) {
            f32x4 tp;
#pragma unroll
            for (int j = 0; j < 4; ++j) tp[j] = (float)tpv[m][bj][4 * n + j];
            tp = (tp - mu) * rstd * (*(const f32x4*)(g + col0 + bj * 128 + 4 * n)) + *(const f32x4*)(b + col0 + bj * 128 + 4 * n);
            const f32x4 tn = tp * ALPHA + acc[ai][bj][m][n] * scale;
            w[2 * n] = pkh2(tn[0], tn[1]); w[2 * n + 1] = pkh2(tn[2], tn[3]);
            rs += tn[0] + tn[1] + tn[2] + tn[3]; rq += tn[0] * tn[0] + tn[1] * tn[1] + tn[2] * tn[2] + tn[3] * tn[3];
          }
          *(u32x4*)(tb + (size_t)row * DM + col0 + bj * 128) = w;
        }
        rs += __shfl_xor(rs, 16); rs += __shfl_xor(rs, 32); rq += __shfl_xor(rq, 16); rq += __shfl_xor(rq, 32);
        if (fq == 0) { atomicAdd(stats_new + 2 * row, rs); atomicAdd(stats_new + 2 * row + 1, rq); }
      }
      asm volatile("" ::: "memory");
    }
  }
};
struct EpiIn {
  int mode; bf16_t* h; int ld; const float* stats; const float* c1; const float* c2; const float* lbv;
  bf16_t *hq, *hk, *hv, *hg; _Float16* hlf; int reps;
  template <int SECT>
  DI void body(const f32x4 (&acc)[2][2][4][2], const pg8::Unit& u, int wr, int wc, int fr, int fq) const {
    const int col0 = u.pn * 256 + wc * 32 + 8 * fq;
#pragma unroll
    for (int ai = 0; ai < 2; ++ai)
#pragma unroll
      for (int m = 0; m < 4; ++m) {
        const int row = u.pm * 256 + ai * 128 + wr * 64 + m * 16 + fr; float a, bb, mu, rstd; row_affine(stats, row, a, bb, mu, rstd);
#pragma unroll
        for (int bj = 0; bj < 2; ++bj) {
          const int col = col0 + bj * 128;
          f32x4 v[2];
#pragma unroll
          for (int n = 0; n < 2; ++n) v[n] = acc[ai][bj][m][n] * a + (*(const f32x4*)(c1 + col + 4 * n)) * bb + *(const f32x4*)(c2 + col + 4 * n);
          if (SECT < 0) { u32x4 w; w[0] = pk2(v[0][0], v[0][1]); w[1] = pk2(v[0][2], v[0][3]); w[2] = pk2(v[1][0], v[1][1]); w[3] = pk2(v[1][2], v[1][3]); *(u32x4*)(h + (size_t)row * ld + col) = w; }
          else {
            const int cc = col & 1023; const size_t off = (size_t)row * 1024 + cc;
            if (SECT == 0 || SECT == 3) { u32x4 w;
#pragma unroll
              for (int n = 0; n < 2; ++n) { w[2 * n] = pk2(v[n][0] * sigmoidf_(v[n][0]), v[n][1] * sigmoidf_(v[n][1])); w[2 * n + 1] = pk2(v[n][2] * sigmoidf_(v[n][2]), v[n][3] * sigmoidf_(v[n][3])); }
              *(u32x4*)((SECT == 0 ? hq : hg) + off) = w; }
            else if (SECT == 1) {
              typedef _Float16 h8 __attribute__((ext_vector_type(8))); h8 lf; u32x4 w;
#pragma unroll
              for (int n = 0; n < 2; ++n) { const f32x4 lb = *(const f32x4*)(lbv + cc + 4 * n); float kk[4];
#pragma unroll
                for (int j = 0; j < 4; ++j) { kk[j] = (1.0f - lb[j]) * __builtin_amdgcn_rcpf(1.0f + __builtin_amdgcn_exp2f(1.4426950408889634f * v[n][j])); lf[4 * n + j] = (_Float16)fmaxf(__logf(1.0f - kk[j]), -60.0f); }
                w[2 * n] = pk2(kk[0], kk[1]); w[2 * n + 1] = pk2(kk[2], kk[3]); }
              *(u32x4*)(hk + off) = w; *(h8*)(hlf + off) = lf;
            }
            else { u32x4 w; w[0] = pk2(v[0][0], v[0][1]); w[1] = pk2(v[0][2], v[0][3]); w[2] = pk2(v[1][0], v[1][1]); w[3] = pk2(v[1][2], v[1][3]); *(u32x4*)(hv + off) = w; }
          }
        }
        asm volatile("" ::: "memory");
      }
  }
  DI void operator()(const f32x4 (&acc)[2][2][4][2], const pg8::Unit& u, int wr, int wc, int fr, int fq) const {
    if (mode == 0) body<-1>(acc, u, wr, wc, fr, fq);
    else { const int sect = u.pn >> 2;
      if (sect == 0) body<0>(acc, u, wr, wc, fr, fq); else if (sect == 1) body<1>(acc, u, wr, wc, fr, fq); else if (sect == 2) body<2>(acc, u, wr, wc, fr, fq); else body<3>(acc, u, wr, wc, fr, fq); }
  }
};

DI void conv_strip(int wv, LAS unsigned char* lds, const float* src, int ldn, int K, int n0, int nvalid, bf16_t* dst, int dstrow0, const float* g, const float* b, float* c1, float* c2, bool perm = true, int kbeg = 0, int kend = -1) {
  if (kend < 0) kend = K;
  LAS bf16_t* tile = (LAS bf16_t*)lds;
  LAS float* red = (LAS float*)(lds + 64 * 72 * 2);
  int tid_ = wv * 64 + lane_id_(); asm volatile("" : "+v"(tid_)); const int tid = tid_, kr = tid >> 4, nc = (tid & 15) * 4;
  const bool colok = (n0 + nc) < nvalid;
  float s1[4] = {0.f, 0.f, 0.f, 0.f}, s2[4] = {0.f, 0.f, 0.f, 0.f};
  f32x4 w[2];
#pragma unroll
  for (int rr = 0; rr < 2; ++rr) w[rr] = colok ? *(const f32x4*)(src + (size_t)(kbeg + kr + rr * 32) * ldn + n0 + nc) : (f32x4){0.f, 0.f, 0.f, 0.f};
  for (int k0 = kbeg; k0 < kend; k0 += 64) {
    lds_barrier();
#pragma unroll
    for (int rr = 0; rr < 2; ++rr) { const int k = k0 + kr + rr * 32; const float gk = g ? g[k] : 1.0f, bk = b ? b[k] : 0.0f;
#pragma unroll
      for (int j = 0; j < 4; ++j) { const bf16_t v = perm ? f2h(w[rr][j] * gk) : f2bf(w[rr][j] * gk); tile[(nc + j) * 72 + kr + rr * 32] = v; s1[j] += perm ? h2f(v) : bf2f(v); s2[j] += bk * w[rr][j]; } }
    if (k0 + 64 < kend) {
#pragma unroll
      for (int rr = 0; rr < 2; ++rr) w[rr] = colok ? *(const f32x4*)(src + (size_t)(k0 + 64 + kr + rr * 32) * ldn + n0 + nc) : (f32x4){0.f, 0.f, 0.f, 0.f};
    }
    lds_barrier();
    { const int n = tid >> 3, kc = (tid & 7) * 8; const int cc = n & 31, slot = (n & 32) + (perm ? 16 * ((cc >> 2) & 1) + 4 * (cc >> 3) + (cc & 3) : cc);
      *(u32x4*)(dst + (size_t)(dstrow0 + slot) * K + k0 + kc) = *(const LAS u32x4*)(tile + n * 72 + kc); }
  }
  if (c1) {
    __syncthreads();
#pragma unroll
    for (int j = 0; j < 4; ++j) { red[kr * 64 + nc + j] = s1[j]; red[2048 + kr * 64 + nc + j] = s2[j]; }
    __syncthreads();
    if (tid < 128) { const int n = tid & 63, which = tid >> 6; float s = 0.f; for (int i = 0; i < 32; ++i) s += red[which * 2048 + i * 64 + n]; (which ? c2 : c1)[dstrow0 + n] = s; }
  }
  __syncthreads();
}

DI void convert_phase(int wv, const P& p_, int L, LAS unsigned char* lds) {
  P p = p_; { size_t z_ = 0; asm volatile("" : "+s"(z_)); p.ws = p_.ws + z_; }
  const int kind = L % 3, slot = L / 3;
  const int nin = kind == 0 ? 44 : (kind == 1 ? 64 : 20);
  const int njobs = 272 + nin + 16 + (kind == 0 ? 6 : 0);
  unsigned char* ws = p.ws;
  for (int j = blockIdx.x; j < njobs; j += gridDim.x) {
    if (j < 272) {
      const int f = j / 136, jj = j % 136;
      const float* lg = p.ln_gain + (size_t)(L * 3 + (f == 0 ? -1 : 1)) * DM; const float* lbias = p.ln_bias + (size_t)(L * 3 + (f == 0 ? -1 : 1)) * DM;
      const bool fold = !(L == 0 && f == 0);
      float* cbase = (float*)(ws + (f == 0 ? C_GU1 : C_GU2));
      if (jj < 88) {
        const int up = jj / 44, s = jj % 44, n0 = s * 64;
        const float* src = (f == 0 ? (up ? p.f1u : p.f1g) : (up ? p.f2u : p.f2g)) + (size_t)L * DM * DFF;
        conv_strip(wv, lds, src, DFF, DM, n0, DFF, (bf16_t*)(ws + (f == 0 ? W_GU1 : W_GU2)), (n0 >> 7) * 256 + (n0 & 127) + up * 128, fold ? lg : nullptr, fold ? lbias : nullptr, cbase, cbase + 5632);
      } else {
        const int s = (jj - 88) / 3, kc = (jj - 88) % 3;
        const float* src = (f == 0 ? p.f1d : p.f2d) + (size_t)L * DFF * DM;
        conv_strip(wv, lds, src, DM, DFF, s * 64, DM, (bf16_t*)(ws + (f == 0 ? W_D1 : W_D2)), s * 64, nullptr, nullptr, nullptr, nullptr, true, kc * 960, kc == 2 ? DFF : kc * 960 + 960);
      }
    } else if (j < 272 + nin) {
      const int s = j - 272; const float* lg = p.ln_gain + (size_t)(L * 3) * DM; const float* lbias = p.ln_bias + (size_t)(L * 3) * DM;
      const float* src = kind == 0 ? p.nsa_win + (size_t)slot * DM * 2608 : (kind == 1 ? p.hg_win + (size_t)slot * DM * 4096 : p.swa_win + (size_t)slot * DM * 1280);
      const int ldn = kind == 0 ? 2608 : (kind == 1 ? 4096 : 1280);
      float* cbase = (float*)(ws + C_IN);
      conv_strip(wv, lds, src, ldn, DM, s * 64, ldn, (bf16_t*)(ws + W_IN), s * 64, lg, lbias, cbase, cbase + 4096);
    } else if (j < 272 + nin + 16) {
      const int s = j - 272 - nin;
      const float* src = kind == 0 ? p.nsa_wout + (size_t)slot * DM * DM : (kind == 1 ? p.hg_wout + (size_t)slot * DM * DM : p.swa_wout + (size_t)slot * DM * DM);
      conv_strip(wv, lds, src, DM, DM, s * 64, DM, (bf16_t*)(ws + W_OUT), s * 64, nullptr, nullptr, nullptr, nullptr);
    } else {
      const int s = j - 272 - nin - 16;
      if (s < 4) { const int kv = s >> 1, st = s & 1; float* pb = (float*)(ws + C_POSB) + kv * 256;
        conv_strip(wv, lds, p.nsa_w1 + ((size_t)slot * 2 + kv) * 2048 * 128, 128, 2048, st * 64, 128, (bf16_t*)(ws + W_W1T) + (size_t)kv * 128 * 2048, st * 64, nullptr, p.nsa_pos + ((size_t)slot * 2 + kv) * 2048, pb + 128, pb, false); }
      else { const int kv = s - 4; conv_strip(wv, lds, p.nsa_w2 + ((size_t)slot * 2 + kv) * 128 * 64, 64, 128, 0, 64, (bf16_t*)(ws + W_W2T) + (size_t)kv * 64 * 128, 0, nullptr, nullptr, nullptr, nullptr, false); }
    }
  }
}

DI void init_phase(int wv, const P& p_) {
  P p = p_; { size_t z_ = 0; asm volatile("" : "+s"(z_)); p.ws = p_.ws + z_; }
  int tid_ = wv * 64 + lane_id_(); asm volatile("" : "+v"(tid_)); const size_t gtid = (size_t)blockIdx.x * 512 + tid_, gsz = (size_t)gridDim.x * 512;
  for (size_t i = gtid; i < (4 * MiB) / 16; i += gsz) ((f32x4*)(p.ws + WS_STATS))[i] = (f32x4){0.f, 0.f, 0.f, 0.f};
  for (size_t i = gtid; i < (size_t)MTOK; i += gsz) { ((float*)(p.ws + WS_DSTATS))[2 * i] = 0.f; ((float*)(p.ws + WS_DSTATS))[2 * i + 1] = 1024.0f * (1.0f - 1e-5f); }
  if (gtid < 13 * 1024) { ((float*)(p.ws + WS_G13))[gtid] = gtid < 1024 ? 1.0f : p.ln_gain[gtid - 1024]; ((float*)(p.ws + WS_B13))[gtid] = gtid < 1024 ? 0.0f : p.ln_bias[gtid - 1024]; }
  for (size_t i = gtid; i < (size_t)MTOK * DM / 4; i += gsz) { const f32x4 v = ((const f32x4*)p.x)[i]; u32x2 w; w.x = pkh2(v[0], v[1]); w.y = pkh2(v[2], v[3]); ((u32x2*)(p.ws + WS_TB))[i] = w; }
  if (gtid < 16 * 132) { const int hd = (int)gtid / 132, d = (int)gtid % 132; int bk;
    if (d < 16) bk = d; else { const float v = logf((float)d / 16.0f) / 2.0794415416798357f * 16.0f; bk = 16 + (int)v; if (bk > 31 || d >= 128) bk = 31; }
    ((float*)(p.ws + C_BTAB))[gtid] = p.rel_bias[bk * 16 + hd]; }
  if (gtid < 1024) { const float a0 = p.hg_lb[gtid], a1 = p.hg_lb[1024 + gtid], a2 = p.hg_lb[2048 + gtid], a3 = p.hg_lb[3072 + gtid];
    const float mx = fmaxf(fmaxf(a0, a1), fmaxf(a2, a3)); const float e0 = expf(a0 - mx), e1 = expf(a1 - mx), e2 = expf(a2 - mx), e3 = expf(a3 - mx);
    ((float*)(p.ws + C_LBV))[gtid] = e1 / (e0 + e1 + e2 + e3); }
}

DI void final_ln(int wv, const P& p_, const float* stats, const float* g, const float* b) {
  P p = p_; { size_t z_ = 0; asm volatile("" : "+s"(z_)); p.ws = p_.ws + z_; }
  int tid_ = wv * 64 + lane_id_(); asm volatile("" : "+v"(tid_)); const size_t gtid = (size_t)blockIdx.x * 512 + tid_, gsz = (size_t)gridDim.x * 512;
  for (size_t i = gtid; i < (size_t)MTOK * DM / 4; i += gsz) {
    const int row = (int)(i >> 8), c = (int)(i & 255) * 4; float a, bb, mu, rstd; row_affine(stats, row, a, bb, mu, rstd);
    const u32x2 hv = ((const u32x2*)(p.ws + WS_TB))[i]; typedef _Float16 h4 __attribute__((ext_vector_type(4))); const h4 hh = __builtin_bit_cast(h4, hv);
    const f32x4 v = {(float)hh[0], (float)hh[1], (float)hh[2], (float)hh[3]}; ((f32x4*)p.out)[i] = (v - mu) * rstd * (*(const f32x4*)(g + c)) + *(const f32x4*)(b + c);
  }
}
#define MFMA32(a, b, c) __builtin_amdgcn_mfma_f32_32x32x16_bf16((a), (b), (c), 0, 0, 0)
#define MFMA16(a, b, c) __builtin_amdgcn_mfma_f32_16x16x32_bf16((a), (b), (c), 0, 0, 0)
DI int crow(int reg, int h) { return (reg & 3) + 8 * (reg >> 2) + 4 * h; }
constexpr int KS_STRIDE = 72;

struct KVRegs { u32x4 k; bf16x8 v; };
DI void kv_load(KVRegs& r, const bf16_t* kg, const bf16_t* vg, size_t ldg, int tid) {
  asm volatile("" : "+v"(tid));
  const int key = tid >> 3, d8 = (tid & 7) * 8;
  r.k = *(const u32x4*)(kg + (size_t)key * ldg + d8); r.v = *(const bf16x8*)(vg + (size_t)key * ldg + d8);
}
DI void kv_store(const KVRegs& r, LAS bf16_t* Ks, LAS bf16_t* Vt, int vstride, int vcol0, int tid) {
  asm volatile("" : "+v"(tid));
  const int key = tid >> 3, d8 = (tid & 7) * 8;
  *(LAS u32x4*)(Ks + key * KS_STRIDE + d8) = r.k;
  const u32x4 vd = __builtin_bit_cast(u32x4, r.v);
  const bool odd = key & 1;
  const unsigned s0 = odd ? vd[0] : vd[2], s1 = odd ? vd[1] : vd[3];
  const unsigned x0 = (unsigned)__builtin_amdgcn_update_dpp(0, (int)s0, 0x128, 0xf, 0xf, false), x1 = (unsigned)__builtin_amdgcn_update_dpp(0, (int)s1, 0x128, 0xf, 0xf, false);
  const unsigned m0 = odd ? vd[2] : vd[0], m1 = odd ? vd[3] : vd[1];
  const unsigned lo0 = odd ? x0 : m0, hi0 = odd ? m0 : x0, lo1 = odd ? x1 : m1, hi1 = odd ? m1 : x1;
  LAS unsigned* vp = (LAS unsigned*)(Vt + (d8 + (odd ? 4 : 0)) * vstride + vcol0 + (key & ~1));
  const int rs = vstride >> 1;
  vp[0] = (lo0 & 0xffffu) | (hi0 << 16); vp[rs] = (lo0 >> 16) | (hi0 & 0xffff0000u);
  vp[2 * rs] = (lo1 & 0xffffu) | (hi1 << 16); vp[3 * rs] = (lo1 >> 16) | (hi1 & 0xffff0000u);
}
DI void attn_scores(const LAS bf16_t* Ks, const bf16x8 (&qf)[4], int r, int h, f32x16 (&s)[2]) {
#pragma unroll
  for (int sub = 0; sub < 2; ++sub) {
    f32x16 a;
#pragma unroll
    for (int i = 0; i < 16; ++i) a[i] = 0.f;
#pragma unroll
    for (int ks = 0; ks < 4; ++ks) { const bf16x8 kf = *(const LAS bf16x8*)(Ks + (sub * 32 + r) * KS_STRIDE + ks * 16 + 8 * h); a = MFMA32(kf, qf[ks], a); }
    s[sub] = a;
  }
}
constexpr float QK_SCALE2 = 0.125f * 1.4426950408889634f;
DI void attn_logits(f32x16 (&s)[2], int t, int tw, int nt, int h, int base, int stride, int dmax, bool ok, const LAS float* btl) {
  const int dmin = tw - (base + 63 * stride), dmaxw = tw + nt - 1 - base;
  const bool far = dmin >= 128, interior = dmin >= 0 && dmaxw < dmax;
  const float bfar = btl[128];
  if (far && interior) {
#pragma unroll
    for (int sub = 0; sub < 2; ++sub)
#pragma unroll
      for (int reg = 0; reg < 16; ++reg) s[sub][reg] = ok ? s[sub][reg] * QK_SCALE2 + bfar : -1e30f;
  } else if (far) {
#pragma unroll
    for (int sub = 0; sub < 2; ++sub)
#pragma unroll
      for (int reg = 0; reg < 16; ++reg) {
        const int kk = sub * 32 + crow(reg, h); const int d = t - (base + kk * stride);
        const bool valid = (d >= 0) && (d < dmax) && ok;
        s[sub][reg] = valid ? s[sub][reg] * QK_SCALE2 + bfar : -1e30f;
      }
  } else {
#pragma unroll
    for (int sub = 0; sub < 2; ++sub)
#pragma unroll
      for (int reg = 0; reg < 16; ++reg) {
        const int kk = sub * 32 + crow(reg, h); const int d = t - (base + kk * stride);
        const bool valid = (d >= 0) && (d < dmax) && ok;
        const int di = d < 0 ? 0 : (d > 128 ? 128 : d);
        const float bsv = btl[di];
        const float x = s[sub][reg] * QK_SCALE2 + bsv;
        s[sub][reg] = valid ? x : -1e30f;
      }
  }
}
DI void attn_pv(const LAS bf16_t* Vt, int vstride, const f32x16 (&p)[2], f32x16 (&O)[2], int r, int h) {
#pragma unroll
  for (int sub = 0; sub < 2; ++sub)
#pragma unroll
    for (int s2 = 0; s2 < 2; ++s2) {
      u32x4 pp;
#pragma unroll
      for (int j = 0; j < 4; ++j) pp[j] = pk2(p[sub][8 * s2 + 2 * j], p[sub][8 * s2 + 2 * j + 1]);
      const bf16x8 pf = __builtin_bit_cast(bf16x8, pp);
#pragma unroll
      for (int dt = 0; dt < 2; ++dt) {
        const LAS bf16_t* vp = Vt + (dt * 32 + r) * vstride + sub * 32 + 16 * s2 + 4 * h;
        const s16x4 lo = *(const LAS s16x4*)vp, hi = *(const LAS s16x4*)(vp + 8);
        const bf16x8 vf = __builtin_shufflevector(lo, hi, 0, 1, 2, 3, 4, 5, 6, 7);
        O[dt] = MFMA32(vf, pf, O[dt]);
      }
    }
}
template <bool WITH_O>
DI void attn_online(f32x16 (&s)[2], float& m, float& l, f32x16 (&O)[2]) {
  float mx = -1e30f;
#pragma unroll
  for (int sub = 0; sub < 2; ++sub)
#pragma unroll
    for (int reg = 0; reg < 16; ++reg) mx = fmaxf(mx, s[sub][reg]);
  mx = fmaxf(mx, __shfl_xor(mx, 32));
  const float mn = fmaxf(m, mx);
  const bool grow = mn > m;
  float ls = 0.f;
#pragma unroll
  for (int sub = 0; sub < 2; ++sub)
#pragma unroll
    for (int reg = 0; reg < 16; ++reg) { const float e = __builtin_amdgcn_exp2f(s[sub][reg] - mn); s[sub][reg] = e; ls += e; }
  if (__any(grow)) {
    const float al = __builtin_amdgcn_exp2f(m - mn); m = mn;
    l = l * al + ls;
    if (WITH_O) {
#pragma unroll
      for (int dt = 0; dt < 2; ++dt)
#pragma unroll
        for (int reg = 0; reg < 16; ++reg) O[dt][reg] *= al;
    }
  } else l += ls;
}
DI void attn_tile(const LAS bf16_t* Ks, const LAS bf16_t* Vt, int vstride, const bf16x8 (&qf)[4], f32x16 (&O)[2], float& m, float& l,
                  int t, int tw, int nt, int r, int h, int base, int stride, int dmax, bool ok, const LAS float* btl) {
  f32x16 s[2];
  attn_scores(Ks, qf, r, h, s);
  const int dmin = tw - (base + 63 * stride), dmaxw = tw + nt - 1 - base;
  float mn, ls = 0.f;
  if (dmin >= 128 && dmaxw < dmax) {
    const float cl = ok ? QK_SCALE2 : 0.f, bl = ok ? btl[128] : -1e30f;
    float mr = -3e38f;
#pragma unroll
    for (int sub = 0; sub < 2; ++sub)
#pragma unroll
      for (int reg = 0; reg < 16; ++reg) mr = fmaxf(mr, s[sub][reg]);
    float mx = mr * cl + bl; mx = fmaxf(mx, __shfl_xor(mx, 32));
    mn = fmaxf(m, mx);
    const float off = bl - mn;
#pragma unroll
    for (int sub = 0; sub < 2; ++sub)
#pragma unroll
      for (int reg = 0; reg < 16; ++reg) { const float e = __builtin_amdgcn_exp2f(s[sub][reg] * cl + off); s[sub][reg] = e; ls += e; }
  } else {
    attn_logits(s, t, tw, nt, h, base, stride, dmax, ok, btl);
    float mx = -1e30f;
#pragma unroll
    for (int sub = 0; sub < 2; ++sub)
#pragma unroll
      for (int reg = 0; reg < 16; ++reg) mx = fmaxf(mx, s[sub][reg]);
    mx = fmaxf(mx, __shfl_xor(mx, 32));
    mn = fmaxf(m, mx);
#pragma unroll
    for (int sub = 0; sub < 2; ++sub)
#pragma unroll
      for (int reg = 0; reg < 16; ++reg) { const float e = __builtin_amdgcn_exp2f(s[sub][reg] - mn); s[sub][reg] = e; ls += e; }
  }
  if (__any(mn > m)) {
    const float al = __builtin_amdgcn_exp2f(m - mn); m = mn;
    l = l * al + ls;
#pragma unroll
    for (int dt = 0; dt < 2; ++dt)
#pragma unroll
      for (int reg = 0; reg < 16; ++reg) O[dt][reg] *= al;
  } else l += ls;
  attn_pv(Vt, vstride, s, O, r, h);
}
DI void zero_o(f32x16 (&O)[2]) {
#pragma unroll
  for (int dt = 0; dt < 2; ++dt)
#pragma unroll
    for (int reg = 0; reg < 16; ++reg) O[dt][reg] = 0.f;
}

DI void nsa_compress_phase(int wv, const P& p_, LAS unsigned char* lds) {
  P p = p_; { size_t z_ = 0; asm volatile("" : "+s"(z_)); p.ws = p_.ws + z_; }
  const bf16_t* hb = (const bf16_t*)(p.ws + WS_BIG); const int ld = 2816;
  int tid_ = wv * 64 + lane_id_(); asm volatile("" : "+v"(tid_)); const int tid = tid_, wid = wv, lane = tid & 63, fr = lane & 15, fq = lane >> 4;
  const int pw = wid & 3, half = wid >> 2;
  LAS bf16_t* hid = (LAS bf16_t*)lds + pw * 16 * 136;
  LAS f32x4* part = (LAS f32x4*)(lds + 32768) + pw * 8 * 64;
  for (int base = blockIdx.x * 4; base < 1024; base += gridDim.x * 4) {
    const int task = base + pw;
    const int kv = task >> 9, b = (task >> 6) & 7, g = (task >> 4) & 3, n0 = (task & 15) * 16;
    const bf16_t* w1t = (const bf16_t*)(p.ws + W_W1T) + (size_t)kv * 128 * 2048; const bf16_t* w2t = (const bf16_t*)(p.ws + W_W2T) + (size_t)kv * 64 * 128;
    const float* posb = (const float*)(p.ws + C_POSB) + kv * 256;
    const int colb = 1024 + kv * 256 + g * 64;
    int n = n0 + fr; if (n > 254) n = 254;
    f32x4 acc[8];
#pragma unroll
    for (int i = 0; i < 8; ++i) acc[i] = (f32x4){0.f, 0.f, 0.f, 0.f};
#pragma unroll 2
    for (int l = 16 * half; l < 16 * half + 16; ++l) {
#pragma unroll
      for (int dk = 0; dk < 2; ++dk) {
        const bf16x8 af = *(const bf16x8*)(hb + (size_t)(b * SEQ + 16 * n + l) * ld + colb + dk * 32 + fq * 8);
#pragma unroll
        for (int nt = 0; nt < 8; ++nt) { const bf16x8 bfr = *(const bf16x8*)(w1t + (size_t)(nt * 16 + fr) * 2048 + l * 64 + dk * 32 + fq * 8); acc[nt] = MFMA16(af, bfr, acc[nt]); }
      }
    }
    if (half) {
#pragma unroll
      for (int nt = 0; nt < 8; ++nt) part[nt * 64 + lane] = acc[nt];
    }
    __syncthreads();
    if (!half) {
#pragma unroll
      for (int nt = 0; nt < 8; ++nt) { const float pbv = posb[nt * 16 + fr]; const f32x4 o2 = part[nt * 64 + lane];
#pragma unroll
        for (int j = 0; j < 4; ++j) { const float v = acc[nt][j] + o2[j] + pbv; const float u = 0.7978845608028654f * (v + 0.044715f * v * v * v); const float th = 1.0f - 2.0f * __builtin_amdgcn_rcpf(1.0f + __expf(2.0f * u));
          hid[(4 * fq + j) * 136 + nt * 16 + fr] = f2bf(0.5f * v * (1.0f + th)); } }
    }
    __syncthreads();
    if (!half) {
      f32x4 o[4];
#pragma unroll
      for (int i = 0; i < 4; ++i) o[i] = (f32x4){0.f, 0.f, 0.f, 0.f};
#pragma unroll
      for (int ks = 0; ks < 4; ++ks) { const bf16x8 af = *(const LAS bf16x8*)(hid + fr * 136 + ks * 32 + fq * 8);
#pragma unroll
        for (int nt = 0; nt < 4; ++nt) { const bf16x8 bfr = *(const bf16x8*)(w2t + (size_t)(nt * 16 + fr) * 128 + ks * 32 + fq * 8); o[nt] = MFMA16(af, bfr, o[nt]); } }
      bf16_t* dst = (bf16_t*)(p.ws + (kv ? WS_VC : WS_KC)) + (size_t)((b * 4 + g) * 256) * 64;
#pragma unroll
      for (int nt = 0; nt < 4; ++nt)
#pragma unroll
        for (int j = 0; j < 4; ++j) { const int nn = n0 + 4 * fq + j; dst[(size_t)nn * 64 + nt * 16 + fr] = nn > 254 ? (bf16_t)0 : f2bf(o[nt][j]); }
    }
    __syncthreads();
  }
}

DI void nsa_attn_phase(int wv, const P& p_, LAS unsigned char* lds) {
  P p = p_; { size_t z_ = 0; asm volatile("" : "+s"(z_)); p.ws = p_.ws + z_; }
  const bf16_t* hb = (const bf16_t*)(p.ws + WS_BIG); const int ld = 2816;
  bf16_t* ob = (bf16_t*)(p.ws + WS_O);
  LAS bf16_t* KsB[2] = {(LAS bf16_t*)lds, (LAS bf16_t*)(lds + 17920)}; LAS bf16_t* VtB[2] = {(LAS bf16_t*)(lds + 9216), (LAS bf16_t*)(lds + 17920 + 9216)};
  LAS bf16_t* KC = (LAS bf16_t*)(lds + 35840); LAS bf16_t* VCT = (LAS bf16_t*)(lds + 72704);
  LAS float* OUTL = (LAS float*)(lds + 35840);
  LAS float* G4s = (LAS float*)(lds + 105984); LAS float* Lsm = (LAS float*)(lds + 122368); LAS float* BT = (LAS float*)(lds + 138752);
  LAS unsigned* SELM = (LAS unsigned*)(lds + 140864); LAS unsigned* UNI = (LAS unsigned*)(lds + 141376);
  for (int it = blockIdx.x; it < 2048; it += gridDim.x) {
    int tid_ = wv * 64 + lane_id_(); asm volatile("" : "+v"(tid_)); const int tid = tid_, wid = wv, lane = tid & 63, r = lane & 31, h = lane >> 5, tl = r >> 2, hd = r & 3;
    const int c = it & 255, ii = it >> 8, bg = c >> 3, b = bg >> 2, g = bg & 3, j8 = c & 7;
    const int qi = (ii & 1) ? (16 * (ii >> 1) + 15 - j8) : (16 * (ii >> 1) + j8);
    const int t0 = 64 * qi, tw = t0 + 8 * wid, t = tw + tl, head = g * 4 + hd;
    const int nct = (4 * qi + 2) / 64 + 1;
    __syncthreads();
    { KVRegs ka, kb; const bf16_t* kcg = (const bf16_t*)(p.ws + WS_KC) + (size_t)((b * 4 + g) * 256) * 64; const bf16_t* vcg = (const bf16_t*)(p.ws + WS_VC) + (size_t)((b * 4 + g) * 256) * 64;
      kv_load(ka, kcg, vcg, 64, tid); if (nct > 1) kv_load(kb, kcg + 64 * 64, vcg + 64 * 64, 64, tid);
      kv_store(ka, KC, VCT, 260, 0, tid); if (nct > 1) kv_store(kb, KC + 64 * KS_STRIDE, VCT, 260, 64, tid);
      if (nct > 2) { kv_load(ka, kcg + 128 * 64, vcg + 128 * 64, 64, tid); if (nct > 3) kv_load(kb, kcg + 192 * 64, vcg + 192 * 64, 64, tid);
        kv_store(ka, KC + 128 * KS_STRIDE, VCT, 260, 128, tid); if (nct > 3) kv_store(kb, KC + 192 * KS_STRIDE, VCT, 260, 192, tid); } }
    for (int i = tid; i < 4 * 132; i += 512) BT[i] = ((const float*)(p.ws + C_BTAB))[g * 4 * 132 + i] * 1.4426950408889634f;
    if (tid < 128) SELM[tid] = 0u; if (tid < 2) UNI[tid] = 0u;
    bf16x8 qf[4];
#pragma unroll
    for (int ks = 0; ks < 4; ++ks) qf[ks] = *(const bf16x8*)(hb + (size_t)(b * SEQ + t) * ld + head * 64 + ks * 16 + 8 * h);
    const size_t rowoff = (size_t)(b * SEQ + t) * ld;
    const float gc = sigmoidf_(bf2f(hb[rowoff + 2560 + head * 3 + 0])), gs = sigmoidf_(bf2f(hb[rowoff + 2560 + head * 3 + 1])), gw = sigmoidf_(bf2f(hb[rowoff + 2560 + head * 3 + 2]));
    const LAS float* btl = BT + hd * 132;
    KVRegs kvr; { const size_t go = (size_t)(b * SEQ) * ld + g * 64; kv_load(kvr, hb + go + 1536, hb + go + 1792, ld, tid); }
    __syncthreads();
    f32x16 O[2];
    float m = -1e30f, l = 0.f;
#pragma unroll 1
    for (int tile = 0; tile < nct; ++tile) { f32x16 s[2]; attn_scores(KC + tile * 64 * KS_STRIDE, qf, r, h, s); attn_logits(s, t, tw, 8, h, 16 * (tile * 64) + 31, 16, 0x7fffffff, true, btl); attn_online<false>(s, m, l, O); }
    { const float lt = l + __shfl_xor(l, 32); const float inv = (m > -1e29f && lt > 0.f) ? 1.0f / lt : 0.f;
      zero_o(O);
#pragma unroll 1
      for (int tile = 0; tile < nct; ++tile) {
        f32x16 s[2]; attn_scores(KC + tile * 64 * KS_STRIDE, qf, r, h, s); attn_logits(s, t, tw, 8, h, 16 * (tile * 64) + 31, 16, 0x7fffffff, true, btl);
        LAS float* gp = G4s + (8 * wid + tl) * 64 + 16 * tile + h; asm volatile("" : "+v"(gp));
#pragma unroll
        for (int sub = 0; sub < 2; ++sub) {
#pragma unroll
          for (int reg = 0; reg < 16; ++reg) { const float v = s[sub][reg]; s[sub][reg] = v > -1e29f ? __builtin_amdgcn_exp2f(v - m) * inv : 0.f; }
#pragma unroll
          for (int lg = 0; lg < 4; ++lg) { float G = s[sub][4 * lg] + s[sub][4 * lg + 1] + s[sub][4 * lg + 2] + s[sub][4 * lg + 3], Lv = s[sub][4 * lg + 3];
            G += __shfl_xor(G, 1); G += __shfl_xor(G, 2); Lv += __shfl_xor(Lv, 1); Lv += __shfl_xor(Lv, 2);
            if (hd == 0) { gp[8 * sub + 2 * lg] = G; gp[4096 + 8 * sub + 2 * lg] = Lv; } }
        }
        attn_pv(VCT + tile * 64, 260, s, O, r, h);
      }
    }
    __syncthreads();
#pragma unroll
    for (int dt = 0; dt < 2; ++dt)
#pragma unroll
      for (int reg = 0; reg < 16; ++reg) OUTL[(dt * 16 + reg) * 512 + tid] = gc * O[dt][reg];
    if (qi < 16) { const unsigned long long full = (qi == 63) ? ~0ull : ((1ull << (qi + 1)) - 1ull);
      int tsel = tid; asm volatile("" : "+v"(tsel));
      if (tsel < 64) { SELM[2 * tsel] = (unsigned)full; SELM[2 * tsel + 1] = (unsigned)(full >> 32); } if (tsel == 0) { UNI[0] = (unsigned)full; UNI[1] = (unsigned)(full >> 32); } }
    else {
      int tsel = tid; asm volatile("" : "+v"(tsel));
      const int tok = tsel >> 3, jj = tsel & 7, hiJ = qi - 2;
#pragma unroll
      for (int e = 0; e < 8; ++e) { const int j = jj * 8 + e; if (j >= 1 && j <= hiJ) G4s[tok * 64 + j] += Lsm[tok * 64 + j - 1]; }
      __syncthreads();
      float mine[8]; int cnt[8];
#pragma unroll
      for (int e = 0; e < 8; ++e) { const int j = jj * 8 + e; mine[e] = (j >= 1 && j <= hiJ) ? G4s[tok * 64 + j] : 0.f; cnt[e] = 0; }
      for (int j2 = 1; j2 <= hiJ; ++j2) { const float v = G4s[tok * 64 + j2];
#pragma unroll
        for (int e = 0; e < 8; ++e) { const int j = jj * 8 + e; cnt[e] += (v > mine[e] || (v == mine[e] && j2 < j)) ? 1 : 0; } }
      unsigned long long bits = 0ull;
#pragma unroll
      for (int e = 0; e < 8; ++e) { const int j = jj * 8 + e; if (j >= 1 && j <= hiJ && cnt[e] < 13) bits |= 1ull << j; }
      if (jj == 0) bits |= 1ull | (1ull << qi) | (1ull << (qi - 1));
      const unsigned blo = (unsigned)bits, bhi = (unsigned)(bits >> 32);
      if (blo) { atomicOr((unsigned*)&SELM[2 * tok], blo); atomicOr((unsigned*)&UNI[0], blo); }
      if (bhi) { atomicOr((unsigned*)&SELM[2 * tok + 1], bhi); atomicOr((unsigned*)&UNI[1], bhi); }
    }
    __syncthreads();
    int buf = 0;
    { const unsigned long long selm = (unsigned long long)SELM[2 * (8 * wid + tl)] | ((unsigned long long)SELM[2 * (8 * wid + tl) + 1] << 32);
      unsigned long long rem = (unsigned long long)UNI[0] | ((unsigned long long)UNI[1] << 32);
      m = -1e30f; l = 0.f; zero_o(O);
      const int jw0 = qi > 8 ? qi - 8 : 0;
#pragma unroll 1
      while (rem) {
        const int j = __builtin_ctzll(rem); rem &= rem - 1ull;
        kv_store(kvr, KsB[buf], VtB[buf], 68, 0, tid);
        __syncthreads();
        { const bool more = rem != 0ull; const int jn = more ? __builtin_ctzll(rem) : jw0;
          const size_t go = (size_t)(b * SEQ + jn * 64) * ld + g * 64; kv_load(kvr, hb + go + (more ? 1536 : 2048), hb + go + (more ? 1792 : 2304), ld, tid); }
        attn_tile(KsB[buf], VtB[buf], 68, qf, O, m, l, t, tw, 8, r, h, j * 64, 1, 0x7fffffff, ((selm >> j) & 1ull) != 0ull, btl);
        buf ^= 1;
      }
      const float lt = l + __shfl_xor(l, 32); const float sc = lt > 0.f ? gs / lt : 0.f;
#pragma unroll
      for (int dt = 0; dt < 2; ++dt)
#pragma unroll
        for (int reg = 0; reg < 16; ++reg) OUTL[(dt * 16 + reg) * 512 + tid] += sc * O[dt][reg];
    }
    { m = -1e30f; l = 0.f; zero_o(O);
#pragma unroll 1
      for (int j = (qi > 8 ? qi - 8 : 0); j <= qi; ++j) {
        kv_store(kvr, KsB[buf], VtB[buf], 68, 0, tid);
        __syncthreads();
        if (j < qi) { const size_t go = (size_t)(b * SEQ + (j + 1) * 64) * ld + g * 64; kv_load(kvr, hb + go + 2048, hb + go + 2304, ld, tid); }
        attn_tile(KsB[buf], VtB[buf], 68, qf, O, m, l, t, tw, 8, r, h, j * 64, 1, 512, true, btl);
        buf ^= 1;
      }
      const float lt = l + __shfl_xor(l, 32); const float sc = lt > 0.f ? gw / lt : 0.f;
#pragma unroll
      for (int dt = 0; dt < 2; ++dt)
#pragma unroll
        for (int reg = 0; reg < 16; ++reg) O[dt][reg] = OUTL[(dt * 16 + reg) * 512 + tid] + sc * O[dt][reg];
    }
    bf16_t* op = ob + (size_t)(b * SEQ + t) * DM + head * 64;
#pragma unroll
    for (int dt = 0; dt < 2; ++dt)
#pragma unroll
      for (int i4 = 0; i4 < 4; ++i4) { u32x2 w; w.x = pkh2(O[dt][4 * i4], O[dt][4 * i4 + 1]); w.y = pkh2(O[dt][4 * i4 + 2], O[dt][4 * i4 + 3]); *(u32x2*)(op + dt * 32 + 8 * i4 + 4 * h) = w; }
  }
}

DI void swa_attn_phase(int wv, const P& p_, int slot, LAS unsigned char* lds) {
  P p = p_; { size_t z_ = 0; asm volatile("" : "+s"(z_)); p.ws = p_.ws + z_; }
  const bf16_t* hb = (const bf16_t*)(p.ws + WS_BIG); const int ld = 1280;
  bf16_t* ob = (bf16_t*)(p.ws + WS_O);
  LAS bf16_t* KsB[2] = {(LAS bf16_t*)lds, (LAS bf16_t*)(lds + 17920)}; LAS bf16_t* VtB[2] = {(LAS bf16_t*)(lds + 9216), (LAS bf16_t*)(lds + 17920 + 9216)};
  LAS float* BT = (LAS float*)(lds + 35840);
  int tid_ = wv * 64 + lane_id_(); asm volatile("" : "+v"(tid_)); const int tid = tid_, wid = tid >> 6, lane = tid & 63, r = lane & 31, h = lane >> 5, tl = r >> 3, hd = r & 7;
  int buf = 0;
  for (int it = blockIdx.x; it < 2048; it += gridDim.x) {
    const int b = it >> 8, kv = (it >> 7) & 1, t0 = (it & 127) * 32;
    const int tw = t0 + 4 * wid, t = tw + tl, head = kv * 8 + hd;
    const int lo = t0 - 127, first = lo <= 0 ? 0 : (lo >> 6), last = (t0 + 31) >> 6;
    KVRegs kvr; { const size_t go = (size_t)(b * SEQ + first * 64) * ld + kv * 64; kv_load(kvr, hb + go + 1024, hb + go + 1152, ld, tid); }
    __syncthreads();
    for (int i = tid; i < 8 * 132; i += 512) BT[i] = ((const float*)(p.ws + C_BTAB))[kv * 8 * 132 + i] * 1.4426950408889634f;
    const size_t rowoff = (size_t)(b * SEQ + t) * ld;
    bf16x8 qf[4];
#pragma unroll
    for (int ks = 0; ks < 4; ++ks) qf[ks] = *(const bf16x8*)(hb + rowoff + head * 64 + ks * 16 + 8 * h);
    const LAS float* btl = BT + hd * 132;
    float m = p.swa_sinks[slot * 16 + head] * 1.4426950408889634f, l = (h == 0) ? 1.0f : 0.0f;
    f32x16 O[2]; zero_o(O);
#pragma unroll 1
    for (int j = first; j <= last; ++j) {
      kv_store(kvr, KsB[buf], VtB[buf], 68, 0, tid);
      __syncthreads();
      if (j < last) { const size_t go = (size_t)(b * SEQ + (j + 1) * 64) * ld + kv * 64; kv_load(kvr, hb + go + 1024, hb + go + 1152, ld, tid); }
      attn_tile(KsB[buf], VtB[buf], 68, qf, O, m, l, t, tw, 4, r, h, j * 64, 1, 128, true, btl);
      buf ^= 1;
    }
    const float lt = l + __shfl_xor(l, 32); const float sc = 1.0f / lt;
    bf16_t* op = ob + (size_t)(b * SEQ + t) * DM + head * 64;
#pragma unroll
    for (int dt = 0; dt < 2; ++dt)
#pragma unroll
      for (int i4 = 0; i4 < 4; ++i4) { u32x2 w; w.x = pkh2(sc * O[dt][4 * i4], sc * O[dt][4 * i4 + 1]); w.y = pkh2(sc * O[dt][4 * i4 + 2], sc * O[dt][4 * i4 + 3]); *(u32x2*)(op + dt * 32 + 8 * i4 + 4 * h) = w; }
  }
}
constexpr size_t HG_Q = WS_BIG, HG_K = WS_BIG + 64 * MiB, HG_V = WS_BIG + 128 * MiB, HG_G = WS_BIG + 192 * MiB, HG_LF = WS_BIG + 256 * MiB;
DI void hgrn_scan_phase(int wv, const P& p_, LAS unsigned char* lds, float* sumsq) {
  P p = p_; { size_t z_ = 0; asm volatile("" : "+s"(z_)); p.ws = p_.ws + z_; }
  const bf16_t* hq = (const bf16_t*)(p.ws + HG_Q); const bf16_t* hk = (const bf16_t*)(p.ws + HG_K); const bf16_t* hv = (const bf16_t*)(p.ws + HG_V);
  const _Float16* hlf = (const _Float16*)(p.ws + HG_LF);
  bf16_t* oraw = (bf16_t*)p.out;
  LAS bf16_t* Q = (LAS bf16_t*)lds; LAS bf16_t* Kr = (LAS bf16_t*)(lds + 17408); LAS float* BC = (LAS float*)(lds + 34816); LAS bf16_t* KDT = (LAS bf16_t*)(lds + 68608);
  LAS bf16_t* VT = (LAS bf16_t*)(lds + 87040); LAS bf16_t* ST = (LAS bf16_t*)(lds + 91648); LAS bf16_t* AB = (LAS bf16_t*)(lds + 100352);
  LAS float* SEG = (LAS float*)(lds + 109568); LAS float* DEC = (LAS float*)(lds + 111616); LAS _Float16* LF = (LAS _Float16*)(lds + 112128);
  int tid_ = wv * 64 + lane_id_(); asm volatile("" : "+v"(tid_)); const int tid = tid_, wid = tid >> 6, lane = tid & 63, fr = lane & 15, fq = lane >> 4;
  for (int it = blockIdx.x; it < 256; it += gridDim.x) {
    const int b = it >> 5, hh = (it >> 2) & 7, vq = it & 3;
    __syncthreads();
    for (int i = tid; i < 32 * 136 / 2; i += 512) ((LAS unsigned*)ST)[i] = 0u;
    f32x4 sreg[2]; sreg[0] = (f32x4){0.f, 0.f, 0.f, 0.f}; sreg[1] = sreg[0];
    u32x4 pq[2], pkk[2], plf[2], pv;
    const size_t gb = (size_t)(b * SEQ) * 1024 + hh * 128;
    auto prefetch = [&](int c) {
#pragma unroll
      for (int i = 0; i < 2; ++i) { const int idx = tid + 512 * i, row = idx >> 4, c8 = (idx & 15) * 8; const size_t off = gb + (size_t)(c * 64 + row) * 1024 + c8;
        pq[i] = *(const u32x4*)(hq + off); pkk[i] = *(const u32x4*)(hk + off); plf[i] = *(const u32x4*)(hlf + off); }
      if (tid < 256) { const int row = tid >> 2, c8 = (tid & 3) * 8; pv = *(const u32x4*)(hv + gb + (size_t)(c * 64 + row) * 1024 + vq * 32 + c8); }
    };
    prefetch(0);
    for (int c = 0; c < 64; ++c) {
      lds_barrier();
#pragma unroll
      for (int i = 0; i < 2; ++i) { const int idx = tid + 512 * i, row = idx >> 4, c8 = (idx & 15) * 8;
        *(LAS u32x4*)(Q + row * 136 + c8) = pq[i]; *(LAS u32x4*)(Kr + row * 136 + c8) = pkk[i]; *(LAS u32x4*)(LF + row * 128 + c8) = plf[i]; }
      if (tid < 256) { const int row = tid >> 2, c8 = (tid & 3) * 8; const bf16x8 vv = __builtin_bit_cast(bf16x8, pv);
#pragma unroll
        for (int i = 0; i < 8; ++i) VT[(c8 + i) * 72 + row] = (bf16_t)vv[i]; }
      if (c + 1 < 64) prefetch(c + 1);
      lds_barrier();
      const int kx = tid & 127, seg = tid >> 7;
      float bl[16];
      { float run = 0.f;
#pragma unroll
        for (int i = 0; i < 16; ++i) { run += (float)LF[(16 * seg + i) * 128 + kx]; bl[i] = run; }
        SEG[seg * 128 + kx] = run; }
      lds_barrier();
      { float pre = 0.f, blast = 0.f;
#pragma unroll
        for (int s2 = 0; s2 < 4; ++s2) { const float v = SEG[s2 * 128 + kx]; blast += v; if (s2 < seg) pre += v; }
        u32x4 w0, w1; float kd[16];
#pragma unroll
        for (int i = 0; i < 16; ++i) { const float bc = pre + bl[i]; BC[(16 * seg + i) * 132 + kx] = bc; kd[i] = bf2f(Kr[(16 * seg + i) * 136 + kx]) * __expf(blast - bc); }
#pragma unroll
        for (int j = 0; j < 4; ++j) { w0[j] = pk2(kd[2 * j], kd[2 * j + 1]); w1[j] = pk2(kd[8 + 2 * j], kd[8 + 2 * j + 1]); }
        *(LAS u32x4*)(KDT + kx * 72 + 16 * seg) = w0; *(LAS u32x4*)(KDT + kx * 72 + 16 * seg + 8) = w1;
        if (seg == 0) DEC[kx] = __expf(blast); }
      lds_barrier();
      const int mt = wid >> 1, vt = wid & 1;
      f32x4 oacc = (f32x4){0.f, 0.f, 0.f, 0.f}, a0 = oacc, a1 = oacc;
      const int J0 = 2 * vt;
#pragma unroll
      for (int ks = 0; ks < 4; ++ks) {
        const int kb = 32 * ks + 8 * fq, trow = 16 * mt + fr;
        const bf16x8 qv = *(const LAS bf16x8*)(Q + trow * 136 + kb);
        const f32x4 bc0 = *(const LAS f32x4*)(BC + trow * 132 + kb), bc1 = *(const LAS f32x4*)(BC + trow * 132 + kb + 4);
        const f32x4 r0 = *(const LAS f32x4*)(BC + (16 * mt) * 132 + kb), r1 = *(const LAS f32x4*)(BC + (16 * mt) * 132 + kb + 4);
        u32x4 ai, aq;
#pragma unroll
        for (int j = 0; j < 4; ++j) {
          const float q0 = bf2f((bf16_t)qv[2 * j]), q1 = bf2f((bf16_t)qv[2 * j + 1]);
          const float b0 = j < 2 ? bc0[2 * j] : bc1[2 * j - 4], b1 = j < 2 ? bc0[2 * j + 1] : bc1[2 * j - 3];
          const float rr0 = j < 2 ? r0[2 * j] : r1[2 * j - 4], rr1 = j < 2 ? r0[2 * j + 1] : r1[2 * j - 3];
          ai[j] = pk2(q0 * __expf(b0), q1 * __expf(b1)); aq[j] = pk2(q0 * __expf(b0 - rr0), q1 * __expf(b1 - rr1));
        }
        const bf16x8 sb = *(const LAS bf16x8*)(ST + (16 * vt + fr) * 136 + kb);
        oacc = MFMA16(__builtin_bit_cast(bf16x8, ai), sb, oacc);
#pragma unroll
        for (int jj = 0; jj < 2; ++jj) {
          const int J = J0 + jj; if (J > mt) continue;
          const int srow = 16 * J + fr;
          const bf16x8 kv = *(const LAS bf16x8*)(Kr + srow * 136 + kb);
          const f32x4 c0 = *(const LAS f32x4*)(BC + srow * 132 + kb), c1 = *(const LAS f32x4*)(BC + srow * 132 + kb + 4);
          u32x4 bk;
#pragma unroll
          for (int j = 0; j < 4; ++j) {
            const float k0 = bf2f((bf16_t)kv[2 * j]), k1 = bf2f((bf16_t)kv[2 * j + 1]);
            const float b0 = j < 2 ? c0[2 * j] : c1[2 * j - 4], b1 = j < 2 ? c0[2 * j + 1] : c1[2 * j - 3];
            const float rr0 = j < 2 ? r0[2 * j] : r1[2 * j - 4], rr1 = j < 2 ? r0[2 * j + 1] : r1[2 * j - 3];
            bk[j] = pk2(k0 * __expf(fminf(rr0 - b0, 80.f)), k1 * __expf(fminf(rr1 - b1, 80.f)));
          }
          if (jj == 0) a0 = MFMA16(__builtin_bit_cast(bf16x8, aq), __builtin_bit_cast(bf16x8, bk), a0);
          else a1 = MFMA16(__builtin_bit_cast(bf16x8, aq), __builtin_bit_cast(bf16x8, bk), a1);
        }
      }
#pragma unroll
      for (int jj = 0; jj < 2; ++jj) { const int J = J0 + jj;
#pragma unroll
        for (int reg = 0; reg < 4; ++reg) { const int tt = 16 * mt + 4 * fq + reg, ss = 16 * J + fr; const float v = jj == 0 ? a0[reg] : a1[reg];
          AB[tt * 72 + ss] = (J <= mt && ss <= tt) ? f2bf(v) : (bf16_t)0; } }
      lds_barrier();
#pragma unroll
      for (int k2 = 0; k2 < 2; ++k2) {
        const bf16x8 af = *(const LAS bf16x8*)(AB + (16 * mt + fr) * 72 + 32 * k2 + 8 * fq);
        const bf16x8 vb = *(const LAS bf16x8*)(VT + (16 * vt + fr) * 72 + 32 * k2 + 8 * fq);
        oacc = MFMA16(af, vb, oacc);
      }
#pragma unroll
      for (int reg = 0; reg < 4; ++reg) {
        const int tok = b * SEQ + c * 64 + 16 * mt + 4 * fq + reg; const float v = oacc[reg];
        oraw[(size_t)tok * 1024 + hh * 128 + vq * 32 + 16 * vt + fr] = f2bf(v);
        float sq = v * v; sq += __shfl_xor(sq, 1); sq += __shfl_xor(sq, 2); sq += __shfl_xor(sq, 4); sq += __shfl_xor(sq, 8);
        if (fr == 0) atomicAdd(sumsq + (size_t)tok * 8 + hh, sq);
      }
      { const f32x4 dc = *(const LAS f32x4*)(DEC + 16 * wid + 4 * fq);
        sreg[0] *= dc; sreg[1] *= dc;
#pragma unroll
        for (int k2 = 0; k2 < 2; ++k2) {
          const bf16x8 af = *(const LAS bf16x8*)(KDT + (16 * wid + fr) * 72 + 32 * k2 + 8 * fq);
#pragma unroll
          for (int v2 = 0; v2 < 2; ++v2) { const bf16x8 vb = *(const LAS bf16x8*)(VT + (16 * v2 + fr) * 72 + 32 * k2 + 8 * fq); sreg[v2] = MFMA16(af, vb, sreg[v2]); }
        }
#pragma unroll
        for (int v2 = 0; v2 < 2; ++v2) { u32x2 w; w.x = pk2(sreg[v2][0], sreg[v2][1]); w.y = pk2(sreg[v2][2], sreg[v2][3]); *(LAS u32x2*)(ST + (16 * v2 + fr) * 136 + 16 * wid + 4 * fq) = w; }
      }
    }
  }
}
DI void hgrn_norm_phase(int wv, const P& p_, int slot) {
  P p = p_; { size_t z_ = 0; asm volatile("" : "+s"(z_)); p.ws = p_.ws + z_; }
  const bf16_t* oraw = (const bf16_t*)p.out; const bf16_t* hg = (const bf16_t*)(p.ws + HG_G); const float* sumsq = (const float*)(p.ws + WS_SUMSQ);
  bf16_t* ob = (bf16_t*)(p.ws + WS_O); const float* gain = p.hg_gain + slot * 128;
  int tid_ = wv * 64 + lane_id_(); asm volatile("" : "+v"(tid_)); const size_t gtid = (size_t)blockIdx.x * 512 + tid_, gsz = (size_t)gridDim.x * 512;
  for (size_t i = gtid; i < (size_t)MTOK * 1024 / 8; i += gsz) {
    const size_t e = i * 8; const int row = (int)(e >> 10), col = (int)(e & 1023), hh = col >> 7, vv = col & 127;
    const float rs = rsqrtf(sumsq[(size_t)row * 8 + hh] * (1.0f / 128.0f) + 1e-6f);
    const bf16x8 o8 = *(const bf16x8*)(oraw + e), g8 = *(const bf16x8*)(hg + e);
    u32x4 w;
#pragma unroll
    for (int j = 0; j < 4; ++j) w[j] = pkh2(bf2f((bf16_t)o8[2 * j]) * rs * gain[vv + 2 * j] * bf2f((bf16_t)g8[2 * j]), bf2f((bf16_t)o8[2 * j + 1]) * rs * gain[vv + 2 * j + 1] * bf2f((bf16_t)g8[2 * j + 1]));
    *(u32x4*)(ob + e) = w;
  }
}
#define REP_NSA 1
#define REP_CONV 1
#define REP_CMP 1
#define REP_MISC 1
#define REP_DOWN 1
#define REP_HG 1
#define REP_EPI 1
#ifndef SKIP_MIXERS
#define SKIP_MIXERS 0
#endif
__global__ void __launch_bounds__(512, 2) mega_fwd(P p) {
  extern __shared__ __attribute__((aligned(16))) unsigned char lds_raw[];
  LAS unsigned char* lds = (LAS unsigned char*)lds_raw;
  cg::grid_group grid = cg::this_grid();
  const int wv = __builtin_amdgcn_readfirstlane((int)(threadIdx.x >> 6));
  volatile LAS unsigned* xst = (volatile LAS unsigned*)(lds + LDS_BYTES - 16);
  if (wv == 0 && lane_id_() < 4) xst[lane_id_()] = 0u;
  __syncthreads();
  const XcdBarrier xb = xcd_barrier_post(wv, (unsigned*)(p.ws + WS_BAR), xst);
#define GSYNC() xcd_barrier(wv, xb)
  unsigned char* ws = p.ws;
  init_phase(wv, p);
  for (int L = 0; L < 4; ++L) {
    { size_t z_ = 0; asm volatile("" : "+s"(z_)); ws = p.ws + z_; }
    for (int rep = 0; rep < p.rep_conv; ++rep) convert_phase(wv, p, L, lds);
    if (L == 0) grid.sync(); else GSYNC();
    const int kind = L % 3, slot = L / 3;
    for (int s = 0; s < 3; ++s) {
      { size_t z_ = 0; asm volatile("" : "+s"(z_)); ws = p.ws + z_; }
      float* stats = (float*)(ws + WS_STATS); bf16_t* tb = (bf16_t*)(ws + WS_TB); bf16_t* Hb = (bf16_t*)(ws + WS_BIG); bf16_t* ob = (bf16_t*)(ws + WS_O);
      const int lnp = L * 3 + s - 1;
      const float* stp = (const float*)(ws + WS_DSTATS) + (size_t)(lnp + 1) * MTOK * 2;
      pg8::Gemm gr; float scale;
      if (s != 1) {
        pg8::Gemm g; g.A = tb; g.Bt = (const bf16_t*)(ws + (s == 0 ? W_GU1 : W_GU2)); g.M = MTOK; g.N = 5632; g.K = DM;
        pg8::StaticOrder S; S.init(g.M, g.N, gridDim.x, blockIdx.x);
        EpiUp E; E.reps = p.rep_epi; E.H = Hb; E.stats = stp; E.c1 = (const float*)(ws + (s == 0 ? C_GU1 : C_GU2)); E.c2 = E.c1 + 5632;
        pg8::gemm_phase(wv, lds, g, S, E);
        GSYNC();
        gr.A = Hb; gr.Bt = (const bf16_t*)(ws + (s == 0 ? W_D1 : W_D2)); gr.M = MTOK; gr.N = DM; gr.K = DFF; scale = 0.5f;
      } else {
        pg8::Gemm g; g.A = tb; g.Bt = (const bf16_t*)(ws + W_IN); g.M = MTOK; g.N = kind == 0 ? 2816 : (kind == 1 ? 4096 : 1280); g.K = DM;
        pg8::StaticOrder S; S.init(g.M, g.N, gridDim.x, blockIdx.x);
        EpiIn E; E.reps = 1; E.mode = kind == 1 ? 1 : 0; E.h = Hb; E.ld = g.N; E.stats = stp; E.c1 = (const float*)(ws + C_IN); E.c2 = E.c1 + 4096; E.lbv = (const float*)(ws + C_LBV);
        E.hq = (bf16_t*)(ws + HG_Q); E.hk = (bf16_t*)(ws + HG_K); E.hv = (bf16_t*)(ws + HG_V); E.hg = (bf16_t*)(ws + HG_G); E.hlf = (_Float16*)(ws + HG_LF);
        pg8::gemm_phase(wv, lds, g, S, E);
        GSYNC();
#if !SKIP_MIXERS
        if (kind == 0) {
          for (int rep = 0; rep < p.rep_cmp; ++rep) nsa_compress_phase(wv, p, lds);
          GSYNC();
          for (int rep = 0; rep < p.rep_nsa; ++rep) { if (rep) GSYNC(); nsa_attn_phase(wv, p, lds); }
        }
        else if (kind == 1) {
          for (int rep = p.rep_hg - 1; rep >= 0; --rep) hgrn_scan_phase(wv, p, lds, (float*)(ws + (rep ? WS_KC : WS_SUMSQ)));
          GSYNC(); hgrn_norm_phase(wv, p, slot); }
        else {
          for (int rep = 0; rep < p.rep_misc; ++rep) swa_attn_phase(wv, p, slot, lds);
        }
#endif
        GSYNC();
        gr.A = ob; gr.Bt = (const bf16_t*)(ws + W_OUT); gr.M = MTOK; gr.N = DM; gr.K = DM; scale = 1.0f;
      }
      pg8::StaticOrder S2; S2.init(gr.M, gr.N, gridDim.x, blockIdx.x);
      EpiRes R; R.reps = 1; R.stats_prev = stp; R.g = (const float*)(ws + WS_G13) + (size_t)(lnp + 1) * DM; R.b = (const float*)(ws + WS_B13) + (size_t)(lnp + 1) * DM;
      R.stats_new = stats + (size_t)(lnp + 1) * MTOK * 2; R.tb = tb; R.scale = scale;
      for (int rep = (s != 1 ? p.rep_down : 1) - 1; rep >= 0; --rep) {
        R.tb = tb; R.stats_new = stats + (size_t)(lnp + 1) * MTOK * 2;
        pg8::gemm_phase(wv, lds, gr, S2, R);
        GSYNC();
      }
    }
  }
  final_ln(wv, p, (float*)(ws + WS_STATS) + (size_t)11 * MTOK * 2, p.ln_gain + 11 * DM, p.ln_bias + 11 * DM);
}

extern "C" void kernel_launch(void* const* d_in, const int* in_sizes, int n_in, void* d_out, int out_size, void* d_ws, size_t ws_size, hipStream_t stream) {
  static int grid = 0;
  if (grid == 0) {
    if (n_in != 22 || ws_size < WS_END) { fprintf(stderr, "kernel_launch: unexpected n_in %d / ws_size %zu (need %zu)\n", n_in, ws_size, (size_t)WS_END); grid = -1; return; }
    int dev = 0, cus = 0, per_cu = 0;
    hipGetDevice(&dev); hipDeviceGetAttribute(&cus, hipDeviceAttributeMultiprocessorCount, dev);
    if (hipFuncSetAttribute((const void*)mega_fwd, hipFuncAttributeMaxDynamicSharedMemorySize, LDS_BYTES) != hipSuccess) { fprintf(stderr, "hipFuncSetAttribute failed\n"); grid = -1; return; }
    hipOccupancyMaxActiveBlocksPerMultiprocessor(&per_cu, (const void*)mega_fwd, 512, LDS_BYTES);
    if (per_cu < 1) { fprintf(stderr, "occupancy query says %d blocks/CU\n", per_cu); per_cu = 1; }
    (void)hipGetLastError();
    grid = cus * 1;
  }
  if (grid < 0) return;
  if (hipMemsetAsync((char*)d_ws + WS_BAR, 0, 16384, stream) != hipSuccess) { fprintf(stderr, "memset failed\n"); return; }
  P p{};
  const float** pp = (const float**)&p;
  for (int i = 0; i < 22; ++i) pp[i] = (const float*)d_in[i];
  p.out = (float*)d_out; p.ws = (unsigned char*)d_ws;
  p.rep_nsa = REP_NSA; p.rep_conv = REP_CONV; p.rep_cmp = REP_CMP; p.rep_misc = REP_MISC; p.rep_down = REP_DOWN; p.rep_hg = REP_HG; p.rep_epi = REP_EPI; p.rep_pad = 0;
  void* args[] = {&p};
  hipError_t e = hipLaunchCooperativeKernel((const void*)mega_fwd, dim3(grid), dim3(512), args, LDS_BYTES, stream);
  if (e != hipSuccess) fprintf(stderr, "cooperative launch failed: %s (grid %d)\n", hipGetErrorString(e), grid);
}
```

```cpp
#include <hip/hip_runtime.h>
#include <hip/hip_cooperative_groups.h>
#include <cstdio>
namespace cg = cooperative_groups;

typedef unsigned short bf16_t;
typedef short bf16x8 __attribute__((ext_vector_type(8)));
typedef short s16x4 __attribute__((ext_vector_type(4)));
typedef _Float16 half8 __attribute__((ext_vector_type(8)));
typedef float f32x4 __attribute__((ext_vector_type(4)));
typedef float f32x16 __attribute__((ext_vector_type(16)));
typedef unsigned u32x2 __attribute__((ext_vector_type(2)));
typedef unsigned u32x4 __attribute__((ext_vector_type(4)));
#define LAS __attribute__((address_space(3)))
#define DI __device__ __forceinline__

constexpr int MTOK = 32768, DM = 1024, DFF = 2816, SEQ = 4096, NB = 8;
constexpr float ALPHA = 1.681792830507429f;
constexpr size_t MiB = 1ull << 20;
constexpr size_t W_GU1 = 0, W_D1 = 11534336, W_GU2 = 17301504, W_D2 = 28835840, W_IN = 34603008, W_OUT = 42991616,
                 W_W1T = 45088768, W_W2T = 46137344, W_C = 46170112;
constexpr size_t C_GU1 = W_C, C_GU2 = C_GU1 + 2 * 5632 * 4, C_IN = C_GU2 + 2 * 5632 * 4, C_POSB = C_IN + 2 * 4096 * 4,
                 C_LBV = C_POSB + 2 * 256 * 4, C_BTAB = C_LBV + 1024 * 4, C_END = C_BTAB + 16 * 132 * 4;
constexpr size_t WS_TB = 48 * MiB, WS_BIG = 112 * MiB, WS_O = 432 * MiB, WS_MISC = 496 * MiB;
constexpr size_t WS_DSTATS = WS_MISC, WS_STATS = WS_DSTATS + 262144, WS_SUMSQ = WS_STATS + 3 * MiB, WS_KC = WS_SUMSQ + 1 * MiB, WS_VC = WS_KC + 1 * MiB, WS_BAR = WS_VC + 1 * MiB,
                 WS_G13 = WS_BAR + 16384, WS_B13 = WS_G13 + 13 * 4096, WS_END = WS_B13 + 13 * 4096;
static_assert(C_END <= 48 * MiB, "weights region");
constexpr int LDS_BYTES = 144 * 1024;

struct P {
  const float *x, *rel_bias, *ln_gain, *ln_bias, *f1g, *f1u, *f1d, *f2g, *f2u, *f2d, *nsa_win, *nsa_wout, *nsa_pos, *nsa_w1, *nsa_w2,
      *hg_win, *hg_wout, *hg_gain, *hg_lb, *swa_win, *swa_wout, *swa_sinks;
  float* out; unsigned char* ws;
  int rep_nsa, rep_conv, rep_cmp, rep_misc, rep_down, rep_hg, rep_epi, rep_pad;
};

DI unsigned pk2(float a, float b) { typedef __bf16 bf2 __attribute__((ext_vector_type(2))); bf2 v; v[0] = (__bf16)a; v[1] = (__bf16)b; return __builtin_bit_cast(unsigned, v); }
DI unsigned pkh2(float a, float b) { typedef _Float16 h2 __attribute__((ext_vector_type(2))); h2 v; v[0] = (_Float16)a; v[1] = (_Float16)b; return __builtin_bit_cast(unsigned, v); }
DI bf16_t f2h(float a) { return __builtin_bit_cast(unsigned short, (_Float16)a); }
DI float h2f(bf16_t v) { return (float)__builtin_bit_cast(_Float16, v); }
DI bf16_t f2bf(float a) { return __builtin_bit_cast(unsigned short, (__bf16)a); }
DI float bf2f(bf16_t v) { return __uint_as_float(((unsigned)v) << 16); }
DI int lane_id_() { int l; asm volatile("v_mbcnt_lo_u32_b32 %0, -1, 0\n\tv_mbcnt_hi_u32_b32 %0, -1, %0" : "=v"(l)); return l; }
DI void lds_barrier() { asm volatile("s_waitcnt lgkmcnt(0)\n\ts_barrier" ::: "memory"); }
DI float sigmoidf_(float v) { return __builtin_amdgcn_rcpf(1.0f + __builtin_amdgcn_exp2f(-1.4426950408889634f * v)); }


#define XB_TMO      128
#define XB_XCNT(j)  (256  + 64 * (j))
#define XB_XSUB(j)  (1280 + 64 * (j))
#define XB_XGEN(j)  (2304 + 64 * (j))
#define XB_TOP      3328
#define XB_TOPGEN   3392
#define XCD_BAR_WORDS 3456
#define XB_SPIN_CAP (1u << 20)
DI unsigned xb_ld(unsigned* p)              { return __hip_atomic_load(p, __ATOMIC_RELAXED, __HIP_MEMORY_SCOPE_AGENT); }
DI unsigned xb_add(unsigned* p, unsigned v) { return __hip_atomic_fetch_add(p, v, __ATOMIC_RELAXED, __HIP_MEMORY_SCOPE_AGENT); }
DI unsigned xb_xcc_id() { return (unsigned)__builtin_amdgcn_s_getreg((3 << 11) | 20) & 0xFu; }
#define XB_SPIN(cond, bar) do { unsigned _sp = 0; while (cond) { __builtin_amdgcn_s_sleep(1); \
    if ((++_sp & 255u) == 0u) { if (xb_ld(&(bar)[XB_TMO])) break; if (_sp > XB_SPIN_CAP) { atomicAdd(&(bar)[XB_TMO], 1u); break; } } } } while (0)
struct XcdBarrier { unsigned* bar; unsigned x; volatile LAS unsigned* st; };
DI XcdBarrier xcd_barrier_post(int wv, unsigned* bar, volatile LAS unsigned* st) {
  XcdBarrier b; b.bar = bar; b.x = xb_xcc_id(); b.st = st;
  if (wv == 0 && lane_id_() == 0) (void)xb_add(&bar[XB_XCNT(b.x)], 1u);
  return b;
}
DI void xcd_barrier_complete(unsigned* bar, unsigned x, unsigned& nloc, unsigned& nx) {
  const unsigned G = gridDim.x * gridDim.y * gridDim.z;
  unsigned sum, cnt, mine, sp = 0u;
  for (;;) {
    sum = 0u; cnt = 0u; mine = 0u;
#pragma unroll 1
    for (unsigned j = 0; j < 16; ++j) { const unsigned c = xb_ld(&bar[XB_XCNT(j)]); sum += c; cnt += (c > 0u) ? 1u : 0u; mine = (j == x) ? c : mine; }
    if (sum == G) break;
    __builtin_amdgcn_s_sleep(1);
    if ((++sp & 255u) == 0u) { if (xb_ld(&bar[XB_TMO])) break; if (sp > XB_SPIN_CAP) { atomicAdd(&bar[XB_TMO], 1u); break; } }
  }
  nloc = mine > 0u ? mine : 1u; nx = cnt > 0u ? cnt : 1u;
}
DI void xcd_barrier(int wv, const XcdBarrier& b) {
  asm volatile("s_waitcnt vmcnt(0)" ::: "memory");
  __syncthreads();
  if (wv == 0 && lane_id_() == 0) {
    unsigned* bar = b.bar;
    __builtin_amdgcn_s_waitcnt(0);
    unsigned nloc = b.st[0], nx = b.st[1];
    if (nloc == 0u) { xcd_barrier_complete(bar, b.x, nloc, nx); b.st[0] = nloc; b.st[1] = nx; }
    const unsigned old = xb_add(&bar[XB_XSUB(b.x)], 1u);
    const unsigned gen = old / nloc;
    if (old + 1u == (gen + 1u) * nloc) {
      __builtin_amdgcn_fence(__ATOMIC_RELEASE, "agent");
      asm volatile("s_waitcnt vmcnt(0)" ::: "memory");
      const unsigned og = xb_add(&bar[XB_TOP], 1u);
      const unsigned tg = og / nx;
      if (og + 1u == (tg + 1u) * nx) xb_add(&bar[XB_TOPGEN], 1u);
      else XB_SPIN(xb_ld(&bar[XB_TOPGEN]) == tg, bar);
      __builtin_amdgcn_fence(__ATOMIC_ACQUIRE, "agent");
      xb_add(&bar[XB_XGEN(b.x)], 1u);
      asm volatile("s_waitcnt vmcnt(0)" ::: "memory");
    } else {
      XB_SPIN(xb_ld(&bar[XB_XGEN(b.x)]) == gen, bar);
      __builtin_amdgcn_fence(__ATOMIC_ACQUIRE, "agent");
      asm volatile("s_waitcnt vmcnt(0)" ::: "memory");
    }
  }
  __syncthreads();
}

namespace pg8 {
constexpr int BM = 256, BK = 64, HALF = 128, HTB = HALF * BK * 2, STAGE_BYTES = 8 * HTB, NXCD = 8, WGM = 8;
DI int lds_byte(int r, int c) { const int st = (r >> 4) * 2 + (c >> 5), rr = r & 15, cc = c & 31, ob = rr * 64 + cc * 2; return st * 1024 + (ob ^ (((ob >> 9) & 1) << 5)); }
DI void stage_rc(int b, int& R, int& C) { const int st = b / 1024, sb = b % 1024, swz = sb ^ (((sb >> 9) & 1) << 5); R = (st >> 1) * 16 + swz / 64; C = (st & 1) * 32 + (swz % 64) / 2; }
struct Unit { int pm, pn; };
struct Gemm { const bf16_t* A; const bf16_t* Bt; int M, N, K; };
struct StaticOrder {
  int nM, nN, nwg, G, c;
  DI void init(int M, int N, int G_, int c_) { nM = M / BM; nN = N / BM; nwg = nM * nN; G = G_; c = c_; }
  DI bool next(int i, Unit& u) const {
    const long L = (long)i * G + c; if (L >= nwg) return false;
    int wgid = (int)L; { const int q = nwg / NXCD, r = nwg % NXCD, xcd = wgid % NXCD, off = wgid / NXCD; wgid = (xcd < r ? xcd * (q + 1) : r * (q + 1) + (xcd - r) * q) + off; }
    const int nig = WGM * nN, gid = wgid / nig, fm = gid * WGM, gsz = (nM - fm) < WGM ? (nM - fm) : WGM;
    u.pm = fm + ((wgid % nig) % gsz); u.pn = (wgid % nig) / gsz; return true;
  }
};
template <class Epi>
DI void gemm_phase(int wv, LAS unsigned char* lds, const Gemm g, const StaticOrder& S, const Epi& E) {
  int tid_ = wv * 64 + lane_id_(); asm volatile("" : "+v"(tid_)); const int tid = tid_, wid = __builtin_amdgcn_readfirstlane(tid >> 6), lane = tid & 63, wr = wid >> 2, wc = wid & 3, fr = lane & 15, fq = lane >> 4;
  const int K = g.K, nt = K / BK;
  unsigned voffA[2];
#pragma unroll
  for (int i = 0; i < 2; ++i) { int R, C; stage_rc(tid * 16 + i * 8192, R, C); voffA[i] = (unsigned)(R * K + C) * 2u; }
  const size_t kstep = (size_t)(BK * 2), hstep = (size_t)HALF * K * 2, tstep = 2 * hstep;
  const unsigned ldsw = (unsigned)wid * 1024u;
  const int aoff = lds_byte(wr * 64 + fr, fq * 8), boff = lds_byte(wc * 32 + fr, fq * 8);
#define PG8_SA(b, h) (((b) * 2 + (h)) * HTB)
#define PG8_SB(b, h) ((4 + (b) * 2 + (h)) * HTB)
#define PG8_STAGE(bufoff, gbase, voff) do { _Pragma("unroll") for (int _i = 0; _i < 2; ++_i) \
    __builtin_amdgcn_global_load_lds((const unsigned*)((const char*)(gbase) + (voff)[_i]), (LAS unsigned*)(lds + (bufoff) + ldsw + _i * 8192), 16, 0, 0); } while (0)
#define PG8_LDA(dst, b, h) do { _Pragma("unroll") for (int m = 0; m < 4; ++m) _Pragma("unroll") for (int k = 0; k < 2; ++k) dst[m][k] = *(const LAS bf16x8*)(lds + PG8_SA(b, h) + aoff + m * 2048 + k * 1024); } while (0)
#define PG8_LDB(dst, b, h) do { _Pragma("unroll") for (int n = 0; n < 2; ++n) _Pragma("unroll") for (int k = 0; k < 2; ++k) dst[n][k] = *(const LAS bf16x8*)(lds + PG8_SB(b, h) + boff + n * 2048 + k * 1024); } while (0)
#define PG8_MMA(ai, bj, At, Bt) do { __builtin_amdgcn_s_setprio(1); _Pragma("unroll") for (int m = 0; m < 4; ++m) _Pragma("unroll") for (int n = 0; n < 2; ++n) _Pragma("unroll") for (int k = 0; k < 2; ++k) \
    acc[ai][bj][m][n] = __builtin_amdgcn_mfma_f32_16x16x32_f16(__builtin_bit_cast(half8, Bt[n][k]), __builtin_bit_cast(half8, At[m][k]), acc[ai][bj][m][n], 0, 0, 0); __builtin_amdgcn_s_setprio(0); } while (0)
#define PG8_WAIT_V(n) asm volatile("s_waitcnt vmcnt(" #n ")" ::: "memory")
#define PG8_WAIT_L(n) asm volatile("s_waitcnt lgkmcnt(" #n ")" ::: "memory")
#define PG8_BAR __builtin_amdgcn_s_barrier()
#define PG8_SCHED __builtin_amdgcn_sched_barrier(0)
  Unit cur, nxt; int ui = 0;
  if (!S.next(0, cur)) return;
  f32x4 acc[2][2][4][2];
#pragma unroll
  for (int a = 0; a < 2; ++a)
#pragma unroll
    for (int b = 0; b < 2; ++b)
#pragma unroll
      for (int m = 0; m < 4; ++m)
#pragma unroll
        for (int n = 0; n < 2; ++n) acc[a][b][m][n] = (f32x4){0.f, 0.f, 0.f, 0.f};
  bf16x8 At[4][2], B0[2][2], B1[2][2];
  const char* cA = (const char*)g.A + (size_t)cur.pm * tstep; const char* cB = (const char*)g.Bt + (size_t)cur.pn * tstep;
  PG8_STAGE(PG8_SB(0, 0), cB, voffA); PG8_STAGE(PG8_SA(0, 0), cA, voffA); PG8_STAGE(PG8_SB(0, 1), cB + hstep, voffA); PG8_STAGE(PG8_SA(0, 1), cA + hstep, voffA);
  if (wr == 1) PG8_BAR;
  PG8_WAIT_V(4); PG8_BAR;
  PG8_STAGE(PG8_SB(1, 0), cB + kstep, voffA); PG8_STAGE(PG8_SA(1, 0), cA + kstep, voffA); PG8_STAGE(PG8_SB(1, 1), cB + hstep + kstep, voffA);
  PG8_WAIT_V(6); PG8_BAR;
  for (;;) {
    const bool has_next = S.next(ui + 1, nxt);
    const char* nA = has_next ? (const char*)g.A + (size_t)nxt.pm * tstep : cA; const char* nB = has_next ? (const char*)g.Bt + (size_t)nxt.pn * tstep : cB;
    for (int t = 0; t < nt; t += 2) {
      const bool last = (t == nt - 2);
      const char* a1 = cA + (size_t)(t + 1) * kstep;
      const char* a2 = last ? nA : cA + (size_t)(t + 2) * kstep; const char* b2 = last ? nB : cB + (size_t)(t + 2) * kstep;
      const char* a3 = a2 + kstep; const char* b3 = b2 + kstep;
      PG8_LDB(B0, 0, 0); PG8_SCHED; PG8_LDA(At, 0, 0); PG8_STAGE(PG8_SA(1, 1), a1 + hstep, voffA);
      PG8_WAIT_L(8); PG8_BAR; PG8_WAIT_L(0); PG8_MMA(0, 0, At, B0); PG8_BAR; PG8_SCHED;
      PG8_LDB(B1, 0, 1); PG8_STAGE(PG8_SB(0, 0), b2, voffA);
      PG8_BAR; PG8_WAIT_L(0); PG8_MMA(0, 1, At, B1); PG8_BAR;
      PG8_LDA(At, 0, 1); PG8_STAGE(PG8_SA(0, 0), a2, voffA);
      PG8_BAR; PG8_WAIT_L(0); PG8_MMA(1, 0, At, B0); PG8_BAR; PG8_SCHED;
      PG8_STAGE(PG8_SB(0, 1), b2 + hstep, voffA);
      PG8_WAIT_V(6); PG8_BAR; PG8_MMA(1, 1, At, B1); PG8_BAR;
      PG8_LDB(B0, 1, 0); PG8_SCHED; PG8_LDA(At, 1, 0); PG8_STAGE(PG8_SA(0, 1), a2 + hstep, voffA);
      PG8_WAIT_L(8); PG8_BAR; PG8_WAIT_L(0); PG8_MMA(0, 0, At, B0); PG8_BAR; PG8_SCHED;
      PG8_LDB(B1, 1, 1); PG8_STAGE(PG8_SB(1, 0), b3, voffA);
      PG8_BAR; PG8_WAIT_L(0); PG8_MMA(0, 1, At, B1); PG8_BAR;
      PG8_LDA(At, 1, 1); PG8_STAGE(PG8_SA(1, 0), a3, voffA);
      PG8_BAR; PG8_WAIT_L(0); PG8_MMA(1, 0, At, B0); PG8_BAR; PG8_SCHED;
      PG8_STAGE(PG8_SB(1, 1), b3 + hstep, voffA);
      PG8_WAIT_V(6); PG8_BAR; PG8_MMA(1, 1, At, B1); PG8_BAR;
    }
    for (int r_ = 0; r_ < E.reps; ++r_) E(acc, cur, wr, wc, fr, fq);
    if (!has_next) break;
#pragma unroll
    for (int a = 0; a < 2; ++a)
#pragma unroll
      for (int b = 0; b < 2; ++b)
#pragma unroll
        for (int m = 0; m < 4; ++m)
#pragma unroll
          for (int n = 0; n < 2; ++n) acc[a][b][m][n] = (f32x4){0.f, 0.f, 0.f, 0.f};
    cur = nxt; cA = nA; cB = nB; ++ui;
  }
  PG8_WAIT_V(0);
  if (wr == 0) PG8_BAR;
  PG8_BAR;
}
}
DI void row_affine(const float* stats, int row, float& a, float& bb, float& mu, float& rstd) {
  const float s = stats[2 * row], ss = stats[2 * row + 1]; mu = s * (1.0f / 1024.0f); const float var = fmaxf(ss * (1.0f / 1024.0f) - mu * mu, 0.f); rstd = rsqrtf(var + 1e-5f); a = rstd; bb = -rstd * mu;
}
struct EpiUp {
  bf16_t* H; const float* stats; const float* c1; const float* c2; int reps;
  DI void operator()(const f32x4 (&acc)[2][2][4][2], const pg8::Unit& u, int wr, int wc, int fr, int fq) const {
    const int colg = u.pn * 256 + wc * 32 + 8 * fq, hcol = u.pn * 128 + wc * 32 + 8 * fq;
    f32x4 c1g[2], c2g[2], c1u[2], c2u[2];
#pragma unroll
    for (int n = 0; n < 2; ++n) { c1g[n] = *(const f32x4*)(c1 + colg + 4 * n); c2g[n] = *(const f32x4*)(c2 + colg + 4 * n); c1u[n] = *(const f32x4*)(c1 + colg + 128 + 4 * n); c2u[n] = *(const f32x4*)(c2 + colg + 128 + 4 * n); }
    float ra[8], rb[8];
#pragma unroll
    for (int i = 0; i < 8; ++i) { float mu, rstd; row_affine(stats, u.pm * 256 + (i >> 2) * 128 + wr * 64 + (i & 3) * 16 + fr, ra[i], rb[i], mu, rstd); }
#pragma unroll
    for (int ai = 0; ai < 2; ++ai)
#pragma unroll
      for (int m = 0; m < 4; ++m) {
        const int row = u.pm * 256 + ai * 128 + wr * 64 + m * 16 + fr; const float a = ra[ai * 4 + m], bb = rb[ai * 4 + m];
        u32x4 w;
#pragma unroll
        for (int n = 0; n < 2; ++n) {
          const f32x4 gv = acc[ai][0][m][n] * a + c1g[n] * bb + c2g[n], uv = acc[ai][1][m][n] * a + c1u[n] * bb + c2u[n];
          float h[4];
#pragma unroll
          for (int j = 0; j < 4; ++j) h[j] = gv[j] * sigmoidf_(gv[j]) * uv[j];
          w[2 * n] = pkh2(h[0], h[1]); w[2 * n + 1] = pkh2(h[2], h[3]);
        }
        *(u32x4*)(H + (size_t)row * DFF + hcol) = w;
        asm volatile("" ::: "memory");
      }
  }
};
struct EpiRes {
  const float* stats_prev; const float* g; const float* b; float* stats_new; bf16_t* tb; float scale; int reps;
  DI void operator()(const f32x4 (&acc)[2][2][4][2], const pg8::Unit& u, int wr, int wc, int fr, int fq) const {
    const int col0 = u.pn * 256 + wc * 32 + 8 * fq;
    float rmu[8], rrs[8];
#pragma unroll
    for (int i = 0; i < 8; ++i) { float a, bb; row_affine(stats_prev, u.pm * 256 + (i >> 2) * 128 + wr * 64 + (i & 3) * 16 + fr, a, bb, rmu[i], rrs[i]); }
#pragma unroll
    for (int ai = 0; ai < 2; ++ai) {
      half8 tpv[4][2];
#pragma unroll
      for (int m = 0; m < 4; ++m)
#pragma unroll
        for (int bj = 0; bj < 2; ++bj) tpv[m][bj] = *(const half8*)(tb + (size_t)(u.pm * 256 + ai * 128 + wr * 64 + m * 16 + fr) * DM + col0 + bj * 128);
#pragma unroll
      for (int m = 0; m < 4; ++m) {
        const int row = u.pm * 256 + ai * 128 + wr * 64 + m * 16 + fr; const float mu = rmu[ai * 4 + m], rstd = rrs[ai * 4 + m];
        float rs = 0.f, rq = 0.f;
#pragma unroll
        for (int bj = 0; bj < 2; ++bj) {
          u32x4 w;
#pragma unroll
          for (int n = 0; n < 2; ++n) {
            f32x4 tp;
#pragma unroll
            for (int j = 0; j < 4; ++j) tp[j] = (float)tpv[m][bj][4 * n + j];
            tp = (tp - mu) * rstd * (*(const f32x4*)(g + col0 + bj * 128 + 4 * n)) + *(const f32x4*)(b + col0 + bj * 128 + 4 * n);
            const f32x4 tn = tp * ALPHA + acc[ai][bj][m][n] * scale;
            w[2 * n] = pkh2(tn[0], tn[1]); w[2 * n + 1] = pkh2(tn[2], tn[3]);
            rs += tn[0] + tn[1] + tn[2] + tn[3]; rq += tn[0] * tn[0] + tn[1] * tn[1] + tn[2] * tn[2] + tn[3] * tn[3];
          }
          *(u32x4*)(tb + (size_t)row * DM + col0 + bj * 128) = w;
        }
        rs += __shfl_xor(rs, 16); rs += __shfl_xor(rs, 32); rq += __shfl_xor(rq, 16); rq += __shfl_xor(rq, 32);
        if (fq == 0) { atomicAdd(stats_new + 2 * row, rs); atomicAdd(stats_new + 2 * row + 1, rq); }
      }
      asm volatile("" ::: "memory");
    }
  }
};
struct EpiIn {
  int mode; bf16_t* h; int ld; const float* stats; const float* c1; const float* c2; const float* lbv;
  bf16_t *hq, *hk, *hv, *hg; _Float16* hlf; int reps;
  template <int SECT>
  DI void body(const f32x4 (&acc)[2][2][4][2], const pg8::Unit& u, int wr, int wc, int fr, int fq) const {
    const int col0 = u.pn * 256 + wc * 32 + 8 * fq;
#pragma unroll
    for (int ai = 0; ai < 2; ++ai)
#pragma unroll
      for (int m = 0; m < 4; ++m) {
        const int row = u.pm * 256 + ai * 128 + wr * 64 + m * 16 + fr; float a, bb, mu, rstd; row_affine(stats, row, a, bb, mu, rstd);
#pragma unroll
        for (int bj = 0; bj < 2; ++bj) {
          const int col = col0 + bj * 128;
          f32x4 v[2];
#pragma unroll
          for (int n = 0; n < 2; ++n) v[n] = acc[ai][bj][m][n] * a + (*(const f32x4*)(c1 + col + 4 * n)) * bb + *(const f32x4*)(c2 + col + 4 * n);
          if (SECT < 0) { u32x4 w; w[0] = pk2(v[0][0], v[0][1]); w[1] = pk2(v[0][2], v[0][3]); w[2] = pk2(v[1][0], v[1][1]); w[3] = pk2(v[1][2], v[1][3]); *(u32x4*)(h + (size_t)row * ld + col) = w; }
          else {
            const int cc = col & 1023; const size_t off = (size_t)row * 1024 + cc;
            if (SECT == 0 || SECT == 3) { u32x4 w;
#pragma unroll
              for (int n = 0; n < 2; ++n) { w[2 * n] = pk2(v[n][0] * sigmoidf_(v[n][0]), v[n][1] * sigmoidf_(v[n][1])); w[2 * n + 1] = pk2(v[n][2] * sigmoidf_(v[n][2]), v[n][3] * sigmoidf_(v[n][3])); }
              *(u32x4*)((SECT == 0 ? hq : hg) + off) = w; }
            else if (SECT == 1) {
              typedef _Float16 h8 __attribute__((ext_vector_type(8))); h8 lf; u32x4 w;
#pragma unroll
              for (int n = 0; n < 2; ++n) { const f32x4 lb = *(const f32x4*)(lbv + cc + 4 * n); float kk[4];
#pragma unroll
                for (int j = 0; j < 4; ++j) { kk[j] = (1.0f - lb[j]) * __builtin_amdgcn_rcpf(1.0f + __builtin_amdgcn_exp2f(1.4426950408889634f * v[n][j])); lf[4 * n + j] = (_Float16)fmaxf(__builtin_amdgcn_logf(1.0f - kk[j]), -87.0f); }
                w[2 * n] = pk2(kk[0], kk[1]); w[2 * n + 1] = pk2(kk[2], kk[3]); }
              *(u32x4*)(hk + off) = w; *(h8*)(hlf + off) = lf;
            }
            else { u32x4 w; w[0] = pk2(v[0][0], v[0][1]); w[1] = pk2(v[0][2], v[0][3]); w[2] = pk2(v[1][0], v[1][1]); w[3] = pk2(v[1][2], v[1][3]); *(u32x4*)(hv + off) = w; }
          }
        }
        asm volatile("" ::: "memory");
      }
  }
  DI void operator()(const f32x4 (&acc)[2][2][4][2], const pg8::Unit& u, int wr, int wc, int fr, int fq) const {
    if (mode == 0) body<-1>(acc, u, wr, wc, fr, fq);
    else { const int sect = u.pn >> 2;
      if (sect == 0) body<0>(acc, u, wr, wc, fr, fq); else if (sect == 1) body<1>(acc, u, wr, wc, fr, fq); else if (sect == 2) body<2>(acc, u, wr, wc, fr, fq); else body<3>(acc, u, wr, wc, fr, fq); }
  }
};

DI void conv_strip(int wv, LAS unsigned char* lds, const float* src, int ldn, int K, int n0, int nvalid, bf16_t* dst, int dstrow0, const float* g, const float* b, float* c1, float* c2, bool perm = true, int kbeg = 0, int kend = -1) {
  if (kend < 0) kend = K;
  LAS bf16_t* tile = (LAS bf16_t*)lds;
  LAS float* red = (LAS float*)(lds + 64 * 72 * 2);
  int tid_ = wv * 64 + lane_id_(); asm volatile("" : "+v"(tid_)); const int tid = tid_, kr = tid >> 4, nc = (tid & 15) * 4;
  const bool colok = (n0 + nc) < nvalid;
  float s1[4] = {0.f, 0.f, 0.f, 0.f}, s2[4] = {0.f, 0.f, 0.f, 0.f};
  f32x4 w[2];
#pragma unroll
  for (int rr = 0; rr < 2; ++rr) w[rr] = colok ? *(const f32x4*)(src + (size_t)(kbeg + kr + rr * 32) * ldn + n0 + nc) : (f32x4){0.f, 0.f, 0.f, 0.f};
  for (int k0 = kbeg; k0 < kend; k0 += 64) {
    lds_barrier();
#pragma unroll
    for (int rr = 0; rr < 2; ++rr) { const int k = k0 + kr + rr * 32; const float gk = g ? g[k] : 1.0f, bk = b ? b[k] : 0.0f;
#pragma unroll
      for (int j = 0; j < 4; ++j) { const bf16_t v = perm ? f2h(w[rr][j] * gk) : f2bf(w[rr][j] * gk); tile[(nc + j) * 72 + kr + rr * 32] = v; s1[j] += perm ? h2f(v) : bf2f(v); s2[j] += bk * w[rr][j]; } }
    if (k0 + 64 < kend) {
#pragma unroll
      for (int rr = 0; rr < 2; ++rr) w[rr] = colok ? *(const f32x4*)(src + (size_t)(k0 + 64 + kr + rr * 32) * ldn + n0 + nc) : (f32x4){0.f, 0.f, 0.f, 0.f};
    }
    lds_barrier();
    { const int n = tid >> 3, kc = (tid & 7) * 8; const int cc = n & 31, slot = (n & 32) + (perm ? 16 * ((cc >> 2) & 1) + 4 * (cc >> 3) + (cc & 3) : cc);
      *(u32x4*)(dst + (size_t)(dstrow0 + slot) * K + k0 + kc) = *(const LAS u32x4*)(tile + n * 72 + kc); }
  }
  if (c1) {
    __syncthreads();
#pragma unroll
    for (int j = 0; j < 4; ++j) { red[kr * 64 + nc + j] = s1[j]; red[2048 + kr * 64 + nc + j] = s2[j]; }
    __syncthreads();
    if (tid < 128) { const int n = tid & 63, which = tid >> 6; float s = 0.f; for (int i = 0; i < 32; ++i) s += red[which * 2048 + i * 64 + n]; (which ? c2 : c1)[dstrow0 + n] = s; }
  }
  __syncthreads();
}

DI void convert_phase(int wv, const P& p_, int L, LAS unsigned char* lds) {
  P p = p_; { size_t z_ = 0; asm volatile("" : "+s"(z_)); p.ws = p_.ws + z_; }
  const int kind = L % 3, slot = L / 3;
  const int nin = kind == 0 ? 44 : (kind == 1 ? 64 : 20);
  const int njobs = 272 + nin + 16 + (kind == 0 ? 6 : 0);
  unsigned char* ws = p.ws;
  for (int j = blockIdx.x; j < njobs; j += gridDim.x) {
    if (j < 272) {
      const int f = j / 136, jj = j % 136;
      const float* lg = p.ln_gain + (size_t)(L * 3 + (f == 0 ? -1 : 1)) * DM; const float* lbias = p.ln_bias + (size_t)(L * 3 + (f == 0 ? -1 : 1)) * DM;
      const bool fold = !(L == 0 && f == 0);
      float* cbase = (float*)(ws + (f == 0 ? C_GU1 : C_GU2));
      if (jj < 88) {
        const int up = jj / 44, s = jj % 44, n0 = s * 64;
        const float* src = (f == 0 ? (up ? p.f1u : p.f1g) : (up ? p.f2u : p.f2g)) + (size_t)L * DM * DFF;
        conv_strip(wv, lds, src, DFF, DM, n0, DFF, (bf16_t*)(ws + (f == 0 ? W_GU1 : W_GU2)), (n0 >> 7) * 256 + (n0 & 127) + up * 128, fold ? lg : nullptr, fold ? lbias : nullptr, cbase, cbase + 5632);
      } else {
        const int s = (jj - 88) / 3, kc = (jj - 88) % 3;
        const float* src = (f == 0 ? p.f1d : p.f2d) + (size_t)L * DFF * DM;
        conv_strip(wv, lds, src, DM, DFF, s * 64, DM, (bf16_t*)(ws + (f == 0 ? W_D1 : W_D2)), s * 64, nullptr, nullptr, nullptr, nullptr, true, kc * 960, kc == 2 ? DFF : kc * 960 + 960);
      }
    } else if (j < 272 + nin) {
      const int s = j - 272; const float* lg = p.ln_gain + (size_t)(L * 3) * DM; const float* lbias = p.ln_bias + (size_t)(L * 3) * DM;
      const float* src = kind == 0 ? p.nsa_win + (size_t)slot * DM * 2608 : (kind == 1 ? p.hg_win + (size_t)slot * DM * 4096 : p.swa_win + (size_t)slot * DM * 1280);
      const int ldn = kind == 0 ? 2608 : (kind == 1 ? 4096 : 1280);
      float* cbase = (float*)(ws + C_IN);
      conv_strip(wv, lds, src, ldn, DM, s * 64, ldn, (bf16_t*)(ws + W_IN), s * 64, lg, lbias, cbase, cbase + 4096);
    } else if (j < 272 + nin + 16) {
      const int s = j - 272 - nin;
      const float* src = kind == 0 ? p.nsa_wout + (size_t)slot * DM * DM : (kind == 1 ? p.hg_wout + (size_t)slot * DM * DM : p.swa_wout + (size_t)slot * DM * DM);
      conv_strip(wv, lds, src, DM, DM, s * 64, DM, (bf16_t*)(ws + W_OUT), s * 64, nullptr, nullptr, nullptr, nullptr);
    } else {
      const int s = j - 272 - nin - 16;
      if (s < 4) { const int kv = s >> 1, st = s & 1; float* pb = (float*)(ws + C_POSB) + kv * 256;
        conv_strip(wv, lds, p.nsa_w1 + ((size_t)slot * 2 + kv) * 2048 * 128, 128, 2048, st * 64, 128, (bf16_t*)(ws + W_W1T) + (size_t)kv * 128 * 2048, st * 64, nullptr, p.nsa_pos + ((size_t)slot * 2 + kv) * 2048, pb + 128, pb, false); }
      else { const int kv = s - 4; conv_strip(wv, lds, p.nsa_w2 + ((size_t)slot * 2 + kv) * 128 * 64, 64, 128, 0, 64, (bf16_t*)(ws + W_W2T) + (size_t)kv * 64 * 128, 0, nullptr, nullptr, nullptr, nullptr, false); }
    }
  }
}

DI void init_phase(int wv, const P& p_) {
  P p = p_; { size_t z_ = 0; asm volatile("" : "+s"(z_)); p.ws = p_.ws + z_; }
  int tid_ = wv * 64 + lane_id_(); asm volatile("" : "+v"(tid_)); const size_t gtid = (size_t)blockIdx.x * 512 + tid_, gsz = (size_t)gridDim.x * 512;
  for (size_t i = gtid; i < (4 * MiB) / 16; i += gsz) ((f32x4*)(p.ws + WS_STATS))[i] = (f32x4){0.f, 0.f, 0.f, 0.f};
  for (size_t i = gtid; i < (size_t)MTOK; i += gsz) { ((float*)(p.ws + WS_DSTATS))[2 * i] = 0.f; ((float*)(p.ws + WS_DSTATS))[2 * i + 1] = 1024.0f * (1.0f - 1e-5f); }
  if (gtid < 13 * 1024) { ((float*)(p.ws + WS_G13))[gtid] = gtid < 1024 ? 1.0f : p.ln_gain[gtid - 1024]; ((float*)(p.ws + WS_B13))[gtid] = gtid < 1024 ? 0.0f : p.ln_bias[gtid - 1024]; }
  for (size_t i = gtid; i < (size_t)MTOK * DM / 4; i += gsz) { const f32x4 v = ((const f32x4*)p.x)[i]; u32x2 w; w.x = pkh2(v[0], v[1]); w.y = pkh2(v[2], v[3]); ((u32x2*)(p.ws + WS_TB))[i] = w; }
  if (gtid < 16 * 132) { const int hd = (int)gtid / 132, d = (int)gtid % 132; int bk;
    if (d < 16) bk = d; else { const float v = logf((float)d / 16.0f) / 2.0794415416798357f * 16.0f; bk = 16 + (int)v; if (bk > 31 || d >= 128) bk = 31; }
    ((float*)(p.ws + C_BTAB))[gtid] = p.rel_bias[bk * 16 + hd]; }
  if (gtid < 1024) { const float a0 = p.hg_lb[gtid], a1 = p.hg_lb[1024 + gtid], a2 = p.hg_lb[2048 + gtid], a3 = p.hg_lb[3072 + gtid];
    const float mx = fmaxf(fmaxf(a0, a1), fmaxf(a2, a3)); const float e0 = expf(a0 - mx), e1 = expf(a1 - mx), e2 = expf(a2 - mx), e3 = expf(a3 - mx);
    ((float*)(p.ws + C_LBV))[gtid] = e1 / (e0 + e1 + e2 + e3); }
}

DI void final_ln(int wv, const P& p_, const float* stats, const float* g, const float* b) {
  P p = p_; { size_t z_ = 0; asm volatile("" : "+s"(z_)); p.ws = p_.ws + z_; }
  int tid_ = wv * 64 + lane_id_(); asm volatile("" : "+v"(tid_)); const size_t gtid = (size_t)blockIdx.x * 512 + tid_, gsz = (size_t)gridDim.x * 512;
  for (size_t i = gtid; i < (size_t)MTOK * DM / 4; i += gsz) {
    const int row = (int)(i >> 8), c = (int)(i & 255) * 4; float a, bb, mu, rstd; row_affine(stats, row, a, bb, mu, rstd);
    const u32x2 hv = ((const u32x2*)(p.ws + WS_TB))[i]; typedef _Float16 h4 __attribute__((ext_vector_type(4))); const h4 hh = __builtin_bit_cast(h4, hv);
    const f32x4 v = {(float)hh[0], (float)hh[1], (float)hh[2], (float)hh[3]}; ((f32x4*)p.out)[i] = (v - mu) * rstd * (*(const f32x4*)(g + c)) + *(const f32x4*)(b + c);
  }
}
#define MFMA32(a, b, c) __builtin_amdgcn_mfma_f32_32x32x16_bf16((a), (b), (c), 0, 0, 0)
#define MFMA16(a, b, c) __builtin_amdgcn_mfma_f32_16x16x32_bf16((a), (b), (c), 0, 0, 0)
DI int crow(int reg, int h) { return (reg & 3) + 8 * (reg >> 2) + 4 * h; }
constexpr int KS_STRIDE = 72;

struct KVRegs { u32x4 k; bf16x8 v; };
DI void kv_load(KVRegs& r, const bf16_t* kg, const bf16_t* vg, size_t ldg, int tid) {
  asm volatile("" : "+v"(tid));
  const int key = tid >> 3, d8 = (tid & 7) * 8;
  r.k = *(const u32x4*)(kg + (size_t)key * ldg + d8); r.v = *(const bf16x8*)(vg + (size_t)key * ldg + d8);
}
DI void kv_store(const KVRegs& r, LAS bf16_t* Ks, LAS bf16_t* Vt, int vstride, int vcol0, int tid) {
  asm volatile("" : "+v"(tid));
  const int key = tid >> 3, d8 = (tid & 7) * 8;
  *(LAS u32x4*)(Ks + key * KS_STRIDE + d8) = r.k;
  const u32x4 vd = __builtin_bit_cast(u32x4, r.v);
  const bool odd = key & 1;
  const unsigned s0 = odd ? vd[0] : vd[2], s1 = odd ? vd[1] : vd[3];
  const unsigned x0 = (unsigned)__builtin_amdgcn_update_dpp(0, (int)s0, 0x128, 0xf, 0xf, false), x1 = (unsigned)__builtin_amdgcn_update_dpp(0, (int)s1, 0x128, 0xf, 0xf, false);
  const unsigned m0 = odd ? vd[2] : vd[0], m1 = odd ? vd[3] : vd[1];
  const unsigned lo0 = odd ? x0 : m0, hi0 = odd ? m0 : x0, lo1 = odd ? x1 : m1, hi1 = odd ? m1 : x1;
  LAS unsigned* vp = (LAS unsigned*)(Vt + (d8 + (odd ? 4 : 0)) * vstride + vcol0 + (key & ~1));
  const int rs = vstride >> 1;
  vp[0] = (lo0 & 0xffffu) | (hi0 << 16); vp[rs] = (lo0 >> 16) | (hi0 & 0xffff0000u);
  vp[2 * rs] = (lo1 & 0xffffu) | (hi1 << 16); vp[3 * rs] = (lo1 >> 16) | (hi1 & 0xffff0000u);
}
DI void attn_scores(const LAS bf16_t* Ks, const bf16x8 (&qf)[4], int r, int h, f32x16 (&s)[2]) {
#pragma unroll
  for (int sub = 0; sub < 2; ++sub) {
    f32x16 a;
#pragma unroll
    for (int i = 0; i < 16; ++i) a[i] = 0.f;
#pragma unroll
    for (int ks = 0; ks < 4; ++ks) { const bf16x8 kf = *(const LAS bf16x8*)(Ks + (sub * 32 + r) * KS_STRIDE + ks * 16 + 8 * h); a = MFMA32(kf, qf[ks], a); }
    s[sub] = a;
  }
}
constexpr float QK_SCALE2 = 0.125f * 1.4426950408889634f;
DI void attn_logits(f32x16 (&s)[2], int t, int tw, int nt, int h, int base, int stride, int dmax, bool ok, const LAS float* btl) {
  const int dmin = tw - (base + 63 * stride), dmaxw = tw + nt - 1 - base;
  const bool far = dmin >= 128, interior = dmin >= 0 && dmaxw < dmax;
  const float bfar = btl[128];
  if (far && interior) {
#pragma unroll
    for (int sub = 0; sub < 2; ++sub)
#pragma unroll
      for (int reg = 0; reg < 16; ++reg) s[sub][reg] = ok ? s[sub][reg] * QK_SCALE2 + bfar : -1e30f;
  } else if (far) {
#pragma unroll
    for (int sub = 0; sub < 2; ++sub)
#pragma unroll
      for (int reg = 0; reg < 16; ++reg) {
        const int kk = sub * 32 + crow(reg, h); const int d = t - (base + kk * stride);
        const bool valid = (d >= 0) && (d < dmax) && ok;
        s[sub][reg] = valid ? s[sub][reg] * QK_SCALE2 + bfar : -1e30f;
      }
  } else {
#pragma unroll
    for (int sub = 0; sub < 2; ++sub)
#pragma unroll
      for (int reg = 0; reg < 16; ++reg) {
        const int kk = sub * 32 + crow(reg, h); const int d = t - (base + kk * stride);
        const bool valid = (d >= 0) && (d < dmax) && ok;
        const int di = d < 0 ? 0 : (d > 128 ? 128 : d);
        const float bsv = btl[di];
        const float x = s[sub][reg] * QK_SCALE2 + bsv;
        s[sub][reg] = valid ? x : -1e30f;
      }
  }
}
DI void attn_pv(const LAS bf16_t* Vt, int vstride, const f32x16 (&p)[2], f32x16 (&O)[2], int r, int h) {
#pragma unroll
  for (int sub = 0; sub < 2; ++sub)
#pragma unroll
    for (int s2 = 0; s2 < 2; ++s2) {
      u32x4 pp;
#pragma unroll
      for (int j = 0; j < 4; ++j) pp[j] = pk2(p[sub][8 * s2 + 2 * j], p[sub][8 * s2 + 2 * j + 1]);
      const bf16x8 pf = __builtin_bit_cast(bf16x8, pp);
#pragma unroll
      for (int dt = 0; dt < 2; ++dt) {
        const LAS bf16_t* vp = Vt + (dt * 32 + r) * vstride + sub * 32 + 16 * s2 + 4 * h;
        const s16x4 lo = *(const LAS s16x4*)vp, hi = *(const LAS s16x4*)(vp + 8);
        const bf16x8 vf = __builtin_shufflevector(lo, hi, 0, 1, 2, 3, 4, 5, 6, 7);
        O[dt] = MFMA32(vf, pf, O[dt]);
      }
    }
}
template <bool WITH_O>
DI void attn_online(f32x16 (&s)[2], float& m, float& l, f32x16 (&O)[2]) {
  float mx = -1e30f;
#pragma unroll
  for (int sub = 0; sub < 2; ++sub)
#pragma unroll
    for (int reg = 0; reg < 16; ++reg) mx = fmaxf(mx, s[sub][reg]);
  mx = fmaxf(mx, __shfl_xor(mx, 32));
  const float mn = fmaxf(m, mx);
  const bool grow = mn > m;
  float ls = 0.f;
#pragma unroll
  for (int sub = 0; sub < 2; ++sub)
#pragma unroll
    for (int reg = 0; reg < 16; ++reg) { const float e = __builtin_amdgcn_exp2f(s[sub][reg] - mn); s[sub][reg] = e; ls += e; }
  if (__any(grow)) {
    const float al = __builtin_amdgcn_exp2f(m - mn); m = mn;
    l = l * al + ls;
    if (WITH_O) {
#pragma unroll
      for (int dt = 0; dt < 2; ++dt)
#pragma unroll
        for (int reg = 0; reg < 16; ++reg) O[dt][reg] *= al;
    }
  } else l += ls;
}
DI void attn_tile(const LAS bf16_t* Ks, const LAS bf16_t* Vt, int vstride, const bf16x8 (&qf)[4], f32x16 (&O)[2], float& m, float& l,
                  int t, int tw, int nt, int r, int h, int base, int stride, int dmax, bool ok, const LAS float* btl) {
  f32x16 s[2];
  attn_scores(Ks, qf, r, h, s);
  const int dmin = tw - (base + 63 * stride), dmaxw = tw + nt - 1 - base;
  float mn, ls = 0.f;
  if (dmin >= 128 && dmaxw < dmax) {
    const float cl = ok ? QK_SCALE2 : 0.f, bl = ok ? btl[128] : -1e30f;
    float mr = -3e38f;
#pragma unroll
    for (int sub = 0; sub < 2; ++sub)
#pragma unroll
      for (int reg = 0; reg < 16; ++reg) mr = fmaxf(mr, s[sub][reg]);
    float mx = mr * cl + bl; mx = fmaxf(mx, __shfl_xor(mx, 32));
    mn = fmaxf(m, mx);
    const float off = bl - mn;
#pragma unroll
    for (int sub = 0; sub < 2; ++sub)
#pragma unroll
      for (int reg = 0; reg < 16; ++reg) { const float e = __builtin_amdgcn_exp2f(s[sub][reg] * cl + off); s[sub][reg] = e; ls += e; }
  } else {
    attn_logits(s, t, tw, nt, h, base, stride, dmax, ok, btl);
    float mx = -1e30f;
#pragma unroll
    for (int sub = 0; sub < 2; ++sub)
#pragma unroll
      for (int reg = 0; reg < 16; ++reg) mx = fmaxf(mx, s[sub][reg]);
    mx = fmaxf(mx, __shfl_xor(mx, 32));
    mn = fmaxf(m, mx);
#pragma unroll
    for (int sub = 0; sub < 2; ++sub)
#pragma unroll
      for (int reg = 0; reg < 16; ++reg) { const float e = __builtin_amdgcn_exp2f(s[sub][reg] - mn); s[sub][reg] = e; ls += e; }
  }
  if (__any(mn > m)) {
    const float al = __builtin_amdgcn_exp2f(m - mn); m = mn;
    l = l * al + ls;
#pragma unroll
    for (int dt = 0; dt < 2; ++dt)
#pragma unroll
      for (int reg = 0; reg < 16; ++reg) O[dt][reg] *= al;
  } else l += ls;
  attn_pv(Vt, vstride, s, O, r, h);
}
DI void zero_o(f32x16 (&O)[2]) {
#pragma unroll
  for (int dt = 0; dt < 2; ++dt)
#pragma unroll
    for (int reg = 0; reg < 16; ++reg) O[dt][reg] = 0.f;
}

DI void nsa_compress_phase(int wv, const P& p_, LAS unsigned char* lds) {
  P p = p_; { size_t z_ = 0; asm volatile("" : "+s"(z_)); p.ws = p_.ws + z_; }
  const bf16_t* hb = (const bf16_t*)(p.ws + WS_BIG); const int ld = 2816;
  int tid_ = wv * 64 + lane_id_(); asm volatile("" : "+v"(tid_)); const int tid = tid_, wid = wv, lane = tid & 63, fr = lane & 15, fq = lane >> 4;
  const int pw = wid & 3, half = wid >> 2;
  LAS bf16_t* hid = (LAS bf16_t*)lds + pw * 16 * 136;
  LAS f32x4* part = (LAS f32x4*)(lds + 32768) + pw * 8 * 64;
  for (int base = blockIdx.x * 4; base < 1024; base += gridDim.x * 4) {
    const int task = base + pw;
    const int kv = task >> 9, b = (task >> 6) & 7, g = (task >> 4) & 3, n0 = (task & 15) * 16;
    const bf16_t* w1t = (const bf16_t*)(p.ws + W_W1T) + (size_t)kv * 128 * 2048; const bf16_t* w2t = (const bf16_t*)(p.ws + W_W2T) + (size_t)kv * 64 * 128;
    const float* posb = (const float*)(p.ws + C_POSB) + kv * 256;
    const int colb = 1024 + kv * 256 + g * 64;
    int n = n0 + fr; if (n > 254) n = 254;
    f32x4 acc[8];
#pragma unroll
    for (int i = 0; i < 8; ++i) acc[i] = (f32x4){0.f, 0.f, 0.f, 0.f};
    { LAS bf16_t* WB = (LAS bf16_t*)(lds + 65536);
      const int er = tid >> 2, kc0 = (tid & 3) * 16;
      const bf16_t* wsrc = w1t + (size_t)er * 2048 + kc0;
      const bf16_t* asrc = hb + (size_t)(b * SEQ + 16 * n + 16 * half) * ld + colb + fq * 8;
      u32x4 wr4[2][2]; bf16x8 afc[2], afn[2];
#pragma unroll
      for (int sl = 0; sl < 2; ++sl)
#pragma unroll
        for (int c = 0; c < 2; ++c) wr4[sl][c] = *(const u32x4*)(wsrc + (size_t)(16 * sl) * 64 + c * 8);
#pragma unroll
      for (int dk = 0; dk < 2; ++dk) afc[dk] = *(const bf16x8*)(asrc + dk * 32);
#pragma unroll 1
      for (int st = 0; st < 16; ++st) {
        LAS bf16_t* wb = WB + (st & 1) * (2 * 128 * 72);
#pragma unroll
        for (int sl = 0; sl < 2; ++sl)
#pragma unroll
          for (int c = 0; c < 2; ++c) *(LAS u32x4*)(wb + (sl * 128 + er) * 72 + kc0 + c * 8) = wr4[sl][c];
        lds_barrier();
        if (st + 1 < 16) {
#pragma unroll
          for (int sl = 0; sl < 2; ++sl)
#pragma unroll
            for (int c = 0; c < 2; ++c) wr4[sl][c] = *(const u32x4*)(wsrc + (size_t)(st + 1 + 16 * sl) * 64 + c * 8);
#pragma unroll
          for (int dk = 0; dk < 2; ++dk) afn[dk] = *(const bf16x8*)(asrc + (size_t)(st + 1) * ld + dk * 32);
        }
#pragma unroll
        for (int dk = 0; dk < 2; ++dk) {
#pragma unroll
          for (int nt = 0; nt < 8; ++nt) { const bf16x8 bfr = *(const LAS bf16x8*)(wb + (half * 128 + nt * 16 + fr) * 72 + dk * 32 + fq * 8); acc[nt] = MFMA16(afc[dk], bfr, acc[nt]); }
        }
        afc[0] = afn[0]; afc[1] = afn[1];
      }
    }
    if (half) {
#pragma unroll
      for (int nt = 0; nt < 8; ++nt) part[nt * 64 + lane] = acc[nt];
    }
    __syncthreads();
    if (!half) {
#pragma unroll
      for (int nt = 0; nt < 8; ++nt) { const float pbv = posb[nt * 16 + fr]; const f32x4 o2 = part[nt * 64 + lane];
#pragma unroll
        for (int j = 0; j < 4; ++j) { const float v = acc[nt][j] + o2[j] + pbv; const float u = 0.7978845608028654f * (v + 0.044715f * v * v * v); const float th = 1.0f - 2.0f * __builtin_amdgcn_rcpf(1.0f + __expf(2.0f * u));
          hid[(4 * fq + j) * 136 + nt * 16 + fr] = f2bf(0.5f * v * (1.0f + th)); } }
    }
    __syncthreads();
    if (!half) {
      f32x4 o[4];
#pragma unroll
      for (int i = 0; i < 4; ++i) o[i] = (f32x4){0.f, 0.f, 0.f, 0.f};
#pragma unroll
      for (int ks = 0; ks < 4; ++ks) { const bf16x8 af = *(const LAS bf16x8*)(hid + fr * 136 + ks * 32 + fq * 8);
#pragma unroll
        for (int nt = 0; nt < 4; ++nt) { const bf16x8 bfr = *(const bf16x8*)(w2t + (size_t)(nt * 16 + fr) * 128 + ks * 32 + fq * 8); o[nt] = MFMA16(af, bfr, o[nt]); } }
      bf16_t* dst = (bf16_t*)(p.ws + (kv ? WS_VC : WS_KC)) + (size_t)((b * 4 + g) * 256) * 64;
#pragma unroll
      for (int nt = 0; nt < 4; ++nt)
#pragma unroll
        for (int j = 0; j < 4; ++j) { const int nn = n0 + 4 * fq + j; dst[(size_t)nn * 64 + nt * 16 + fr] = nn > 254 ? (bf16_t)0 : f2bf(o[nt][j]); }
    }
    __syncthreads();
  }
}

DI void nsa_attn_phase(int wv, const P& p_, LAS unsigned char* lds) {
  P p = p_; { size_t z_ = 0; asm volatile("" : "+s"(z_)); p.ws = p_.ws + z_; }
  const bf16_t* hb = (const bf16_t*)(p.ws + WS_BIG); const int ld = 2816;
  bf16_t* ob = (bf16_t*)(p.ws + WS_O);
  LAS bf16_t* KsB[2] = {(LAS bf16_t*)lds, (LAS bf16_t*)(lds + 17920)}; LAS bf16_t* VtB[2] = {(LAS bf16_t*)(lds + 9216), (LAS bf16_t*)(lds + 17920 + 9216)};
  LAS bf16_t* KC = (LAS bf16_t*)(lds + 35840); LAS bf16_t* VCT = (LAS bf16_t*)(lds + 72704);
  LAS float* OUTL = (LAS float*)(lds + 35840);
  LAS float* G4s = (LAS float*)(lds + 105984); LAS float* Lsm = (LAS float*)(lds + 122368); LAS float* BT = (LAS float*)(lds + 138752);
  LAS unsigned* SELM = (LAS unsigned*)(lds + 140864); LAS unsigned* UNI = (LAS unsigned*)(lds + 141376);
  for (int it = blockIdx.x; it < 2048; it += gridDim.x) {
    int tid_ = wv * 64 + lane_id_(); asm volatile("" : "+v"(tid_)); const int tid = tid_, wid = wv, lane = tid & 63, r = lane & 31, h = lane >> 5, tl = r >> 2, hd = r & 3;
    const int c = it & 255, ii = it >> 8, bg = c >> 3, b = bg >> 2, g = bg & 3, j8 = c & 7;
    const int qi = (ii & 1) ? (16 * (ii >> 1) + 15 - j8) : (16 * (ii >> 1) + j8);
    const int t0 = 64 * qi, tw = t0 + 8 * wid, t = tw + tl, head = g * 4 + hd;
    const int nct = (4 * qi + 2) / 64 + 1;
    __syncthreads();
    { KVRegs ka, kb; const bf16_t* kcg = (const bf16_t*)(p.ws + WS_KC) + (size_t)((b * 4 + g) * 256) * 64; const bf16_t* vcg = (const bf16_t*)(p.ws + WS_VC) + (size_t)((b * 4 + g) * 256) * 64;
      kv_load(ka, kcg, vcg, 64, tid); if (nct > 1) kv_load(kb, kcg + 64 * 64, vcg + 64 * 64, 64, tid);
      kv_store(ka, KC, VCT, 260, 0, tid); if (nct > 1) kv_store(kb, KC + 64 * KS_STRIDE, VCT, 260, 64, tid);
      if (nct > 2) { kv_load(ka, kcg + 128 * 64, vcg + 128 * 64, 64, tid); if (nct > 3) kv_load(kb, kcg + 192 * 64, vcg + 192 * 64, 64, tid);
        kv_store(ka, KC + 128 * KS_STRIDE, VCT, 260, 128, tid); if (nct > 3) kv_store(kb, KC + 192 * KS_STRIDE, VCT, 260, 192, tid); } }
    for (int i = tid; i < 4 * 132; i += 512) BT[i] = ((const float*)(p.ws + C_BTAB))[g * 4 * 132 + i] * 1.4426950408889634f;
    if (tid < 128) SELM[tid] = 0u; if (tid < 2) UNI[tid] = 0u;
    bf16x8 qf[4];
#pragma unroll
    for (int ks = 0; ks < 4; ++ks) qf[ks] = *(const bf16x8*)(hb + (size_t)(b * SEQ + t) * ld + head * 64 + ks * 16 + 8 * h);
    const size_t rowoff = (size_t)(b * SEQ + t) * ld;
    const float gc = sigmoidf_(bf2f(hb[rowoff + 2560 + head * 3 + 0])), gs = sigmoidf_(bf2f(hb[rowoff + 2560 + head * 3 + 1])), gw = sigmoidf_(bf2f(hb[rowoff + 2560 + head * 3 + 2]));
    const LAS float* btl = BT + hd * 132;
    KVRegs kvr; { const size_t go = (size_t)(b * SEQ) * ld + g * 64; kv_load(kvr, hb + go + 1536, hb + go + 1792, ld, tid); }
    __syncthreads();
    f32x16 O[2];
    float m = -1e30f, l = 0.f;
#pragma unroll 1
    for (int tile = 0; tile < nct; ++tile) { f32x16 s[2]; attn_scores(KC + tile * 64 * KS_STRIDE, qf, r, h, s); attn_logits(s, t, tw, 8, h, 16 * (tile * 64) + 31, 16, 0x7fffffff, true, btl); attn_online<false>(s, m, l, O); }
    { const float lt = l + __shfl_xor(l, 32); const float inv = (m > -1e29f && lt > 0.f) ? 1.0f / lt : 0.f;
      zero_o(O);
#pragma unroll 1
      for (int tile = 0; tile < nct; ++tile) {
        f32x16 s[2]; attn_scores(KC + tile * 64 * KS_STRIDE, qf, r, h, s); attn_logits(s, t, tw, 8, h, 16 * (tile * 64) + 31, 16, 0x7fffffff, true, btl);
        LAS float* gp = G4s + (8 * wid + tl) * 64 + 16 * tile + h; asm volatile("" : "+v"(gp));
#pragma unroll
        for (int sub = 0; sub < 2; ++sub) {
#pragma unroll
          for (int reg = 0; reg < 16; ++reg) { const float v = s[sub][reg]; s[sub][reg] = v > -1e29f ? __builtin_amdgcn_exp2f(v - m) * inv : 0.f; }
#pragma unroll
          for (int lg = 0; lg < 4; ++lg) { float G = s[sub][4 * lg] + s[sub][4 * lg + 1] + s[sub][4 * lg + 2] + s[sub][4 * lg + 3], Lv = s[sub][4 * lg + 3];
            G += __shfl_xor(G, 1); G += __shfl_xor(G, 2); Lv += __shfl_xor(Lv, 1); Lv += __shfl_xor(Lv, 2);
            if (hd == 0) { gp[8 * sub + 2 * lg] = G; gp[4096 + 8 * sub + 2 * lg] = Lv; } }
        }
        attn_pv(VCT + tile * 64, 260, s, O, r, h);
      }
    }
    __syncthreads();
#pragma unroll
    for (int dt = 0; dt < 2; ++dt)
#pragma unroll
      for (int reg = 0; reg < 16; ++reg) OUTL[(dt * 16 + reg) * 512 + tid] = gc * O[dt][reg];
    if (qi < 16) { const unsigned long long full = (qi == 63) ? ~0ull : ((1ull << (qi + 1)) - 1ull);
      int tsel = tid; asm volatile("" : "+v"(tsel));
      if (tsel < 64) { SELM[2 * tsel] = (unsigned)full; SELM[2 * tsel + 1] = (unsigned)(full >> 32); } if (tsel == 0) { UNI[0] = (unsigned)full; UNI[1] = (unsigned)(full >> 32); } }
    else {
      int tsel = tid; asm volatile("" : "+v"(tsel));
      const int tok = tsel >> 3, jj = tsel & 7, hiJ = qi - 2;
#pragma unroll
      for (int e = 0; e < 8; ++e) { const int j = jj * 8 + e; if (j >= 1 && j <= hiJ) G4s[tok * 64 + j] += Lsm[tok * 64 + j - 1]; }
      __syncthreads();
      float mine[8]; int cnt[8];
#pragma unroll
      for (int e = 0; e < 8; ++e) { const int j = jj * 8 + e; mine[e] = (j >= 1 && j <= hiJ) ? G4s[tok * 64 + j] : 0.f; cnt[e] = 0; }
      for (int j2 = 1; j2 <= hiJ; ++j2) { const float v = G4s[tok * 64 + j2];
#pragma unroll
        for (int e = 0; e < 8; ++e) { const int j = jj * 8 + e; cnt[e] += (v > mine[e] || (v == mine[e] && j2 < j)) ? 1 : 0; } }
      unsigned long long bits = 0ull;
#pragma unroll
      for (int e = 0; e < 8; ++e) { const int j = jj * 8 + e; if (j >= 1 && j <= hiJ && cnt[e] < 13) bits |= 1ull << j; }
      if (jj == 0) bits |= 1ull | (1ull << qi) | (1ull << (qi - 1));
      const unsigned blo = (unsigned)bits, bhi = (unsigned)(bits >> 32);
      if (blo) { atomicOr((unsigned*)&SELM[2 * tok], blo); atomicOr((unsigned*)&UNI[0], blo); }
      if (bhi) { atomicOr((unsigned*)&SELM[2 * tok + 1], bhi); atomicOr((unsigned*)&UNI[1], bhi); }
    }
    __syncthreads();
    int buf = 0;
    { const unsigned long long selm = (unsigned long long)SELM[2 * (8 * wid + tl)] | ((unsigned long long)SELM[2 * (8 * wid + tl) + 1] << 32);
      unsigned long long rem = (unsigned long long)UNI[0] | ((unsigned long long)UNI[1] << 32);
      m = -1e30f; l = 0.f; zero_o(O);
      const int jw0 = qi > 8 ? qi - 8 : 0;
#pragma unroll 1
      while (rem) {
        const int j = __builtin_ctzll(rem); rem &= rem - 1ull;
        kv_store(kvr, KsB[buf], VtB[buf], 68, 0, tid);
        __syncthreads();
        { const bool more = rem != 0ull; const int jn = more ? __builtin_ctzll(rem) : jw0;
          const size_t go = (size_t)(b * SEQ + jn * 64) * ld + g * 64; kv_load(kvr, hb + go + (more ? 1536 : 2048), hb + go + (more ? 1792 : 2304), ld, tid); }
        attn_tile(KsB[buf], VtB[buf], 68, qf, O, m, l, t, tw, 8, r, h, j * 64, 1, 0x7fffffff, ((selm >> j) & 1ull) != 0ull, btl);
        buf ^= 1;
      }
      const float lt = l + __shfl_xor(l, 32); const float sc = lt > 0.f ? gs / lt : 0.f;
#pragma unroll
      for (int dt = 0; dt < 2; ++dt)
#pragma unroll
        for (int reg = 0; reg < 16; ++reg) OUTL[(dt * 16 + reg) * 512 + tid] += sc * O[dt][reg];
    }
    { m = -1e30f; l = 0.f; zero_o(O);
#pragma unroll 1
      for (int j = (qi > 8 ? qi - 8 : 0); j <= qi; ++j) {
        kv_store(kvr, KsB[buf], VtB[buf], 68, 0, tid);
        __syncthreads();
        if (j < qi) { const size_t go = (size_t)(b * SEQ + (j + 1) * 64) * ld + g * 64; kv_load(kvr, hb + go + 2048, hb + go + 2304, ld, tid); }
        attn_tile(KsB[buf], VtB[buf], 68, qf, O, m, l, t, tw, 8, r, h, j * 64, 1, 512, true, btl);
        buf ^= 1;
      }
      const float lt = l + __shfl_xor(l, 32); const float sc = lt > 0.f ? gw / lt : 0.f;
#pragma unroll
      for (int dt = 0; dt < 2; ++dt)
#pragma unroll
        for (int reg = 0; reg < 16; ++reg) O[dt][reg] = OUTL[(dt * 16 + reg) * 512 + tid] + sc * O[dt][reg];
    }
    bf16_t* op = ob + (size_t)(b * SEQ + t) * DM + head * 64;
#pragma unroll
    for (int dt = 0; dt < 2; ++dt)
#pragma unroll
      for (int i4 = 0; i4 < 4; ++i4) { u32x2 w; w.x = pkh2(O[dt][4 * i4], O[dt][4 * i4 + 1]); w.y = pkh2(O[dt][4 * i4 + 2], O[dt][4 * i4 + 3]); *(u32x2*)(op + dt * 32 + 8 * i4 + 4 * h) = w; }
  }
}

DI void swa_attn_phase(int wv, const P& p_, int slot, LAS unsigned char* lds) {
  P p = p_; { size_t z_ = 0; asm volatile("" : "+s"(z_)); p.ws = p_.ws + z_; }
  const bf16_t* hb = (const bf16_t*)(p.ws + WS_BIG); const int ld = 1280;
  bf16_t* ob = (bf16_t*)(p.ws + WS_O);
  LAS bf16_t* KsB[2] = {(LAS bf16_t*)lds, (LAS bf16_t*)(lds + 17920)}; LAS bf16_t* VtB[2] = {(LAS bf16_t*)(lds + 9216), (LAS bf16_t*)(lds + 17920 + 9216)};
  LAS float* BT = (LAS float*)(lds + 35840);
  int tid_ = wv * 64 + lane_id_(); asm volatile("" : "+v"(tid_)); const int tid = tid_, wid = tid >> 6, lane = tid & 63, r = lane & 31, h = lane >> 5, tl = r >> 3, hd = r & 7;
  int buf = 0;
  for (int it = blockIdx.x; it < 2048; it += gridDim.x) {
    const int b = it >> 8, kv = (it >> 7) & 1, t0 = (it & 127) * 32;
    const int tw = t0 + 4 * wid, t = tw + tl, head = kv * 8 + hd;
    const int lo = t0 - 127, first = lo <= 0 ? 0 : (lo >> 6), last = (t0 + 31) >> 6;
    KVRegs kvr; { const size_t go = (size_t)(b * SEQ + first * 64) * ld + kv * 64; kv_load(kvr, hb + go + 1024, hb + go + 1152, ld, tid); }
    __syncthreads();
    for (int i = tid; i < 8 * 132; i += 512) BT[i] = ((const float*)(p.ws + C_BTAB))[kv * 8 * 132 + i] * 1.4426950408889634f;
    const size_t rowoff = (size_t)(b * SEQ + t) * ld;
    bf16x8 qf[4];
#pragma unroll
    for (int ks = 0; ks < 4; ++ks) qf[ks] = *(const bf16x8*)(hb + rowoff + head * 64 + ks * 16 + 8 * h);
    const LAS float* btl = BT + hd * 132;
    float m = p.swa_sinks[slot * 16 + head] * 1.4426950408889634f, l = (h == 0) ? 1.0f : 0.0f;
    f32x16 O[2]; zero_o(O);
#pragma unroll 1
    for (int j = first; j <= last; ++j) {
      kv_store(kvr, KsB[buf], VtB[buf], 68, 0, tid);
      __syncthreads();
      if (j < last) { const size_t go = (size_t)(b * SEQ + (j + 1) * 64) * ld + kv * 64; kv_load(kvr, hb + go + 1024, hb + go + 1152, ld, tid); }
      attn_tile(KsB[buf], VtB[buf], 68, qf, O, m, l, t, tw, 4, r, h, j * 64, 1, 128, true, btl);
      buf ^= 1;
    }
    const float lt = l + __shfl_xor(l, 32); const float sc = 1.0f / lt;
    bf16_t* op = ob + (size_t)(b * SEQ + t) * DM + head * 64;
#pragma unroll
    for (int dt = 0; dt < 2; ++dt)
#pragma unroll
      for (int i4 = 0; i4 < 4; ++i4) { u32x2 w; w.x = pkh2(sc * O[dt][4 * i4], sc * O[dt][4 * i4 + 1]); w.y = pkh2(sc * O[dt][4 * i4 + 2], sc * O[dt][4 * i4 + 3]); *(u32x2*)(op + dt * 32 + 8 * i4 + 4 * h) = w; }
  }
}
constexpr size_t HG_Q = WS_BIG, HG_K = WS_BIG + 64 * MiB, HG_V = WS_BIG + 128 * MiB, HG_G = WS_BIG + 192 * MiB, HG_LF = WS_BIG + 256 * MiB;
DI void hgrn_scan_phase(int wv, const P& p_, LAS unsigned char* lds, float* sumsq) {
  P p = p_; { size_t z_ = 0; asm volatile("" : "+s"(z_)); p.ws = p_.ws + z_; }
  const bf16_t* hq = (const bf16_t*)(p.ws + HG_Q); const bf16_t* hk = (const bf16_t*)(p.ws + HG_K); const bf16_t* hv = (const bf16_t*)(p.ws + HG_V);
  const _Float16* hlf = (const _Float16*)(p.ws + HG_LF);
  bf16_t* oraw = (bf16_t*)p.out;
  LAS bf16_t* Q = (LAS bf16_t*)lds; LAS bf16_t* Kr = (LAS bf16_t*)(lds + 17408); LAS float* BC = (LAS float*)(lds + 34816); LAS bf16_t* KDT = (LAS bf16_t*)(lds + 68608);
  LAS bf16_t* VT = (LAS bf16_t*)(lds + 87040); LAS bf16_t* ST = (LAS bf16_t*)(lds + 91648); LAS bf16_t* AB = (LAS bf16_t*)(lds + 100352);
  LAS float* SEG = (LAS float*)(lds + 109568); LAS float* DEC = (LAS float*)(lds + 111616); LAS _Float16* LF = (LAS _Float16*)(lds + 112128);
  int tid_ = wv * 64 + lane_id_(); asm volatile("" : "+v"(tid_)); const int tid = tid_, wid = tid >> 6, lane = tid & 63, fr = lane & 15, fq = lane >> 4;
  for (int it = blockIdx.x; it < 256; it += gridDim.x) {
    const int b = it >> 5, hh = (it >> 2) & 7, vq = it & 3;
    __syncthreads();
    for (int i = tid; i < 32 * 136 / 2; i += 512) ((LAS unsigned*)ST)[i] = 0u;
    f32x4 sreg[2]; sreg[0] = (f32x4){0.f, 0.f, 0.f, 0.f}; sreg[1] = sreg[0];
    u32x4 pq[2], pkk[2], plf[2], pv;
    const size_t gb = (size_t)(b * SEQ) * 1024 + hh * 128;
    auto prefetch = [&](int c) {
#pragma unroll
      for (int i = 0; i < 2; ++i) { const int idx = tid + 512 * i, row = idx >> 4, c8 = (idx & 15) * 8; const size_t off = gb + (size_t)(c * 64 + row) * 1024 + c8;
        pq[i] = *(const u32x4*)(hq + off); pkk[i] = *(const u32x4*)(hk + off); plf[i] = *(const u32x4*)(hlf + off); }
      if (tid < 256) { const int row = tid >> 2, c8 = (tid & 3) * 8; pv = *(const u32x4*)(hv + gb + (size_t)(c * 64 + row) * 1024 + vq * 32 + c8); }
    };
    prefetch(0);
    for (int c = 0; c < 64; ++c) {
      lds_barrier();
#pragma unroll
      for (int i = 0; i < 2; ++i) { const int idx = tid + 512 * i, row = idx >> 4, c8 = (idx & 15) * 8;
        *(LAS u32x4*)(Q + row * 136 + c8) = pq[i]; *(LAS u32x4*)(Kr + row * 136 + c8) = pkk[i]; *(LAS u32x4*)(LF + row * 128 + c8) = plf[i]; }
      if (tid < 256) { const int row = tid >> 2, c8 = (tid & 3) * 8; const bf16x8 vv = __builtin_bit_cast(bf16x8, pv);
#pragma unroll
        for (int i = 0; i < 8; ++i) VT[(c8 + i) * 72 + row] = (bf16_t)vv[i]; }
      if (c + 1 < 64) prefetch(c + 1);
      lds_barrier();
      const int kx = tid & 127, seg = tid >> 7;
      float bl[16];
      { float run = 0.f;
#pragma unroll
        for (int i = 0; i < 16; ++i) { run += (float)LF[(16 * seg + i) * 128 + kx]; bl[i] = run; }
        SEG[seg * 128 + kx] = run; }
      lds_barrier();
      { float pre = 0.f, blast = 0.f;
#pragma unroll
        for (int s2 = 0; s2 < 4; ++s2) { const float v = SEG[s2 * 128 + kx]; blast += v; if (s2 < seg) pre += v; }
        u32x4 w0, w1; float kd[16];
#pragma unroll
        for (int i = 0; i < 16; ++i) { const float bc = pre + bl[i]; BC[(16 * seg + i) * 132 + kx] = bc; kd[i] = bf2f(Kr[(16 * seg + i) * 136 + kx]) * __builtin_amdgcn_exp2f(blast - bc); }
#pragma unroll
        for (int j = 0; j < 4; ++j) { w0[j] = pk2(kd[2 * j], kd[2 * j + 1]); w1[j] = pk2(kd[8 + 2 * j], kd[8 + 2 * j + 1]); }
        *(LAS u32x4*)(KDT + kx * 72 + 16 * seg) = w0; *(LAS u32x4*)(KDT + kx * 72 + 16 * seg + 8) = w1;
        if (seg == 0) DEC[kx] = __builtin_amdgcn_exp2f(blast); }
      lds_barrier();
      const int mt = wid >> 1, vt = wid & 1;
      f32x4 oacc = (f32x4){0.f, 0.f, 0.f, 0.f}, a0 = oacc, a1 = oacc;
      const int J0 = 2 * vt;
#pragma unroll
      for (int ks = 0; ks < 4; ++ks) {
        const int kb = 32 * ks + 8 * fq, trow = 16 * mt + fr;
        const bf16x8 qv = *(const LAS bf16x8*)(Q + trow * 136 + kb);
        const f32x4 bc0 = *(const LAS f32x4*)(BC + trow * 132 + kb), bc1 = *(const LAS f32x4*)(BC + trow * 132 + kb + 4);
        const f32x4 r0 = *(const LAS f32x4*)(BC + (16 * mt) * 132 + kb), r1 = *(const LAS f32x4*)(BC + (16 * mt) * 132 + kb + 4);
        u32x4 ai, aq;
#pragma unroll
        for (int j = 0; j < 4; ++j) {
          const float q0 = bf2f((bf16_t)qv[2 * j]), q1 = bf2f((bf16_t)qv[2 * j + 1]);
          const float b0 = j < 2 ? bc0[2 * j] : bc1[2 * j - 4], b1 = j < 2 ? bc0[2 * j + 1] : bc1[2 * j - 3];
          const float rr0 = j < 2 ? r0[2 * j] : r1[2 * j - 4], rr1 = j < 2 ? r0[2 * j + 1] : r1[2 * j - 3];
          ai[j] = pk2(q0 * __builtin_amdgcn_exp2f(b0), q1 * __builtin_amdgcn_exp2f(b1)); aq[j] = pk2(q0 * __builtin_amdgcn_exp2f(b0 - rr0), q1 * __builtin_amdgcn_exp2f(b1 - rr1));
        }
        const bf16x8 sb = *(const LAS bf16x8*)(ST + (16 * vt + fr) * 136 + kb);
        oacc = MFMA16(__builtin_bit_cast(bf16x8, ai), sb, oacc);
#pragma unroll
        for (int jj = 0; jj < 2; ++jj) {
          const int J = J0 + jj; if (J > mt) continue;
          const int srow = 16 * J + fr;
          const bf16x8 kv = *(const LAS bf16x8*)(Kr + srow * 136 + kb);
          const f32x4 c0 = *(const LAS f32x4*)(BC + srow * 132 + kb), c1 = *(const LAS f32x4*)(BC + srow * 132 + kb + 4);
          u32x4 bk;
#pragma unroll
          for (int j = 0; j < 4; ++j) {
            const float k0 = bf2f((bf16_t)kv[2 * j]), k1 = bf2f((bf16_t)kv[2 * j + 1]);
            const float b0 = j < 2 ? c0[2 * j] : c1[2 * j - 4], b1 = j < 2 ? c0[2 * j + 1] : c1[2 * j - 3];
            const float rr0 = j < 2 ? r0[2 * j] : r1[2 * j - 4], rr1 = j < 2 ? r0[2 * j + 1] : r1[2 * j - 3];
            bk[j] = pk2(k0 * __builtin_amdgcn_exp2f(fminf(rr0 - b0, 115.f)), k1 * __builtin_amdgcn_exp2f(fminf(rr1 - b1, 115.f)));
          }
          if (jj == 0) a0 = MFMA16(__builtin_bit_cast(bf16x8, aq), __builtin_bit_cast(bf16x8, bk), a0);
          else a1 = MFMA16(__builtin_bit_cast(bf16x8, aq), __builtin_bit_cast(bf16x8, bk), a1);
        }
      }
#pragma unroll
      for (int jj = 0; jj < 2; ++jj) { const int J = J0 + jj;
#pragma unroll
        for (int reg = 0; reg < 4; ++reg) { const int tt = 16 * mt + 4 * fq + reg, ss = 16 * J + fr; const float v = jj == 0 ? a0[reg] : a1[reg];
          AB[tt * 72 + ss] = (J <= mt && ss <= tt) ? f2bf(v) : (bf16_t)0; } }
      lds_barrier();
#pragma unroll
      for (int k2 = 0; k2 < 2; ++k2) {
        const bf16x8 af = *(const LAS bf16x8*)(AB + (16 * mt + fr) * 72 + 32 * k2 + 8 * fq);
        const bf16x8 vb = *(const LAS bf16x8*)(VT + (16 * vt + fr) * 72 + 32 * k2 + 8 * fq);
        oacc = MFMA16(af, vb, oacc);
      }
#pragma unroll
      for (int reg = 0; reg < 4; ++reg) {
        const int tok = b * SEQ + c * 64 + 16 * mt + 4 * fq + reg; const float v = oacc[reg];
        oraw[(size_t)tok * 1024 + hh * 128 + vq * 32 + 16 * vt + fr] = f2bf(v);
        float sq = v * v; sq += __shfl_xor(sq, 1); sq += __shfl_xor(sq, 2); sq += __shfl_xor(sq, 4); sq += __shfl_xor(sq, 8);
        if (fr == 0) atomicAdd(sumsq + (size_t)tok * 8 + hh, sq);
      }
      { const f32x4 dc = *(const LAS f32x4*)(DEC + 16 * wid + 4 * fq);
        sreg[0] *= dc; sreg[1] *= dc;
#pragma unroll
        for (int k2 = 0; k2 < 2; ++k2) {
          const bf16x8 af = *(const LAS bf16x8*)(KDT + (16 * wid + fr) * 72 + 32 * k2 + 8 * fq);
#pragma unroll
          for (int v2 = 0; v2 < 2; ++v2) { const bf16x8 vb = *(const LAS bf16x8*)(VT + (16 * v2 + fr) * 72 + 32 * k2 + 8 * fq); sreg[v2] = MFMA16(af, vb, sreg[v2]); }
        }
#pragma unroll
        for (int v2 = 0; v2 < 2; ++v2) { u32x2 w; w.x = pk2(sreg[v2][0], sreg[v2][1]); w.y = pk2(sreg[v2][2], sreg[v2][3]); *(LAS u32x2*)(ST + (16 * v2 + fr) * 136 + 16 * wid + 4 * fq) = w; }
      }
    }
  }
}
DI void hgrn_norm_phase(int wv, const P& p_, int slot) {
  P p = p_; { size_t z_ = 0; asm volatile("" : "+s"(z_)); p.ws = p_.ws + z_; }
  const bf16_t* oraw = (const bf16_t*)p.out; const bf16_t* hg = (const bf16_t*)(p.ws + HG_G); const float* sumsq = (const float*)(p.ws + WS_SUMSQ);
  bf16_t* ob = (bf16_t*)(p.ws + WS_O); const float* gain = p.hg_gain + slot * 128;
  int tid_ = wv * 64 + lane_id_(); asm volatile("" : "+v"(tid_)); const size_t gtid = (size_t)blockIdx.x * 512 + tid_, gsz = (size_t)gridDim.x * 512;
  for (size_t i = gtid; i < (size_t)MTOK * 1024 / 8; i += gsz) {
    const size_t e = i * 8; const int row = (int)(e >> 10), col = (int)(e & 1023), hh = col >> 7, vv = col & 127;
    const float rs = rsqrtf(sumsq[(size_t)row * 8 + hh] * (1.0f / 128.0f) + 1e-6f);
    const bf16x8 o8 = *(const bf16x8*)(oraw + e), g8 = *(const bf16x8*)(hg + e);
    u32x4 w;
#pragma unroll
    for (int j = 0; j < 4; ++j) w[j] = pkh2(bf2f((bf16_t)o8[2 * j]) * rs * gain[vv + 2 * j] * bf2f((bf16_t)g8[2 * j]), bf2f((bf16_t)o8[2 * j + 1]) * rs * gain[vv + 2 * j + 1] * bf2f((bf16_t)g8[2 * j + 1]));
    *(u32x4*)(ob + e) = w;
  }
}
#define REP_NSA 1
#define REP_CONV 1
#define REP_CMP 1
#define REP_MISC 1
#define REP_DOWN 1
#define REP_HG 1
#define REP_EPI 1
#ifndef SKIP_MIXERS
#define SKIP_MIXERS 0
#endif
__global__ void __launch_bounds__(512, 2) mega_fwd(P p) {
  extern __shared__ __attribute__((aligned(16))) unsigned char lds_raw[];
  LAS unsigned char* lds = (LAS unsigned char*)lds_raw;
  cg::grid_group grid = cg::this_grid();
  const int wv = __builtin_amdgcn_readfirstlane((int)(threadIdx.x >> 6));
  volatile LAS unsigned* xst = (volatile LAS unsigned*)(lds + LDS_BYTES - 16);
  if (wv == 0 && lane_id_() < 4) xst[lane_id_()] = 0u;
  __syncthreads();
  const XcdBarrier xb = xcd_barrier_post(wv, (unsigned*)(p.ws + WS_BAR), xst);
#define GSYNC() xcd_barrier(wv, xb)
  unsigned char* ws = p.ws;
  init_phase(wv, p);
  for (int L = 0; L < 4; ++L) {
    { size_t z_ = 0; asm volatile("" : "+s"(z_)); ws = p.ws + z_; }
    for (int rep = 0; rep < p.rep_conv; ++rep) convert_phase(wv, p, L, lds);
    if (L == 0) grid.sync(); else GSYNC();
    const int kind = L % 3, slot = L / 3;
    for (int s = 0; s < 3; ++s) {
      { size_t z_ = 0; asm volatile("" : "+s"(z_)); ws = p.ws + z_; }
      float* stats = (float*)(ws + WS_STATS); bf16_t* tb = (bf16_t*)(ws + WS_TB); bf16_t* Hb = (bf16_t*)(ws + WS_BIG); bf16_t* ob = (bf16_t*)(ws + WS_O);
      const int lnp = L * 3 + s - 1;
      const float* stp = (const float*)(ws + WS_DSTATS) + (size_t)(lnp + 1) * MTOK * 2;
      pg8::Gemm gr; float scale;
      if (s != 1) {
        pg8::Gemm g; g.A = tb; g.Bt = (const bf16_t*)(ws + (s == 0 ? W_GU1 : W_GU2)); g.M = MTOK; g.N = 5632; g.K = DM;
        pg8::StaticOrder S; S.init(g.M, g.N, gridDim.x, blockIdx.x);
        EpiUp E; E.reps = p.rep_epi; E.H = Hb; E.stats = stp; E.c1 = (const float*)(ws + (s == 0 ? C_GU1 : C_GU2)); E.c2 = E.c1 + 5632;
        pg8::gemm_phase(wv, lds, g, S, E);
        GSYNC();
        gr.A = Hb; gr.Bt = (const bf16_t*)(ws + (s == 0 ? W_D1 : W_D2)); gr.M = MTOK; gr.N = DM; gr.K = DFF; scale = 0.5f;
      } else {
        pg8::Gemm g; g.A = tb; g.Bt = (const bf16_t*)(ws + W_IN); g.M = MTOK; g.N = kind == 0 ? 2816 : (kind == 1 ? 4096 : 1280); g.K = DM;
        pg8::StaticOrder S; S.init(g.M, g.N, gridDim.x, blockIdx.x);
        EpiIn E; E.reps = 1; E.mode = kind == 1 ? 1 : 0; E.h = Hb; E.ld = g.N; E.stats = stp; E.c1 = (const float*)(ws + C_IN); E.c2 = E.c1 + 4096; E.lbv = (const float*)(ws + C_LBV);
        E.hq = (bf16_t*)(ws + HG_Q); E.hk = (bf16_t*)(ws + HG_K); E.hv = (bf16_t*)(ws + HG_V); E.hg = (bf16_t*)(ws + HG_G); E.hlf = (_Float16*)(ws + HG_LF);
        pg8::gemm_phase(wv, lds, g, S, E);
        GSYNC();
#if !SKIP_MIXERS
        if (kind == 0) {
          for (int rep = 0; rep < p.rep_cmp; ++rep) nsa_compress_phase(wv, p, lds);
          GSYNC();
          for (int rep = 0; rep < p.rep_nsa; ++rep) { if (rep) GSYNC(); nsa_attn_phase(wv, p, lds); }
        }
        else if (kind == 1) {
          for (int rep = p.rep_hg - 1; rep >= 0; --rep) hgrn_scan_phase(wv, p, lds, (float*)(ws + (rep ? WS_KC : WS_SUMSQ)));
          GSYNC(); hgrn_norm_phase(wv, p, slot); }
        else {
          for (int rep = 0; rep < p.rep_misc; ++rep) swa_attn_phase(wv, p, slot, lds);
        }
#endif
        GSYNC();
        gr.A = ob; gr.Bt = (const bf16_t*)(ws + W_OUT); gr.M = MTOK; gr.N = DM; gr.K = DM; scale = 1.0f;
      }
      pg8::StaticOrder S2; S2.init(gr.M, gr.N, gridDim.x, blockIdx.x);
      EpiRes R; R.reps = 1; R.stats_prev = stp; R.g = (const float*)(ws + WS_G13) + (size_t)(lnp + 1) * DM; R.b = (const float*)(ws + WS_B13) + (size_t)(lnp + 1) * DM;
      R.stats_new = stats + (size_t)(lnp + 1) * MTOK * 2; R.tb = tb; R.scale = scale;
      for (int rep = (s != 1 ? p.rep_down : 1) - 1; rep >= 0; --rep) {
        R.tb = tb; R.stats_new = stats + (size_t)(lnp + 1) * MTOK * 2;
        pg8::gemm_phase(wv, lds, gr, S2, R);
        GSYNC();
      }
    }
  }
  final_ln(wv, p, (float*)(ws + WS_STATS) + (size_t)11 * MTOK * 2, p.ln_gain + 11 * DM, p.ln_bias + 11 * DM);
}

extern "C" void kernel_launch(void* const* d_in, const int* in_sizes, int n_in, void* d_out, int out_size, void* d_ws, size_t ws_size, hipStream_t stream) {
  static int grid = 0;
  if (grid == 0) {
    if (n_in != 22 || ws_size < WS_END) { fprintf(stderr, "kernel_launch: unexpected n_in %d / ws_size %zu (need %zu)\n", n_in, ws_size, (size_t)WS_END); grid = -1; return; }
    int dev = 0, cus = 0, per_cu = 0;
    hipGetDevice(&dev); hipDeviceGetAttribute(&cus, hipDeviceAttributeMultiprocessorCount, dev);
    if (hipFuncSetAttribute((const void*)mega_fwd, hipFuncAttributeMaxDynamicSharedMemorySize, LDS_BYTES) != hipSuccess) { fprintf(stderr, "hipFuncSetAttribute failed\n"); grid = -1; return; }
    hipOccupancyMaxActiveBlocksPerMultiprocessor(&per_cu, (const void*)mega_fwd, 512, LDS_BYTES);
    if (per_cu < 1) { fprintf(stderr, "occupancy query says %d blocks/CU\n", per_cu); per_cu = 1; }
    (void)hipGetLastError();
    grid = cus * 1;
  }
  if (grid < 0) return;
  if (hipMemsetAsync((char*)d_ws + WS_BAR, 0, 16384, stream) != hipSuccess) { fprintf(stderr, "memset failed\n"); return; }
  P p{};
  const float** pp = (const float**)&p;
  for (int i = 0; i < 22; ++i) pp[i] = (const float*)d_in[i];
  p.out = (float*)d_out; p.ws = (unsigned char*)d_ws;
  p.rep_nsa = REP_NSA; p.rep_conv = REP_CONV; p.rep_cmp = REP_CMP; p.rep_misc = REP_MISC; p.rep_down = REP_DOWN; p.rep_hg = REP_HG; p.rep_epi = REP_EPI; p.rep_pad = 0;
  void* args[] = {&p};
  hipError_t e = hipLaunchCooperativeKernel((const void*)mega_fwd, dim3(grid), dim3(512), args, LDS_BYTES, stream);
  if (e != hipSuccess) fprintf(stderr, "cooperative launch failed: %s (grid %d)\n", hipGetErrorString(e), grid);
}
```

```cpp
#include <hip/hip_runtime.h>
#include <hip/hip_cooperative_groups.h>
#include <cstdio>
namespace cg = cooperative_groups;

typedef unsigned short bf16_t;
typedef short bf16x8 __attribute__((ext_vector_type(8)));
typedef short s16x4 __attribute__((ext_vector_type(4)));
typedef _Float16 half8 __attribute__((ext_vector_type(8)));
typedef float f32x4 __attribute__((ext_vector_type(4)));
typedef float f32x16 __attribute__((ext_vector_type(16)));
typedef unsigned u32x2 __attribute__((ext_vector_type(2)));
typedef unsigned u32x4 __attribute__((ext_vector_type(4)));
#define LAS __attribute__((address_space(3)))
#define DI __device__ __forceinline__

constexpr int MTOK = 32768, DM = 1024, DFF = 2816, SEQ = 4096, NB = 8;
constexpr float ALPHA = 1.681792830507429f;
constexpr size_t MiB = 1ull << 20;
constexpr size_t W_GU1 = 0, W_D1 = 11534336, W_GU2 = 17301504, W_D2 = 28835840, W_IN = 34603008, W_OUT = 42991616,
                 W_W1T = 45088768, W_W2T = 46137344, W_C = 46170112;
constexpr size_t C_GU1 = W_C, C_GU2 = C_GU1 + 2 * 5632 * 4, C_IN = C_GU2 + 2 * 5632 * 4, C_POSB = C_IN + 2 * 4096 * 4,
                 C_LBV = C_POSB + 2 * 256 * 4, C_BTAB = C_LBV + 1024 * 4, C_END = C_BTAB + 16 * 132 * 4;
constexpr size_t WS_TB = 48 * MiB, WS_BIG = 112 * MiB, WS_O = 432 * MiB, WS_MISC = 496 * MiB;
constexpr size_t WS_DSTATS = WS_MISC, WS_STATS = WS_DSTATS + 262144, WS_SUMSQ = WS_STATS + 3 * MiB, WS_KC = WS_SUMSQ + 1 * MiB, WS_VC = WS_KC + 1 * MiB, WS_BAR = WS_VC + 1 * MiB,
                 WS_G13 = WS_BAR + 16384, WS_B13 = WS_G13 + 13 * 4096, WS_END = WS_B13 + 13 * 4096;
static_assert(C_END <= 48 * MiB, "weights region");
constexpr int LDS_BYTES = 144 * 1024;

struct P {
  const float *x, *rel_bias, *ln_gain, *ln_bias, *f1g, *f1u, *f1d, *f2g, *f2u, *f2d, *nsa_win, *nsa_wout, *nsa_pos, *nsa_w1, *nsa_w2,
      *hg_win, *hg_wout, *hg_gain, *hg_lb, *swa_win, *swa_wout, *swa_sinks;
  float* out; unsigned char* ws;
  int rep_nsa, rep_conv, rep_cmp, rep_misc, rep_down, rep_hg, rep_epi, rep_pad;
};

DI unsigned pk2(float a, float b) { typedef __bf16 bf2 __attribute__((ext_vector_type(2))); bf2 v; v[0] = (__bf16)a; v[1] = (__bf16)b; return __builtin_bit_cast(unsigned, v); }
DI unsigned pkh2(float a, float b) { typedef _Float16 h2 __attribute__((ext_vector_type(2))); h2 v; v[0] = (_Float16)a; v[1] = (_Float16)b; return __builtin_bit_cast(unsigned, v); }
DI bf16_t f2h(float a) { return __builtin_bit_cast(unsigned short, (_Float16)a); }
DI float h2f(bf16_t v) { return (float)__builtin_bit_cast(_Float16, v); }
DI bf16_t f2bf(float a) { return __builtin_bit_cast(unsigned short, (__bf16)a); }
DI float bf2f(bf16_t v) { return __uint_as_float(((unsigned)v) << 16); }
DI int lane_id_() { int l; asm volatile("v_mbcnt_lo_u32_b32 %0, -1, 0\n\tv_mbcnt_hi_u32_b32 %0, -1, %0" : "=v"(l)); return l; }
DI void lds_barrier() { asm volatile("s_waitcnt lgkmcnt(0)\n\ts_barrier" ::: "memory"); }
DI float sigmoidf_(float v) { return __builtin_amdgcn_rcpf(1.0f + __builtin_amdgcn_exp2f(-1.4426950408889634f * v)); }


#define XB_TMO      128
#define XB_XCNT(j)  (256  + 64 * (j))
#define XB_XSUB(j)  (1280 + 64 * (j))
#define XB_XGEN(j)  (2304 + 64 * (j))
#define XB_TOP      3328
#define XB_TOPGEN   3392
#define XCD_BAR_WORDS 3456
#define XB_SPIN_CAP (1u << 20)
DI unsigned xb_ld(unsigned* p)              { return __hip_atomic_load(p, __ATOMIC_RELAXED, __HIP_MEMORY_SCOPE_AGENT); }
DI unsigned xb_add(unsigned* p, unsigned v) { return __hip_atomic_fetch_add(p, v, __ATOMIC_RELAXED, __HIP_MEMORY_SCOPE_AGENT); }
DI unsigned xb_xcc_id() { return (unsigned)__builtin_amdgcn_s_getreg((3 << 11) | 20) & 0xFu; }
#define XB_SPIN(cond, bar) do { unsigned _sp = 0; while (cond) { __builtin_amdgcn_s_sleep(1); \
    if ((++_sp & 255u) == 0u) { if (xb_ld(&(bar)[XB_TMO])) break; if (_sp > XB_SPIN_CAP) { atomicAdd(&(bar)[XB_TMO], 1u); break; } } } } while (0)
struct XcdBarrier { unsigned* bar; unsigned x; volatile LAS unsigned* st; };
DI XcdBarrier xcd_barrier_post(int wv, unsigned* bar, volatile LAS unsigned* st) {
  XcdBarrier b; b.bar = bar; b.x = xb_xcc_id(); b.st = st;
  if (wv == 0 && lane_id_() == 0) (void)xb_add(&bar[XB_XCNT(b.x)], 1u);
  return b;
}
DI void xcd_barrier_complete(unsigned* bar, unsigned x, unsigned& nloc, unsigned& nx) {
  const unsigned G = gridDim.x * gridDim.y * gridDim.z;
  unsigned sum, cnt, mine, sp = 0u;
  for (;;) {
    sum = 0u; cnt = 0u; mine = 0u;
#pragma unroll 1
    for (unsigned j = 0; j < 16; ++j) { const unsigned c = xb_ld(&bar[XB_XCNT(j)]); sum += c; cnt += (c > 0u) ? 1u : 0u; mine = (j == x) ? c : mine; }
    if (sum == G) break;
    __builtin_amdgcn_s_sleep(1);
    if ((++sp & 255u) == 0u) { if (xb_ld(&bar[XB_TMO])) break; if (sp > XB_SPIN_CAP) { atomicAdd(&bar[XB_TMO], 1u); break; } }
  }
  nloc = mine > 0u ? mine : 1u; nx = cnt > 0u ? cnt : 1u;
}
DI void xcd_barrier(int wv, const XcdBarrier& b) {
  asm volatile("s_waitcnt vmcnt(0)" ::: "memory");
  __syncthreads();
  if (wv == 0 && lane_id_() == 0) {
    unsigned* bar = b.bar;
    __builtin_amdgcn_s_waitcnt(0);
    unsigned nloc = b.st[0], nx = b.st[1];
    if (nloc == 0u) { xcd_barrier_complete(bar, b.x, nloc, nx); b.st[0] = nloc; b.st[1] = nx; }
    const unsigned old = xb_add(&bar[XB_XSUB(b.x)], 1u);
    const unsigned gen = old / nloc;
    if (old + 1u == (gen + 1u) * nloc) {
      __builtin_amdgcn_fence(__ATOMIC_RELEASE, "agent");
      asm volatile("s_waitcnt vmcnt(0)" ::: "memory");
      const unsigned og = xb_add(&bar[XB_TOP], 1u);
      const unsigned tg = og / nx;
      if (og + 1u == (tg + 1u) * nx) xb_add(&bar[XB_TOPGEN], 1u);
      else XB_SPIN(xb_ld(&bar[XB_TOPGEN]) == tg, bar);
      __builtin_amdgcn_fence(__ATOMIC_ACQUIRE, "agent");
      xb_add(&bar[XB_XGEN(b.x)], 1u);
      asm volatile("s_waitcnt vmcnt(0)" ::: "memory");
    } else {
      XB_SPIN(xb_ld(&bar[XB_XGEN(b.x)]) == gen, bar);
      __builtin_amdgcn_fence(__ATOMIC_ACQUIRE, "agent");
      asm volatile("s_waitcnt vmcnt(0)" ::: "memory");
    }
  }
  __syncthreads();
}

namespace pg8 {
constexpr int BM = 256, BK = 64, HALF = 128, HTB = HALF * BK * 2, STAGE_BYTES = 8 * HTB, NXCD = 8, WGM = 8;
DI int lds_byte(int r, int c) { const int st = (r >> 4) * 2 + (c >> 5), rr = r & 15, cc = c & 31, ob = rr * 64 + cc * 2; return st * 1024 + (ob ^ (((ob >> 9) & 1) << 5)); }
DI void stage_rc(int b, int& R, int& C) { const int st = b / 1024, sb = b % 1024, swz = sb ^ (((sb >> 9) & 1) << 5); R = (st >> 1) * 16 + swz / 64; C = (st & 1) * 32 + (swz % 64) / 2; }
struct Unit { int pm, pn; };
struct Gemm { const bf16_t* A; const bf16_t* Bt; int M, N, K; };
struct StaticOrder {
  int nM, nN, nwg, G, c;
  DI void init(int M, int N, int G_, int c_) { nM = M / BM; nN = N / BM; nwg = nM * nN; G = G_; c = c_; }
  DI bool next(int i, Unit& u) const {
    const long L = (long)i * G + c; if (L >= nwg) return false;
    int wgid = (int)L; { const int q = nwg / NXCD, r = nwg % NXCD, xcd = wgid % NXCD, off = wgid / NXCD; wgid = (xcd < r ? xcd * (q + 1) : r * (q + 1) + (xcd - r) * q) + off; }
    const int nig = WGM * nN, gid = wgid / nig, fm = gid * WGM, gsz = (nM - fm) < WGM ? (nM - fm) : WGM;
    u.pm = fm + ((wgid % nig) % gsz); u.pn = (wgid % nig) / gsz; return true;
  }
};
template <class Epi>
DI void gemm_phase(int wv, LAS unsigned char* lds, const Gemm g, const StaticOrder& S, const Epi& E) {
  int tid_ = wv * 64 + lane_id_(); asm volatile("" : "+v"(tid_)); const int tid = tid_, wid = __builtin_amdgcn_readfirstlane(tid >> 6), lane = tid & 63, wr = wid >> 2, wc = wid & 3, fr = lane & 15, fq = lane >> 4;
  const int K = g.K, nt = K / BK;
  unsigned voffA[2];
#pragma unroll
  for (int i = 0; i < 2; ++i) { int R, C; stage_rc(tid * 16 + i * 8192, R, C); voffA[i] = (unsigned)(R * K + C) * 2u; }
  const size_t kstep = (size_t)(BK * 2), hstep = (size_t)HALF * K * 2, tstep = 2 * hstep;
  const unsigned ldsw = (unsigned)wid * 1024u;
  const int aoff = lds_byte(wr * 64 + fr, fq * 8), boff = lds_byte(wc * 32 + fr, fq * 8);
#define PG8_SA(b, h) (((b) * 2 + (h)) * HTB)
#define PG8_SB(b, h) ((4 + (b) * 2 + (h)) * HTB)
#define PG8_STAGE(bufoff, gbase, voff) do { _Pragma("unroll") for (int _i = 0; _i < 2; ++_i) \
    __builtin_amdgcn_global_load_lds((const unsigned*)((const char*)(gbase) + (voff)[_i]), (LAS unsigned*)(lds + (bufoff) + ldsw + _i * 8192), 16, 0, 0); } while (0)
#define PG8_LDA(dst, b, h) do { _Pragma("unroll") for (int m = 0; m < 4; ++m) _Pragma("unroll") for (int k = 0; k < 2; ++k) dst[m][k] = *(const LAS bf16x8*)(lds + PG8_SA(b, h) + aoff + m * 2048 + k * 1024); } while (0)
#define PG8_LDB(dst, b, h) do { _Pragma("unroll") for (int n = 0; n < 2; ++n) _Pragma("unroll") for (int k = 0; k < 2; ++k) dst[n][k] = *(const LAS bf16x8*)(lds + PG8_SB(b, h) + boff + n * 2048 + k * 1024); } while (0)
#define PG8_MMA(ai, bj, At, Bt) do { __builtin_amdgcn_s_setprio(1); _Pragma("unroll") for (int m = 0; m < 4; ++m) _Pragma("unroll") for (int n = 0; n < 2; ++n) _Pragma("unroll") for (int k = 0; k < 2; ++k) \
    acc[ai][bj][m][n] = __builtin_amdgcn_mfma_f32_16x16x32_f16(__builtin_bit_cast(half8, Bt[n][k]), __builtin_bit_cast(half8, At[m][k]), acc[ai][bj][m][n], 0, 0, 0); __builtin_amdgcn_s_setprio(0); } while (0)
#define PG8_WAIT_V(n) asm volatile("s_waitcnt vmcnt(" #n ")" ::: "memory")
#define PG8_WAIT_L(n) asm volatile("s_waitcnt lgkmcnt(" #n ")" ::: "memory")
#define PG8_BAR __builtin_amdgcn_s_barrier()
#define PG8_SCHED __builtin_amdgcn_sched_barrier(0)
  Unit cur, nxt; int ui = 0;
  if (!S.next(0, cur)) return;
  f32x4 acc[2][2][4][2];
#pragma unroll
  for (int a = 0; a < 2; ++a)
#pragma unroll
    for (int b = 0; b < 2; ++b)
#pragma unroll
      for (int m = 0; m < 4; ++m)
#pragma unroll
        for (int n = 0; n < 2; ++n) acc[a][b][m][n] = (f32x4){0.f, 0.f, 0.f, 0.f};
  bf16x8 At[4][2], B0[2][2], B1[2][2];
  const char* cA = (const char*)g.A + (size_t)cur.pm * tstep; const char* cB = (const char*)g.Bt + (size_t)cur.pn * tstep;
  E.pre(lds, cur, 0, wid, lane, wr);
  PG8_STAGE(PG8_SB(0, 0), cB, voffA); PG8_STAGE(PG8_SA(0, 0), cA, voffA); PG8_STAGE(PG8_SB(0, 1), cB + hstep, voffA); PG8_STAGE(PG8_SA(0, 1), cA + hstep, voffA);
  if (wr == 1) PG8_BAR;
  PG8_WAIT_V(4); PG8_BAR;
  PG8_STAGE(PG8_SB(1, 0), cB + kstep, voffA); PG8_STAGE(PG8_SA(1, 0), cA + kstep, voffA); PG8_STAGE(PG8_SB(1, 1), cB + hstep + kstep, voffA);
  PG8_WAIT_V(6); PG8_BAR;
  for (;;) {
    const bool has_next = S.next(ui + 1, nxt);
    const char* nA = has_next ? (const char*)g.A + (size_t)nxt.pm * tstep : cA; const char* nB = has_next ? (const char*)g.Bt + (size_t)nxt.pn * tstep : cB;
    for (int t = 0; t < nt; t += 2) {
      const bool last = (t == nt - 2);
      const char* a1 = cA + (size_t)(t + 1) * kstep;
      const char* a2 = last ? nA : cA + (size_t)(t + 2) * kstep; const char* b2 = last ? nB : cB + (size_t)(t + 2) * kstep;
      const char* a3 = a2 + kstep; const char* b3 = b2 + kstep;
      PG8_LDB(B0, 0, 0); PG8_SCHED; PG8_LDA(At, 0, 0); PG8_STAGE(PG8_SA(1, 1), a1 + hstep, voffA);
      PG8_WAIT_L(8); PG8_BAR; PG8_WAIT_L(0); PG8_MMA(0, 0, At, B0); PG8_BAR; PG8_SCHED;
      PG8_LDB(B1, 0, 1); PG8_STAGE(PG8_SB(0, 0), b2, voffA);
      PG8_BAR; PG8_WAIT_L(0); PG8_MMA(0, 1, At, B1); PG8_BAR;
      PG8_LDA(At, 0, 1); PG8_STAGE(PG8_SA(0, 0), a2, voffA);
      PG8_BAR; PG8_WAIT_L(0); PG8_MMA(1, 0, At, B0); PG8_BAR; PG8_SCHED;
      PG8_STAGE(PG8_SB(0, 1), b2 + hstep, voffA);
      PG8_WAIT_V(6); PG8_BAR; PG8_MMA(1, 1, At, B1); PG8_BAR;
      PG8_LDB(B0, 1, 0); PG8_SCHED; PG8_LDA(At, 1, 0); PG8_STAGE(PG8_SA(0, 1), a2 + hstep, voffA);
      PG8_WAIT_L(8); PG8_BAR; PG8_WAIT_L(0); PG8_MMA(0, 0, At, B0); PG8_BAR; PG8_SCHED;
      PG8_LDB(B1, 1, 1); PG8_STAGE(PG8_SB(1, 0), b3, voffA);
      PG8_BAR; PG8_WAIT_L(0); PG8_MMA(0, 1, At, B1); PG8_BAR;
      PG8_LDA(At, 1, 1); PG8_STAGE(PG8_SA(1, 0), a3, voffA);
      PG8_BAR; PG8_WAIT_L(0); PG8_MMA(1, 0, At, B0); PG8_BAR; PG8_SCHED;
      PG8_STAGE(PG8_SB(1, 1), b3 + hstep, voffA);
      PG8_WAIT_V(6); PG8_BAR; PG8_MMA(1, 1, At, B1); PG8_BAR;
    }
    for (int r_ = 0; r_ < E.reps; ++r_) E(acc, cur, wr, wc, fr, fq, lds, ui, wid);
    if (!has_next) break;
    E.pre(lds, nxt, ui + 1, wid, lane, wr);
#pragma unroll
    for (int a = 0; a < 2; ++a)
#pragma unroll
      for (int b = 0; b < 2; ++b)
#pragma unroll
        for (int m = 0; m < 4; ++m)
#pragma unroll
          for (int n = 0; n < 2; ++n) acc[a][b][m][n] = (f32x4){0.f, 0.f, 0.f, 0.f};
    cur = nxt; cA = nA; cB = nB; ++ui;
  }
  PG8_WAIT_V(0);
  if (wr == 0) PG8_BAR;
  PG8_BAR;
}
}
DI void row_affine(const float* stats, int row, float& a, float& bb, float& mu, float& rstd) {
  const float s = stats[2 * row], ss = stats[2 * row + 1]; mu = s * (1.0f / 1024.0f); const float var = fmaxf(ss * (1.0f / 1024.0f) - mu * mu, 0.f); rstd = rsqrtf(var + 1e-5f); a = rstd; bb = -rstd * mu;
}
struct EpiUp {
  bf16_t* H; const float* stats; const float* c1; const float* c2; int reps;
  DI void pre(LAS unsigned char* lds, const pg8::Unit& u, int ui, int wid, int lane, int wr) const {
    asm volatile("" : "+v"(lane));
    __builtin_amdgcn_global_load_lds((const unsigned*)(stats + (size_t)(u.pm * 256 + (lane >> 5) * 128 + wr * 64 + (lane & 31) * 2) * 2), (LAS unsigned*)(lds + 131072 + wid * 1024), 16, 0, 0);
    if (wid < 2) __builtin_amdgcn_global_load_lds((const unsigned*)((wid ? c2 : c1) + u.pn * 256 + lane * 4), (LAS unsigned*)(lds + 139264 + (ui & 1) * 2048 + wid * 1024), 16, 0, 0);
  }
  DI void operator()(const f32x4 (&acc)[2][2][4][2], const pg8::Unit& u, int wr, int wc, int fr, int fq, LAS unsigned char* lds, int ui, int wid) const {
    const int colg = u.pn * 256 + wc * 32 + 8 * fq, hcol = u.pn * 128 + wc * 32 + 8 * fq;
    f32x4 c1g[2], c2g[2], c1u[2], c2u[2];
    int fq_ = fq, fr_ = fr; asm volatile("" : "+v"(fq_), "+v"(fr_));
    const LAS float* cl = (const LAS float*)(lds + 139264 + (ui & 1) * 2048) + wc * 32 + 8 * fq_;
#pragma unroll
    for (int n = 0; n < 2; ++n) { c1g[n] = *(const LAS f32x4*)(cl + 4 * n); c2g[n] = *(const LAS f32x4*)(cl + 256 + 4 * n); c1u[n] = *(const LAS f32x4*)(cl + 128 + 4 * n); c2u[n] = *(const LAS f32x4*)(cl + 256 + 128 + 4 * n); }
    float ra[8], rb[8];
    const LAS float* sl = (const LAS float*)(lds + 131072 + wid * 1024);
#pragma unroll
    for (int i = 0; i < 8; ++i) { typedef float f32x2_ __attribute__((ext_vector_type(2))); const f32x2_ sv = *(const LAS f32x2_*)(sl + (i >> 2) * 128 + ((i & 3) * 16 + fr_) * 2);
      const float mu = sv.x * (1.0f / 1024.0f), var = fmaxf(sv.y * (1.0f / 1024.0f) - mu * mu, 0.f), rstd = rsqrtf(var + 1e-5f); ra[i] = rstd; rb[i] = -rstd * mu; }
#pragma unroll
    for (int ai = 0; ai < 2; ++ai)
#pragma unroll
      for (int m = 0; m < 4; ++m) {
        const int row = u.pm * 256 + ai * 128 + wr * 64 + m * 16 + fr; const float a = ra[ai * 4 + m], bb = rb[ai * 4 + m];
        u32x4 w;
#pragma unroll
        for (int n = 0; n < 2; ++n) {
          const f32x4 gv = acc[ai][0][m][n] * a + c1g[n] * bb + c2g[n], uv = acc[ai][1][m][n] * a + c1u[n] * bb + c2u[n];
          float h[4];
#pragma unroll
          for (int j = 0; j < 4; ++j) h[j] = gv[j] * sigmoidf_(gv[j]) * uv[j];
          w[2 * n] = pkh2(h[0], h[1]); w[2 * n + 1] = pkh2(h[2], h[3]);
        }
        *(u32x4*)(H + (size_t)row * DFF + hcol) = w;
        asm volatile("" ::: "memory");
      }
  }
};
struct EpiRes {
  const float* stats_prev; const float* g; const float* b; float* stats_new; bf16_t* tb; float scale; int reps;
  DI void pre(LAS unsigned char*, const pg8::Unit&, int, int, int, int) const {}
  DI void operator()(const f32x4 (&acc)[2][2][4][2], const pg8::Unit& u, int wr, int wc, int fr, int fq, LAS unsigned char* lds, int ui, int wid) const {
    const int col0 = u.pn * 256 + wc * 32 + 8 * fq;
    float rmu[8], rrs[8];
#pragma unroll
    for (int i = 0; i < 8; ++i) { float a, bb; row_affine(stats_prev, u.pm * 256 + (i >> 2) * 128 + wr * 64 + (i & 3) * 16 + fr, a, bb, rmu[i], rrs[i]); }
#pragma unroll
    for (int ai = 0; ai < 2; ++ai) {
      half8 tpv[4][2];
#pragma unroll
      for (int m = 0; m < 4; ++m)
#pragma unroll
        for (int bj = 0; bj < 2; ++bj) tpv[m][bj] = *(const half8*)(tb + (size_t)(u.pm * 256 + ai * 128 + wr * 64 + m * 16 + fr) * DM + col0 + bj * 128);
#pragma unroll
      for (int m = 0; m < 4; ++m) {
        const int row = u.pm * 256 + ai * 128 + wr * 64 + m * 16 + fr; const float mu = rmu[ai * 4 + m], rstd = rrs[ai * 4 + m];
        float rs = 0.f, rq = 0.f;
#pragma unroll
        for (int bj = 0; bj < 2; ++bj) {
          u32x4 w;
#pragma unroll
          for (int n = 0; n < 2; ++n) {
            f32x4 tp;
#pragma unroll
            for (int j = 0; j < 4; ++j) tp[j] = (float)tpv[m][bj][4 * n + j];
            tp = (tp - mu) * rstd * (*(const f32x4*)(g + col0 + bj * 128 + 4 * n)) + *(const f32x4*)(b + col0 + bj * 128 + 4 * n);
            const f32x4 tn = tp * ALPHA + acc[ai][bj][m][n] * scale;
            w[2 * n] = pkh2(tn[0], tn[1]); w[2 * n + 1] = pkh2(tn[2], tn[3]);
            rs += tn[0] + tn[1] + tn[2] + tn[3]; rq += tn[0] * tn[0] + tn[1] * tn[1] + tn[2] * tn[2] + tn[3] * tn[3];
          }
          *(u32x4*)(tb + (size_t)row * DM + col0 + bj * 128) = w;
        }
        rs += __shfl_xor(rs, 16); rs += __shfl_xor(rs, 32); rq += __shfl_xor(rq, 16); rq += __shfl_xor(rq, 32);
        if (fq == 0) { atomicAdd(stats_new + 2 * row, rs); atomicAdd(stats_new + 2 * row + 1, rq); }
      }
      asm volatile("" ::: "memory");
    }
  }
};
struct EpiIn {
  int mode; bf16_t* h; int ld; const float* stats; const float* c1; const float* c2; const float* lbv;
  bf16_t *hq, *hk, *hv, *hg; _Float16* hlf; int reps;
  DI void pre(LAS unsigned char*, const pg8::Unit&, int, int, int, int) const {}
  template <int SECT>
  DI void body(const f32x4 (&acc)[2][2][4][2], const pg8::Unit& u, int wr, int wc, int fr, int fq) const {
    const int col0 = u.pn * 256 + wc * 32 + 8 * fq;
#pragma unroll
    for (int ai = 0; ai < 2; ++ai)
#pragma unroll
      for (int m = 0; m < 4; ++m) {
        const int row = u.pm * 256 + ai * 128 + wr * 64 + m * 16 + fr; float a, bb, mu, rstd; row_affine(stats, row, a, bb, mu, rstd);
#pragma unroll
        for (int bj = 0; bj < 2; ++bj) {
          const int col = col0 + bj * 128;
          f32x4 v[2];
#pragma unroll
          for (int n = 0; n < 2; ++n) v[n] = acc[ai][bj][m][n] * a + (*(const f32x4*)(c1 + col + 4 * n)) * bb + *(const f32x4*)(c2 + col + 4 * n);
          if (SECT < 0) { u32x4 w; w[0] = pk2(v[0][0], v[0][1]); w[1] = pk2(v[0][2], v[0][3]); w[2] = pk2(v[1][0], v[1][1]); w[3] = pk2(v[1][2], v[1][3]); *(u32x4*)(h + (size_t)row * ld + col) = w; }
          else {
            const int cc = col & 1023; const size_t off = (size_t)row * 1024 + cc;
            if (SECT == 0 || SECT == 3) { u32x4 w;
#pragma unroll
              for (int n = 0; n < 2; ++n) { w[2 * n] = pk2(v[n][0] * sigmoidf_(v[n][0]), v[n][1] * sigmoidf_(v[n][1])); w[2 * n + 1] = pk2(v[n][2] * sigmoidf_(v[n][2]), v[n][3] * sigmoidf_(v[n][3])); }
              *(u32x4*)((SECT == 0 ? hq : hg) + off) = w; }
            else if (SECT == 1) {
              typedef _Float16 h8 __attribute__((ext_vector_type(8))); h8 lf; u32x4 w;
#pragma unroll
              for (int n = 0; n < 2; ++n) { const f32x4 lb = *(const f32x4*)(lbv + cc + 4 * n); float kk[4];
#pragma unroll
                for (int j = 0; j < 4; ++j) { kk[j] = (1.0f - lb[j]) * __builtin_amdgcn_rcpf(1.0f + __builtin_amdgcn_exp2f(1.4426950408889634f * v[n][j])); lf[4 * n + j] = (_Float16)fmaxf(__builtin_amdgcn_logf(1.0f - kk[j]), -87.0f); }
                w[2 * n] = pk2(kk[0], kk[1]); w[2 * n + 1] = pk2(kk[2], kk[3]); }
              *(u32x4*)(hk + off) = w; *(h8*)(hlf + off) = lf;
            }
            else { u32x4 w; w[0] = pk2(v[0][0], v[0][1]); w[1] = pk2(v[0][2], v[0][3]); w[2] = pk2(v[1][0], v[1][1]); w[3] = pk2(v[1][2], v[1][3]); *(u32x4*)(hv + off) = w; }
          }
        }
        asm volatile("" ::: "memory");
      }
  }
  DI void operator()(const f32x4 (&acc)[2][2][4][2], const pg8::Unit& u, int wr, int wc, int fr, int fq, LAS unsigned char* lds, int ui, int wid) const {
    if (mode == 0) body<-1>(acc, u, wr, wc, fr, fq);
    else { const int sect = u.pn >> 2;
      if (sect == 0) body<0>(acc, u, wr, wc, fr, fq); else if (sect == 1) body<1>(acc, u, wr, wc, fr, fq); else if (sect == 2) body<2>(acc, u, wr, wc, fr, fq); else body<3>(acc, u, wr, wc, fr, fq); }
  }
};

DI void conv_strip(int wv, LAS unsigned char* lds, const float* src, int ldn, int K, int n0, int nvalid, bf16_t* dst, int dstrow0, const float* g, const float* b, float* c1, float* c2, bool perm = true, int kbeg = 0, int kend = -1) {
  if (kend < 0) kend = K;
  LAS bf16_t* tile = (LAS bf16_t*)lds;
  LAS float* red = (LAS float*)(lds + 64 * 72 * 2);
  int tid_ = wv * 64 + lane_id_(); asm volatile("" : "+v"(tid_)); const int tid = tid_, kr = tid >> 4, nc = (tid & 15) * 4;
  const bool colok = (n0 + nc) < nvalid;
  float s1[4] = {0.f, 0.f, 0.f, 0.f}, s2[4] = {0.f, 0.f, 0.f, 0.f};
  f32x4 w[2];
#pragma unroll
  for (int rr = 0; rr < 2; ++rr) w[rr] = colok ? *(const f32x4*)(src + (size_t)(kbeg + kr + rr * 32) * ldn + n0 + nc) : (f32x4){0.f, 0.f, 0.f, 0.f};
  for (int k0 = kbeg; k0 < kend; k0 += 64) {
    lds_barrier();
#pragma unroll
    for (int rr = 0; rr < 2; ++rr) { const int k = k0 + kr + rr * 32; const float gk = g ? g[k] : 1.0f, bk = b ? b[k] : 0.0f;
#pragma unroll
      for (int j = 0; j < 4; ++j) { const bf16_t v = perm ? f2h(w[rr][j] * gk) : f2bf(w[rr][j] * gk); tile[(nc + j) * 72 + kr + rr * 32] = v; s1[j] += perm ? h2f(v) : bf2f(v); s2[j] += bk * w[rr][j]; } }
    if (k0 + 64 < kend) {
#pragma unroll
      for (int rr = 0; rr < 2; ++rr) w[rr] = colok ? *(const f32x4*)(src + (size_t)(k0 + 64 + kr + rr * 32) * ldn + n0 + nc) : (f32x4){0.f, 0.f, 0.f, 0.f};
    }
    lds_barrier();
    { const int n = tid >> 3, kc = (tid & 7) * 8; const int cc = n & 31, slot = (n & 32) + (perm ? 16 * ((cc >> 2) & 1) + 4 * (cc >> 3) + (cc & 3) : cc);
      *(u32x4*)(dst + (size_t)(dstrow0 + slot) * K + k0 + kc) = *(const LAS u32x4*)(tile + n * 72 + kc); }
  }
  if (c1) {
    __syncthreads();
#pragma unroll
    for (int j = 0; j < 4; ++j) { red[kr * 64 + nc + j] = s1[j]; red[2048 + kr * 64 + nc + j] = s2[j]; }
    __syncthreads();
    if (tid < 128) { const int n = tid & 63, which = tid >> 6; float s = 0.f; for (int i = 0; i < 32; ++i) s += red[which * 2048 + i * 64 + n]; (which ? c2 : c1)[dstrow0 + n] = s; }
  }
  __syncthreads();
}

DI void convert_phase(int wv, const P& p_, int L, LAS unsigned char* lds) {
  P p = p_; { size_t z_ = 0; asm volatile("" : "+s"(z_)); p.ws = p_.ws + z_; }
  const int kind = L % 3, slot = L / 3;
  const int nin = kind == 0 ? 44 : (kind == 1 ? 64 : 20);
  const int njobs = 272 + nin + 16 + (kind == 0 ? 6 : 0);
  unsigned char* ws = p.ws;
  for (int j = blockIdx.x; j < njobs; j += gridDim.x) {
    if (j < 272) {
      const int f = j / 136, jj = j % 136;
      const float* lg = p.ln_gain + (size_t)(L * 3 + (f == 0 ? -1 : 1)) * DM; const float* lbias = p.ln_bias + (size_t)(L * 3 + (f == 0 ? -1 : 1)) * DM;
      const bool fold = !(L == 0 && f == 0);
      float* cbase = (float*)(ws + (f == 0 ? C_GU1 : C_GU2));
      if (jj < 88) {
        const int up = jj / 44, s = jj % 44, n0 = s * 64;
        const float* src = (f == 0 ? (up ? p.f1u : p.f1g) : (up ? p.f2u : p.f2g)) + (size_t)L * DM * DFF;
        conv_strip(wv, lds, src, DFF, DM, n0, DFF, (bf16_t*)(ws + (f == 0 ? W_GU1 : W_GU2)), (n0 >> 7) * 256 + (n0 & 127) + up * 128, fold ? lg : nullptr, fold ? lbias : nullptr, cbase, cbase + 5632);
      } else {
        const int s = (jj - 88) / 3, kc = (jj - 88) % 3;
        const float* src = (f == 0 ? p.f1d : p.f2d) + (size_t)L * DFF * DM;
        conv_strip(wv, lds, src, DM, DFF, s * 64, DM, (bf16_t*)(ws + (f == 0 ? W_D1 : W_D2)), s * 64, nullptr, nullptr, nullptr, nullptr, true, kc * 960, kc == 2 ? DFF : kc * 960 + 960);
      }
    } else if (j < 272 + nin) {
      const int s = j - 272; const float* lg = p.ln_gain + (size_t)(L * 3) * DM; const float* lbias = p.ln_bias + (size_t)(L * 3) * DM;
      const float* src = kind == 0 ? p.nsa_win + (size_t)slot * DM * 2608 : (kind == 1 ? p.hg_win + (size_t)slot * DM * 4096 : p.swa_win + (size_t)slot * DM * 1280);
      const int ldn = kind == 0 ? 2608 : (kind == 1 ? 4096 : 1280);
      float* cbase = (float*)(ws + C_IN);
      conv_strip(wv, lds, src, ldn, DM, s * 64, ldn, (bf16_t*)(ws + W_IN), s * 64, lg, lbias, cbase, cbase + 4096);
    } else if (j < 272 + nin + 16) {
      const int s = j - 272 - nin;
      const float* src = kind == 0 ? p.nsa_wout + (size_t)slot * DM * DM : (kind == 1 ? p.hg_wout + (size_t)slot * DM * DM : p.swa_wout + (size_t)slot * DM * DM);
      conv_strip(wv, lds, src, DM, DM, s * 64, DM, (bf16_t*)(ws + W_OUT), s * 64, nullptr, nullptr, nullptr, nullptr);
    } else {
      const int s = j - 272 - nin - 16;
      if (s < 4) { const int kv = s >> 1, st = s & 1; float* pb = (float*)(ws + C_POSB) + kv * 256;
        conv_strip(wv, lds, p.nsa_w1 + ((size_t)slot * 2 + kv) * 2048 * 128, 128, 2048, st * 64, 128, (bf16_t*)(ws + W_W1T) + (size_t)kv * 128 * 2048, st * 64, nullptr, p.nsa_pos + ((size_t)slot * 2 + kv) * 2048, pb + 128, pb, false); }
      else { const int kv = s - 4; conv_strip(wv, lds, p.nsa_w2 + ((size_t)slot * 2 + kv) * 128 * 64, 64, 128, 0, 64, (bf16_t*)(ws + W_W2T) + (size_t)kv * 64 * 128, 0, nullptr, nullptr, nullptr, nullptr, false); }
    }
  }
}

DI void init_phase(int wv, const P& p_) {
  P p = p_; { size_t z_ = 0; asm volatile("" : "+s"(z_)); p.ws = p_.ws + z_; }
  int tid_ = wv * 64 + lane_id_(); asm volatile("" : "+v"(tid_)); const size_t gtid = (size_t)blockIdx.x * 512 + tid_, gsz = (size_t)gridDim.x * 512;
  for (size_t i = gtid; i < (4 * MiB) / 16; i += gsz) ((f32x4*)(p.ws + WS_STATS))[i] = (f32x4){0.f, 0.f, 0.f, 0.f};
  for (size_t i = gtid; i < (size_t)MTOK; i += gsz) { ((float*)(p.ws + WS_DSTATS))[2 * i] = 0.f; ((float*)(p.ws + WS_DSTATS))[2 * i + 1] = 1024.0f * (1.0f - 1e-5f); }
  if (gtid < 13 * 1024) { ((float*)(p.ws + WS_G13))[gtid] = gtid < 1024 ? 1.0f : p.ln_gain[gtid - 1024]; ((float*)(p.ws + WS_B13))[gtid] = gtid < 1024 ? 0.0f : p.ln_bias[gtid - 1024]; }
  for (size_t i = gtid; i < (size_t)MTOK * DM / 4; i += gsz) { const f32x4 v = ((const f32x4*)p.x)[i]; u32x2 w; w.x = pkh2(v[0], v[1]); w.y = pkh2(v[2], v[3]); ((u32x2*)(p.ws + WS_TB))[i] = w; }
  if (gtid < 16 * 132) { const int hd = (int)gtid / 132, d = (int)gtid % 132; int bk;
    if (d < 16) bk = d; else { const float v = logf((float)d / 16.0f) / 2.0794415416798357f * 16.0f; bk = 16 + (int)v; if (bk > 31 || d >= 128) bk = 31; }
    ((float*)(p.ws + C_BTAB))[gtid] = p.rel_bias[bk * 16 + hd]; }
  if (gtid < 1024) { const float a0 = p.hg_lb[gtid], a1 = p.hg_lb[1024 + gtid], a2 = p.hg_lb[2048 + gtid], a3 = p.hg_lb[3072 + gtid];
    const float mx = fmaxf(fmaxf(a0, a1), fmaxf(a2, a3)); const float e0 = expf(a0 - mx), e1 = expf(a1 - mx), e2 = expf(a2 - mx), e3 = expf(a3 - mx);
    ((float*)(p.ws + C_LBV))[gtid] = e1 / (e0 + e1 + e2 + e3); }
}

DI void final_ln(int wv, const P& p_, const float* stats, const float* g, const float* b) {
  P p = p_; { size_t z_ = 0; asm volatile("" : "+s"(z_)); p.ws = p_.ws + z_; }
  int tid_ = wv * 64 + lane_id_(); asm volatile("" : "+v"(tid_)); const size_t gtid = (size_t)blockIdx.x * 512 + tid_, gsz = (size_t)gridDim.x * 512;
  for (size_t i = gtid; i < (size_t)MTOK * DM / 4; i += gsz) {
    const int row = (int)(i >> 8), c = (int)(i & 255) * 4; float a, bb, mu, rstd; row_affine(stats, row, a, bb, mu, rstd);
    const u32x2 hv = ((const u32x2*)(p.ws + WS_TB))[i]; typedef _Float16 h4 __attribute__((ext_vector_type(4))); const h4 hh = __builtin_bit_cast(h4, hv);
    const f32x4 v = {(float)hh[0], (float)hh[1], (float)hh[2], (float)hh[3]}; ((f32x4*)p.out)[i] = (v - mu) * rstd * (*(const f32x4*)(g + c)) + *(const f32x4*)(b + c);
  }
}
#define MFMA32(a, b, c) __builtin_amdgcn_mfma_f32_32x32x16_bf16((a), (b), (c), 0, 0, 0)
#define MFMA16(a, b, c) __builtin_amdgcn_mfma_f32_16x16x32_bf16((a), (b), (c), 0, 0, 0)
DI int crow(int reg, int h) { return (reg & 3) + 8 * (reg >> 2) + 4 * h; }
constexpr int KS_STRIDE = 72;

struct KVRegs { u32x4 k; bf16x8 v; };
DI void kv_load(KVRegs& r, const bf16_t* kg, const bf16_t* vg, size_t ldg, int tid) {
  asm volatile("" : "+v"(tid));
  const int key = tid >> 3, d8 = (tid & 7) * 8;
  r.k = *(const u32x4*)(kg + (size_t)key * ldg + d8); r.v = *(const bf16x8*)(vg + (size_t)key * ldg + d8);
}
DI void kv_store(const KVRegs& r, LAS bf16_t* Ks, LAS bf16_t* Vt, int vstride, int vcol0, int tid) {
  asm volatile("" : "+v"(tid));
  const int key = tid >> 3, d8 = (tid & 7) * 8;
  *(LAS u32x4*)(Ks + key * KS_STRIDE + d8) = r.k;
  const u32x4 vd = __builtin_bit_cast(u32x4, r.v);
  const bool odd = key & 1;
  const unsigned s0 = odd ? vd[0] : vd[2], s1 = odd ? vd[1] : vd[3];
  const unsigned x0 = (unsigned)__builtin_amdgcn_update_dpp(0, (int)s0, 0x128, 0xf, 0xf, false), x1 = (unsigned)__builtin_amdgcn_update_dpp(0, (int)s1, 0x128, 0xf, 0xf, false);
  const unsigned m0 = odd ? vd[2] : vd[0], m1 = odd ? vd[3] : vd[1];
  const unsigned lo0 = odd ? x0 : m0, hi0 = odd ? m0 : x0, lo1 = odd ? x1 : m1, hi1 = odd ? m1 : x1;
  LAS unsigned* vp = (LAS unsigned*)(Vt + (d8 + (odd ? 4 : 0)) * vstride + vcol0 + (key & ~1));
  const int rs = vstride >> 1;
  vp[0] = (lo0 & 0xffffu) | (hi0 << 16); vp[rs] = (lo0 >> 16) | (hi0 & 0xffff0000u);
  vp[2 * rs] = (lo1 & 0xffffu) | (hi1 << 16); vp[3 * rs] = (lo1 >> 16) | (hi1 & 0xffff0000u);
}
DI void attn_scores(const LAS bf16_t* Ks, const bf16x8 (&qf)[4], int r, int h, f32x16 (&s)[2]) {
#pragma unroll
  for (int sub = 0; sub < 2; ++sub) {
    f32x16 a;
#pragma unroll
    for (int i = 0; i < 16; ++i) a[i] = 0.f;
#pragma unroll
    for (int ks = 0; ks < 4; ++ks) { const bf16x8 kf = *(const LAS bf16x8*)(Ks + (sub * 32 + r) * KS_STRIDE + ks * 16 + 8 * h); a = MFMA32(kf, qf[ks], a); }
    s[sub] = a;
  }
}
constexpr float QK_SCALE2 = 0.125f * 1.4426950408889634f;
DI void attn_logits(f32x16 (&s)[2], int t, int tw, int nt, int h, int base, int stride, int dmax, bool ok, const LAS float* btl) {
  const int dmin = tw - (base + 63 * stride), dmaxw = tw + nt - 1 - base;
  const bool far = dmin >= 128, interior = dmin >= 0 && dmaxw < dmax;
  const float bfar = btl[128];
  if (far && interior) {
#pragma unroll
    for (int sub = 0; sub < 2; ++sub)
#pragma unroll
      for (int reg = 0; reg < 16; ++reg) s[sub][reg] = ok ? s[sub][reg] * QK_SCALE2 + bfar : -1e30f;
  } else if (far) {
#pragma unroll
    for (int sub = 0; sub < 2; ++sub)
#pragma unroll
      for (int reg = 0; reg < 16; ++reg) {
        const int kk = sub * 32 + crow(reg, h); const int d = t - (base + kk * stride);
        const bool valid = (d >= 0) && (d < dmax) && ok;
        s[sub][reg] = valid ? s[sub][reg] * QK_SCALE2 + bfar : -1e30f;
      }
  } else {
#pragma unroll
    for (int sub = 0; sub < 2; ++sub)
#pragma unroll
      for (int reg = 0; reg < 16; ++reg) {
        const int kk = sub * 32 + crow(reg, h); const int d = t - (base + kk * stride);
        const bool valid = (d >= 0) && (d < dmax) && ok;
        const int di = d < 0 ? 0 : (d > 128 ? 128 : d);
        const float bsv = btl[di];
        const float x = s[sub][reg] * QK_SCALE2 + bsv;
        s[sub][reg] = valid ? x : -1e30f;
      }
  }
}
DI void attn_pv(const LAS bf16_t* Vt, int vstride, const f32x16 (&p)[2], f32x16 (&O)[2], int r, int h) {
#pragma unroll
  for (int sub = 0; sub < 2; ++sub)
#pragma unroll
    for (int s2 = 0; s2 < 2; ++s2) {
      u32x4 pp;
#pragma unroll
      for (int j = 0; j < 4; ++j) pp[j] = pk2(p[sub][8 * s2 + 2 * j], p[sub][8 * s2 + 2 * j + 1]);
      const bf16x8 pf = __builtin_bit_cast(bf16x8, pp);
#pragma unroll
      for (int dt = 0; dt < 2; ++dt) {
        const LAS bf16_t* vp = Vt + (dt * 32 + r) * vstride + sub * 32 + 16 * s2 + 4 * h;
        const s16x4 lo = *(const LAS s16x4*)vp, hi = *(const LAS s16x4*)(vp + 8);
        const bf16x8 vf = __builtin_shufflevector(lo, hi, 0, 1, 2, 3, 4, 5, 6, 7);
        O[dt] = MFMA32(vf, pf, O[dt]);
      }
    }
}
template <bool WITH_O>
DI void attn_online(f32x16 (&s)[2], float& m, float& l, f32x16 (&O)[2]) {
  float mx = -1e30f;
#pragma unroll
  for (int sub = 0; sub < 2; ++sub)
#pragma unroll
    for (int reg = 0; reg < 16; ++reg) mx = fmaxf(mx, s[sub][reg]);
  mx = fmaxf(mx, __shfl_xor(mx, 32));
  const float mn = fmaxf(m, mx);
  const bool grow = mn > m;
  float ls = 0.f;
#pragma unroll
  for (int sub = 0; sub < 2; ++sub)
#pragma unroll
    for (int reg = 0; reg < 16; ++reg) { const float e = __builtin_amdgcn_exp2f(s[sub][reg] - mn); s[sub][reg] = e; ls += e; }
  if (__any(grow)) {
    const float al = __builtin_amdgcn_exp2f(m - mn); m = mn;
    l = l * al + ls;
    if (WITH_O) {
#pragma unroll
      for (int dt = 0; dt < 2; ++dt)
#pragma unroll
        for (int reg = 0; reg < 16; ++reg) O[dt][reg] *= al;
    }
  } else l += ls;
}
DI void attn_tile(const LAS bf16_t* Ks, const LAS bf16_t* Vt, int vstride, const bf16x8 (&qf)[4], f32x16 (&O)[2], float& m, float& l,
                  int t, int tw, int nt, int r, int h, int base, int stride, int dmax, bool ok, const LAS float* btl) {
  f32x16 s[2];
  attn_scores(Ks, qf, r, h, s);
  const int dmin = tw - (base + 63 * stride), dmaxw = tw + nt - 1 - base;
  float mn, ls = 0.f;
  if (dmin >= 128 && dmaxw < dmax) {
    const float cl = ok ? QK_SCALE2 : 0.f, bl = ok ? btl[128] : -1e30f;
    float mr = -3e38f;
#pragma unroll
    for (int sub = 0; sub < 2; ++sub)
#pragma unroll
      for (int reg = 0; reg < 16; ++reg) mr = fmaxf(mr, s[sub][reg]);
    float mx = mr * cl + bl; mx = fmaxf(mx, __shfl_xor(mx, 32));
    mn = fmaxf(m, mx);
    const float off = bl - mn;
#pragma unroll
    for (int sub = 0; sub < 2; ++sub)
#pragma unroll
      for (int reg = 0; reg < 16; ++reg) { const float e = __builtin_amdgcn_exp2f(s[sub][reg] * cl + off); s[sub][reg] = e; ls += e; }
  } else {
    attn_logits(s, t, tw, nt, h, base, stride, dmax, ok, btl);
    float mx = -1e30f;
#pragma unroll
    for (int sub = 0; sub < 2; ++sub)
#pragma unroll
      for (int reg = 0; reg < 16; ++reg) mx = fmaxf(mx, s[sub][reg]);
    mx = fmaxf(mx, __shfl_xor(mx, 32));
    mn = fmaxf(m, mx);
#pragma unroll
    for (int sub = 0; sub < 2; ++sub)
#pragma unroll
      for (int reg = 0; reg < 16; ++reg) { const float e = __builtin_amdgcn_exp2f(s[sub][reg] - mn); s[sub][reg] = e; ls += e; }
  }
  if (__any(mn > m)) {
    const float al = __builtin_amdgcn_exp2f(m - mn); m = mn;
    l = l * al + ls;
#pragma unroll
    for (int dt = 0; dt < 2; ++dt)
#pragma unroll
      for (int reg = 0; reg < 16; ++reg) O[dt][reg] *= al;
  } else l += ls;
  attn_pv(Vt, vstride, s, O, r, h);
}
DI void zero_o(f32x16 (&O)[2]) {
#pragma unroll
  for (int dt = 0; dt < 2; ++dt)
#pragma unroll
    for (int reg = 0; reg < 16; ++reg) O[dt][reg] = 0.f;
}

DI void nsa_compress_phase(int wv, const P& p_, LAS unsigned char* lds) {
  P p = p_; { size_t z_ = 0; asm volatile("" : "+s"(z_)); p.ws = p_.ws + z_; }
  const bf16_t* hb = (const bf16_t*)(p.ws + WS_BIG); const int ld = 2816;
  int tid_ = wv * 64 + lane_id_(); asm volatile("" : "+v"(tid_)); const int tid = tid_, wid = wv, lane = tid & 63, fr = lane & 15, fq = lane >> 4;
  const int pw = wid & 3, half = wid >> 2;
  LAS bf16_t* hid = (LAS bf16_t*)lds + pw * 16 * 136;
  LAS f32x4* part = (LAS f32x4*)(lds + 32768) + pw * 8 * 64;
  for (int base = blockIdx.x * 4; base < 1024; base += gridDim.x * 4) {
    const int task = base + pw;
    const int kv = task >> 9, b = (task >> 6) & 7, g = (task >> 4) & 3, n0 = (task & 15) * 16;
    const bf16_t* w1t = (const bf16_t*)(p.ws + W_W1T) + (size_t)kv * 128 * 2048; const bf16_t* w2t = (const bf16_t*)(p.ws + W_W2T) + (size_t)kv * 64 * 128;
    const float* posb = (const float*)(p.ws + C_POSB) + kv * 256;
    const int colb = 1024 + kv * 256 + g * 64;
    int n = n0 + fr; if (n > 254) n = 254;
    f32x4 acc[8];
#pragma unroll
    for (int i = 0; i < 8; ++i) acc[i] = (f32x4){0.f, 0.f, 0.f, 0.f};
    { LAS bf16_t* WB = (LAS bf16_t*)(lds + 65536);
      const int er = tid >> 2, kc0 = (tid & 3) * 16;
      const bf16_t* wsrc = w1t + (size_t)er * 2048 + kc0;
      const bf16_t* asrc = hb + (size_t)(b * SEQ + 16 * n + 16 * half) * ld + colb + fq * 8;
      u32x4 wr4[2][2]; bf16x8 afc[2], afn[2];
#pragma unroll
      for (int sl = 0; sl < 2; ++sl)
#pragma unroll
        for (int c = 0; c < 2; ++c) wr4[sl][c] = *(const u32x4*)(wsrc + (size_t)(16 * sl) * 64 + c * 8);
#pragma unroll
      for (int dk = 0; dk < 2; ++dk) afc[dk] = *(const bf16x8*)(asrc + dk * 32);
#pragma unroll 1
      for (int st = 0; st < 16; ++st) {
        LAS bf16_t* wb = WB + (st & 1) * (2 * 128 * 72);
#pragma unroll
        for (int sl = 0; sl < 2; ++sl)
#pragma unroll
          for (int c = 0; c < 2; ++c) *(LAS u32x4*)(wb + (sl * 128 + er) * 72 + kc0 + c * 8) = wr4[sl][c];
        lds_barrier();
        if (st + 1 < 16) {
#pragma unroll
          for (int sl = 0; sl < 2; ++sl)
#pragma unroll
            for (int c = 0; c < 2; ++c) wr4[sl][c] = *(const u32x4*)(wsrc + (size_t)(st + 1 + 16 * sl) * 64 + c * 8);
#pragma unroll
          for (int dk = 0; dk < 2; ++dk) afn[dk] = *(const bf16x8*)(asrc + (size_t)(st + 1) * ld + dk * 32);
        }
#pragma unroll
        for (int dk = 0; dk < 2; ++dk) {
#pragma unroll
          for (int nt = 0; nt < 8; ++nt) { const bf16x8 bfr = *(const LAS bf16x8*)(wb + (half * 128 + nt * 16 + fr) * 72 + dk * 32 + fq * 8); acc[nt] = MFMA16(afc[dk], bfr, acc[nt]); }
        }
        afc[0] = afn[0]; afc[1] = afn[1];
      }
    }
    if (half) {
#pragma unroll
      for (int nt = 0; nt < 8; ++nt) part[nt * 64 + lane] = acc[nt];
    }
    __syncthreads();
    if (!half) {
#pragma unroll
      for (int nt = 0; nt < 8; ++nt) { const float pbv = posb[nt * 16 + fr]; const f32x4 o2 = part[nt * 64 + lane];
#pragma unroll
        for (int j = 0; j < 4; ++j) { const float v = acc[nt][j] + o2[j] + pbv; const float u = 0.7978845608028654f * (v + 0.044715f * v * v * v); const float th = 1.0f - 2.0f * __builtin_amdgcn_rcpf(1.0f + __expf(2.0f * u));
          hid[(4 * fq + j) * 136 + nt * 16 + fr] = f2bf(0.5f * v * (1.0f + th)); } }
    }
    __syncthreads();
    if (!half) {
      f32x4 o[4];
#pragma unroll
      for (int i = 0; i < 4; ++i) o[i] = (f32x4){0.f, 0.f, 0.f, 0.f};
#pragma unroll
      for (int ks = 0; ks < 4; ++ks) { const bf16x8 af = *(const LAS bf16x8*)(hid + fr * 136 + ks * 32 + fq * 8);
#pragma unroll
        for (int nt = 0; nt < 4; ++nt) { const bf16x8 bfr = *(const bf16x8*)(w2t + (size_t)(nt * 16 + fr) * 128 + ks * 32 + fq * 8); o[nt] = MFMA16(af, bfr, o[nt]); } }
      bf16_t* dst = (bf16_t*)(p.ws + (kv ? WS_VC : WS_KC)) + (size_t)((b * 4 + g) * 256) * 64;
#pragma unroll
      for (int nt = 0; nt < 4; ++nt)
#pragma unroll
        for (int j = 0; j < 4; ++j) { const int nn = n0 + 4 * fq + j; dst[(size_t)nn * 64 + nt * 16 + fr] = nn > 254 ? (bf16_t)0 : f2bf(o[nt][j]); }
    }
    __syncthreads();
  }
}

DI void nsa_attn_phase(int wv, const P& p_, LAS unsigned char* lds) {
  P p = p_; { size_t z_ = 0; asm volatile("" : "+s"(z_)); p.ws = p_.ws + z_; }
  const bf16_t* hb = (const bf16_t*)(p.ws + WS_BIG); const int ld = 2816;
  bf16_t* ob = (bf16_t*)(p.ws + WS_O);
  LAS bf16_t* KsB[2] = {(LAS bf16_t*)lds, (LAS bf16_t*)(lds + 17920)}; LAS bf16_t* VtB[2] = {(LAS bf16_t*)(lds + 9216), (LAS bf16_t*)(lds + 17920 + 9216)};
  LAS bf16_t* KC = (LAS bf16_t*)(lds + 35840); LAS bf16_t* VCT = (LAS bf16_t*)(lds + 72704);
  LAS float* OUTL = (LAS float*)(lds + 35840);
  LAS float* G4s = (LAS float*)(lds + 105984); LAS float* Lsm = (LAS float*)(lds + 122368); LAS float* BT = (LAS float*)(lds + 138752);
  LAS unsigned* SELM = (LAS unsigned*)(lds + 140864); LAS unsigned* UNI = (LAS unsigned*)(lds + 141376);
  for (int it = blockIdx.x; it < 2048; it += gridDim.x) {
    int tid_ = wv * 64 + lane_id_(); asm volatile("" : "+v"(tid_)); const int tid = tid_, wid = wv, lane = tid & 63, r = lane & 31, h = lane >> 5, tl = r >> 2, hd = r & 3;
    const int c = it & 255, ii = it >> 8, bg = c >> 3, b = bg >> 2, g = bg & 3, j8 = c & 7;
    const int qi = (ii & 1) ? (16 * (ii >> 1) + 15 - j8) : (16 * (ii >> 1) + j8);
    const int t0 = 64 * qi, tw = t0 + 8 * wid, t = tw + tl, head = g * 4 + hd;
    const int nct = (4 * qi + 2) / 64 + 1;
    __syncthreads();
    { KVRegs ka, kb; const bf16_t* kcg = (const bf16_t*)(p.ws + WS_KC) + (size_t)((b * 4 + g) * 256) * 64; const bf16_t* vcg = (const bf16_t*)(p.ws + WS_VC) + (size_t)((b * 4 + g) * 256) * 64;
      kv_load(ka, kcg, vcg, 64, tid); if (nct > 1) kv_load(kb, kcg + 64 * 64, vcg + 64 * 64, 64, tid);
      kv_store(ka, KC, VCT, 260, 0, tid); if (nct > 1) kv_store(kb, KC + 64 * KS_STRIDE, VCT, 260, 64, tid);
      if (nct > 2) { kv_load(ka, kcg + 128 * 64, vcg + 128 * 64, 64, tid); if (nct > 3) kv_load(kb, kcg + 192 * 64, vcg + 192 * 64, 64, tid);
        kv_store(ka, KC + 128 * KS_STRIDE, VCT, 260, 128, tid); if (nct > 3) kv_store(kb, KC + 192 * KS_STRIDE, VCT, 260, 192, tid); } }
    for (int i = tid; i < 4 * 132; i += 512) BT[i] = ((const float*)(p.ws + C_BTAB))[g * 4 * 132 + i] * 1.4426950408889634f;
    if (tid < 128) SELM[tid] = 0u; if (tid < 2) UNI[tid] = 0u;
    bf16x8 qf[4];
#pragma unroll
    for (int ks = 0; ks < 4; ++ks) qf[ks] = *(const bf16x8*)(hb + (size_t)(b * SEQ + t) * ld + head * 64 + ks * 16 + 8 * h);
    const size_t rowoff = (size_t)(b * SEQ + t) * ld;
    const float gc = sigmoidf_(bf2f(hb[rowoff + 2560 + head * 3 + 0])), gs = sigmoidf_(bf2f(hb[rowoff + 2560 + head * 3 + 1])), gw = sigmoidf_(bf2f(hb[rowoff + 2560 + head * 3 + 2]));
    const LAS float* btl = BT + hd * 132;
    KVRegs kvr; { const size_t go = (size_t)(b * SEQ) * ld + g * 64; kv_load(kvr, hb + go + 1536, hb + go + 1792, ld, tid); }
    __syncthreads();
    f32x16 O[2];
    float m = -1e30f, l = 0.f;
#pragma unroll 1
    for (int tile = 0; tile < nct; ++tile) { f32x16 s[2]; attn_scores(KC + tile * 64 * KS_STRIDE, qf, r, h, s); attn_logits(s, t, tw, 8, h, 16 * (tile * 64) + 31, 16, 0x7fffffff, true, btl); attn_online<false>(s, m, l, O); }
    { const float lt = l + __shfl_xor(l, 32); const float inv = (m > -1e29f && lt > 0.f) ? 1.0f / lt : 0.f;
      zero_o(O);
#pragma unroll 1
      for (int tile = 0; tile < nct; ++tile) {
        f32x16 s[2]; attn_scores(KC + tile * 64 * KS_STRIDE, qf, r, h, s); attn_logits(s, t, tw, 8, h, 16 * (tile * 64) + 31, 16, 0x7fffffff, true, btl);
        LAS float* gp = G4s + (8 * wid + tl) * 64 + 16 * tile + h; asm volatile("" : "+v"(gp));
#pragma unroll
        for (int sub = 0; sub < 2; ++sub) {
#pragma unroll
          for (int reg = 0; reg < 16; ++reg) { const float v = s[sub][reg]; s[sub][reg] = v > -1e29f ? __builtin_amdgcn_exp2f(v - m) * inv : 0.f; }
#pragma unroll
          for (int lg = 0; lg < 4; ++lg) { float G = s[sub][4 * lg] + s[sub][4 * lg + 1] + s[sub][4 * lg + 2] + s[sub][4 * lg + 3], Lv = s[sub][4 * lg + 3];
            G += __shfl_xor(G, 1); G += __shfl_xor(G, 2); Lv += __shfl_xor(Lv, 1); Lv += __shfl_xor(Lv, 2);
            if (hd == 0) { gp[8 * sub + 2 * lg] = G; gp[4096 + 8 * sub + 2 * lg] = Lv; } }
        }
        attn_pv(VCT + tile * 64, 260, s, O, r, h);
      }
    }
    __syncthreads();
#pragma unroll
    for (int dt = 0; dt < 2; ++dt)
#pragma unroll
      for (int reg = 0; reg < 16; ++reg) OUTL[(dt * 16 + reg) * 512 + tid] = gc * O[dt][reg];
    if (qi < 16) { const unsigned long long full = (qi == 63) ? ~0ull : ((1ull << (qi + 1)) - 1ull);
      int tsel = tid; asm volatile("" : "+v"(tsel));
      if (tsel < 64) { SELM[2 * tsel] = (unsigned)full; SELM[2 * tsel + 1] = (unsigned)(full >> 32); } if (tsel == 0) { UNI[0] = (unsigned)full; UNI[1] = (unsigned)(full >> 32); } }
    else {
      int tsel = tid; asm volatile("" : "+v"(tsel));
      const int tok = tsel >> 3, jj = tsel & 7, hiJ = qi - 2;
#pragma unroll
      for (int e = 0; e < 8; ++e) { const int j = jj * 8 + e; if (j >= 1 && j <= hiJ) G4s[tok * 64 + j] += Lsm[tok * 64 + j - 1]; }
      __syncthreads();
      float mine[8]; int cnt[8];
#pragma unroll
      for (int e = 0; e < 8; ++e) { const int j = jj * 8 + e; mine[e] = (j >= 1 && j <= hiJ) ? G4s[tok * 64 + j] : 0.f; cnt[e] = 0; }
      for (int j2 = 1; j2 <= hiJ; ++j2) { const float v = G4s[tok * 64 + j2];
#pragma unroll
        for (int e = 0; e < 8; ++e) { const int j = jj * 8 + e; cnt[e] += (v > mine[e] || (v == mine[e] && j2 < j)) ? 1 : 0; } }
      unsigned long long bits = 0ull;
#pragma unroll
      for (int e = 0; e < 8; ++e) { const int j = jj * 8 + e; if (j >= 1 && j <= hiJ && cnt[e] < 13) bits |= 1ull << j; }
      if (jj == 0) bits |= 1ull | (1ull << qi) | (1ull << (qi - 1));
      const unsigned blo = (unsigned)bits, bhi = (unsigned)(bits >> 32);
      if (blo) { atomicOr((unsigned*)&SELM[2 * tok], blo); atomicOr((unsigned*)&UNI[0], blo); }
      if (bhi) { atomicOr((unsigned*)&SELM[2 * tok + 1], bhi); atomicOr((unsigned*)&UNI[1], bhi); }
    }
    __syncthreads();
    int buf = 0;
    { const unsigned long long selm = (unsigned long long)SELM[2 * (8 * wid + tl)] | ((unsigned long long)SELM[2 * (8 * wid + tl) + 1] << 32);
      unsigned long long rem = (unsigned long long)UNI[0] | ((unsigned long long)UNI[1] << 32);
      m = -1e30f; l = 0.f; zero_o(O);
      const int jw0 = qi > 8 ? qi - 8 : 0;
#pragma unroll 1
      while (rem) {
        const int j = __builtin_ctzll(rem); rem &= rem - 1ull;
        kv_store(kvr, KsB[buf], VtB[buf], 68, 0, tid);
        __syncthreads();
        { const bool more = rem != 0ull; const int jn = more ? __builtin_ctzll(rem) : jw0;
          const size_t go = (size_t)(b * SEQ + jn * 64) * ld + g * 64; kv_load(kvr, hb + go + (more ? 1536 : 2048), hb + go + (more ? 1792 : 2304), ld, tid); }
        attn_tile(KsB[buf], VtB[buf], 68, qf, O, m, l, t, tw, 8, r, h, j * 64, 1, 0x7fffffff, ((selm >> j) & 1ull) != 0ull, btl);
        buf ^= 1;
      }
      const float lt = l + __shfl_xor(l, 32); const float sc = lt > 0.f ? gs / lt : 0.f;
#pragma unroll
      for (int dt = 0; dt < 2; ++dt)
#pragma unroll
        for (int reg = 0; reg < 16; ++reg) OUTL[(dt * 16 + reg) * 512 + tid] += sc * O[dt][reg];
    }
    { m = -1e30f; l = 0.f; zero_o(O);
#pragma unroll 1
      for (int j = (qi > 8 ? qi - 8 : 0); j <= qi; ++j) {
        kv_store(kvr, KsB[buf], VtB[buf], 68, 0, tid);
        __syncthreads();
        if (j < qi) { const size_t go = (size_t)(b * SEQ + (j + 1) * 64) * ld + g * 64; kv_load(kvr, hb + go + 2048, hb + go + 2304, ld, tid); }
        attn_tile(KsB[buf], VtB[buf], 68, qf, O, m, l, t, tw, 8, r, h, j * 64, 1, 512, true, btl);
        buf ^= 1;
      }
      const float lt = l + __shfl_xor(l, 32); const float sc = lt > 0.f ? gw / lt : 0.f;
#pragma unroll
      for (int dt = 0; dt < 2; ++dt)
#pragma unroll
        for (int reg = 0; reg < 16; ++reg) O[dt][reg] = OUTL[(dt * 16 + reg) * 512 + tid] + sc * O[dt][reg];
    }
    bf16_t* op = ob + (size_t)(b * SEQ + t) * DM + head * 64;
#pragma unroll
    for (int dt = 0; dt < 2; ++dt)
#pragma unroll
      for (int i4 = 0; i4 < 4; ++i4) { u32x2 w; w.x = pkh2(O[dt][4 * i4], O[dt][4 * i4 + 1]); w.y = pkh2(O[dt][4 * i4 + 2], O[dt][4 * i4 + 3]); *(u32x2*)(op + dt * 32 + 8 * i4 + 4 * h) = w; }
  }
}

DI void swa_attn_phase(int wv, const P& p_, int slot, LAS unsigned char* lds) {
  P p = p_; { size_t z_ = 0; asm volatile("" : "+s"(z_)); p.ws = p_.ws + z_; }
  const bf16_t* hb = (const bf16_t*)(p.ws + WS_BIG); const int ld = 1280;
  bf16_t* ob = (bf16_t*)(p.ws + WS_O);
  LAS bf16_t* KsB[2] = {(LAS bf16_t*)lds, (LAS bf16_t*)(lds + 17920)}; LAS bf16_t* VtB[2] = {(LAS bf16_t*)(lds + 9216), (LAS bf16_t*)(lds + 17920 + 9216)};
  LAS float* BT = (LAS float*)(lds + 35840);
  int tid_ = wv * 64 + lane_id_(); asm volatile("" : "+v"(tid_)); const int tid = tid_, wid = tid >> 6, lane = tid & 63, r = lane & 31, h = lane >> 5, tl = r >> 3, hd = r & 7;
  int buf = 0;
  for (int it = blockIdx.x; it < 2048; it += gridDim.x) {
    const int b = it >> 8, kv = (it >> 7) & 1, t0 = (it & 127) * 32;
    const int tw = t0 + 4 * wid, t = tw + tl, head = kv * 8 + hd;
    const int lo = t0 - 127, first = lo <= 0 ? 0 : (lo >> 6), last = (t0 + 31) >> 6;
    KVRegs kvr; { const size_t go = (size_t)(b * SEQ + first * 64) * ld + kv * 64; kv_load(kvr, hb + go + 1024, hb + go + 1152, ld, tid); }
    __syncthreads();
    for (int i = tid; i < 8 * 132; i += 512) BT[i] = ((const float*)(p.ws + C_BTAB))[kv * 8 * 132 + i] * 1.4426950408889634f;
    const size_t rowoff = (size_t)(b * SEQ + t) * ld;
    bf16x8 qf[4];
#pragma unroll
    for (int ks = 0; ks < 4; ++ks) qf[ks] = *(const bf16x8*)(hb + rowoff + head * 64 + ks * 16 + 8 * h);
    const LAS float* btl = BT + hd * 132;
    float m = p.swa_sinks[slot * 16 + head] * 1.4426950408889634f, l = (h == 0) ? 1.0f : 0.0f;
    f32x16 O[2]; zero_o(O);
#pragma unroll 1
    for (int j = first; j <= last; ++j) {
      kv_store(kvr, KsB[buf], VtB[buf], 68, 0, tid);
      __syncthreads();
      if (j < last) { const size_t go = (size_t)(b * SEQ + (j + 1) * 64) * ld + kv * 64; kv_load(kvr, hb + go + 1024, hb + go + 1152, ld, tid); }
      attn_tile(KsB[buf], VtB[buf], 68, qf, O, m, l, t, tw, 4, r, h, j * 64, 1, 128, true, btl);
      buf ^= 1;
    }
    const float lt = l + __shfl_xor(l, 32); const float sc = 1.0f / lt;
    bf16_t* op = ob + (size_t)(b * SEQ + t) * DM + head * 64;
#pragma unroll
    for (int dt = 0; dt < 2; ++dt)
#pragma unroll
      for (int i4 = 0; i4 < 4; ++i4) { u32x2 w; w.x = pkh2(sc * O[dt][4 * i4], sc * O[dt][4 * i4 + 1]); w.y = pkh2(sc * O[dt][4 * i4 + 2], sc * O[dt][4 * i4 + 3]); *(u32x2*)(op + dt * 32 + 8 * i4 + 4 * h) = w; }
  }
}
constexpr size_t HG_Q = WS_BIG, HG_K = WS_BIG + 64 * MiB, HG_V = WS_BIG + 128 * MiB, HG_G = WS_BIG + 192 * MiB, HG_LF = WS_BIG + 256 * MiB;
DI void hgrn_scan_phase(int wv, const P& p_, LAS unsigned char* lds, float* sumsq) {
  P p = p_; { size_t z_ = 0; asm volatile("" : "+s"(z_)); p.ws = p_.ws + z_; }
  const bf16_t* hq = (const bf16_t*)(p.ws + HG_Q); const bf16_t* hk = (const bf16_t*)(p.ws + HG_K); const bf16_t* hv = (const bf16_t*)(p.ws + HG_V);
  const _Float16* hlf = (const _Float16*)(p.ws + HG_LF);
  bf16_t* oraw = (bf16_t*)p.out;
  LAS bf16_t* Q = (LAS bf16_t*)lds; LAS bf16_t* Kr = (LAS bf16_t*)(lds + 17408); LAS float* BC = (LAS float*)(lds + 34816); LAS bf16_t* KDT = (LAS bf16_t*)(lds + 68608);
  LAS bf16_t* VT = (LAS bf16_t*)(lds + 87040); LAS bf16_t* ST = (LAS bf16_t*)(lds + 91648); LAS bf16_t* AB = (LAS bf16_t*)(lds + 100352);
  LAS float* SEG = (LAS float*)(lds + 109568); LAS float* DEC = (LAS float*)(lds + 111616); LAS _Float16* LF = (LAS _Float16*)(lds + 112128);
  int tid_ = wv * 64 + lane_id_(); asm volatile("" : "+v"(tid_)); const int tid = tid_, wid = tid >> 6, lane = tid & 63, fr = lane & 15, fq = lane >> 4;
  for (int it = blockIdx.x; it < 256; it += gridDim.x) {
    const int b = it >> 5, hh = (it >> 2) & 7, vq = it & 3;
    __syncthreads();
    for (int i = tid; i < 32 * 136 / 2; i += 512) ((LAS unsigned*)ST)[i] = 0u;
    f32x4 sreg[2]; sreg[0] = (f32x4){0.f, 0.f, 0.f, 0.f}; sreg[1] = sreg[0];
    u32x4 pq[2], pkk[2], plf[2], pv;
    const size_t gb = (size_t)(b * SEQ) * 1024 + hh * 128;
    auto prefetch = [&](int c) {
#pragma unroll
      for (int i = 0; i < 2; ++i) { const int idx = tid + 512 * i, row = idx >> 4, c8 = (idx & 15) * 8; const size_t off = gb + (size_t)(c * 64 + row) * 1024 + c8;
        pq[i] = *(const u32x4*)(hq + off); pkk[i] = *(const u32x4*)(hk + off); plf[i] = *(const u32x4*)(hlf + off); }
      if (tid < 256) { const int row = tid >> 2, c8 = (tid & 3) * 8; pv = *(const u32x4*)(hv + gb + (size_t)(c * 64 + row) * 1024 + vq * 32 + c8); }
    };
    prefetch(0);
    for (int c = 0; c < 64; ++c) {
      lds_barrier();
#pragma unroll
      for (int i = 0; i < 2; ++i) { const int idx = tid + 512 * i, row = idx >> 4, c8 = (idx & 15) * 8;
        *(LAS u32x4*)(Q + row * 136 + c8) = pq[i]; *(LAS u32x4*)(Kr + row * 136 + c8) = pkk[i]; *(LAS u32x4*)(LF + row * 128 + c8) = plf[i]; }
      if (tid < 256) { const int row = tid >> 2, c8 = (tid & 3) * 8; const bf16x8 vv = __builtin_bit_cast(bf16x8, pv);
#pragma unroll
        for (int i = 0; i < 8; ++i) VT[(c8 + i) * 72 + row] = (bf16_t)vv[i]; }
      if (c + 1 < 64) prefetch(c + 1);
      lds_barrier();
      const int kx = tid & 127, seg = tid >> 7;
      float bl[16];
      { float run = 0.f;
#pragma unroll
        for (int i = 0; i < 16; ++i) { run += (float)LF[(16 * seg + i) * 128 + kx]; bl[i] = run; }
        SEG[seg * 128 + kx] = run; }
      lds_barrier();
      { float pre = 0.f, blast = 0.f;
#pragma unroll
        for (int s2 = 0; s2 < 4; ++s2) { const float v = SEG[s2 * 128 + kx]; blast += v; if (s2 < seg) pre += v; }
        u32x4 w0, w1; float kd[16];
#pragma unroll
        for (int i = 0; i < 16; ++i) { const float bc = pre + bl[i]; BC[(16 * seg + i) * 132 + kx] = bc; kd[i] = bf2f(Kr[(16 * seg + i) * 136 + kx]) * __builtin_amdgcn_exp2f(blast - bc); }
#pragma unroll
        for (int j = 0; j < 4; ++j) { w0[j] = pk2(kd[2 * j], kd[2 * j + 1]); w1[j] = pk2(kd[8 + 2 * j], kd[8 + 2 * j + 1]); }
        *(LAS u32x4*)(KDT + kx * 72 + 16 * seg) = w0; *(LAS u32x4*)(KDT + kx * 72 + 16 * seg + 8) = w1;
        if (seg == 0) DEC[kx] = __builtin_amdgcn_exp2f(blast); }
      lds_barrier();
      const int mt = wid >> 1, vt = wid & 1;
      f32x4 oacc = (f32x4){0.f, 0.f, 0.f, 0.f}, a0 = oacc, a1 = oacc;
      const int J0 = 2 * vt;
#pragma unroll
      for (int ks = 0; ks < 4; ++ks) {
        const int kb = 32 * ks + 8 * fq, trow = 16 * mt + fr;
        const bf16x8 qv = *(const LAS bf16x8*)(Q + trow * 136 + kb);
        const f32x4 bc0 = *(const LAS f32x4*)(BC + trow * 132 + kb), bc1 = *(const LAS f32x4*)(BC + trow * 132 + kb + 4);
        const f32x4 r0 = *(const LAS f32x4*)(BC + (16 * mt) * 132 + kb), r1 = *(const LAS f32x4*)(BC + (16 * mt) * 132 + kb + 4);
        u32x4 ai, aq;
#pragma unroll
        for (int j = 0; j < 4; ++j) {
          const float q0 = bf2f((bf16_t)qv[2 * j]), q1 = bf2f((bf16_t)qv[2 * j + 1]);
          const float b0 = j < 2 ? bc0[2 * j] : bc1[2 * j - 4], b1 = j < 2 ? bc0[2 * j + 1] : bc1[2 * j - 3];
          const float rr0 = j < 2 ? r0[2 * j] : r1[2 * j - 4], rr1 = j < 2 ? r0[2 * j + 1] : r1[2 * j - 3];
          ai[j] = pk2(q0 * __builtin_amdgcn_exp2f(b0), q1 * __builtin_amdgcn_exp2f(b1)); aq[j] = pk2(q0 * __builtin_amdgcn_exp2f(b0 - rr0), q1 * __builtin_amdgcn_exp2f(b1 - rr1));
        }
        const bf16x8 sb = *(const LAS bf16x8*)(ST + (16 * vt + fr) * 136 + kb);
        oacc = MFMA16(__builtin_bit_cast(bf16x8, ai), sb, oacc);
#pragma unroll
        for (int jj = 0; jj < 2; ++jj) {
          const int J = J0 + jj; if (J > mt) continue;
          const int srow = 16 * J + fr;
          const bf16x8 kv = *(const LAS bf16x8*)(Kr + srow * 136 + kb);
          const f32x4 c0 = *(const LAS f32x4*)(BC + srow * 132 + kb), c1 = *(const LAS f32x4*)(BC + srow * 132 + kb + 4);
          u32x4 bk;
#pragma unroll
          for (int j = 0; j < 4; ++j) {
            const float k0 = bf2f((bf16_t)kv[2 * j]), k1 = bf2f((bf16_t)kv[2 * j + 1]);
            const float b0 = j < 2 ? c0[2 * j] : c1[2 * j - 4], b1 = j < 2 ? c0[2 * j + 1] : c1[2 * j - 3];
            const float rr0 = j < 2 ? r0[2 * j] : r1[2 * j - 4], rr1 = j < 2 ? r0[2 * j + 1] : r1[2 * j - 3];
            bk[j] = pk2(k0 * __builtin_amdgcn_exp2f(fminf(rr0 - b0, 115.f)), k1 * __builtin_amdgcn_exp2f(fminf(rr1 - b1, 115.f)));
          }
          if (jj == 0) a0 = MFMA16(__builtin_bit_cast(bf16x8, aq), __builtin_bit_cast(bf16x8, bk), a0);
          else a1 = MFMA16(__builtin_bit_cast(bf16x8, aq), __builtin_bit_cast(bf16x8, bk), a1);
        }
      }
#pragma unroll
      for (int jj = 0; jj < 2; ++jj) { const int J = J0 + jj;
#pragma unroll
        for (int reg = 0; reg < 4; ++reg) { const int tt = 16 * mt + 4 * fq + reg, ss = 16 * J + fr; const float v = jj == 0 ? a0[reg] : a1[reg];
          AB[tt * 72 + ss] = (J <= mt && ss <= tt) ? f2bf(v) : (bf16_t)0; } }
      lds_barrier();
#pragma unroll
      for (int k2 = 0; k2 < 2; ++k2) {
        const bf16x8 af = *(const LAS bf16x8*)(AB + (16 * mt + fr) * 72 + 32 * k2 + 8 * fq);
        const bf16x8 vb = *(const LAS bf16x8*)(VT + (16 * vt + fr) * 72 + 32 * k2 + 8 * fq);
        oacc = MFMA16(af, vb, oacc);
      }
#pragma unroll
      for (int reg = 0; reg < 4; ++reg) {
        const int tok = b * SEQ + c * 64 + 16 * mt + 4 * fq + reg; const float v = oacc[reg];
        oraw[(size_t)tok * 1024 + hh * 128 + vq * 32 + 16 * vt + fr] = f2bf(v);
        float sq = v * v; sq += __shfl_xor(sq, 1); sq += __shfl_xor(sq, 2); sq += __shfl_xor(sq, 4); sq += __shfl_xor(sq, 8);
        if (fr == 0) atomicAdd(sumsq + (size_t)tok * 8 + hh, sq);
      }
      { const f32x4 dc = *(const LAS f32x4*)(DEC + 16 * wid + 4 * fq);
        sreg[0] *= dc; sreg[1] *= dc;
#pragma unroll
        for (int k2 = 0; k2 < 2; ++k2) {
          const bf16x8 af = *(const LAS bf16x8*)(KDT + (16 * wid + fr) * 72 + 32 * k2 + 8 * fq);
#pragma unroll
          for (int v2 = 0; v2 < 2; ++v2) { const bf16x8 vb = *(const LAS bf16x8*)(VT + (16 * v2 + fr) * 72 + 32 * k2 + 8 * fq); sreg[v2] = MFMA16(af, vb, sreg[v2]); }
        }
#pragma unroll
        for (int v2 = 0; v2 < 2; ++v2) { u32x2 w; w.x = pk2(sreg[v2][0], sreg[v2][1]); w.y = pk2(sreg[v2][2], sreg[v2][3]); *(LAS u32x2*)(ST + (16 * v2 + fr) * 136 + 16 * wid + 4 * fq) = w; }
      }
    }
  }
}
DI void hgrn_norm_phase(int wv, const P& p_, int slot) {
  P p = p_; { size_t z_ = 0; asm volatile("" : "+s"(z_)); p.ws = p_.ws + z_; }
  const bf16_t* oraw = (const bf16_t*)p.out; const bf16_t* hg = (const bf16_t*)(p.ws + HG_G); const float* sumsq = (const float*)(p.ws + WS_SUMSQ);
  bf16_t* ob = (bf16_t*)(p.ws + WS_O); const float* gain = p.hg_gain + slot * 128;
  int tid_ = wv * 64 + lane_id_(); asm volatile("" : "+v"(tid_)); const size_t gtid = (size_t)blockIdx.x * 512 + tid_, gsz = (size_t)gridDim.x * 512;
  for (size_t i = gtid; i < (size_t)MTOK * 1024 / 8; i += gsz) {
    const size_t e = i * 8; const int row = (int)(e >> 10), col = (int)(e & 1023), hh = col >> 7, vv = col & 127;
    const float rs = rsqrtf(sumsq[(size_t)row * 8 + hh] * (1.0f / 128.0f) + 1e-6f);
    const bf16x8 o8 = *(const bf16x8*)(oraw + e), g8 = *(const bf16x8*)(hg + e);
    u32x4 w;
#pragma unroll
    for (int j = 0; j < 4; ++j) w[j] = pkh2(bf2f((bf16_t)o8[2 * j]) * rs * gain[vv + 2 * j] * bf2f((bf16_t)g8[2 * j]), bf2f((bf16_t)o8[2 * j + 1]) * rs * gain[vv + 2 * j + 1] * bf2f((bf16_t)g8[2 * j + 1]));
    *(u32x4*)(ob + e) = w;
  }
}
#define REP_NSA 1
#define REP_CONV 1
#define REP_CMP 1
#define REP_MISC 1
#define REP_DOWN 1
#define REP_HG 1
#define REP_EPI 1
#ifndef SKIP_MIXERS
#define SKIP_MIXERS 0
#endif
__global__ void __launch_bounds__(512, 2) mega_fwd(P p) {
  extern __shared__ __attribute__((aligned(16))) unsigned char lds_raw[];
  LAS unsigned char* lds = (LAS unsigned char*)lds_raw;
  cg::grid_group grid = cg::this_grid();
  const int wv = __builtin_amdgcn_readfirstlane((int)(threadIdx.x >> 6));
  volatile LAS unsigned* xst = (volatile LAS unsigned*)(lds + LDS_BYTES - 16);
  if (wv == 0 && lane_id_() < 4) xst[lane_id_()] = 0u;
  __syncthreads();
  const XcdBarrier xb = xcd_barrier_post(wv, (unsigned*)(p.ws + WS_BAR), xst);
#define GSYNC() xcd_barrier(wv, xb)
  unsigned char* ws = p.ws;
  init_phase(wv, p);
  for (int L = 0; L < 4; ++L) {
    { size_t z_ = 0; asm volatile("" : "+s"(z_)); ws = p.ws + z_; }
    for (int rep = 0; rep < p.rep_conv; ++rep) convert_phase(wv, p, L, lds);
    if (L == 0) grid.sync(); else GSYNC();
    const int kind = L % 3, slot = L / 3;
    for (int s = 0; s < 3; ++s) {
      { size_t z_ = 0; asm volatile("" : "+s"(z_)); ws = p.ws + z_; }
      float* stats = (float*)(ws + WS_STATS); bf16_t* tb = (bf16_t*)(ws + WS_TB); bf16_t* Hb = (bf16_t*)(ws + WS_BIG); bf16_t* ob = (bf16_t*)(ws + WS_O);
      const int lnp = L * 3 + s - 1;
      const float* stp = (const float*)(ws + WS_DSTATS) + (size_t)(lnp + 1) * MTOK * 2;
      pg8::Gemm gr; float scale;
      if (s != 1) {
        pg8::Gemm g; g.A = tb; g.Bt = (const bf16_t*)(ws + (s == 0 ? W_GU1 : W_GU2)); g.M = MTOK; g.N = 5632; g.K = DM;
        pg8::StaticOrder S; S.init(g.M, g.N, gridDim.x, blockIdx.x);
        EpiUp E; E.reps = p.rep_epi; E.H = Hb; E.stats = stp; E.c1 = (const float*)(ws + (s == 0 ? C_GU1 : C_GU2)); E.c2 = E.c1 + 5632;
        pg8::gemm_phase(wv, lds, g, S, E);
        GSYNC();
        gr.A = Hb; gr.Bt = (const bf16_t*)(ws + (s == 0 ? W_D1 : W_D2)); gr.M = MTOK; gr.N = DM; gr.K = DFF; scale = 0.5f;
      } else {
        pg8::Gemm g; g.A = tb; g.Bt = (const bf16_t*)(ws + W_IN); g.M = MTOK; g.N = kind == 0 ? 2816 : (kind == 1 ? 4096 : 1280); g.K = DM;
        pg8::StaticOrder S; S.init(g.M, g.N, gridDim.x, blockIdx.x);
        EpiIn E; E.reps = 1; E.mode = kind == 1 ? 1 : 0; E.h = Hb; E.ld = g.N; E.stats = stp; E.c1 = (const float*)(ws + C_IN); E.c2 = E.c1 + 4096; E.lbv = (const float*)(ws + C_LBV);
        E.hq = (bf16_t*)(ws + HG_Q); E.hk = (bf16_t*)(ws + HG_K); E.hv = (bf16_t*)(ws + HG_V); E.hg = (bf16_t*)(ws + HG_G); E.hlf = (_Float16*)(ws + HG_LF);
        pg8::gemm_phase(wv, lds, g, S, E);
        GSYNC();
#if !SKIP_MIXERS
        if (kind == 0) {
          for (int rep = 0; rep < p.rep_cmp; ++rep) nsa_compress_phase(wv, p, lds);
          GSYNC();
          for (int rep = 0; rep < p.rep_nsa; ++rep) { if (rep) GSYNC(); nsa_attn_phase(wv, p, lds); }
        }
        else if (kind == 1) {
          for (int rep = p.rep_hg - 1; rep >= 0; --rep) hgrn_scan_phase(wv, p, lds, (float*)(ws + (rep ? WS_KC : WS_SUMSQ)));
          GSYNC(); hgrn_norm_phase(wv, p, slot); }
        else {
          for (int rep = 0; rep < p.rep_misc; ++rep) swa_attn_phase(wv, p, slot, lds);
        }
#endif
        GSYNC();
        gr.A = ob; gr.Bt = (const bf16_t*)(ws + W_OUT); gr.M = MTOK; gr.N = DM; gr.K = DM; scale = 1.0f;
      }
      pg8::StaticOrder S2; S2.init(gr.M, gr.N, gridDim.x, blockIdx.x);
      EpiRes R; R.reps = 1; R.stats_prev = stp; R.g = (const float*)(ws + WS_G13) + (size_t)(lnp + 1) * DM; R.b = (const float*)(ws + WS_B13) + (size_t)(lnp + 1) * DM;
      R.stats_new = stats + (size_t)(lnp + 1) * MTOK * 2; R.tb = tb; R.scale = scale;
      for (int rep = (s != 1 ? p.rep_down : 1) - 1; rep >= 0; --rep) {
        R.tb = tb; R.stats_new = stats + (size_t)(lnp + 1) * MTOK * 2;
        pg8::gemm_phase(wv, lds, gr, S2, R);
        GSYNC();
      }
    }
  }
  final_ln(wv, p, (float*)(ws + WS_STATS) + (size_t)11 * MTOK * 2, p.ln_gain + 11 * DM, p.ln_bias + 11 * DM);
}

extern "C" void kernel_launch(void* const* d_in, const int* in_sizes, int n_in, void* d_out, int out_size, void* d_ws, size_t ws_size, hipStream_t stream) {
  static int grid = 0;
  if (grid == 0) {
    if (n_in != 22 || ws_size < WS_END) { fprintf(stderr, "kernel_launch: unexpected n_in %d / ws_size %zu (need %zu)\n", n_in, ws_size, (size_t)WS_END); grid = -1; return; }
    int dev = 0, cus = 0, per_cu = 0;
    hipGetDevice(&dev); hipDeviceGetAttribute(&cus, hipDeviceAttributeMultiprocessorCount, dev);
    if (hipFuncSetAttribute((const void*)mega_fwd, hipFuncAttributeMaxDynamicSharedMemorySize, LDS_BYTES) != hipSuccess) { fprintf(stderr, "hipFuncSetAttribute failed\n"); grid = -1; return; }
    hipOccupancyMaxActiveBlocksPerMultiprocessor(&per_cu, (const void*)mega_fwd, 512, LDS_BYTES);
    if (per_cu < 1) { fprintf(stderr, "occupancy query says %d blocks/CU\n", per_cu); per_cu = 1; }
    (void)hipGetLastError();
    grid = cus * 1;
  }
  if (grid < 0) return;
  if (hipMemsetAsync((char*)d_ws + WS_BAR, 0, 16384, stream) != hipSuccess) { fprintf(stderr, "memset failed\n"); return; }
  P p{};
  const float** pp = (const float**)&p;
  for (int i = 0; i < 22; ++i) pp[i] = (const float*)d_in[i];
  p.out = (float*)d_out; p.ws = (unsigned char*)d_ws;
  p.rep_nsa = REP_NSA; p.rep_conv = REP_CONV; p.rep_cmp = REP_CMP; p.rep_misc = REP_MISC; p.rep_down = REP_DOWN; p.rep_hg = REP_HG; p.rep_epi = REP_EPI; p.rep_pad = 0;
  void* args[] = {&p};
  hipError_t e = hipLaunchCooperativeKernel((const void*)mega_fwd, dim3(grid), dim3(512), args, LDS_BYTES, stream);
  if (e != hipSuccess) fprintf(stderr, "cooperative launch failed: %s (grid %d)\n", hipGetErrorString(e), grid);
}
```

```cpp
#include <hip/hip_runtime.h>
#include <hip/hip_cooperative_groups.h>
#include <cstdio>
namespace cg = cooperative_groups;

typedef unsigned short bf16_t;
typedef short bf16x8 __attribute__((ext_vector_type(8)));
typedef short s16x4 __attribute__((ext_vector_type(4)));
typedef _Float16 half8 __attribute__((ext_vector_type(8)));
typedef float f32x4 __attribute__((ext_vector_type(4)));
typedef float f32x16 __attribute__((ext_vector_type(16)));
typedef unsigned u32x2 __attribute__((ext_vector_type(2)));
typedef unsigned u32x4 __attribute__((ext_vector_type(4)));
#define LAS __attribute__((address_space(3)))
#define DI __device__ __forceinline__

constexpr int MTOK = 32768, DM = 1024, DFF = 2816, SEQ = 4096, NB = 8;
constexpr float ALPHA = 1.681792830507429f;
constexpr size_t MiB = 1ull << 20;
constexpr size_t W_GU1 = 0, W_D1 = 11534336, W_GU2 = 17301504, W_D2 = 28835840, W_IN = 34603008, W_OUT = 42991616,
                 W_W1T = 45088768, W_W2T = 46137344, W_C = 46170112;
constexpr size_t C_GU1 = W_C, C_GU2 = C_GU1 + 2 * 5632 * 4, C_IN = C_GU2 + 2 * 5632 * 4, C_POSB = C_IN + 2 * 4096 * 4,
                 C_LBV = C_POSB + 2 * 256 * 4, C_BTAB = C_LBV + 1024 * 4, C_END = C_BTAB + 16 * 132 * 4;
constexpr size_t WS_TB = 48 * MiB, WS_BIG = 112 * MiB, WS_O = 432 * MiB, WS_MISC = 496 * MiB;
constexpr size_t WS_DSTATS = WS_MISC, WS_STATS = WS_DSTATS + 262144, WS_SUMSQ = WS_STATS + 3 * MiB, WS_KC = WS_SUMSQ + 1 * MiB, WS_VC = WS_KC + 1 * MiB, WS_BAR = WS_VC + 1 * MiB,
                 WS_G13 = WS_BAR + 16384, WS_B13 = WS_G13 + 13 * 4096, WS_END = WS_B13 + 13 * 4096;
static_assert(C_END <= 48 * MiB, "weights region");
constexpr int LDS_BYTES = 144 * 1024;

struct P {
  const float *x, *rel_bias, *ln_gain, *ln_bias, *f1g, *f1u, *f1d, *f2g, *f2u, *f2d, *nsa_win, *nsa_wout, *nsa_pos, *nsa_w1, *nsa_w2,
      *hg_win, *hg_wout, *hg_gain, *hg_lb, *swa_win, *swa_wout, *swa_sinks;
  float* out; unsigned char* ws;
  int rep_nsa, rep_conv, rep_cmp, rep_misc, rep_down, rep_hg, rep_epi, rep_pad;
};

DI unsigned pk2(float a, float b) { typedef __bf16 bf2 __attribute__((ext_vector_type(2))); bf2 v; v[0] = (__bf16)a; v[1] = (__bf16)b; return __builtin_bit_cast(unsigned, v); }
DI unsigned pkh2(float a, float b) { typedef _Float16 h2 __attribute__((ext_vector_type(2))); h2 v; v[0] = (_Float16)a; v[1] = (_Float16)b; return __builtin_bit_cast(unsigned, v); }
DI bf16_t f2h(float a) { return __builtin_bit_cast(unsigned short, (_Float16)a); }
DI float h2f(bf16_t v) { return (float)__builtin_bit_cast(_Float16, v); }
DI bf16_t f2bf(float a) { return __builtin_bit_cast(unsigned short, (__bf16)a); }
DI float bf2f(bf16_t v) { return __uint_as_float(((unsigned)v) << 16); }
DI int lane_id_() { int l; asm volatile("v_mbcnt_lo_u32_b32 %0, -1, 0\n\tv_mbcnt_hi_u32_b32 %0, -1, %0" : "=v"(l)); return l; }
DI void lds_barrier() { asm volatile("s_waitcnt lgkmcnt(0)\n\ts_barrier" ::: "memory"); }
DI float sigmoidf_(float v) { return __builtin_amdgcn_rcpf(1.0f + __builtin_amdgcn_exp2f(-1.4426950408889634f * v)); }


#define XB_TMO      128
#define XB_XCNT(j)  (256  + 64 * (j))
#define XB_XSUB(j)  (1280 + 64 * (j))
#define XB_XGEN(j)  (2304 + 64 * (j))
#define XB_TOP      3328
#define XB_TOPGEN   3392
#define XCD_BAR_WORDS 3456
#define XB_SPIN_CAP (1u << 20)
DI unsigned xb_ld(unsigned* p)              { return __hip_atomic_load(p, __ATOMIC_RELAXED, __HIP_MEMORY_SCOPE_AGENT); }
DI unsigned xb_add(unsigned* p, unsigned v) { return __hip_atomic_fetch_add(p, v, __ATOMIC_RELAXED, __HIP_MEMORY_SCOPE_AGENT); }
DI unsigned xb_xcc_id() { return (unsigned)__builtin_amdgcn_s_getreg((3 << 11) | 20) & 0xFu; }
#define XB_SPIN(cond, bar) do { unsigned _sp = 0; while (cond) { __builtin_amdgcn_s_sleep(1); \
    if ((++_sp & 255u) == 0u) { if (xb_ld(&(bar)[XB_TMO])) break; if (_sp > XB_SPIN_CAP) { atomicAdd(&(bar)[XB_TMO], 1u); break; } } } } while (0)
struct XcdBarrier { unsigned* bar; unsigned x; volatile LAS unsigned* st; };
DI XcdBarrier xcd_barrier_post(int wv, unsigned* bar, volatile LAS unsigned* st) {
  XcdBarrier b; b.bar = bar; b.x = xb_xcc_id(); b.st = st;
  if (wv == 0 && lane_id_() == 0) (void)xb_add(&bar[XB_XCNT(b.x)], 1u);
  return b;
}
DI void xcd_barrier_complete(unsigned* bar, unsigned x, unsigned& nloc, unsigned& nx) {
  const unsigned G = gridDim.x * gridDim.y * gridDim.z;
  unsigned sum, cnt, mine, sp = 0u;
  for (;;) {
    sum = 0u; cnt = 0u; mine = 0u;
#pragma unroll 1
    for (unsigned j = 0; j < 16; ++j) { const unsigned c = xb_ld(&bar[XB_XCNT(j)]); sum += c; cnt += (c > 0u) ? 1u : 0u; mine = (j == x) ? c : mine; }
    if (sum == G) break;
    __builtin_amdgcn_s_sleep(1);
    if ((++sp & 255u) == 0u) { if (xb_ld(&bar[XB_TMO])) break; if (sp > XB_SPIN_CAP) { atomicAdd(&bar[XB_TMO], 1u); break; } }
  }
  nloc = mine > 0u ? mine : 1u; nx = cnt > 0u ? cnt : 1u;
}
DI void xcd_barrier(int wv, const XcdBarrier& b) {
  asm volatile("s_waitcnt vmcnt(0)" ::: "memory");
  __syncthreads();
  if (wv == 0 && lane_id_() == 0) {
    unsigned* bar = b.bar;
    __builtin_amdgcn_s_waitcnt(0);
    unsigned nloc = b.st[0], nx = b.st[1];
    if (nloc == 0u) { xcd_barrier_complete(bar, b.x, nloc, nx); b.st[0] = nloc; b.st[1] = nx; }
    const unsigned old = xb_add(&bar[XB_XSUB(b.x)], 1u);
    const unsigned gen = old / nloc;
    if (old + 1u == (gen + 1u) * nloc) {
      __builtin_amdgcn_fence(__ATOMIC_RELEASE, "agent");
      asm volatile("s_waitcnt vmcnt(0)" ::: "memory");
      const unsigned og = xb_add(&bar[XB_TOP], 1u);
      const unsigned tg = og / nx;
      if (og + 1u == (tg + 1u) * nx) xb_add(&bar[XB_TOPGEN], 1u);
      else XB_SPIN(xb_ld(&bar[XB_TOPGEN]) == tg, bar);
      __builtin_amdgcn_fence(__ATOMIC_ACQUIRE, "agent");
      xb_add(&bar[XB_XGEN(b.x)], 1u);
      asm volatile("s_waitcnt vmcnt(0)" ::: "memory");
    } else {
      XB_SPIN(xb_ld(&bar[XB_XGEN(b.x)]) == gen, bar);
      __builtin_amdgcn_fence(__ATOMIC_ACQUIRE, "agent");
      asm volatile("s_waitcnt vmcnt(0)" ::: "memory");
    }
  }
  __syncthreads();
}

namespace pg8 {
constexpr int BM = 256, BK = 64, HALF = 128, HTB = HALF * BK * 2, STAGE_BYTES = 8 * HTB, NXCD = 8, WGM = 8;
DI int lds_byte(int r, int c) { const int st = (r >> 4) * 2 + (c >> 5), rr = r & 15, cc = c & 31, ob = rr * 64 + cc * 2; return st * 1024 + (ob ^ (((ob >> 9) & 1) << 5)); }
DI void stage_rc(int b, int& R, int& C) { const int st = b / 1024, sb = b % 1024, swz = sb ^ (((sb >> 9) & 1) << 5); R = (st >> 1) * 16 + swz / 64; C = (st & 1) * 32 + (swz % 64) / 2; }
struct Unit { int pm, pn; };
struct Gemm { const bf16_t* A; const bf16_t* Bt; int M, N, K; };
struct StaticOrder {
  int nM, nN, nwg, G, c;
  DI void init(int M, int N, int G_, int c_) { nM = M / BM; nN = N / BM; nwg = nM * nN; G = G_; c = c_; }
  DI bool next(int i, Unit& u) const {
    const long L = (long)i * G + c; if (L >= nwg) return false;
    int wgid = (int)L; { const int q = nwg / NXCD, r = nwg % NXCD, xcd = wgid % NXCD, off = wgid / NXCD; wgid = (xcd < r ? xcd * (q + 1) : r * (q + 1) + (xcd - r) * q) + off; }
    const int nig = WGM * nN, gid = wgid / nig, fm = gid * WGM, gsz = (nM - fm) < WGM ? (nM - fm) : WGM;
    u.pm = fm + ((wgid % nig) % gsz); u.pn = (wgid % nig) / gsz; return true;
  }
};
template <class Epi>
DI void gemm_phase(int wv, LAS unsigned char* lds, const Gemm g, const StaticOrder& S, const Epi& E) {
  int tid_ = wv * 64 + lane_id_(); asm volatile("" : "+v"(tid_)); const int tid = tid_, wid = __builtin_amdgcn_readfirstlane(tid >> 6), lane = tid & 63, wr = wid >> 2, wc = wid & 3, fr = lane & 15, fq = lane >> 4;
  const int K = g.K, nt = K / BK;
  unsigned voffA[2];
#pragma unroll
  for (int i = 0; i < 2; ++i) { int R, C; stage_rc(tid * 16 + i * 8192, R, C); voffA[i] = (unsigned)(R * K + C) * 2u; }
  const size_t kstep = (size_t)(BK * 2), hstep = (size_t)HALF * K * 2, tstep = 2 * hstep;
  const unsigned ldsw = (unsigned)wid * 1024u;
  const int aoff = lds_byte(wr * 64 + fr, fq * 8), boff = lds_byte(wc * 32 + fr, fq * 8);
#define PG8_SA(b, h) (((b) * 2 + (h)) * HTB)
#define PG8_SB(b, h) ((4 + (b) * 2 + (h)) * HTB)
#define PG8_STAGE(bufoff, gbase, voff) do { _Pragma("unroll") for (int _i = 0; _i < 2; ++_i) \
    __builtin_amdgcn_global_load_lds((const unsigned*)((const char*)(gbase) + (voff)[_i]), (LAS unsigned*)(lds + (bufoff) + ldsw + _i * 8192), 16, 0, 0); } while (0)
#define PG8_LDA(dst, b, h) do { _Pragma("unroll") for (int m = 0; m < 4; ++m) _Pragma("unroll") for (int k = 0; k < 2; ++k) dst[m][k] = *(const LAS bf16x8*)(lds + PG8_SA(b, h) + aoff + m * 2048 + k * 1024); } while (0)
#define PG8_LDB(dst, b, h) do { _Pragma("unroll") for (int n = 0; n < 2; ++n) _Pragma("unroll") for (int k = 0; k < 2; ++k) dst[n][k] = *(const LAS bf16x8*)(lds + PG8_SB(b, h) + boff + n * 2048 + k * 1024); } while (0)
#define PG8_MMA(ai, bj, At, Bt) do { __builtin_amdgcn_s_setprio(1); _Pragma("unroll") for (int m = 0; m < 4; ++m) _Pragma("unroll") for (int n = 0; n < 2; ++n) _Pragma("unroll") for (int k = 0; k < 2; ++k) \
    acc[ai][bj][m][n] = __builtin_amdgcn_mfma_f32_16x16x32_f16(__builtin_bit_cast(half8, Bt[n][k]), __builtin_bit_cast(half8, At[m][k]), acc[ai][bj][m][n], 0, 0, 0); __builtin_amdgcn_s_setprio(0); } while (0)
#define PG8_WAIT_V(n) asm volatile("s_waitcnt vmcnt(" #n ")" ::: "memory")
#define PG8_WAIT_L(n) asm volatile("s_waitcnt lgkmcnt(" #n ")" ::: "memory")
#define PG8_BAR __builtin_amdgcn_s_barrier()
#define PG8_SCHED __builtin_amdgcn_sched_barrier(0)
  Unit cur, nxt; int ui = 0;
  if (!S.next(0, cur)) return;
  f32x4 acc[2][2][4][2];
#pragma unroll
  for (int a = 0; a < 2; ++a)
#pragma unroll
    for (int b = 0; b < 2; ++b)
#pragma unroll
      for (int m = 0; m < 4; ++m)
#pragma unroll
        for (int n = 0; n < 2; ++n) acc[a][b][m][n] = (f32x4){0.f, 0.f, 0.f, 0.f};
  bf16x8 At[4][2], B0[2][2], B1[2][2];
  const char* cA = (const char*)g.A + (size_t)cur.pm * tstep; const char* cB = (const char*)g.Bt + (size_t)cur.pn * tstep;
  E.pre(lds, cur, 0, wid, lane, wr);
  PG8_STAGE(PG8_SB(0, 0), cB, voffA); PG8_STAGE(PG8_SA(0, 0), cA, voffA); PG8_STAGE(PG8_SB(0, 1), cB + hstep, voffA); PG8_STAGE(PG8_SA(0, 1), cA + hstep, voffA);
  if (wr == 1) PG8_BAR;
  PG8_WAIT_V(4); PG8_BAR;
  PG8_STAGE(PG8_SB(1, 0), cB + kstep, voffA); PG8_STAGE(PG8_SA(1, 0), cA + kstep, voffA); PG8_STAGE(PG8_SB(1, 1), cB + hstep + kstep, voffA);
  PG8_WAIT_V(6); PG8_BAR;
  for (;;) {
    const bool has_next = S.next(ui + 1, nxt);
    const char* nA = has_next ? (const char*)g.A + (size_t)nxt.pm * tstep : cA; const char* nB = has_next ? (const char*)g.Bt + (size_t)nxt.pn * tstep : cB;
    for (int t = 0; t < nt; t += 2) {
      const bool last = (t == nt - 2);
      const char* a1 = cA + (size_t)(t + 1) * kstep;
      const char* a2 = last ? nA : cA + (size_t)(t + 2) * kstep; const char* b2 = last ? nB : cB + (size_t)(t + 2) * kstep;
      const char* a3 = a2 + kstep; const char* b3 = b2 + kstep;
      PG8_LDB(B0, 0, 0); PG8_SCHED; PG8_LDA(At, 0, 0); PG8_STAGE(PG8_SA(1, 1), a1 + hstep, voffA);
      PG8_WAIT_L(8); PG8_BAR; PG8_WAIT_L(0); PG8_MMA(0, 0, At, B0); PG8_BAR; PG8_SCHED;
      PG8_LDB(B1, 0, 1); PG8_STAGE(PG8_SB(0, 0), b2, voffA);
      PG8_BAR; PG8_WAIT_L(0); PG8_MMA(0, 1, At, B1); PG8_BAR;
      PG8_LDA(At, 0, 1); PG8_STAGE(PG8_SA(0, 0), a2, voffA);
      PG8_BAR; PG8_WAIT_L(0); PG8_MMA(1, 0, At, B0); PG8_BAR; PG8_SCHED;
      PG8_STAGE(PG8_SB(0, 1), b2 + hstep, voffA);
      PG8_WAIT_V(6); PG8_BAR; PG8_MMA(1, 1, At, B1); PG8_BAR;
      PG8_LDB(B0, 1, 0); PG8_SCHED; PG8_LDA(At, 1, 0); PG8_STAGE(PG8_SA(0, 1), a2 + hstep, voffA);
      PG8_WAIT_L(8); PG8_BAR; PG8_WAIT_L(0); PG8_MMA(0, 0, At, B0); PG8_BAR; PG8_SCHED;
      PG8_LDB(B1, 1, 1); PG8_STAGE(PG8_SB(1, 0), b3, voffA);
      PG8_BAR; PG8_WAIT_L(0); PG8_MMA(0, 1, At, B1); PG8_BAR;
      PG8_LDA(At, 1, 1); PG8_STAGE(PG8_SA(1, 0), a3, voffA);
      PG8_BAR; PG8_WAIT_L(0); PG8_MMA(1, 0, At, B0); PG8_BAR; PG8_SCHED;
      PG8_STAGE(PG8_SB(1, 1), b3 + hstep, voffA);
      PG8_WAIT_V(6); PG8_BAR; PG8_MMA(1, 1, At, B1); PG8_BAR;
    }
    for (int r_ = 0; r_ < E.reps; ++r_) E(acc, cur, wr, wc, fr, fq, lds, ui, wid);
    if (!has_next) break;
    E.pre(lds, nxt, ui + 1, wid, lane, wr);
#pragma unroll
    for (int a = 0; a < 2; ++a)
#pragma unroll
      for (int b = 0; b < 2; ++b)
#pragma unroll
        for (int m = 0; m < 4; ++m)
#pragma unroll
          for (int n = 0; n < 2; ++n) acc[a][b][m][n] = (f32x4){0.f, 0.f, 0.f, 0.f};
    cur = nxt; cA = nA; cB = nB; ++ui;
  }
  PG8_WAIT_V(0);
  if (wr == 0) PG8_BAR;
  PG8_BAR;
}
}
DI void row_affine(const float* stats, int row, float& a, float& bb, float& mu, float& rstd) {
  const float s = stats[2 * row], ss = stats[2 * row + 1]; mu = s * (1.0f / 1024.0f); const float var = fmaxf(ss * (1.0f / 1024.0f) - mu * mu, 0.f); rstd = rsqrtf(var + 1e-5f); a = rstd; bb = -rstd * mu;
}
struct EpiUp {
  bf16_t* H; const float* stats; const float* c1; const float* c2; int reps;
  DI void pre(LAS unsigned char* lds, const pg8::Unit& u, int ui, int wid, int lane, int wr) const {
    asm volatile("" : "+v"(lane));
    __builtin_amdgcn_global_load_lds((const unsigned*)(stats + (size_t)(u.pm * 256 + (lane >> 5) * 128 + wr * 64 + (lane & 31) * 2) * 2), (LAS unsigned*)(lds + 131072 + wid * 1024), 16, 0, 0);
    if (wid < 2) __builtin_amdgcn_global_load_lds((const unsigned*)((wid ? c2 : c1) + u.pn * 256 + lane * 4), (LAS unsigned*)(lds + 139264 + (ui & 1) * 2048 + wid * 1024), 16, 0, 0);
  }
  DI void operator()(const f32x4 (&acc)[2][2][4][2], const pg8::Unit& u, int wr, int wc, int fr, int fq, LAS unsigned char* lds, int ui, int wid) const {
    const int colg = u.pn * 256 + wc * 32 + 8 * fq, hcol = u.pn * 128 + wc * 32 + 8 * fq;
    f32x4 c1g[2], c2g[2], c1u[2], c2u[2];
    int fq_ = fq, fr_ = fr; asm volatile("" : "+v"(fq_), "+v"(fr_));
    const LAS float* cl = (const LAS float*)(lds + 139264 + (ui & 1) * 2048) + wc * 32 + 8 * fq_;
#pragma unroll
    for (int n = 0; n < 2; ++n) { c1g[n] = *(const LAS f32x4*)(cl + 4 * n); c2g[n] = *(const LAS f32x4*)(cl + 256 + 4 * n); c1u[n] = *(const LAS f32x4*)(cl + 128 + 4 * n); c2u[n] = *(const LAS f32x4*)(cl + 256 + 128 + 4 * n); }
    float ra[8], rb[8];
    const LAS float* sl = (const LAS float*)(lds + 131072 + wid * 1024);
#pragma unroll
    for (int i = 0; i < 8; ++i) { typedef float f32x2_ __attribute__((ext_vector_type(2))); const f32x2_ sv = *(const LAS f32x2_*)(sl + (i >> 2) * 128 + ((i & 3) * 16 + fr_) * 2);
      const float mu = sv.x * (1.0f / 1024.0f), var = fmaxf(sv.y * (1.0f / 1024.0f) - mu * mu, 0.f), rstd = rsqrtf(var + 1e-5f); ra[i] = rstd; rb[i] = -rstd * mu; }
#pragma unroll
    for (int ai = 0; ai < 2; ++ai)
#pragma unroll
      for (int m = 0; m < 4; ++m) {
        const int row = u.pm * 256 + ai * 128 + wr * 64 + m * 16 + fr; const float a = ra[ai * 4 + m], bb = rb[ai * 4 + m];
        u32x4 w;
#pragma unroll
        for (int n = 0; n < 2; ++n) {
          const f32x4 gv = acc[ai][0][m][n] * a + c1g[n] * bb + c2g[n], uv = acc[ai][1][m][n] * a + c1u[n] * bb + c2u[n];
          float h[4];
#pragma unroll
          for (int j = 0; j < 4; ++j) h[j] = gv[j] * sigmoidf_(gv[j]) * uv[j];
          w[2 * n] = pkh2(h[0], h[1]); w[2 * n + 1] = pkh2(h[2], h[3]);
        }
        *(u32x4*)(H + (size_t)row * DFF + hcol) = w;
        asm volatile("" ::: "memory");
      }
  }
};
struct EpiRes {
  const float* stats_prev; const float* g; const float* b; float* stats_new; bf16_t* tb; float scale; int reps;
  DI void pre(LAS unsigned char* lds, const pg8::Unit& u, int ui, int wid, int lane, int wr) const {
    asm volatile("" : "+v"(lane));
    __builtin_amdgcn_global_load_lds((const unsigned*)(stats_prev + (size_t)(u.pm * 256 + (lane >> 5) * 128 + wr * 64 + (lane & 31) * 2) * 2), (LAS unsigned*)(lds + 131072 + wid * 1024), 16, 0, 0);
    if (wid < 2) __builtin_amdgcn_global_load_lds((const unsigned*)((wid ? b : g) + u.pn * 256 + lane * 4), (LAS unsigned*)(lds + 139264 + (ui & 1) * 3072 + wid * 1024), 16, 0, 0);
  }
  DI void operator()(const f32x4 (&acc)[2][2][4][2], const pg8::Unit& u, int wr, int wc, int fr, int fq, LAS unsigned char* lds, int ui, int wid) const {
    const int col0 = u.pn * 256 + wc * 32 + 8 * fq;
    int fq_ = fq, fr_ = fr; asm volatile("" : "+v"(fq_), "+v"(fr_));
    const LAS float* gl = (const LAS float*)(lds + 139264 + (ui & 1) * 3072) + wc * 32 + 8 * fq_;
    const LAS float* sl = (const LAS float*)(lds + 131072 + wid * 1024);
    float rmu[8], rrs[8];
#pragma unroll
    for (int i = 0; i < 8; ++i) { typedef float f32x2_ __attribute__((ext_vector_type(2))); const f32x2_ sv = *(const LAS f32x2_*)(sl + (i >> 2) * 128 + ((i & 3) * 16 + fr_) * 2);
      const float mu = sv.x * (1.0f / 1024.0f), var = fmaxf(sv.y * (1.0f / 1024.0f) - mu * mu, 0.f); rmu[i] = mu; rrs[i] = rsqrtf(var + 1e-5f); }
#pragma unroll
    for (int ai = 0; ai < 2; ++ai) {
      half8 tpv[4][2];
#pragma unroll
      for (int m = 0; m < 4; ++m)
#pragma unroll
        for (int bj = 0; bj < 2; ++bj) tpv[m][bj] = *(const half8*)(tb + (size_t)(u.pm * 256 + ai * 128 + wr * 64 + m * 16 + fr) * DM + col0 + bj * 128);
#pragma unroll
      for (int m = 0; m < 4; ++m) {
        const int row = u.pm * 256 + ai * 128 + wr * 64 + m * 16 + fr; const float mu = rmu[ai * 4 + m], rstd = rrs[ai * 4 + m];
        float rs = 0.f, rq = 0.f;
#pragma unroll
        for (int bj = 0; bj < 2; ++bj) {
          u32x4 w;
#pragma unroll
          for (int n = 0; n < 2; ++n) {
            f32x4 tp;
#pragma unroll
            for (int j = 0; j < 4; ++j) tp[j] = (float)tpv[m][bj][4 * n + j];
            tp = (tp - mu) * rstd * (*(const LAS f32x4*)(gl + bj * 128 + 4 * n)) + *(const LAS f32x4*)(gl + 256 + bj * 128 + 4 * n);
            const f32x4 tn = tp * ALPHA + acc[ai][bj][m][n] * scale;
            w[2 * n] = pkh2(tn[0], tn[1]); w[2 * n + 1] = pkh2(tn[2], tn[3]);
            rs += tn[0] + tn[1] + tn[2] + tn[3]; rq += tn[0] * tn[0] + tn[1] * tn[1] + tn[2] * tn[2] + tn[3] * tn[3];
          }
          *(u32x4*)(tb + (size_t)row * DM + col0 + bj * 128) = w;
        }
        rs += __shfl_xor(rs, 16); rs += __shfl_xor(rs, 32); rq += __shfl_xor(rq, 16); rq += __shfl_xor(rq, 32);
        if (fq == 0) { atomicAdd(stats_new + 2 * row, rs); atomicAdd(stats_new + 2 * row + 1, rq); }
      }
      asm volatile("" ::: "memory");
    }
  }
};
struct EpiIn {
  int mode; bf16_t* h; int ld; const float* stats; const float* c1; const float* c2; const float* lbv;
  bf16_t *hq, *hk, *hv, *hg; _Float16* hlf; int reps;
  DI void pre(LAS unsigned char* lds, const pg8::Unit& u, int ui, int wid, int lane, int wr) const {
    asm volatile("" : "+v"(lane));
    __builtin_amdgcn_global_load_lds((const unsigned*)(stats + (size_t)(u.pm * 256 + (lane >> 5) * 128 + wr * 64 + (lane & 31) * 2) * 2), (LAS unsigned*)(lds + 131072 + wid * 1024), 16, 0, 0);
    if (wid < 3) __builtin_amdgcn_global_load_lds((const unsigned*)((wid == 0 ? c1 + u.pn * 256 : (wid == 1 ? c2 + u.pn * 256 : lbv + ((u.pn * 256) & 1023))) + lane * 4), (LAS unsigned*)(lds + 139264 + (ui & 1) * 3072 + wid * 1024), 16, 0, 0);
  }
  template <int SECT>
  DI void body(const f32x4 (&acc)[2][2][4][2], const pg8::Unit& u, int wr, int wc, int fr, int fq, LAS unsigned char* lds, int ui, int wid) const {
    const int col0 = u.pn * 256 + wc * 32 + 8 * fq;
    int fq_ = fq, fr_ = fr; asm volatile("" : "+v"(fq_), "+v"(fr_));
    const LAS float* cl = (const LAS float*)(lds + 139264 + (ui & 1) * 3072) + wc * 32 + 8 * fq_;
    const LAS float* sl = (const LAS float*)(lds + 131072 + wid * 1024);
#pragma unroll
    for (int ai = 0; ai < 2; ++ai)
#pragma unroll
      for (int m = 0; m < 4; ++m) {
        const int row = u.pm * 256 + ai * 128 + wr * 64 + m * 16 + fr; float a, bb;
        { typedef float f32x2_ __attribute__((ext_vector_type(2))); const f32x2_ sv = *(const LAS f32x2_*)(sl + ai * 128 + (m * 16 + fr_) * 2);
          const float mu = sv.x * (1.0f / 1024.0f), var = fmaxf(sv.y * (1.0f / 1024.0f) - mu * mu, 0.f), rstd = rsqrtf(var + 1e-5f); a = rstd; bb = -rstd * mu; }
#pragma unroll
        for (int bj = 0; bj < 2; ++bj) {
          const int col = col0 + bj * 128;
          f32x4 v[2];
#pragma unroll
          for (int n = 0; n < 2; ++n) v[n] = acc[ai][bj][m][n] * a + (*(const LAS f32x4*)(cl + bj * 128 + 4 * n)) * bb + *(const LAS f32x4*)(cl + 256 + bj * 128 + 4 * n);
          if (SECT < 0) { u32x4 w; w[0] = pk2(v[0][0], v[0][1]); w[1] = pk2(v[0][2], v[0][3]); w[2] = pk2(v[1][0], v[1][1]); w[3] = pk2(v[1][2], v[1][3]); *(u32x4*)(h + (size_t)row * ld + col) = w; }
          else {
            const int cc = col & 1023; const size_t off = (size_t)row * 1024 + cc;
            if (SECT == 0 || SECT == 3) { u32x4 w;
#pragma unroll
              for (int n = 0; n < 2; ++n) { w[2 * n] = pk2(v[n][0] * sigmoidf_(v[n][0]), v[n][1] * sigmoidf_(v[n][1])); w[2 * n + 1] = pk2(v[n][2] * sigmoidf_(v[n][2]), v[n][3] * sigmoidf_(v[n][3])); }
              *(u32x4*)((SECT == 0 ? hq : hg) + off) = w; }
            else if (SECT == 1) {
              typedef _Float16 h8 __attribute__((ext_vector_type(8))); h8 lf; u32x4 w;
#pragma unroll
              for (int n = 0; n < 2; ++n) { const f32x4 lb = *(const LAS f32x4*)(cl + 512 + bj * 128 + 4 * n); float kk[4];
#pragma unroll
                for (int j = 0; j < 4; ++j) { kk[j] = (1.0f - lb[j]) * __builtin_amdgcn_rcpf(1.0f + __builtin_amdgcn_exp2f(1.4426950408889634f * v[n][j])); lf[4 * n + j] = (_Float16)fmaxf(__builtin_amdgcn_logf(1.0f - kk[j]), -87.0f); }
                w[2 * n] = pk2(kk[0], kk[1]); w[2 * n + 1] = pk2(kk[2], kk[3]); }
              *(u32x4*)(hk + off) = w; *(h8*)(hlf + off) = lf;
            }
            else { u32x4 w; w[0] = pk2(v[0][0], v[0][1]); w[1] = pk2(v[0][2], v[0][3]); w[2] = pk2(v[1][0], v[1][1]); w[3] = pk2(v[1][2], v[1][3]); *(u32x4*)(hv + off) = w; }
          }
        }
        asm volatile("" ::: "memory");
      }
  }
  DI void operator()(const f32x4 (&acc)[2][2][4][2], const pg8::Unit& u, int wr, int wc, int fr, int fq, LAS unsigned char* lds, int ui, int wid) const {
    if (mode == 0) body<-1>(acc, u, wr, wc, fr, fq, lds, ui, wid);
    else { const int sect = u.pn >> 2;
      if (sect == 0) body<0>(acc, u, wr, wc, fr, fq, lds, ui, wid); else if (sect == 1) body<1>(acc, u, wr, wc, fr, fq, lds, ui, wid); else if (sect == 2) body<2>(acc, u, wr, wc, fr, fq, lds, ui, wid); else body<3>(acc, u, wr, wc, fr, fq, lds, ui, wid); }
  }
};

DI void conv_strip(int wv, LAS unsigned char* lds, const float* src, int ldn, int K, int n0, int nvalid, bf16_t* dst, int dstrow0, const float* g, const float* b, float* c1, float* c2, bool perm = true, int kbeg = 0, int kend = -1) {
  if (kend < 0) kend = K;
  LAS bf16_t* tile = (LAS bf16_t*)lds;
  LAS float* red = (LAS float*)(lds + 64 * 72 * 2);
  int tid_ = wv * 64 + lane_id_(); asm volatile("" : "+v"(tid_)); const int tid = tid_, kr = tid >> 4, nc = (tid & 15) * 4;
  const bool colok = (n0 + nc) < nvalid;
  float s1[4] = {0.f, 0.f, 0.f, 0.f}, s2[4] = {0.f, 0.f, 0.f, 0.f};
  f32x4 w[2];
#pragma unroll
  for (int rr = 0; rr < 2; ++rr) w[rr] = colok ? *(const f32x4*)(src + (size_t)(kbeg + kr + rr * 32) * ldn + n0 + nc) : (f32x4){0.f, 0.f, 0.f, 0.f};
  for (int k0 = kbeg; k0 < kend; k0 += 64) {
    lds_barrier();
#pragma unroll
    for (int rr = 0; rr < 2; ++rr) { const int k = k0 + kr + rr * 32; const float gk = g ? g[k] : 1.0f, bk = b ? b[k] : 0.0f;
#pragma unroll
      for (int j = 0; j < 4; ++j) { const bf16_t v = perm ? f2h(w[rr][j] * gk) : f2bf(w[rr][j] * gk); tile[(nc + j) * 72 + kr + rr * 32] = v; s1[j] += perm ? h2f(v) : bf2f(v); s2[j] += bk * w[rr][j]; } }
    if (k0 + 64 < kend) {
#pragma unroll
      for (int rr = 0; rr < 2; ++rr) w[rr] = colok ? *(const f32x4*)(src + (size_t)(k0 + 64 + kr + rr * 32) * ldn + n0 + nc) : (f32x4){0.f, 0.f, 0.f, 0.f};
    }
    lds_barrier();
    { const int n = tid >> 3, kc = (tid & 7) * 8; const int cc = n & 31, slot = (n & 32) + (perm ? 16 * ((cc >> 2) & 1) + 4 * (cc >> 3) + (cc & 3) : cc);
      *(u32x4*)(dst + (size_t)(dstrow0 + slot) * K + k0 + kc) = *(const LAS u32x4*)(tile + n * 72 + kc); }
  }
  if (c1) {
    __syncthreads();
#pragma unroll
    for (int j = 0; j < 4; ++j) { red[kr * 64 + nc + j] = s1[j]; red[2048 + kr * 64 + nc + j] = s2[j]; }
    __syncthreads();
    if (tid < 128) { const int n = tid & 63, which = tid >> 6; float s = 0.f; for (int i = 0; i < 32; ++i) s += red[which * 2048 + i * 64 + n]; (which ? c2 : c1)[dstrow0 + n] = s; }
  }
  __syncthreads();
}

DI void convert_phase(int wv, const P& p_, int L, LAS unsigned char* lds) {
  P p = p_; { size_t z_ = 0; asm volatile("" : "+s"(z_)); p.ws = p_.ws + z_; }
  const int kind = L % 3, slot = L / 3;
  const int nin = kind == 0 ? 44 : (kind == 1 ? 64 : 20);
  const int njobs = 272 + nin + 16 + (kind == 0 ? 6 : 0);
  unsigned char* ws = p.ws;
  for (int j = blockIdx.x; j < njobs; j += gridDim.x) {
    if (j < 272) {
      const int f = j / 136, jj = j % 136;
      const float* lg = p.ln_gain + (size_t)(L * 3 + (f == 0 ? -1 : 1)) * DM; const float* lbias = p.ln_bias + (size_t)(L * 3 + (f == 0 ? -1 : 1)) * DM;
      const bool fold = !(L == 0 && f == 0);
      float* cbase = (float*)(ws + (f == 0 ? C_GU1 : C_GU2));
      if (jj < 88) {
        const int up = jj / 44, s = jj % 44, n0 = s * 64;
        const float* src = (f == 0 ? (up ? p.f1u : p.f1g) : (up ? p.f2u : p.f2g)) + (size_t)L * DM * DFF;
        conv_strip(wv, lds, src, DFF, DM, n0, DFF, (bf16_t*)(ws + (f == 0 ? W_GU1 : W_GU2)), (n0 >> 7) * 256 + (n0 & 127) + up * 128, fold ? lg : nullptr, fold ? lbias : nullptr, cbase, cbase + 5632);
      } else {
        const int s = (jj - 88) / 3, kc = (jj - 88) % 3;
        const float* src = (f == 0 ? p.f1d : p.f2d) + (size_t)L * DFF * DM;
        conv_strip(wv, lds, src, DM, DFF, s * 64, DM, (bf16_t*)(ws + (f == 0 ? W_D1 : W_D2)), s * 64, nullptr, nullptr, nullptr, nullptr, true, kc * 960, kc == 2 ? DFF : kc * 960 + 960);
      }
    } else if (j < 272 + nin) {
      const int s = j - 272; const float* lg = p.ln_gain + (size_t)(L * 3) * DM; const float* lbias = p.ln_bias + (size_t)(L * 3) * DM;
      const float* src = kind == 0 ? p.nsa_win + (size_t)slot * DM * 2608 : (kind == 1 ? p.hg_win + (size_t)slot * DM * 4096 : p.swa_win + (size_t)slot * DM * 1280);
      const int ldn = kind == 0 ? 2608 : (kind == 1 ? 4096 : 1280);
      float* cbase = (float*)(ws + C_IN);
      conv_strip(wv, lds, src, ldn, DM, s * 64, ldn, (bf16_t*)(ws + W_IN), s * 64, lg, lbias, cbase, cbase + 4096);
    } else if (j < 272 + nin + 16) {
      const int s = j - 272 - nin;
      const float* src = kind == 0 ? p.nsa_wout + (size_t)slot * DM * DM : (kind == 1 ? p.hg_wout + (size_t)slot * DM * DM : p.swa_wout + (size_t)slot * DM * DM);
      conv_strip(wv, lds, src, DM, DM, s * 64, DM, (bf16_t*)(ws + W_OUT), s * 64, nullptr, nullptr, nullptr, nullptr);
    } else {
      const int s = j - 272 - nin - 16;
      if (s < 4) { const int kv = s >> 1, st = s & 1; float* pb = (float*)(ws + C_POSB) + kv * 256;
        conv_strip(wv, lds, p.nsa_w1 + ((size_t)slot * 2 + kv) * 2048 * 128, 128, 2048, st * 64, 128, (bf16_t*)(ws + W_W1T) + (size_t)kv * 128 * 2048, st * 64, nullptr, p.nsa_pos + ((size_t)slot * 2 + kv) * 2048, pb + 128, pb, false); }
      else { const int kv = s - 4; conv_strip(wv, lds, p.nsa_w2 + ((size_t)slot * 2 + kv) * 128 * 64, 64, 128, 0, 64, (bf16_t*)(ws + W_W2T) + (size_t)kv * 64 * 128, 0, nullptr, nullptr, nullptr, nullptr, false); }
    }
  }
}

DI void init_phase(int wv, const P& p_) {
  P p = p_; { size_t z_ = 0; asm volatile("" : "+s"(z_)); p.ws = p_.ws + z_; }
  int tid_ = wv * 64 + lane_id_(); asm volatile("" : "+v"(tid_)); const size_t gtid = (size_t)blockIdx.x * 512 + tid_, gsz = (size_t)gridDim.x * 512;
  for (size_t i = gtid; i < (4 * MiB) / 16; i += gsz) ((f32x4*)(p.ws + WS_STATS))[i] = (f32x4){0.f, 0.f, 0.f, 0.f};
  for (size_t i = gtid; i < (size_t)MTOK; i += gsz) { ((float*)(p.ws + WS_DSTATS))[2 * i] = 0.f; ((float*)(p.ws + WS_DSTATS))[2 * i + 1] = 1024.0f * (1.0f - 1e-5f); }
  if (gtid < 13 * 1024) { ((float*)(p.ws + WS_G13))[gtid] = gtid < 1024 ? 1.0f : p.ln_gain[gtid - 1024]; ((float*)(p.ws + WS_B13))[gtid] = gtid < 1024 ? 0.0f : p.ln_bias[gtid - 1024]; }
  for (size_t i = gtid; i < (size_t)MTOK * DM / 4; i += gsz) { const f32x4 v = ((const f32x4*)p.x)[i]; u32x2 w; w.x = pkh2(v[0], v[1]); w.y = pkh2(v[2], v[3]); ((u32x2*)(p.ws + WS_TB))[i] = w; }
  if (gtid < 16 * 132) { const int hd = (int)gtid / 132, d = (int)gtid % 132; int bk;
    if (d < 16) bk = d; else { const float v = logf((float)d / 16.0f) / 2.0794415416798357f * 16.0f; bk = 16 + (int)v; if (bk > 31 || d >= 128) bk = 31; }
    ((float*)(p.ws + C_BTAB))[gtid] = p.rel_bias[bk * 16 + hd]; }
  if (gtid < 1024) { const float a0 = p.hg_lb[gtid], a1 = p.hg_lb[1024 + gtid], a2 = p.hg_lb[2048 + gtid], a3 = p.hg_lb[3072 + gtid];
    const float mx = fmaxf(fmaxf(a0, a1), fmaxf(a2, a3)); const float e0 = expf(a0 - mx), e1 = expf(a1 - mx), e2 = expf(a2 - mx), e3 = expf(a3 - mx);
    ((float*)(p.ws + C_LBV))[gtid] = e1 / (e0 + e1 + e2 + e3); }
}

DI void final_ln(int wv, const P& p_, const float* stats, const float* g, const float* b) {
  P p = p_; { size_t z_ = 0; asm volatile("" : "+s"(z_)); p.ws = p_.ws + z_; }
  int tid_ = wv * 64 + lane_id_(); asm volatile("" : "+v"(tid_)); const size_t gtid = (size_t)blockIdx.x * 512 + tid_, gsz = (size_t)gridDim.x * 512;
  for (size_t i = gtid; i < (size_t)MTOK * DM / 4; i += gsz) {
    const int row = (int)(i >> 8), c = (int)(i & 255) * 4; float a, bb, mu, rstd; row_affine(stats, row, a, bb, mu, rstd);
    const u32x2 hv = ((const u32x2*)(p.ws + WS_TB))[i]; typedef _Float16 h4 __attribute__((ext_vector_type(4))); const h4 hh = __builtin_bit_cast(h4, hv);
    const f32x4 v = {(float)hh[0], (float)hh[1], (float)hh[2], (float)hh[3]}; ((f32x4*)p.out)[i] = (v - mu) * rstd * (*(const f32x4*)(g + c)) + *(const f32x4*)(b + c);
  }
}
#define MFMA32(a, b, c) __builtin_amdgcn_mfma_f32_32x32x16_bf16((a), (b), (c), 0, 0, 0)
#define MFMA16(a, b, c) __builtin_amdgcn_mfma_f32_16x16x32_bf16((a), (b), (c), 0, 0, 0)
DI int crow(int reg, int h) { return (reg & 3) + 8 * (reg >> 2) + 4 * h; }
constexpr int KS_STRIDE = 72;

struct KVRegs { u32x4 k; bf16x8 v; };
DI void kv_load(KVRegs& r, const bf16_t* kg, const bf16_t* vg, size_t ldg, int tid) {
  asm volatile("" : "+v"(tid));
  const int key = tid >> 3, d8 = (tid & 7) * 8;
  r.k = *(const u32x4*)(kg + (size_t)key * ldg + d8); r.v = *(const bf16x8*)(vg + (size_t)key * ldg + d8);
}
DI void kv_store(const KVRegs& r, LAS bf16_t* Ks, LAS bf16_t* Vt, int vstride, int vcol0, int tid) {
  asm volatile("" : "+v"(tid));
  const int key = tid >> 3, d8 = (tid & 7) * 8;
  *(LAS u32x4*)(Ks + key * KS_STRIDE + d8) = r.k;
  const u32x4 vd = __builtin_bit_cast(u32x4, r.v);
  const bool odd = key & 1;
  const unsigned s0 = odd ? vd[0] : vd[2], s1 = odd ? vd[1] : vd[3];
  const unsigned x0 = (unsigned)__builtin_amdgcn_update_dpp(0, (int)s0, 0x128, 0xf, 0xf, false), x1 = (unsigned)__builtin_amdgcn_update_dpp(0, (int)s1, 0x128, 0xf, 0xf, false);
  const unsigned m0 = odd ? vd[2] : vd[0], m1 = odd ? vd[3] : vd[1];
  const unsigned lo0 = odd ? x0 : m0, hi0 = odd ? m0 : x0, lo1 = odd ? x1 : m1, hi1 = odd ? m1 : x1;
  LAS unsigned* vp = (LAS unsigned*)(Vt + (d8 + (odd ? 4 : 0)) * vstride + vcol0 + (key & ~1));
  const int rs = vstride >> 1;
  vp[0] = (lo0 & 0xffffu) | (hi0 << 16); vp[rs] = (lo0 >> 16) | (hi0 & 0xffff0000u);
  vp[2 * rs] = (lo1 & 0xffffu) | (hi1 << 16); vp[3 * rs] = (lo1 >> 16) | (hi1 & 0xffff0000u);
}
DI void attn_scores(const LAS bf16_t* Ks, const bf16x8 (&qf)[4], int r, int h, f32x16 (&s)[2]) {
#pragma unroll
  for (int sub = 0; sub < 2; ++sub) {
    f32x16 a;
#pragma unroll
    for (int i = 0; i < 16; ++i) a[i] = 0.f;
#pragma unroll
    for (int ks = 0; ks < 4; ++ks) { const bf16x8 kf = *(const LAS bf16x8*)(Ks + (sub * 32 + r) * KS_STRIDE + ks * 16 + 8 * h); a = MFMA32(kf, qf[ks], a); }
    s[sub] = a;
  }
}
constexpr float QK_SCALE2 = 0.125f * 1.4426950408889634f;
DI void attn_logits(f32x16 (&s)[2], int t, int tw, int nt, int h, int base, int stride, int dmax, bool ok, const LAS float* btl) {
  const int dmin = tw - (base + 63 * stride), dmaxw = tw + nt - 1 - base;
  const bool far = dmin >= 128, interior = dmin >= 0 && dmaxw < dmax;
  const float bfar = btl[128];
  if (far && interior) {
#pragma unroll
    for (int sub = 0; sub < 2; ++sub)
#pragma unroll
      for (int reg = 0; reg < 16; ++reg) s[sub][reg] = ok ? s[sub][reg] * QK_SCALE2 + bfar : -1e30f;
  } else if (far) {
#pragma unroll
    for (int sub = 0; sub < 2; ++sub)
#pragma unroll
      for (int reg = 0; reg < 16; ++reg) {
        const int kk = sub * 32 + crow(reg, h); const int d = t - (base + kk * stride);
        const bool valid = (d >= 0) && (d < dmax) && ok;
        s[sub][reg] = valid ? s[sub][reg] * QK_SCALE2 + bfar : -1e30f;
      }
  } else {
#pragma unroll
    for (int sub = 0; sub < 2; ++sub)
#pragma unroll
      for (int reg = 0; reg < 16; ++reg) {
        const int kk = sub * 32 + crow(reg, h); const int d = t - (base + kk * stride);
        const bool valid = (d >= 0) && (d < dmax) && ok;
        const int di = d < 0 ? 0 : (d > 128 ? 128 : d);
        const float bsv = btl[di];
        const float x = s[sub][reg] * QK_SCALE2 + bsv;
        s[sub][reg] = valid ? x : -1e30f;
      }
  }
}
DI void attn_pv(const LAS bf16_t* Vt, int vstride, const f32x16 (&p)[2], f32x16 (&O)[2], int r, int h) {
#pragma unroll
  for (int sub = 0; sub < 2; ++sub)
#pragma unroll
    for (int s2 = 0; s2 < 2; ++s2) {
      u32x4 pp;
#pragma unroll
      for (int j = 0; j < 4; ++j) pp[j] = pk2(p[sub][8 * s2 + 2 * j], p[sub][8 * s2 + 2 * j + 1]);
      const bf16x8 pf = __builtin_bit_cast(bf16x8, pp);
#pragma unroll
      for (int dt = 0; dt < 2; ++dt) {
        const LAS bf16_t* vp = Vt + (dt * 32 + r) * vstride + sub * 32 + 16 * s2 + 4 * h;
        const s16x4 lo = *(const LAS s16x4*)vp, hi = *(const LAS s16x4*)(vp + 8);
        const bf16x8 vf = __builtin_shufflevector(lo, hi, 0, 1, 2, 3, 4, 5, 6, 7);
        O[dt] = MFMA32(vf, pf, O[dt]);
      }
    }
}
template <bool WITH_O>
DI void attn_online(f32x16 (&s)[2], float& m, float& l, f32x16 (&O)[2]) {
  float mx = -1e30f;
#pragma unroll
  for (int sub = 0; sub < 2; ++sub)
#pragma unroll
    for (int reg = 0; reg < 16; ++reg) mx = fmaxf(mx, s[sub][reg]);
  mx = fmaxf(mx, __shfl_xor(mx, 32));
  const float mn = fmaxf(m, mx);
  const bool grow = mn > m;
  float ls = 0.f;
#pragma unroll
  for (int sub = 0; sub < 2; ++sub)
#pragma unroll
    for (int reg = 0; reg < 16; ++reg) { const float e = __builtin_amdgcn_exp2f(s[sub][reg] - mn); s[sub][reg] = e; ls += e; }
  if (__any(grow)) {
    const float al = __builtin_amdgcn_exp2f(m - mn); m = mn;
    l = l * al + ls;
    if (WITH_O) {
#pragma unroll
      for (int dt = 0; dt < 2; ++dt)
#pragma unroll
        for (int reg = 0; reg < 16; ++reg) O[dt][reg] *= al;
    }
  } else l += ls;
}
DI void attn_tile(const LAS bf16_t* Ks, const LAS bf16_t* Vt, int vstride, const bf16x8 (&qf)[4], f32x16 (&O)[2], float& m, float& l,
                  int t, int tw, int nt, int r, int h, int base, int stride, int dmax, bool ok, const LAS float* btl) {
  f32x16 s[2];
  attn_scores(Ks, qf, r, h, s);
  const int dmin = tw - (base + 63 * stride), dmaxw = tw + nt - 1 - base;
  float mn, ls = 0.f;
  if (dmin >= 128 && dmaxw < dmax) {
    const float cl = ok ? QK_SCALE2 : 0.f, bl = ok ? btl[128] : -1e30f;
    float mr = -3e38f;
#pragma unroll
    for (int sub = 0; sub < 2; ++sub)
#pragma unroll
      for (int reg = 0; reg < 16; ++reg) mr = fmaxf(mr, s[sub][reg]);
    float mx = mr * cl + bl; mx = fmaxf(mx, __shfl_xor(mx, 32));
    mn = fmaxf(m, mx);
    const float off = bl - mn;
#pragma unroll
    for (int sub = 0; sub < 2; ++sub)
#pragma unroll
      for (int reg = 0; reg < 16; ++reg) { const float e = __builtin_amdgcn_exp2f(s[sub][reg] * cl + off); s[sub][reg] = e; ls += e; }
  } else {
    attn_logits(s, t, tw, nt, h, base, stride, dmax, ok, btl);
    float mx = -1e30f;
#pragma unroll
    for (int sub = 0; sub < 2; ++sub)
#pragma unroll
      for (int reg = 0; reg < 16; ++reg) mx = fmaxf(mx, s[sub][reg]);
    mx = fmaxf(mx, __shfl_xor(mx, 32));
    mn = fmaxf(m, mx);
#pragma unroll
    for (int sub = 0; sub < 2; ++sub)
#pragma unroll
      for (int reg = 0; reg < 16; ++reg) { const float e = __builtin_amdgcn_exp2f(s[sub][reg] - mn); s[sub][reg] = e; ls += e; }
  }
  if (__any(mn > m)) {
    const float al = __builtin_amdgcn_exp2f(m - mn); m = mn;
    l = l * al + ls;
#pragma unroll
    for (int dt = 0; dt < 2; ++dt)
#pragma unroll
      for (int reg = 0; reg < 16; ++reg) O[dt][reg] *= al;
  } else l += ls;
  attn_pv(Vt, vstride, s, O, r, h);
}
DI void zero_o(f32x16 (&O)[2]) {
#pragma unroll
  for (int dt = 0; dt < 2; ++dt)
#pragma unroll
    for (int reg = 0; reg < 16; ++reg) O[dt][reg] = 0.f;
}

DI void nsa_compress_phase(int wv, const P& p_, LAS unsigned char* lds) {
  P p = p_; { size_t z_ = 0; asm volatile("" : "+s"(z_)); p.ws = p_.ws + z_; }
  const bf16_t* hb = (const bf16_t*)(p.ws + WS_BIG); const int ld = 2816;
  int tid_ = wv * 64 + lane_id_(); asm volatile("" : "+v"(tid_)); const int tid = tid_, wid = wv, lane = tid & 63, fr = lane & 15, fq = lane >> 4;
  const int pw = wid & 3, half = wid >> 2;
  LAS bf16_t* hid = (LAS bf16_t*)lds + pw * 16 * 136;
  LAS f32x4* part = (LAS f32x4*)(lds + 32768) + pw * 8 * 64;
  for (int base = blockIdx.x * 4; base < 1024; base += gridDim.x * 4) {
    const int task = base + pw;
    const int kv = task >> 9, b = (task >> 6) & 7, g = (task >> 4) & 3, n0 = (task & 15) * 16;
    const bf16_t* w1t = (const bf16_t*)(p.ws + W_W1T) + (size_t)kv * 128 * 2048; const bf16_t* w2t = (const bf16_t*)(p.ws + W_W2T) + (size_t)kv * 64 * 128;
    const float* posb = (const float*)(p.ws + C_POSB) + kv * 256;
    const int colb = 1024 + kv * 256 + g * 64;
    int n = n0 + fr; if (n > 254) n = 254;
    f32x4 acc[8];
#pragma unroll
    for (int i = 0; i < 8; ++i) acc[i] = (f32x4){0.f, 0.f, 0.f, 0.f};
    { LAS bf16_t* WB = (LAS bf16_t*)(lds + 65536);
      const int er = tid >> 2, kc0 = (tid & 3) * 16;
      const bf16_t* wsrc = w1t + (size_t)er * 2048 + kc0;
      const bf16_t* asrc = hb + (size_t)(b * SEQ + 16 * n + 16 * half) * ld + colb + fq * 8;
      u32x4 wr4[2][2]; bf16x8 afc[2], afn[2];
#pragma unroll
      for (int sl = 0; sl < 2; ++sl)
#pragma unroll
        for (int c = 0; c < 2; ++c) wr4[sl][c] = *(const u32x4*)(wsrc + (size_t)(16 * sl) * 64 + c * 8);
#pragma unroll
      for (int dk = 0; dk < 2; ++dk) afc[dk] = *(const bf16x8*)(asrc + dk * 32);
#pragma unroll 1
      for (int st = 0; st < 16; ++st) {
        LAS bf16_t* wb = WB + (st & 1) * (2 * 128 * 72);
#pragma unroll
        for (int sl = 0; sl < 2; ++sl)
#pragma unroll
          for (int c = 0; c < 2; ++c) *(LAS u32x4*)(wb + (sl * 128 + er) * 72 + kc0 + c * 8) = wr4[sl][c];
        lds_barrier();
        if (st + 1 < 16) {
#pragma unroll
          for (int sl = 0; sl < 2; ++sl)
#pragma unroll
            for (int c = 0; c < 2; ++c) wr4[sl][c] = *(const u32x4*)(wsrc + (size_t)(st + 1 + 16 * sl) * 64 + c * 8);
#pragma unroll
          for (int dk = 0; dk < 2; ++dk) afn[dk] = *(const bf16x8*)(asrc + (size_t)(st + 1) * ld + dk * 32);
        }
#pragma unroll
        for (int dk = 0; dk < 2; ++dk) {
#pragma unroll
          for (int nt = 0; nt < 8; ++nt) { const bf16x8 bfr = *(const LAS bf16x8*)(wb + (half * 128 + nt * 16 + fr) * 72 + dk * 32 + fq * 8); acc[nt] = MFMA16(afc[dk], bfr, acc[nt]); }
        }
        afc[0] = afn[0]; afc[1] = afn[1];
      }
    }
    if (half) {
#pragma unroll
      for (int nt = 0; nt < 8; ++nt) part[nt * 64 + lane] = acc[nt];
    }
    __syncthreads();
    if (!half) {
#pragma unroll
      for (int nt = 0; nt < 8; ++nt) { const float pbv = posb[nt * 16 + fr]; const f32x4 o2 = part[nt * 64 + lane];
#pragma unroll
        for (int j = 0; j < 4; ++j) { const float v = acc[nt][j] + o2[j] + pbv; const float u = 0.7978845608028654f * (v + 0.044715f * v * v * v); const float th = 1.0f - 2.0f * __builtin_amdgcn_rcpf(1.0f + __expf(2.0f * u));
          hid[(4 * fq + j) * 136 + nt * 16 + fr] = f2bf(0.5f * v * (1.0f + th)); } }
    }
    __syncthreads();
    if (!half) {
      f32x4 o[4];
#pragma unroll
      for (int i = 0; i < 4; ++i) o[i] = (f32x4){0.f, 0.f, 0.f, 0.f};
#pragma unroll
      for (int ks = 0; ks < 4; ++ks) { const bf16x8 af = *(const LAS bf16x8*)(hid + fr * 136 + ks * 32 + fq * 8);
#pragma unroll
        for (int nt = 0; nt < 4; ++nt) { const bf16x8 bfr = *(const bf16x8*)(w2t + (size_t)(nt * 16 + fr) * 128 + ks * 32 + fq * 8); o[nt] = MFMA16(af, bfr, o[nt]); } }
      bf16_t* dst = (bf16_t*)(p.ws + (kv ? WS_VC : WS_KC)) + (size_t)((b * 4 + g) * 256) * 64;
#pragma unroll
      for (int nt = 0; nt < 4; ++nt)
#pragma unroll
        for (int j = 0; j < 4; ++j) { const int nn = n0 + 4 * fq + j; dst[(size_t)nn * 64 + nt * 16 + fr] = nn > 254 ? (bf16_t)0 : f2bf(o[nt][j]); }
    }
    __syncthreads();
  }
}

DI void nsa_attn_phase(int wv, const P& p_, LAS unsigned char* lds) {
  P p = p_; { size_t z_ = 0; asm volatile("" : "+s"(z_)); p.ws = p_.ws + z_; }
  const bf16_t* hb = (const bf16_t*)(p.ws + WS_BIG); const int ld = 2816;
  bf16_t* ob = (bf16_t*)(p.ws + WS_O);
  LAS bf16_t* KsB[2] = {(LAS bf16_t*)lds, (LAS bf16_t*)(lds + 17920)}; LAS bf16_t* VtB[2] = {(LAS bf16_t*)(lds + 9216), (LAS bf16_t*)(lds + 17920 + 9216)};
  LAS bf16_t* KC = (LAS bf16_t*)(lds + 35840); LAS bf16_t* VCT = (LAS bf16_t*)(lds + 72704);
  LAS float* OUTL = (LAS float*)(lds + 35840);
  LAS float* G4s = (LAS float*)(lds + 105984); LAS float* Lsm = (LAS float*)(lds + 122368); LAS float* BT = (LAS float*)(lds + 138752);
  LAS unsigned* SELM = (LAS unsigned*)(lds + 140864); LAS unsigned* UNI = (LAS unsigned*)(lds + 141376);
  for (int it = blockIdx.x; it < 2048; it += gridDim.x) {
    int tid_ = wv * 64 + lane_id_(); asm volatile("" : "+v"(tid_)); const int tid = tid_, wid = wv, lane = tid & 63, r = lane & 31, h = lane >> 5, tl = r >> 2, hd = r & 3;
    const int c = it & 255, ii = it >> 8, bg = c >> 3, b = bg >> 2, g = bg & 3, j8 = c & 7;
    const int qi = (ii & 1) ? (16 * (ii >> 1) + 15 - j8) : (16 * (ii >> 1) + j8);
    const int t0 = 64 * qi, tw = t0 + 8 * wid, t = tw + tl, head = g * 4 + hd;
    const int nct = (4 * qi + 2) / 64 + 1;
    __syncthreads();
    { KVRegs ka, kb; const bf16_t* kcg = (const bf16_t*)(p.ws + WS_KC) + (size_t)((b * 4 + g) * 256) * 64; const bf16_t* vcg = (const bf16_t*)(p.ws + WS_VC) + (size_t)((b * 4 + g) * 256) * 64;
      kv_load(ka, kcg, vcg, 64, tid); if (nct > 1) kv_load(kb, kcg + 64 * 64, vcg + 64 * 64, 64, tid);
      kv_store(ka, KC, VCT, 260, 0, tid); if (nct > 1) kv_store(kb, KC + 64 * KS_STRIDE, VCT, 260, 64, tid);
      if (nct > 2) { kv_load(ka, kcg + 128 * 64, vcg + 128 * 64, 64, tid); if (nct > 3) kv_load(kb, kcg + 192 * 64, vcg + 192 * 64, 64, tid);
        kv_store(ka, KC + 128 * KS_STRIDE, VCT, 260, 128, tid); if (nct > 3) kv_store(kb, KC + 192 * KS_STRIDE, VCT, 260, 192, tid); } }
    for (int i = tid; i < 4 * 132; i += 512) BT[i] = ((const float*)(p.ws + C_BTAB))[g * 4 * 132 + i] * 1.4426950408889634f;
    if (tid < 128) SELM[tid] = 0u; if (tid < 2) UNI[tid] = 0u;
    bf16x8 qf[4];
#pragma unroll
    for (int ks = 0; ks < 4; ++ks) qf[ks] = *(const bf16x8*)(hb + (size_t)(b * SEQ + t) * ld + head * 64 + ks * 16 + 8 * h);
    const size_t rowoff = (size_t)(b * SEQ + t) * ld;
    const float gc = sigmoidf_(bf2f(hb[rowoff + 2560 + head * 3 + 0])), gs = sigmoidf_(bf2f(hb[rowoff + 2560 + head * 3 + 1])), gw = sigmoidf_(bf2f(hb[rowoff + 2560 + head * 3 + 2]));
    const LAS float* btl = BT + hd * 132;
    KVRegs kvr; { const size_t go = (size_t)(b * SEQ) * ld + g * 64; kv_load(kvr, hb + go + 1536, hb + go + 1792, ld, tid); }
    __syncthreads();
    f32x16 O[2];
    float m = -1e30f, l = 0.f;
#pragma unroll 1
    for (int tile = 0; tile < nct; ++tile) { f32x16 s[2]; attn_scores(KC + tile * 64 * KS_STRIDE, qf, r, h, s); attn_logits(s, t, tw, 8, h, 16 * (tile * 64) + 31, 16, 0x7fffffff, true, btl); attn_online<false>(s, m, l, O); }
    { const float lt = l + __shfl_xor(l, 32); const float inv = (m > -1e29f && lt > 0.f) ? 1.0f / lt : 0.f;
      zero_o(O);
#pragma unroll 1
      for (int tile = 0; tile < nct; ++tile) {
        f32x16 s[2]; attn_scores(KC + tile * 64 * KS_STRIDE, qf, r, h, s); attn_logits(s, t, tw, 8, h, 16 * (tile * 64) + 31, 16, 0x7fffffff, true, btl);
        LAS float* gp = G4s + (8 * wid + tl) * 64 + 16 * tile + h; asm volatile("" : "+v"(gp));
#pragma unroll
        for (int sub = 0; sub < 2; ++sub) {
#pragma unroll
          for (int reg = 0; reg < 16; ++reg) { const float v = s[sub][reg]; s[sub][reg] = v > -1e29f ? __builtin_amdgcn_exp2f(v - m) * inv : 0.f; }
#pragma unroll
          for (int lg = 0; lg < 4; ++lg) { float G = s[sub][4 * lg] + s[sub][4 * lg + 1] + s[sub][4 * lg + 2] + s[sub][4 * lg + 3], Lv = s[sub][4 * lg + 3];
            G += __shfl_xor(G, 1); G += __shfl_xor(G, 2); Lv += __shfl_xor(Lv, 1); Lv += __shfl_xor(Lv, 2);
            if (hd == 0) { gp[8 * sub + 2 * lg] = G; gp[4096 + 8 * sub + 2 * lg] = Lv; } }
        }
        attn_pv(VCT + tile * 64, 260, s, O, r, h);
      }
    }
    __syncthreads();
#pragma unroll
    for (int dt = 0; dt < 2; ++dt)
#pragma unroll
      for (int reg = 0; reg < 16; ++reg) OUTL[(dt * 16 + reg) * 512 + tid] = gc * O[dt][reg];
    if (qi < 16) { const unsigned long long full = (qi == 63) ? ~0ull : ((1ull << (qi + 1)) - 1ull);
      int tsel = tid; asm volatile("" : "+v"(tsel));
      if (tsel < 64) { SELM[2 * tsel] = (unsigned)full; SELM[2 * tsel + 1] = (unsigned)(full >> 32); } if (tsel == 0) { UNI[0] = (unsigned)full; UNI[1] = (unsigned)(full >> 32); } }
    else {
      int tsel = tid; asm volatile("" : "+v"(tsel));
      const int tok = tsel >> 3, jj = tsel & 7, hiJ = qi - 2;
#pragma unroll
      for (int e = 0; e < 8; ++e) { const int j = jj * 8 + e; if (j >= 1 && j <= hiJ) G4s[tok * 64 + j] += Lsm[tok * 64 + j - 1]; }
      __syncthreads();
      float mine[8]; int cnt[8];
#pragma unroll
      for (int e = 0; e < 8; ++e) { const int j = jj * 8 + e; mine[e] = (j >= 1 && j <= hiJ) ? G4s[tok * 64 + j] : 0.f; cnt[e] = 0; }
      for (int j2 = 1; j2 <= hiJ; ++j2) { const float v = G4s[tok * 64 + j2];
#pragma unroll
        for (int e = 0; e < 8; ++e) { const int j = jj * 8 + e; cnt[e] += (v > mine[e] || (v == mine[e] && j2 < j)) ? 1 : 0; } }
      unsigned long long bits = 0ull;
#pragma unroll
      for (int e = 0; e < 8; ++e) { const int j = jj * 8 + e; if (j >= 1 && j <= hiJ && cnt[e] < 13) bits |= 1ull << j; }
      if (jj == 0) bits |= 1ull | (1ull << qi) | (1ull << (qi - 1));
      const unsigned blo = (unsigned)bits, bhi = (unsigned)(bits >> 32);
      if (blo) { atomicOr((unsigned*)&SELM[2 * tok], blo); atomicOr((unsigned*)&UNI[0], blo); }
      if (bhi) { atomicOr((unsigned*)&SELM[2 * tok + 1], bhi); atomicOr((unsigned*)&UNI[1], bhi); }
    }
    __syncthreads();
    int buf = 0;
    { const unsigned long long selm = (unsigned long long)SELM[2 * (8 * wid + tl)] | ((unsigned long long)SELM[2 * (8 * wid + tl) + 1] << 32);
      unsigned long long rem = (unsigned long long)UNI[0] | ((unsigned long long)UNI[1] << 32);
      m = -1e30f; l = 0.f; zero_o(O);
      const int jw0 = qi > 8 ? qi - 8 : 0;
#pragma unroll 1
      while (rem) {
        const int j = __builtin_ctzll(rem); rem &= rem - 1ull;
        kv_store(kvr, KsB[buf], VtB[buf], 68, 0, tid);
        __syncthreads();
        { const bool more = rem != 0ull; const int jn = more ? __builtin_ctzll(rem) : jw0;
          const size_t go = (size_t)(b * SEQ + jn * 64) * ld + g * 64; kv_load(kvr, hb + go + (more ? 1536 : 2048), hb + go + (more ? 1792 : 2304), ld, tid); }
        attn_tile(KsB[buf], VtB[buf], 68, qf, O, m, l, t, tw, 8, r, h, j * 64, 1, 0x7fffffff, ((selm >> j) & 1ull) != 0ull, btl);
        buf ^= 1;
      }
      const float lt = l + __shfl_xor(l, 32); const float sc = lt > 0.f ? gs / lt : 0.f;
#pragma unroll
      for (int dt = 0; dt < 2; ++dt)
#pragma unroll
        for (int reg = 0; reg < 16; ++reg) OUTL[(dt * 16 + reg) * 512 + tid] += sc * O[dt][reg];
    }
    { m = -1e30f; l = 0.f; zero_o(O);
#pragma unroll 1
      for (int j = (qi > 8 ? qi - 8 : 0); j <= qi; ++j) {
        kv_store(kvr, KsB[buf], VtB[buf], 68, 0, tid);
        __syncthreads();
        if (j < qi) { const size_t go = (size_t)(b * SEQ + (j + 1) * 64) * ld + g * 64; kv_load(kvr, hb + go + 2048, hb + go + 2304, ld, tid); }
        attn_tile(KsB[buf], VtB[buf], 68, qf, O, m, l, t, tw, 8, r, h, j * 64, 1, 512, true, btl);
        buf ^= 1;
      }
      const float lt = l + __shfl_xor(l, 32); const float sc = lt > 0.f ? gw / lt : 0.f;
#pragma unroll
      for (int dt = 0; dt < 2; ++dt)
#pragma unroll
        for (int reg = 0; reg < 16; ++reg) O[dt][reg] = OUTL[(dt * 16 + reg) * 512 + tid] + sc * O[dt][reg];
    }
    bf16_t* op = ob + (size_t)(b * SEQ + t) * DM + head * 64;
#pragma unroll
    for (int dt = 0; dt < 2; ++dt)
#pragma unroll
      for (int i4 = 0; i4 < 4; ++i4) { u32x2 w; w.x = pkh2(O[dt][4 * i4], O[dt][4 * i4 + 1]); w.y = pkh2(O[dt][4 * i4 + 2], O[dt][4 * i4 + 3]); *(u32x2*)(op + dt * 32 + 8 * i4 + 4 * h) = w; }
  }
}

DI void swa_attn_phase(int wv, const P& p_, int slot, LAS unsigned char* lds) {
  P p = p_; { size_t z_ = 0; asm volatile("" : "+s"(z_)); p.ws = p_.ws + z_; }
  const bf16_t* hb = (const bf16_t*)(p.ws + WS_BIG); const int ld = 1280;
  bf16_t* ob = (bf16_t*)(p.ws + WS_O);
  LAS bf16_t* KsB[2] = {(LAS bf16_t*)lds, (LAS bf16_t*)(lds + 17920)}; LAS bf16_t* VtB[2] = {(LAS bf16_t*)(lds + 9216), (LAS bf16_t*)(lds + 17920 + 9216)};
  LAS float* BT = (LAS float*)(lds + 35840);
  int tid_ = wv * 64 + lane_id_(); asm volatile("" : "+v"(tid_)); const int tid = tid_, wid = tid >> 6, lane = tid & 63, r = lane & 31, h = lane >> 5, tl = r >> 3, hd = r & 7;
  int buf = 0;
  for (int it = blockIdx.x; it < 2048; it += gridDim.x) {
    const int b = it >> 8, kv = (it >> 7) & 1, t0 = (it & 127) * 32;
    const int tw = t0 + 4 * wid, t = tw + tl, head = kv * 8 + hd;
    const int lo = t0 - 127, first = lo <= 0 ? 0 : (lo >> 6), last = (t0 + 31) >> 6;
    KVRegs kvr; { const size_t go = (size_t)(b * SEQ + first * 64) * ld + kv * 64; kv_load(kvr, hb + go + 1024, hb + go + 1152, ld, tid); }
    __syncthreads();
    for (int i = tid; i < 8 * 132; i += 512) BT[i] = ((const float*)(p.ws + C_BTAB))[kv * 8 * 132 + i] * 1.4426950408889634f;
    const size_t rowoff = (size_t)(b * SEQ + t) * ld;
    bf16x8 qf[4];
#pragma unroll
    for (int ks = 0; ks < 4; ++ks) qf[ks] = *(const bf16x8*)(hb + rowoff + head * 64 + ks * 16 + 8 * h);
    const LAS float* btl = BT + hd * 132;
    float m = p.swa_sinks[slot * 16 + head] * 1.4426950408889634f, l = (h == 0) ? 1.0f : 0.0f;
    f32x16 O[2]; zero_o(O);
#pragma unroll 1
    for (int j = first; j <= last; ++j) {
      kv_store(kvr, KsB[buf], VtB[buf], 68, 0, tid);
      __syncthreads();
      if (j < last) { const size_t go = (size_t)(b * SEQ + (j + 1) * 64) * ld + kv * 64; kv_load(kvr, hb + go + 1024, hb + go + 1152, ld, tid); }
      attn_tile(KsB[buf], VtB[buf], 68, qf, O, m, l, t, tw, 4, r, h, j * 64, 1, 128, true, btl);
      buf ^= 1;
    }
    const float lt = l + __shfl_xor(l, 32); const float sc = 1.0f / lt;
    bf16_t* op = ob + (size_t)(b * SEQ + t) * DM + head * 64;
#pragma unroll
    for (int dt = 0; dt < 2; ++dt)
#pragma unroll
      for (int i4 = 0; i4 < 4; ++i4) { u32x2 w; w.x = pkh2(sc * O[dt][4 * i4], sc * O[dt][4 * i4 + 1]); w.y = pkh2(sc * O[dt][4 * i4 + 2], sc * O[dt][4 * i4 + 3]); *(u32x2*)(op + dt * 32 + 8 * i4 + 4 * h) = w; }
  }
}
constexpr size_t HG_Q = WS_BIG, HG_K = WS_BIG + 64 * MiB, HG_V = WS_BIG + 128 * MiB, HG_G = WS_BIG + 192 * MiB, HG_LF = WS_BIG + 256 * MiB;
DI void hgrn_scan_phase(int wv, const P& p_, LAS unsigned char* lds, float* sumsq) {
  P p = p_; { size_t z_ = 0; asm volatile("" : "+s"(z_)); p.ws = p_.ws + z_; }
  const bf16_t* hq = (const bf16_t*)(p.ws + HG_Q); const bf16_t* hk = (const bf16_t*)(p.ws + HG_K); const bf16_t* hv = (const bf16_t*)(p.ws + HG_V);
  const _Float16* hlf = (const _Float16*)(p.ws + HG_LF);
  bf16_t* oraw = (bf16_t*)p.out;
  LAS bf16_t* Q = (LAS bf16_t*)lds; LAS bf16_t* Kr = (LAS bf16_t*)(lds + 17408); LAS float* BC = (LAS float*)(lds + 34816); LAS bf16_t* KDT = (LAS bf16_t*)(lds + 68608);
  LAS bf16_t* VT = (LAS bf16_t*)(lds + 87040); LAS bf16_t* ST = (LAS bf16_t*)(lds + 91648); LAS bf16_t* AB = (LAS bf16_t*)(lds + 100352);
  LAS float* SEG = (LAS float*)(lds + 109568); LAS float* DEC = (LAS float*)(lds + 111616); LAS _Float16* LF = (LAS _Float16*)(lds + 112128);
  int tid_ = wv * 64 + lane_id_(); asm volatile("" : "+v"(tid_)); const int tid = tid_, wid = tid >> 6, lane = tid & 63, fr = lane & 15, fq = lane >> 4;
  for (int it = blockIdx.x; it < 256; it += gridDim.x) {
    const int b = it >> 5, hh = (it >> 2) & 7, vq = it & 3;
    __syncthreads();
    for (int i = tid; i < 32 * 136 / 2; i += 512) ((LAS unsigned*)ST)[i] = 0u;
    f32x4 sreg[2]; sreg[0] = (f32x4){0.f, 0.f, 0.f, 0.f}; sreg[1] = sreg[0];
    u32x4 pq[2], pkk[2], plf[2], pv;
    const size_t gb = (size_t)(b * SEQ) * 1024 + hh * 128;
    auto prefetch = [&](int c) {
#pragma unroll
      for (int i = 0; i < 2; ++i) { const int idx = tid + 512 * i, row = idx >> 4, c8 = (idx & 15) * 8; const size_t off = gb + (size_t)(c * 64 + row) * 1024 + c8;
        pq[i] = *(const u32x4*)(hq + off); pkk[i] = *(const u32x4*)(hk + off); plf[i] = *(const u32x4*)(hlf + off); }
      if (tid < 256) { const int row = tid >> 2, c8 = (tid & 3) * 8; pv = *(const u32x4*)(hv + gb + (size_t)(c * 64 + row) * 1024 + vq * 32 + c8); }
    };
    prefetch(0);
    for (int c = 0; c < 64; ++c) {
      lds_barrier();
#pragma unroll
      for (int i = 0; i < 2; ++i) { const int idx = tid + 512 * i, row = idx >> 4, c8 = (idx & 15) * 8;
        *(LAS u32x4*)(Q + row * 136 + c8) = pq[i]; *(LAS u32x4*)(Kr + row * 136 + c8) = pkk[i]; *(LAS u32x4*)(LF + row * 128 + c8) = plf[i]; }
      if (tid < 256) { const int row = tid >> 2, c8 = (tid & 3) * 8; const bf16x8 vv = __builtin_bit_cast(bf16x8, pv);
#pragma unroll
        for (int i = 0; i < 8; ++i) VT[(c8 + i) * 72 + row] = (bf16_t)vv[i]; }
      if (c + 1 < 64) prefetch(c + 1);
      lds_barrier();
      const int kx = tid & 127, seg = tid >> 7;
      float bl[16];
      { float run = 0.f;
#pragma unroll
        for (int i = 0; i < 16; ++i) { run += (float)LF[(16 * seg + i) * 128 + kx]; bl[i] = run; }
        SEG[seg * 128 + kx] = run; }
      lds_barrier();
      { float pre = 0.f, blast = 0.f;
#pragma unroll
        for (int s2 = 0; s2 < 4; ++s2) { const float v = SEG[s2 * 128 + kx]; blast += v; if (s2 < seg) pre += v; }
        u32x4 w0, w1; float kd[16];
#pragma unroll
        for (int i = 0; i < 16; ++i) { const float bc = pre + bl[i]; BC[(16 * seg + i) * 132 + kx] = bc; kd[i] = bf2f(Kr[(16 * seg + i) * 136 + kx]) * __builtin_amdgcn_exp2f(blast - bc); }
#pragma unroll
        for (int j = 0; j < 4; ++j) { w0[j] = pk2(kd[2 * j], kd[2 * j + 1]); w1[j] = pk2(kd[8 + 2 * j], kd[8 + 2 * j + 1]); }
        *(LAS u32x4*)(KDT + kx * 72 + 16 * seg) = w0; *(LAS u32x4*)(KDT + kx * 72 + 16 * seg + 8) = w1;
        if (seg == 0) DEC[kx] = __builtin_amdgcn_exp2f(blast); }
      lds_barrier();
      const int mt = wid >> 1, vt = wid & 1;
      f32x4 oacc = (f32x4){0.f, 0.f, 0.f, 0.f}, a0 = oacc, a1 = oacc;
      const int J0 = 2 * vt;
#pragma unroll
      for (int ks = 0; ks < 4; ++ks) {
        const int kb = 32 * ks + 8 * fq, trow = 16 * mt + fr;
        const bf16x8 qv = *(const LAS bf16x8*)(Q + trow * 136 + kb);
        const f32x4 bc0 = *(const LAS f32x4*)(BC + trow * 132 + kb), bc1 = *(const LAS f32x4*)(BC + trow * 132 + kb + 4);
        const f32x4 r0 = *(const LAS f32x4*)(BC + (16 * mt) * 132 + kb), r1 = *(const LAS f32x4*)(BC + (16 * mt) * 132 + kb + 4);
        u32x4 ai, aq;
#pragma unroll
        for (int j = 0; j < 4; ++j) {
          const float q0 = bf2f((bf16_t)qv[2 * j]), q1 = bf2f((bf16_t)qv[2 * j + 1]);
          const float b0 = j < 2 ? bc0[2 * j] : bc1[2 * j - 4], b1 = j < 2 ? bc0[2 * j + 1] : bc1[2 * j - 3];
          const float rr0 = j < 2 ? r0[2 * j] : r1[2 * j - 4], rr1 = j < 2 ? r0[2 * j + 1] : r1[2 * j - 3];
          ai[j] = pk2(q0 * __builtin_amdgcn_exp2f(b0), q1 * __builtin_amdgcn_exp2f(b1)); aq[j] = pk2(q0 * __builtin_amdgcn_exp2f(b0 - rr0), q1 * __builtin_amdgcn_exp2f(b1 - rr1));
        }
        const bf16x8 sb = *(const LAS bf16x8*)(ST + (16 * vt + fr) * 136 + kb);
        oacc = MFMA16(__builtin_bit_cast(bf16x8, ai), sb, oacc);
#pragma unroll
        for (int jj = 0; jj < 2; ++jj) {
          const int J = J0 + jj; if (J > mt) continue;
          const int srow = 16 * J + fr;
          const bf16x8 kv = *(const LAS bf16x8*)(Kr + srow * 136 + kb);
          const f32x4 c0 = *(const LAS f32x4*)(BC + srow * 132 + kb), c1 = *(const LAS f32x4*)(BC + srow * 132 + kb + 4);
          u32x4 bk;
#pragma unroll
          for (int j = 0; j < 4; ++j) {
            const float k0 = bf2f((bf16_t)kv[2 * j]), k1 = bf2f((bf16_t)kv[2 * j + 1]);
            const float b0 = j < 2 ? c0[2 * j] : c1[2 * j - 4], b1 = j < 2 ? c0[2 * j + 1] : c1[2 * j - 3];
            const float rr0 = j < 2 ? r0[2 * j] : r1[2 * j - 4], rr1 = j < 2 ? r0[2 * j + 1] : r1[2 * j - 3];
            bk[j] = pk2(k0 * __builtin_amdgcn_exp2f(fminf(rr0 - b0, 115.f)), k1 * __builtin_amdgcn_exp2f(fminf(rr1 - b1, 115.f)));
          }
          if (jj == 0) a0 = MFMA16(__builtin_bit_cast(bf16x8, aq), __builtin_bit_cast(bf16x8, bk), a0);
          else a1 = MFMA16(__builtin_bit_cast(bf16x8, aq), __builtin_bit_cast(bf16x8, bk), a1);
        }
      }
#pragma unroll
      for (int jj = 0; jj < 2; ++jj) { const int J = J0 + jj;
#pragma unroll
        for (int reg = 0; reg < 4; ++reg) { const int tt = 16 * mt + 4 * fq + reg, ss = 16 * J + fr; const float v = jj == 0 ? a0[reg] : a1[reg];
          AB[tt * 72 + ss] = (J <= mt && ss <= tt) ? f2bf(v) : (bf16_t)0; } }
      lds_barrier();
#pragma unroll
      for (int k2 = 0; k2 < 2; ++k2) {
        const bf16x8 af = *(const LAS bf16x8*)(AB + (16 * mt + fr) * 72 + 32 * k2 + 8 * fq);
        const bf16x8 vb = *(const LAS bf16x8*)(VT + (16 * vt + fr) * 72 + 32 * k2 + 8 * fq);
        oacc = MFMA16(af, vb, oacc);
      }
#pragma unroll
      for (int reg = 0; reg < 4; ++reg) {
        const int tok = b * SEQ + c * 64 + 16 * mt + 4 * fq + reg; const float v = oacc[reg];
        oraw[(size_t)tok * 1024 + hh * 128 + vq * 32 + 16 * vt + fr] = f2bf(v);
        float sq = v * v; sq += __shfl_xor(sq, 1); sq += __shfl_xor(sq, 2); sq += __shfl_xor(sq, 4); sq += __shfl_xor(sq, 8);
        if (fr == 0) atomicAdd(sumsq + (size_t)tok * 8 + hh, sq);
      }
      { const f32x4 dc = *(const LAS f32x4*)(DEC + 16 * wid + 4 * fq);
        sreg[0] *= dc; sreg[1] *= dc;
#pragma unroll
        for (int k2 = 0; k2 < 2; ++k2) {
          const bf16x8 af = *(const LAS bf16x8*)(KDT + (16 * wid + fr) * 72 + 32 * k2 + 8 * fq);
#pragma unroll
          for (int v2 = 0; v2 < 2; ++v2) { const bf16x8 vb = *(const LAS bf16x8*)(VT + (16 * v2 + fr) * 72 + 32 * k2 + 8 * fq); sreg[v2] = MFMA16(af, vb, sreg[v2]); }
        }
#pragma unroll
        for (int v2 = 0; v2 < 2; ++v2) { u32x2 w; w.x = pk2(sreg[v2][0], sreg[v2][1]); w.y = pk2(sreg[v2][2], sreg[v2][3]); *(LAS u32x2*)(ST + (16 * v2 + fr) * 136 + 16 * wid + 4 * fq) = w; }
      }
    }
  }
}
DI void hgrn_norm_phase(int wv, const P& p_, int slot) {
  P p = p_; { size_t z_ = 0; asm volatile("" : "+s"(z_)); p.ws = p_.ws + z_; }
  const bf16_t* oraw = (const bf16_t*)p.out; const bf16_t* hg = (const bf16_t*)(p.ws + HG_G); const float* sumsq = (const float*)(p.ws + WS_SUMSQ);
  bf16_t* ob = (bf16_t*)(p.ws + WS_O); const float* gain = p.hg_gain + slot * 128;
  int tid_ = wv * 64 + lane_id_(); asm volatile("" : "+v"(tid_)); const size_t gtid = (size_t)blockIdx.x * 512 + tid_, gsz = (size_t)gridDim.x * 512;
  for (size_t i = gtid; i < (size_t)MTOK * 1024 / 8; i += gsz) {
    const size_t e = i * 8; const int row = (int)(e >> 10), col = (int)(e & 1023), hh = col >> 7, vv = col & 127;
    const float rs = rsqrtf(sumsq[(size_t)row * 8 + hh] * (1.0f / 128.0f) + 1e-6f);
    const bf16x8 o8 = *(const bf16x8*)(oraw + e), g8 = *(const bf16x8*)(hg + e);
    u32x4 w;
#pragma unroll
    for (int j = 0; j < 4; ++j) w[j] = pkh2(bf2f((bf16_t)o8[2 * j]) * rs * gain[vv + 2 * j] * bf2f((bf16_t)g8[2 * j]), bf2f((bf16_t)o8[2 * j + 1]) * rs * gain[vv + 2 * j + 1] * bf2f((bf16_t)g8[2 * j + 1]));
    *(u32x4*)(ob + e) = w;
  }
}
#define REP_NSA 1
#define REP_CONV 1
#define REP_CMP 1
#define REP_MISC 1
#define REP_DOWN 1
#define REP_HG 1
#define REP_EPI 1
#ifndef SKIP_MIXERS
#define SKIP_MIXERS 0
#endif
__global__ void __launch_bounds__(512, 2) mega_fwd(P p) {
  extern __shared__ __attribute__((aligned(16))) unsigned char lds_raw[];
  LAS unsigned char* lds = (LAS unsigned char*)lds_raw;
  cg::grid_group grid = cg::this_grid();
  const int wv = __builtin_amdgcn_readfirstlane((int)(threadIdx.x >> 6));
  volatile LAS unsigned* xst = (volatile LAS unsigned*)(lds + LDS_BYTES - 16);
  if (wv == 0 && lane_id_() < 4) xst[lane_id_()] = 0u;
  __syncthreads();
  const XcdBarrier xb = xcd_barrier_post(wv, (unsigned*)(p.ws + WS_BAR), xst);
#define GSYNC() xcd_barrier(wv, xb)
  unsigned char* ws = p.ws;
  init_phase(wv, p);
  for (int L = 0; L < 4; ++L) {
    { size_t z_ = 0; asm volatile("" : "+s"(z_)); ws = p.ws + z_; }
    for (int rep = 0; rep < p.rep_conv; ++rep) convert_phase(wv, p, L, lds);
    if (L == 0) grid.sync(); else GSYNC();
    const int kind = L % 3, slot = L / 3;
    for (int s = 0; s < 3; ++s) {
      { size_t z_ = 0; asm volatile("" : "+s"(z_)); ws = p.ws + z_; }
      float* stats = (float*)(ws + WS_STATS); bf16_t* tb = (bf16_t*)(ws + WS_TB); bf16_t* Hb = (bf16_t*)(ws + WS_BIG); bf16_t* ob = (bf16_t*)(ws + WS_O);
      const int lnp = L * 3 + s - 1;
      const float* stp = (const float*)(ws + WS_DSTATS) + (size_t)(lnp + 1) * MTOK * 2;
      pg8::Gemm gr; float scale;
      if (s != 1) {
        pg8::Gemm g; g.A = tb; g.Bt = (const bf16_t*)(ws + (s == 0 ? W_GU1 : W_GU2)); g.M = MTOK; g.N = 5632; g.K = DM;
        pg8::StaticOrder S; S.init(g.M, g.N, gridDim.x, blockIdx.x);
        EpiUp E; E.reps = p.rep_epi; E.H = Hb; E.stats = stp; E.c1 = (const float*)(ws + (s == 0 ? C_GU1 : C_GU2)); E.c2 = E.c1 + 5632;
        pg8::gemm_phase(wv, lds, g, S, E);
        GSYNC();
        gr.A = Hb; gr.Bt = (const bf16_t*)(ws + (s == 0 ? W_D1 : W_D2)); gr.M = MTOK; gr.N = DM; gr.K = DFF; scale = 0.5f;
      } else {
        pg8::Gemm g; g.A = tb; g.Bt = (const bf16_t*)(ws + W_IN); g.M = MTOK; g.N = kind == 0 ? 2816 : (kind == 1 ? 4096 : 1280); g.K = DM;
        pg8::StaticOrder S; S.init(g.M, g.N, gridDim.x, blockIdx.x);
        EpiIn E; E.reps = 1; E.mode = kind == 1 ? 1 : 0; E.h = Hb; E.ld = g.N; E.stats = stp; E.c1 = (const float*)(ws + C_IN); E.c2 = E.c1 + 4096; E.lbv = (const float*)(ws + C_LBV);
        E.hq = (bf16_t*)(ws + HG_Q); E.hk = (bf16_t*)(ws + HG_K); E.hv = (bf16_t*)(ws + HG_V); E.hg = (bf16_t*)(ws + HG_G); E.hlf = (_Float16*)(ws + HG_LF);
        pg8::gemm_phase(wv, lds, g, S, E);
        GSYNC();
#if !SKIP_MIXERS
        if (kind == 0) {
          for (int rep = 0; rep < p.rep_cmp; ++rep) nsa_compress_phase(wv, p, lds);
          GSYNC();
          for (int rep = 0; rep < p.rep_nsa; ++rep) { if (rep) GSYNC(); nsa_attn_phase(wv, p, lds); }
        }
        else if (kind == 1) {
          for (int rep = p.rep_hg - 1; rep >= 0; --rep) hgrn_scan_phase(wv, p, lds, (float*)(ws + (rep ? WS_KC : WS_SUMSQ)));
          GSYNC(); hgrn_norm_phase(wv, p, slot); }
        else {
          for (int rep = 0; rep < p.rep_misc; ++rep) swa_attn_phase(wv, p, slot, lds);
        }
#endif
        GSYNC();
        gr.A = ob; gr.Bt = (const bf16_t*)(ws + W_OUT); gr.M = MTOK; gr.N = DM; gr.K = DM; scale = 1.0f;
      }
      pg8::StaticOrder S2; S2.init(gr.M, gr.N, gridDim.x, blockIdx.x);
      EpiRes R; R.reps = 1; R.stats_prev = stp; R.g = (const float*)(ws + WS_G13) + (size_t)(lnp + 1) * DM; R.b = (const float*)(ws + WS_B13) + (size_t)(lnp + 1) * DM;
      R.stats_new = stats + (size_t)(lnp + 1) * MTOK * 2; R.tb = tb; R.scale = scale;
      for (int rep = (s != 1 ? p.rep_down : 1) - 1; rep >= 0; --rep) {
        R.tb = tb; R.stats_new = stats + (size_t)(lnp + 1) * MTOK * 2;
        pg8::gemm_phase(wv, lds, gr, S2, R);
        GSYNC();
      }
    }
  }
  final_ln(wv, p, (float*)(ws + WS_STATS) + (size_t)11 * MTOK * 2, p.ln_gain + 11 * DM, p.ln_bias + 11 * DM);
}

extern "C" void kernel_launch(void* const* d_in, const int* in_sizes, int n_in, void* d_out, int out_size, void* d_ws, size_t ws_size, hipStream_t stream) {
  static int grid = 0;
  if (grid == 0) {
    if (n_in != 22 || ws_size < WS_END) { fprintf(stderr, "kernel_launch: unexpected n_in %d / ws_size %zu (need %zu)\n", n_in, ws_size, (size_t)WS_END); grid = -1; return; }
    int dev = 0, cus = 0, per_cu = 0;
    hipGetDevice(&dev); hipDeviceGetAttribute(&cus, hipDeviceAttributeMultiprocessorCount, dev);
    if (hipFuncSetAttribute((const void*)mega_fwd, hipFuncAttributeMaxDynamicSharedMemorySize, LDS_BYTES) != hipSuccess) { fprintf(stderr, "hipFuncSetAttribute failed\n"); grid = -1; return; }
    hipOccupancyMaxActiveBlocksPerMultiprocessor(&per_cu, (const void*)mega_fwd, 512, LDS_BYTES);
    if (per_cu < 1) { fprintf(stderr, "occupancy query says %d blocks/CU\n", per_cu); per_cu = 1; }
    (void)hipGetLastError();
    grid = cus * 1;
  }
  if (grid < 0) return;
  if (hipMemsetAsync((char*)d_ws + WS_BAR, 0, 16384, stream) != hipSuccess) { fprintf(stderr, "memset failed\n"); return; }
  P p{};
  const float** pp = (const float**)&p;
  for (int i = 0; i < 22; ++i) pp[i] = (const float*)d_in[i];
  p.out = (float*)d_out; p.ws = (unsigned char*)d_ws;
  p.rep_nsa = REP_NSA; p.rep_conv = REP_CONV; p.rep_cmp = REP_CMP; p.rep_misc = REP_MISC; p.rep_down = REP_DOWN; p.rep_hg = REP_HG; p.rep_epi = REP_EPI; p.rep_pad = 0;
  void* args[] = {&p};
  hipError_t e = hipLaunchCooperativeKernel((const void*)mega_fwd, dim3(grid), dim3(512), args, LDS_BYTES, stream);
  if (e != hipSuccess) fprintf(stderr, "cooperative launch failed: %s (grid %d)\n", hipGetErrorString(e), grid);
}
```
